# Optimizing an MI355X kernel written in HIP

```python
import math
import jax, jax.numpy as jnp
from jax import lax
import numpy as np

D_MODEL = 1024
BATCH = 16
SEQ = 256
DEPTH = 2
DEC_BATCH = 8
DEC_SEQ = 1024
PAST_LEN = 512

GRID_W = 64
N_EVEN = (DEPTH + 1) // 2
N_ODD = DEPTH // 2
EPS = 1e-6
FOURIER_GROUPS = 4
FOURIER_GROUP_W = D_MODEL // 16
FOURIER_W = FOURIER_GROUPS * FOURIER_GROUP_W
HEAD_DIM = 64
N_Q_HEADS = (D_MODEL - FOURIER_W) // HEAD_DIM
N_KV_HEADS = N_Q_HEADS // 3
GQA_GROUP = N_Q_HEADS // N_KV_HEADS
Q_W = N_Q_HEADS * HEAD_DIM
KV_W = N_KV_HEADS * HEAD_DIM
EVEN_IN = FOURIER_W + Q_W + 2 * KV_W
EVEN_MIX = FOURIER_W + Q_W
Q_BLOCK = 128
ROPE_THETA = 10000.0
AX_PAIRS = HEAD_DIM // 4
CONV_W = 4
LRU_W = D_MODEL // 2
LRU_BLOCKS = 8
LRU_BLOCK_W = LRU_W // LRU_BLOCKS
LRU_C = 8.0
SSD_INNER = D_MODEL
SSD_HEAD_P = 64
SSD_HEADS = SSD_INNER // SSD_HEAD_P
SSD_GROUPS = 2
SSD_STATE = 64
SSD_CHUNK = 128
SSD_CONV_CH = SSD_INNER + 2 * SSD_GROUPS * SSD_STATE
ODD_IN = 2 * LRU_W + SSD_INNER + SSD_CONV_CH + 2 * SSD_HEADS
ODD_MIX = LRU_W + SSD_INNER
D_FF = -(-(8 * D_MODEL) // (3 * 256)) * 256

kernel_name = "hybrid_dit_fourier_gqa_rglru_ssd_step"


def rmsnorm(x, g):
    xf = x.astype(jnp.float32)
    y = xf * lax.rsqrt(jnp.mean(xf * xf, axis=-1, keepdims=True) + EPS)
    return (y * g.astype(jnp.float32)).astype(x.dtype)


def modulation(cond, w, b):
    m = jax.nn.silu(cond) @ w + b
    return [t[:, None, :] for t in jnp.split(m, 6, axis=-1)]


def centred_dwconv(x, w, b):
    y = lax.conv_general_dilated(
        x, w.astype(x.dtype)[:, None, :], window_strides=(1,),
        padding=[((CONV_W - 1) // 2, CONV_W // 2)],
        dimension_numbers=("NWC", "WIO", "NWC"), feature_group_count=x.shape[-1])
    return y + b.astype(x.dtype)


def swiglu(h, w1, w3, w2):
    return (jax.nn.silu(h @ w1) * (h @ w3)) @ w2


def fourier_mix(f):
    B, S, _ = f.shape
    fg = f.astype(jnp.float32).reshape(B, S, FOURIER_GROUPS, FOURIER_GROUP_W)
    out = jnp.fft.fft2(fg, axes=(1, 3), norm="ortho").real
    return out.reshape(B, S, FOURIER_W).astype(f.dtype)


def axial_rope_tables(S):
    rows = S // GRID_W
    row = jnp.repeat(jnp.arange(rows, dtype=jnp.float32), GRID_W)
    col = jnp.tile(jnp.arange(GRID_W, dtype=jnp.float32), rows)
    freqs = ROPE_THETA ** (-jnp.arange(AX_PAIRS, dtype=jnp.float32) / AX_PAIRS)
    ang = jnp.stack([row[:, None] * freqs, col[:, None] * freqs], axis=1)
    return jnp.cos(ang), jnp.sin(ang)


def apply_axial_rope(x, cos, sin):
    B, S, H, _ = x.shape
    xa = x.astype(jnp.float32).reshape(B, S, H, 2, 2, AX_PAIRS)
    x1, x2 = xa[..., 0, :], xa[..., 1, :]
    c = cos[None, :, None]
    s = sin[None, :, None]
    out = jnp.stack([x1 * c - x2 * s, x2 * c + x1 * s], axis=-2)
    return out.reshape(x.shape).astype(x.dtype)


def block_attention(q, k, v):
    B, S, _, _ = q.shape
    nb = S // Q_BLOCK
    qb = q.reshape(B, nb, Q_BLOCK, N_KV_HEADS, GQA_GROUP, HEAD_DIM).transpose(1, 0, 2, 3, 4, 5)
    kf = k.astype(jnp.float32)
    vf = v.astype(jnp.float32)
    scale = HEAD_DIM ** -0.5

    def one_block(qblk):
        s = jnp.einsum("bqhgd,bkhd->bhgqk", qblk.astype(jnp.float32), kf) * scale
        p = jax.nn.softmax(s, axis=-1)
        return jnp.einsum("bhgqk,bkhd->bqhgd", p, vf)

    o = lax.map(one_block, qb)
    return o.transpose(1, 0, 2, 3, 4, 5).reshape(B, S, Q_W).astype(q.dtype)


def even_mixer(h, w_in, q_norm, k_norm, w_out, ctx_kv):
    B, S, _ = h.shape
    p = h @ w_in
    f, q, k, v = jnp.split(p, [FOURIER_W, FOURIER_W + Q_W, FOURIER_W + Q_W + KV_W], axis=-1)
    fo = fourier_mix(f)
    q = rmsnorm(q.reshape(B, S, N_Q_HEADS, HEAD_DIM), q_norm)
    k = rmsnorm(k.reshape(B, S, N_KV_HEADS, HEAD_DIM), k_norm)
    v = v.reshape(B, S, N_KV_HEADS, HEAD_DIM)
    if ctx_kv is None:
        ao = block_attention(q, k, v)
        kv_out = (k, v)
    else:
        cos, sin = axial_rope_tables(S)
        q = apply_axial_rope(q, cos, sin)
        kl = apply_axial_rope(k, cos, sin)
        ck, cv = ctx_kv
        keys = jnp.concatenate([kl, ck.astype(kl.dtype)], axis=1)
        vals = jnp.concatenate([v, cv.astype(v.dtype)], axis=1)
        ao = block_attention(q, keys, vals)
        kv_out = None
    return jnp.concatenate([fo, ao], axis=-1) @ w_out, kv_out


def linear_scan(a, b, h0, reverse):
    if reverse:
        a = jnp.flip(a, axis=1)
        b = jnp.flip(b, axis=1)
    b = b.at[:, 0].add(a[:, 0] * h0)

    def combine(l, r):
        return (l[0] * r[0], r[0] * l[1] + r[1])

    _, h = lax.associative_scan(combine, (a, b), axis=1)
    final = h[:, -1]
    if reverse:
        h = jnp.flip(h, axis=1)
    return h, final


def rglru_direction(xc, wa, ba, wx, bx, lam, h0, reverse):
    B, S, _ = xc.shape
    xf = xc.astype(jnp.float32)
    xb = xf.reshape(B, S, LRU_BLOCKS, LRU_BLOCK_W)
    r = jax.nn.sigmoid(jnp.einsum("bshi,hij->bshj", xb, wa.astype(jnp.float32)).reshape(B, S, LRU_W)
                       + ba.astype(jnp.float32))
    i = jax.nn.sigmoid(jnp.einsum("bshi,hij->bshj", xb, wx.astype(jnp.float32)).reshape(B, S, LRU_W)
                       + bx.astype(jnp.float32))
    log_a = -LRU_C * r * jax.nn.softplus(-lam.astype(jnp.float32))
    a = jnp.exp(log_a)
    b = jnp.sqrt(-jnp.expm1(2.0 * log_a)) * (i * xf)
    return linear_scan(a, b, h0.astype(jnp.float32), reverse)


def ssd_direction(x, dt, A, Bm, Cm, h0, reverse):
    if reverse:
        x, dt, Bm, Cm = (jnp.flip(t, axis=1) for t in (x, dt, Bm, Cm))
    Bsz, L = x.shape[:2]
    nc = L // SSD_CHUNK
    Q = SSD_CHUNK
    G = SSD_GROUPS
    Hg = SSD_HEADS // G
    xc = x.reshape(Bsz, nc, Q, G, Hg, SSD_HEAD_P)
    dtc = dt.reshape(Bsz, nc, Q, G, Hg)
    Bc = Bm.reshape(Bsz, nc, Q, G, SSD_STATE)
    Cc = Cm.reshape(Bsz, nc, Q, G, SSD_STATE)
    acs = jnp.cumsum(dtc * A.reshape(G, Hg), axis=2)
    diff = acs[:, :, :, None] - acs[:, :, None, :]
    causal = jnp.tril(jnp.ones((Q, Q), dtype=bool))[:, :, None, None]
    decay = jnp.exp(jnp.where(causal, diff, -jnp.inf))
    cb = jnp.einsum("bcqgn,bckgn->bcqkg", Cc, Bc)
    y_diag = jnp.einsum("bcqkg,bcqkgh,bckgh,bckghp->bcqghp", cb, decay, dtc, xc)
    decay_end = jnp.exp(acs[:, :, -1:] - acs)
    states = jnp.einsum("bckgn,bckgh,bckghp->bcghpn", Bc, decay_end * dtc, xc)
    chunk_decay = jnp.exp(acs[:, :, -1])

    def step(h_prev, inp):
        st, dec = inp
        return dec[..., None, None] * h_prev + st, h_prev

    h0g = h0.reshape(Bsz, G, Hg, SSD_HEAD_P, SSD_STATE)
    h_final, h_in = lax.scan(step, h0g, (jnp.moveaxis(states, 1, 0), jnp.moveaxis(chunk_decay, 1, 0)))
    h_in = jnp.moveaxis(h_in, 0, 1)
    y_off = jnp.einsum("bcqgn,bcghpn,bcqgh->bcqghp", Cc, h_in, jnp.exp(acs))
    y = (y_diag + y_off).reshape(Bsz, L, SSD_HEADS, SSD_HEAD_P)
    if reverse:
        y = jnp.flip(y, axis=1)
    return y, h_final.reshape(Bsz, SSD_HEADS, SSD_HEAD_P, SSD_STATE)


def odd_mixer(h, w_in, conv_lru_w, conv_lru_b, lru_wa, lru_ba, lru_wx, lru_bx, lru_lambda,
              conv_ssd_w, conv_ssd_b, ssd_dt_bias, ssd_a_log, ssd_d, ssd_norm, w_out,
              lru_h0, ssd_h0):
    B, S, _ = h.shape
    f32 = jnp.float32
    p = h @ w_in
    g, xl, z, xbc, dt = jnp.split(
        p, [LRU_W, 2 * LRU_W, 2 * LRU_W + SSD_INNER, 2 * LRU_W + SSD_INNER + SSD_CONV_CH], axis=-1)
    xc = centred_dwconv(xl, conv_lru_w, conv_lru_b)
    y_f, hl_f = rglru_direction(xc, lru_wa[0], lru_ba[0], lru_wx[0], lru_bx[0], lru_lambda[0],
                                lru_h0[:, 0], False)
    y_b, hl_b = rglru_direction(xc, lru_wa[1], lru_ba[1], lru_wx[1], lru_bx[1], lru_lambda[1],
                                lru_h0[:, 1], True)
    y_lru = ((y_f + y_b) * jax.nn.gelu(g.astype(f32))).astype(h.dtype)
    xbc = jax.nn.silu(centred_dwconv(xbc, conv_ssd_w, conv_ssd_b)).astype(f32)
    xs, Bm, Cm = jnp.split(xbc, [SSD_INNER, SSD_INNER + SSD_GROUPS * SSD_STATE], axis=-1)
    xs = xs.reshape(B, S, SSD_HEADS, SSD_HEAD_P)
    Bm = Bm.reshape(B, S, SSD_GROUPS, SSD_STATE)
    Cm = Cm.reshape(B, S, SSD_GROUPS, SSD_STATE)
    dt = dt.astype(f32)
    dt_f = jax.nn.softplus(dt[..., :SSD_HEADS] + ssd_dt_bias[0].astype(f32))
    dt_b = jax.nn.softplus(dt[..., SSD_HEADS:] + ssd_dt_bias[1].astype(f32))
    A_f = -jnp.exp(ssd_a_log[0].astype(f32))
    A_b = -jnp.exp(ssd_a_log[1].astype(f32))
    ys_f, hs_f = ssd_direction(xs, dt_f, A_f, Bm, Cm, ssd_h0[:, 0].astype(f32), False)
    ys_b, hs_b = ssd_direction(xs, dt_b, A_b, Bm, Cm, ssd_h0[:, 1].astype(f32), True)
    y = ys_f + ys_b + ssd_d.astype(f32)[:, None] * xs
    y = (y.reshape(B, S, SSD_INNER) * jax.nn.silu(z.astype(f32)))
    y_ssd = rmsnorm(y, ssd_norm).astype(h.dtype)
    out = jnp.concatenate([y_lru, y_ssd], axis=-1) @ w_out
    return out, jnp.stack([hl_f, hl_b], axis=1), jnp.stack([hs_f, hs_b], axis=1)


def run_trunk(x, cond, p, ctx_k, ctx_v, ctx_lru, ctx_ssd, is_ctx):
    B = x.shape[0]
    new_k, new_v, new_lru, new_ssd = [], [], [], []
    for l in range(DEPTH):
        sm, cm, gm, sf, cf, gf = modulation(cond, p["w_ada"][l], p["b_ada"][l])
        hmix = rmsnorm(x, p["norm_mix"][l]) * (1 + cm) + sm
        j = l // 2
        if l % 2 == 0:
            kv = None if is_ctx else (ctx_k[:, j], ctx_v[:, j])
            out, kv_new = even_mixer(hmix, p["w_in_even"][j], p["q_norm"][j], p["k_norm"][j],
                                     p["w_out_even"][j], kv)
            if is_ctx:
                new_k.append(kv_new[0])
                new_v.append(kv_new[1])
        else:
            if is_ctx:
                h0l = jnp.zeros((B, 2, LRU_W), jnp.float32)
                h0s = jnp.zeros((B, 2, SSD_HEADS, SSD_HEAD_P, SSD_STATE), jnp.float32)
            else:
                h0l = ctx_lru[:, j]
                h0s = ctx_ssd[:, j]
            out, sl, ss = odd_mixer(
                hmix, p["w_in_odd"][j], p["conv_lru_w"][j], p["conv_lru_b"][j],
                p["lru_wa"][j], p["lru_ba"][j], p["lru_wx"][j], p["lru_bx"][j], p["lru_lambda"][j],
                p["conv_ssd_w"][j], p["conv_ssd_b"][j], p["ssd_dt_bias"][j], p["ssd_a_log"][j],
                p["ssd_d"][j], p["ssd_norm"][j], p["w_out_odd"][j], h0l, h0s)
            if is_ctx:
                new_lru.append(sl.astype(x.dtype))
                new_ssd.append(ss.astype(x.dtype))
        x = x + gm * out
        hff = rmsnorm(x, p["norm_ffn"][l]) * (1 + cf) + sf
        x = x + gf * swiglu(hff, p["ffn_w1"][l], p["ffn_w3"][l], p["ffn_w2"][l])
    return x, new_k, new_v, new_lru, new_ssd


def setup_inputs(seed: int = 0) -> dict:
    key = jax.random.key(seed)
    ks = iter(jax.random.split(key, 48))
    f32 = jnp.float32

    def nrm(shape, scale=1.0):
        return jax.random.normal(next(ks), shape, f32) * scale

    def gain(shape):
        return 1.0 + 0.02 * jax.random.normal(next(ks), shape, f32)

    u = jax.random.uniform(next(ks), (N_ODD, 2, LRU_W), f32,
                           minval=0.9 ** (1.0 / LRU_C), maxval=0.999 ** (1.0 / LRU_C))
    lru_lambda = jnp.log(u) - jnp.log1p(-u)
    dt0 = jnp.exp(jax.random.uniform(next(ks), (N_ODD, 2, SSD_HEADS), f32,
                                     minval=math.log(1e-3), maxval=math.log(1e-1)))
    ssd_dt_bias = dt0 + jnp.log(-jnp.expm1(-dt0))
    ssd_a_log = jnp.log(jax.random.uniform(next(ks), (N_ODD, 2, SSD_HEADS), f32, minval=1.0, maxval=16.0))

    return {
        "x_prompt": nrm((BATCH, SEQ, D_MODEL)),
        "x_sample": nrm((DEC_BATCH, DEC_SEQ, D_MODEL)),
        "c": nrm((DEC_BATCH, D_MODEL)),
        "cache_k": nrm((DEC_BATCH, N_EVEN, PAST_LEN, N_KV_HEADS, HEAD_DIM)),
        "cache_v": nrm((DEC_BATCH, N_EVEN, PAST_LEN, N_KV_HEADS, HEAD_DIM)),
        "state_lru": nrm((DEC_BATCH, N_ODD, 2, LRU_W), 0.5),
        "state_ssd": nrm((DEC_BATCH, N_ODD, 2, SSD_HEADS, SSD_HEAD_P, SSD_STATE), 0.5),
        "c_ctx": nrm((D_MODEL,)),
        "w_ada": nrm((DEPTH, D_MODEL, 6 * D_MODEL), 0.5 * D_MODEL ** -0.5),
        "b_ada": nrm((DEPTH, 6 * D_MODEL), 0.02),
        "norm_mix": gain((DEPTH, D_MODEL)),
        "norm_ffn": gain((DEPTH, D_MODEL)),
        "w_in_even": nrm((N_EVEN, D_MODEL, EVEN_IN), D_MODEL ** -0.5),
        "q_norm": gain((N_EVEN, HEAD_DIM)),
        "k_norm": gain((N_EVEN, HEAD_DIM)),
        "w_out_even": nrm((N_EVEN, EVEN_MIX, D_MODEL), EVEN_MIX ** -0.5),
        "w_in_odd": nrm((N_ODD, D_MODEL, ODD_IN), D_MODEL ** -0.5),
        "conv_lru_w": nrm((N_ODD, CONV_W, LRU_W), CONV_W ** -0.5),
        "conv_lru_b": nrm((N_ODD, LRU_W), 0.02),
        "lru_wa": nrm((N_ODD, 2, LRU_BLOCKS, LRU_BLOCK_W, LRU_BLOCK_W), LRU_BLOCK_W ** -0.5),
        "lru_ba": nrm((N_ODD, 2, LRU_W), 0.02),
        "lru_wx": nrm((N_ODD, 2, LRU_BLOCKS, LRU_BLOCK_W, LRU_BLOCK_W), LRU_BLOCK_W ** -0.5),
        "lru_bx": nrm((N_ODD, 2, LRU_W), 0.02),
        "lru_lambda": lru_lambda,
        "conv_ssd_w": nrm((N_ODD, CONV_W, SSD_CONV_CH), CONV_W ** -0.5),
        "conv_ssd_b": nrm((N_ODD, SSD_CONV_CH), 0.02),
        "ssd_dt_bias": ssd_dt_bias,
        "ssd_a_log": ssd_a_log,
        "ssd_d": gain((N_ODD, SSD_HEADS)),
        "ssd_norm": gain((N_ODD, SSD_INNER)),
        "w_out_odd": nrm((N_ODD, ODD_MIX, D_MODEL), ODD_MIX ** -0.5),
        "ffn_w1": nrm((DEPTH, D_MODEL, D_FF), D_MODEL ** -0.5),
        "ffn_w3": nrm((DEPTH, D_MODEL, D_FF), D_MODEL ** -0.5),
        "ffn_w2": nrm((DEPTH, D_FF, D_MODEL), D_FF ** -0.5),
    }


def reference(x_prompt, x_sample, c, cache_k, cache_v, state_lru, state_ssd, c_ctx,
              w_ada, b_ada, norm_mix, norm_ffn, w_in_even, q_norm, k_norm, w_out_even,
              w_in_odd, conv_lru_w, conv_lru_b, lru_wa, lru_ba, lru_wx, lru_bx, lru_lambda,
              conv_ssd_w, conv_ssd_b, ssd_dt_bias, ssd_a_log, ssd_d, ssd_norm, w_out_odd,
              ffn_w1, ffn_w3, ffn_w2):
    p = dict(w_ada=w_ada, b_ada=b_ada, norm_mix=norm_mix, norm_ffn=norm_ffn,
             w_in_even=w_in_even, q_norm=q_norm, k_norm=k_norm, w_out_even=w_out_even,
             w_in_odd=w_in_odd, conv_lru_w=conv_lru_w, conv_lru_b=conv_lru_b,
             lru_wa=lru_wa, lru_ba=lru_ba, lru_wx=lru_wx, lru_bx=lru_bx, lru_lambda=lru_lambda,
             conv_ssd_w=conv_ssd_w, conv_ssd_b=conv_ssd_b, ssd_dt_bias=ssd_dt_bias,
             ssd_a_log=ssd_a_log, ssd_d=ssd_d, ssd_norm=ssd_norm, w_out_odd=w_out_odd,
             ffn_w1=ffn_w1, ffn_w3=ffn_w3, ffn_w2=ffn_w2)
    y_prompt, ks_, vs_, lrus_, ssds_ = run_trunk(
        x_prompt, c_ctx[None, :], p, None, None, None, None, True)
    new_k = jnp.stack(ks_, axis=1)
    new_v = jnp.stack(vs_, axis=1)
    new_lru = jnp.stack(lrus_, axis=1)
    new_ssd = jnp.stack(ssds_, axis=1)
    y_sample, _, _, _, _ = run_trunk(
        x_sample, c, p, cache_k, cache_v, state_lru, state_ssd, False)
    return (y_prompt, y_sample, new_k, new_v, new_lru, new_ssd)
```

```cpp
#include <hip/hip_runtime.h>
#include <hip/hip_bf16.h>
#include <hip/hip_cooperative_groups.h>
#include <cstdio>
#include <cstring>
namespace cg = cooperative_groups;

typedef unsigned short u16;
using bf16x8 = __attribute__((ext_vector_type(8))) short;
using bf16x4 = __attribute__((ext_vector_type(4))) short;
using f32x4 = __attribute__((ext_vector_type(4))) float;

#define MFMA(a, b, c) __builtin_amdgcn_mfma_f32_16x16x32_bf16(a, b, c, 0, 0, 0)
#define LOG2E 1.4426950408889634f

constexpr int T_ALL = 12288;
constexpr int T_CTX = 4096;
constexpr int SMEM_BYTES = 81664;
constexpr int LDT = 72;

constexpr size_t OFF_WIE = 0;
constexpr size_t OFF_WOE = OFF_WIE + 3670016;
constexpr size_t OFF_WIO = OFF_WOE + 2097152;
constexpr size_t OFF_WOO = OFF_WIO + 7077888;
constexpr size_t OFF_W13 = OFF_WOO + 3145728;
constexpr size_t OFF_W2 = OFF_W13 + 23068672;
constexpr size_t OFF_MOD = OFF_W2 + 11534336;
constexpr size_t OFF_D1K = OFF_MOD + 442368;
constexpr size_t OFF_D256 = OFF_D1K + 4194304;
constexpr size_t OFF_H = OFF_D256 + 262144;
constexpr size_t OFF_R1 = OFF_H + 37748736;
constexpr size_t OFF_Y = OFF_R1 + 84934656;
constexpr size_t OFF_YL = OFF_Y + 50331648;
constexpr size_t OFF_DT = OFF_YL + 25165824;
constexpr size_t OFF_BAR = OFF_DT + 1572864;
constexpr size_t OFF_PRM = OFF_BAR + 32768;
constexpr int PRM_NORM_MIX = 0, PRM_NORM_FFN = 2048, PRM_QN = 4096, PRM_KN = 4160, PRM_CLW = 4224, PRM_CLB = 6272,
              PRM_LBA = 6784, PRM_LBX = 7808, PRM_LAM = 8832, PRM_CSW = 9856, PRM_CSB = 14976, PRM_DTB = 16256,
              PRM_ALOG = 16288, PRM_SSDD = 16320, PRM_SNORM = 16384, PRM_LWA = 17408, PRM_LWX = 82944;
#define PRM(P, off) ((const float*)((P).ws + OFF_PRM) + (off))
constexpr size_t OFF_YTS = OFF_Y;
constexpr size_t OFF_YTC = OFF_Y + 8388608;
constexpr size_t OFF_QB = OFF_Y + 12582912;
constexpr size_t OFF_KBS = OFF_Y + 31457280;
constexpr size_t OFF_KBC = OFF_Y + 37748736;
constexpr size_t OFF_VTS = OFF_Y + 39845888;
constexpr size_t OFF_VTC = OFF_Y + 46137344;

struct Params {
  const float* in[34];
  float* out;
  char* ws;
};

typedef __bf16 bf16x2_t __attribute__((ext_vector_type(2)));
typedef float f32x2_t __attribute__((ext_vector_type(2)));
__device__ __forceinline__ unsigned pack2(float a, float b) {
  f32x2_t v = {a, b};
  bf16x2_t r = __builtin_convertvector(v, bf16x2_t);
  return __builtin_bit_cast(unsigned, r);
}
__device__ __forceinline__ u16 f2bf(float f) { return (u16)(pack2(f, 0.f) & 0xffffu); }
__device__ __forceinline__ float bf2f(u16 h) { return __uint_as_float(((unsigned)h) << 16); }
__device__ __forceinline__ float silu_f(float v) { return v * __builtin_amdgcn_rcpf(1.f + __expf(-v)); }
__device__ __forceinline__ float sigmoid_f(float v) { return __builtin_amdgcn_rcpf(1.f + __expf(-v)); }
__device__ __forceinline__ float fexp2(float v) { return __builtin_amdgcn_exp2f(v); }

__device__ __forceinline__ float xor16_sum(float x) {
  const unsigned u = __float_as_uint(x);
  auto r = __builtin_amdgcn_permlane16_swap(u, u, false, false);
  return __uint_as_float(r[0]) + __uint_as_float(r[1]);
}
__device__ __forceinline__ float xor32_sum(float x) {
  const unsigned u = __float_as_uint(x);
  auto r = __builtin_amdgcn_permlane32_swap(u, u, false, false);
  return __uint_as_float(r[0]) + __uint_as_float(r[1]);
}
__device__ __forceinline__ float xor16_max(float x) {
  const unsigned u = __float_as_uint(x);
  auto r = __builtin_amdgcn_permlane16_swap(u, u, false, false);
  return fmaxf(__uint_as_float(r[0]), __uint_as_float(r[1]));
}
__device__ __forceinline__ float xor32_max(float x) {
  const unsigned u = __float_as_uint(x);
  auto r = __builtin_amdgcn_permlane32_swap(u, u, false, false);
  return fmaxf(__uint_as_float(r[0]), __uint_as_float(r[1]));
}
__device__ __forceinline__ int cond_row(int t) { return t < T_CTX ? 8 : ((t - T_CTX) >> 10); }
__device__ __forceinline__ const float* xin(const Params& P, int t) {
  return t < T_CTX ? P.in[0] + (size_t)t * 1024 : P.in[1] + (size_t)(t - T_CTX) * 1024;
}


#define XB_TMO      128
#define XB_XCNT(j)  (256  + 64 * (j))
#define XB_XSUB(j)  (1280 + 64 * (j))
#define XB_XGEN(j)  (2304 + 64 * (j))
#define XB_TOP      3328
#define XB_TOPGEN   3392
#define XCD_BAR_WORDS 3456
#define XB_SPIN_CAP (1u << 22)
#define LAS __attribute__((address_space(3)))
__device__ __forceinline__ unsigned xb_ld(unsigned* p)              { return __hip_atomic_load(p, __ATOMIC_RELAXED, __HIP_MEMORY_SCOPE_AGENT); }
__device__ __forceinline__ unsigned xb_add(unsigned* p, unsigned v) { return __hip_atomic_fetch_add(p, v, __ATOMIC_RELAXED, __HIP_MEMORY_SCOPE_AGENT); }
__device__ __forceinline__ unsigned xb_xcc_id() { return (unsigned)__builtin_amdgcn_s_getreg((3 << 11) | 20) & 0xFu; }
#define XB_SPIN(cond, bar) do { unsigned _sp = 0; while (cond) { __builtin_amdgcn_s_sleep(1); \
    if ((++_sp & 255u) == 0u) { if (xb_ld(&(bar)[XB_TMO])) break; if (_sp > XB_SPIN_CAP) { atomicAdd(&(bar)[XB_TMO], 1u); break; } } } } while (0)
struct XcdBarrier { unsigned* bar; unsigned x; volatile LAS unsigned* st; };
__device__ __forceinline__ XcdBarrier xcd_barrier_post(unsigned* bar, volatile LAS unsigned* st) {
    XcdBarrier b; b.bar = bar; b.x = xb_xcc_id(); b.st = st;
    if (threadIdx.x == 0) (void)xb_add(&bar[XB_XCNT(b.x)], 1u);
    return b;
}
__device__ __forceinline__ void xcd_barrier_complete(unsigned* bar, unsigned x, unsigned& nloc, unsigned& nx) {
    const unsigned G = gridDim.x * gridDim.y * gridDim.z;
    unsigned sum, cnt, mine, sp = 0u;
    for (;;) {
        sum = 0u; cnt = 0u; mine = 0u;
#pragma unroll
        for (unsigned j = 0; j < 16; ++j) { const unsigned c = xb_ld(&bar[XB_XCNT(j)]); sum += c; cnt += (c > 0u) ? 1u : 0u; mine = (j == x) ? c : mine; }
        if (sum == G) break;
        __builtin_amdgcn_s_sleep(1);
        if ((++sp & 255u) == 0u) { if (xb_ld(&bar[XB_TMO])) break; if (sp > XB_SPIN_CAP) { atomicAdd(&bar[XB_TMO], 1u); break; } }
    }
    nloc = mine > 0u ? mine : 1u; nx = cnt > 0u ? cnt : 1u;
}
__device__ __forceinline__ void xcd_barrier(const XcdBarrier& b) {
    asm volatile("s_waitcnt vmcnt(0)" ::: "memory");
    __syncthreads();
    if (threadIdx.x == 0) {
        unsigned* bar = b.bar;
        __builtin_amdgcn_s_waitcnt(0);
        unsigned nloc = b.st[0], nx = b.st[1];
        if (nloc == 0u) { xcd_barrier_complete(bar, b.x, nloc, nx); b.st[0] = nloc; b.st[1] = nx; }
        const unsigned old = xb_add(&bar[XB_XSUB(b.x)], 1u);
        const unsigned gen = old / nloc;
        if (old + 1u == (gen + 1u) * nloc) {
            __builtin_amdgcn_fence(__ATOMIC_RELEASE, "agent");
            asm volatile("s_waitcnt vmcnt(0)" ::: "memory");
            const unsigned og = xb_add(&bar[XB_TOP], 1u);
            const unsigned tg = og / nx;
            if (og + 1u == (tg + 1u) * nx) xb_add(&bar[XB_TOPGEN], 1u);
            else XB_SPIN(xb_ld(&bar[XB_TOPGEN]) == tg, bar);
            __builtin_amdgcn_fence(__ATOMIC_ACQUIRE, "agent");
            xb_add(&bar[XB_XGEN(b.x)], 1u);
            asm volatile("s_waitcnt vmcnt(0)" ::: "memory");
        } else {
            XB_SPIN(xb_ld(&bar[XB_XGEN(b.x)]) == gen, bar);
            __builtin_amdgcn_fence(__ATOMIC_ACQUIRE, "agent");
            asm volatile("s_waitcnt vmcnt(0)" ::: "memory");
        }
    }
    __syncthreads();
}

using u32x4 = __attribute__((ext_vector_type(4))) unsigned int;
struct GRegs { u32x4 a0, a1, a2, a3, b0, b1; };
template <int MTW>
__device__ __forceinline__ void gemm_gload(GRegs& R, const u16* ga, const u16* gb, int lda, int ldb) {
  R.a0 = *(const u32x4*)(ga);
  R.a1 = *(const u32x4*)(ga + (size_t)64 * lda);
  R.a2 = *(const u32x4*)(ga + (size_t)128 * lda);
  if (MTW == 8) R.a3 = *(const u32x4*)(ga + (size_t)192 * lda);
  R.b0 = *(const u32x4*)(gb);
  R.b1 = *(const u32x4*)(gb + (size_t)64 * ldb);
}
template <int MTW>
__device__ __forceinline__ void gemm_swrite(const GRegs& R, u16* dA, u16* dB) {
  *(u32x4*)(dA) = R.a0;
  *(u32x4*)(dA + 64 * 40) = R.a1;
  *(u32x4*)(dA + 128 * 40) = R.a2;
  if (MTW == 8) *(u32x4*)(dA + 192 * 40) = R.a3;
  *(u32x4*)(dB) = R.b0;
  *(u32x4*)(dB + 64 * 40) = R.b1;
}

template <bool SWAP, int MTW>
__device__ __forceinline__ void gemm_compute_tile(const u16* cA, const u16* cB, f32x4 (&acc)[MTW][4]) {
  constexpr int LS = 40;
  constexpr int HM = MTW / 2;
  bf16x8 bfr[4];
#pragma unroll
  for (int j = 0; j < 4; j++) bfr[j] = *(const bf16x8*)(cB + j * 16 * LS);
#pragma unroll
  for (int h = 0; h < 2; h++) {
    bf16x8 af[HM];
#pragma unroll
    for (int i = 0; i < HM; i++) af[i] = *(const bf16x8*)(cA + (h * HM + i) * 16 * LS);
#pragma unroll
    for (int i = 0; i < HM; i++)
#pragma unroll
      for (int j = 0; j < 4; j++) {
        if (SWAP) acc[h * HM + i][j] = MFMA(bfr[j], af[i], acc[h * HM + i][j]);
        else acc[h * HM + i][j] = MFMA(af[i], bfr[j], acc[h * HM + i][j]);
      }
  }
}

template <bool SWAP, int MTW = 8>
__device__ __forceinline__ void gemm_mainloop_reg(const u16* __restrict__ A, int lda, const u16* __restrict__ Bt, int ldb,
                                              int K, u16* sm, f32x4 (&acc)[MTW][4]) {
  constexpr int LS = 40;
  const int tid = threadIdx.x, lane = tid & 63, wave = tid >> 6;
  const int wm = wave >> 1, wn = wave & 1;
  const int fr = lane & 15, fq = lane >> 4;
  u16* sA = sm;
  u16* sB = sm + 2 * 256 * LS;
  const int lr = tid >> 2, lc = (tid & 3) * 8;
  const u16* ga = A + (size_t)lr * lda + lc;
  const u16* gb = Bt + (size_t)lr * ldb + lc;
  GRegs r0, r1;
#define GLOAD(R, KT) gemm_gload<MTW>(R, ga + (KT) * 32, gb + (KT) * 32, lda, ldb);
#define SWRITE(R, BUF) gemm_swrite<MTW>(R, sA + (BUF) * 256 * LS + lr * LS + lc, sB + (BUF) * 128 * LS + lr * LS + lc);
  GLOAD(r0, 0)
  GLOAD(r1, 1)
#pragma unroll
  for (int i = 0; i < MTW; i++)
#pragma unroll
    for (int j = 0; j < 4; j++) acc[i][j] = f32x4{0.f, 0.f, 0.f, 0.f};
  SWRITE(r0, 0)
  __syncthreads();
  const int nk = K >> 5;
  const u16* cA0 = sA + (wm * 16 * MTW + fr) * LS + fq * 8;
  const u16* cB0 = sB + (wn * 64 + fr) * LS + fq * 8;
  for (int kt = 0; kt < nk; kt += 2) {
    GLOAD(r0, min(kt + 2, nk - 1))
    gemm_compute_tile<SWAP, MTW>(cA0, cB0, acc);
    SWRITE(r1, 1)
    __syncthreads();
    GLOAD(r1, min(kt + 3, nk - 1))
    gemm_compute_tile<SWAP, MTW>(cA0 + 256 * LS, cB0 + 128 * LS, acc);
    SWRITE(r0, 0)
    __syncthreads();
  }
#undef GLOAD
#undef SWRITE
}

__device__ __forceinline__ void glds16(const u16* g, char* lds) {
  __builtin_amdgcn_global_load_lds((const unsigned*)g, (unsigned*)lds, 16, 0, 0);
}
#define DSR128(dst, addr, OFF) asm volatile("ds_read_b128 %0, %1 offset:%2" : "=v"(dst) : "v"(addr), "n"(OFF))
template <bool SWAP, int MTW>
__device__ __forceinline__ void gemm_compute_glds(unsigned aA, unsigned aB, f32x4 (&acc)[MTW][4]) {
  bf16x8 bfr[4], af[MTW];
  DSR128(bfr[0], aB, 0); DSR128(bfr[1], aB, 1024); DSR128(bfr[2], aB, 2048); DSR128(bfr[3], aB, 3072);
  if (MTW == 8) {
    DSR128(af[0], aA, 0); DSR128(af[1], aA, 1024); DSR128(af[2], aA, 2048); DSR128(af[3], aA, 3072);
    DSR128(af[4], aA, 4096); DSR128(af[5], aA, 5120); DSR128(af[6], aA, 6144); DSR128(af[7], aA, 7168);
    asm volatile("s_waitcnt lgkmcnt(4)" : "+v"(bfr[0]), "+v"(bfr[1]), "+v"(bfr[2]), "+v"(bfr[3]), "+v"(af[0]), "+v"(af[1]), "+v"(af[2]), "+v"(af[3]));
  } else if (MTW == 6) {
    DSR128(af[0], aA, 0); DSR128(af[1], aA, 1024); DSR128(af[2], aA, 2048);
    DSR128(af[3], aA, 3072); DSR128(af[4], aA, 4096); DSR128(af[5], aA, 5120);
    asm volatile("s_waitcnt lgkmcnt(3)" : "+v"(bfr[0]), "+v"(bfr[1]), "+v"(bfr[2]), "+v"(bfr[3]), "+v"(af[0]), "+v"(af[1]), "+v"(af[2]));
  } else if (MTW == 4) {
    DSR128(af[0], aA, 0); DSR128(af[1], aA, 1024); DSR128(af[2], aA, 2048); DSR128(af[3], aA, 3072);
    asm volatile("s_waitcnt lgkmcnt(2)" : "+v"(bfr[0]), "+v"(bfr[1]), "+v"(bfr[2]), "+v"(bfr[3]), "+v"(af[0]), "+v"(af[1]));
  } else {
    DSR128(af[0], aA, 0); DSR128(af[1], aA, 1024);
    asm volatile("s_waitcnt lgkmcnt(1)" : "+v"(bfr[0]), "+v"(bfr[1]), "+v"(bfr[2]), "+v"(bfr[3]), "+v"(af[0]));
  }
  constexpr int HM = MTW / 2;
#pragma unroll
  for (int i = 0; i < HM; i++)
#pragma unroll
    for (int j = 0; j < 4; j++) {
      if (SWAP) acc[i][j] = MFMA(bfr[j], af[i], acc[i][j]);
      else acc[i][j] = MFMA(af[i], bfr[j], acc[i][j]);
    }
  __builtin_amdgcn_sched_barrier(0);
  if (MTW == 8) asm volatile("s_waitcnt lgkmcnt(0)" : "+v"(af[4]), "+v"(af[5]), "+v"(af[6]), "+v"(af[7]));
  else if (MTW == 6) asm volatile("s_waitcnt lgkmcnt(0)" : "+v"(af[3]), "+v"(af[4]), "+v"(af[5]));
  else if (MTW == 4) asm volatile("s_waitcnt lgkmcnt(0)" : "+v"(af[2]), "+v"(af[3]));
  else asm volatile("s_waitcnt lgkmcnt(0)" : "+v"(af[1]));
  __builtin_amdgcn_sched_barrier(0);
#pragma unroll
  for (int i = HM; i < MTW; i++)
#pragma unroll
    for (int j = 0; j < 4; j++) {
      if (SWAP) acc[i][j] = MFMA(bfr[j], af[i], acc[i][j]);
      else acc[i][j] = MFMA(af[i], bfr[j], acc[i][j]);
    }
}

template <bool SWAP, int MTW = 8>
__device__ __forceinline__ void gemm_mainloop(const u16* __restrict__ A, int lda, const u16* __restrict__ Bt, int ldb,
                                              int K, u16* sm, f32x4 (&acc)[MTW][4]) {
  constexpr int STG = 24576;
  constexpr int AW = MTW / 2;
  constexpr int NL = AW + 2;
  const int tid = threadIdx.x, lane = tid & 63, wave = tid >> 6;
  const int wm = wave >> 1, wn = wave & 1;
  const int fr = lane & 15, fq = lane >> 4;
  char* smc = (char*)sm;
  const int rowl = lane >> 2;
  const int lch = ((lane & 3) ^ (((lane >> 5) & 1) << 1)) * 8;
  const u16* gA = A + (size_t)(wave * AW * 16 + rowl) * lda + lch;
  const u16* gB = Bt + (size_t)(wave * 32 + rowl) * ldb + lch;
  char* dA = smc + (wave * AW) * 1024;
  char* dB = smc + 16384 + (wave * 2) * 1024;
  const int loff = fr * 64 + ((fq ^ (((fr >> 3) & 1) << 1)) * 16);
  const unsigned lds0 = (unsigned)(size_t)((LAS char*)smc);
  const unsigned rA = lds0 + (wm * MTW) * 1024 + loff;
  const unsigned rB = lds0 + 16384 + (wn * 4) * 1024 + loff;
#define GSTAGE(S, KT) { _Pragma("unroll") for (int _i = 0; _i < AW; _i++) glds16(gA + (size_t)(_i * 16) * lda + (KT) * 32, dA + (S) * STG + _i * 1024); \
                        _Pragma("unroll") for (int _i = 0; _i < 2; _i++) glds16(gB + (size_t)(_i * 16) * ldb + (KT) * 32, dB + (S) * STG + _i * 1024); }
#pragma unroll
  for (int i = 0; i < MTW; i++)
#pragma unroll
    for (int j = 0; j < 4; j++) acc[i][j] = f32x4{0.f, 0.f, 0.f, 0.f};
  const int nk = K >> 5;
  GSTAGE(0, 0)
  GSTAGE(1, 1)
  asm volatile("s_waitcnt vmcnt(%0)" ::"n"(NL) : "memory");
  asm volatile("s_waitcnt lgkmcnt(0)" ::: "memory");
  __builtin_amdgcn_s_barrier();
  int cur = 0;
  for (int t = 0; t < nk; t++) {
    int nx2 = cur + 2; if (nx2 >= 3) nx2 -= 3;
    const bool more = (t + 2 < nk);
    if (more) GSTAGE(nx2, t + 2)
    gemm_compute_glds<SWAP, MTW>(rA + cur * STG, rB + cur * STG, acc);
    if (more) asm volatile("s_waitcnt vmcnt(%0)" ::"n"(NL) : "memory");
    else asm volatile("s_waitcnt vmcnt(0)" ::: "memory");
    asm volatile("s_waitcnt lgkmcnt(0)" ::: "memory");
    __builtin_amdgcn_s_barrier();
    cur = (cur == 2) ? 0 : cur + 1;
  }
#undef GSTAGE
}

template <bool SWAP>
__device__ __forceinline__ void gemm_mainloop128(const u16* __restrict__ A, int lda, const u16* __restrict__ Bt, int ldb,
                                              int K, u16* sm, f32x4 (&acc)[4][4]) {
  const int tid = threadIdx.x, lane = tid & 63, wave = tid >> 6;
  const int wm = wave >> 1, wn = wave & 1;
  const int fr = lane & 15, fq = lane >> 4;
  u16* sA = sm;
  u16* sB = sm + 2 * 128 * LDT;
  const int lr = tid >> 3, lc = (tid & 7) * 8;
  const u16* ga = A + (size_t)lr * lda + lc;
  const u16* gb = Bt + (size_t)lr * ldb + lc;
  uint4 ra[4], rb[4];
#pragma unroll
  for (int i = 0; i < 4; i++) {
    ra[i] = *(const uint4*)(ga + (size_t)(i * 32) * lda);
    rb[i] = *(const uint4*)(gb + (size_t)(i * 32) * ldb);
  }
#pragma unroll
  for (int i = 0; i < 4; i++)
#pragma unroll
    for (int j = 0; j < 4; j++) acc[i][j] = f32x4{0.f, 0.f, 0.f, 0.f};
#pragma unroll
  for (int i = 0; i < 4; i++) {
    *(uint4*)(sA + (lr + i * 32) * LDT + lc) = ra[i];
    *(uint4*)(sB + (lr + i * 32) * LDT + lc) = rb[i];
  }
  __syncthreads();
  const int nk = K >> 6;
  for (int kt = 0; kt < nk; kt++) {
    const int cur = kt & 1;
    const bool more = (kt + 1 < nk);
    if (more) {
      const u16* ga2 = ga + (kt + 1) * 64;
      const u16* gb2 = gb + (kt + 1) * 64;
#pragma unroll
      for (int i = 0; i < 4; i++) {
        ra[i] = *(const uint4*)(ga2 + (size_t)(i * 32) * lda);
        rb[i] = *(const uint4*)(gb2 + (size_t)(i * 32) * ldb);
      }
    }
    const u16* cA = sA + cur * 128 * LDT + (wm * 64 + fr) * LDT + fq * 8;
    const u16* cB = sB + cur * 128 * LDT + (wn * 64 + fr) * LDT + fq * 8;
#pragma unroll
    for (int kk = 0; kk < 2; kk++) {
      bf16x8 af[4], bfr[4];
#pragma unroll
      for (int i = 0; i < 4; i++) af[i] = *(const bf16x8*)(cA + i * 16 * LDT + kk * 32);
#pragma unroll
      for (int j = 0; j < 4; j++) bfr[j] = *(const bf16x8*)(cB + j * 16 * LDT + kk * 32);
#pragma unroll
      for (int i = 0; i < 4; i++)
#pragma unroll
        for (int j = 0; j < 4; j++) {
          if (SWAP) acc[i][j] = MFMA(bfr[j], af[i], acc[i][j]);
          else acc[i][j] = MFMA(af[i], bfr[j], acc[i][j]);
        }
    }
    if (more) {
      u16* dA = sA + (cur ^ 1) * 128 * LDT;
      u16* dB = sB + (cur ^ 1) * 128 * LDT;
#pragma unroll
      for (int i = 0; i < 4; i++) {
        *(uint4*)(dA + (lr + i * 32) * LDT + lc) = ra[i];
        *(uint4*)(dB + (lr + i * 32) * LDT + lc) = rb[i];
      }
    }
    __syncthreads();
  }
}

__device__ __forceinline__ void tile_coords(int L, int MT, int NT, int& mt, int& nt) {
  const int full = NT >> 3;
  const int per = MT * 8;
  if (L < full * per) {
    int sc = L / per, r = L - sc * per;
    mt = r >> 3;
    nt = sc * 8 + (r & 7);
  } else {
    int L2 = L - full * per;
    int w = NT - full * 8;
    mt = L2 / w;
    nt = full * 8 + (L2 - mt * w);
  }
}

struct TileIter {
  int cur, end, step;
  __device__ TileIter(int ntiles) {
    int nb = gridDim.x, b = blockIdx.x;
    if ((nb & 7) == 0) {
      int per = (ntiles + 7) >> 3;
      int x = b & 7, j = b >> 3;
      cur = x * per + j;
      end = min((x + 1) * per, ntiles);
      step = nb >> 3;
    } else {
      cur = b; end = ntiles; step = nb;
    }
  }
};


constexpr size_t OFF_Q = OFF_BAR + 16384;
__device__ __forceinline__ int queue_next(unsigned* ctr, int* sh) {
  __syncthreads();
  if (threadIdx.x == 0) *sh = (int)__hip_atomic_fetch_add(ctr, 1u, __ATOMIC_RELAXED, __HIP_MEMORY_SCOPE_AGENT);
  __syncthreads();
  return *sh;
}

struct TrDesc { const float* src; u16* dst; int lds, nvalid, ldd, mode, rowoff, k0, n0; };
__device__ __forceinline__ TrDesc tr_desc(const Params& P, int j) {
  TrDesc d; int ntn; d.mode = 0; d.rowoff = 0;
  if (j < 320) { d.src = P.in[12] + 256; d.lds = 1536; d.nvalid = 1280; d.dst = (u16*)(P.ws + OFF_WIE); d.ldd = 1024; d.rowoff = 512; ntn = 20; }
  else if ((j -= 320) < 256) { d.src = P.in[15]; d.lds = 1024; d.nvalid = 1024; d.dst = (u16*)(P.ws + OFF_WOE); d.ldd = 1024; ntn = 16; }
  else if ((j -= 256) < 864) { d.src = P.in[16]; d.lds = 3360; d.nvalid = 3360; d.dst = (u16*)(P.ws + OFF_WIO); d.ldd = 1024; ntn = 54; }
  else if ((j -= 864) < 384) { d.src = P.in[30]; d.lds = 1024; d.nvalid = 1024; d.dst = (u16*)(P.ws + OFF_WOO); d.ldd = 1536; ntn = 16; }
  else if ((j -= 384) < 2816) {
    int q = j / 704; j -= q * 704; int l = q >> 1, w3 = q & 1;
    d.src = (w3 ? P.in[32] : P.in[31]) + (size_t)l * 1024 * 2816; d.lds = 2816; d.nvalid = 2816;
    d.dst = (u16*)(P.ws + OFF_W13) + (size_t)l * 5632 * 1024; d.ldd = 1024; d.mode = 1; d.rowoff = w3 * 16; ntn = 44;
  } else {
    j -= 2816; int l = j / 704; j -= l * 704;
    d.src = P.in[33] + (size_t)l * 2816 * 1024; d.lds = 1024; d.nvalid = 1024;
    d.dst = (u16*)(P.ws + OFF_W2) + (size_t)l * 1024 * 2816; d.ldd = 2816; ntn = 16;
  }
  const int kt = j / ntn, nt = j - kt * ntn;
  d.k0 = kt * 64; d.n0 = nt * 64;
  return d;
}
__device__ __forceinline__ void tr_load(const TrDesc& d, int tid, float4 (&v)[4]) {
#pragma unroll
  for (int i = 0; i < 4; i++) {
    const int r = i * 16 + (tid >> 4), n = d.n0 + (tid & 15) * 4;
    v[i] = make_float4(0.f, 0.f, 0.f, 0.f);
    if (n < d.nvalid) v[i] = *(const float4*)(d.src + (size_t)(d.k0 + r) * d.lds + n);
  }
}
__device__ __forceinline__ void tr_emit(const TrDesc& d, int tid, const float4 (&v)[4], float* tile) {
#pragma unroll
  for (int i = 0; i < 4; i++) {
    const int r = i * 16 + (tid >> 4), c4 = (tid & 15) * 4;
    tile[r * 65 + c4] = v[i].x; tile[r * 65 + c4 + 1] = v[i].y; tile[r * 65 + c4 + 2] = v[i].z; tile[r * 65 + c4 + 3] = v[i].w;
  }
  __syncthreads();
#pragma unroll
  for (int i = 0; i < 4; i++) {
    const int n = i * 16 + (tid >> 4), k4 = (tid & 15) * 4;
    const int ng = d.n0 + n;
    const int row = d.mode ? ((ng >> 4) * 32 + (ng & 15) + d.rowoff) : (ng + d.rowoff);
    uint2 o;
    o.x = pack2(tile[(k4 + 0) * 65 + n], tile[(k4 + 1) * 65 + n]);
    o.y = pack2(tile[(k4 + 2) * 65 + n], tile[(k4 + 3) * 65 + n]);
    *(uint2*)(d.dst + (size_t)row * d.ldd + d.k0 + k4) = o;
  }
  __syncthreads();
}
__device__ __forceinline__ void phase_prep(const Params& P, char* smem) {
  const int tid = threadIdx.x, nb = gridDim.x, bid = blockIdx.x;
  const int lane = tid & 63, wave = tid >> 6;
  float* tile = (float*)smem;
  float* tabc = (float*)(smem + 16640);
  float* tabs = tabc + 64;
  float* sc = (float*)(smem + 20480);
  float* red = (float*)(smem + 20480 + 36864);
  {
    float* prm = (float*)(P.ws + OFF_PRM);
    const int gt = bid * 256 + tid, gs = nb * 256;
#define PCOPY(SRC, OFF, N) for (int i = gt; i < (N); i += gs) prm[(OFF) + i] = (SRC)[i];
    PCOPY(P.in[10], PRM_NORM_MIX, 2048) PCOPY(P.in[11], PRM_NORM_FFN, 2048) PCOPY(P.in[13], PRM_QN, 64) PCOPY(P.in[14], PRM_KN, 64)
    PCOPY(P.in[17], PRM_CLW, 2048) PCOPY(P.in[18], PRM_CLB, 512) PCOPY(P.in[20], PRM_LBA, 1024) PCOPY(P.in[22], PRM_LBX, 1024)
    PCOPY(P.in[23], PRM_LAM, 1024) PCOPY(P.in[24], PRM_CSW, 5120) PCOPY(P.in[25], PRM_CSB, 1280) PCOPY(P.in[26], PRM_DTB, 32)
    PCOPY(P.in[27], PRM_ALOG, 32) PCOPY(P.in[28], PRM_SSDD, 16) PCOPY(P.in[29], PRM_SNORM, 1024)
    PCOPY(P.in[19], PRM_LWA, 65536) PCOPY(P.in[21], PRM_LWX, 65536)
#undef PCOPY
  }
  bool sc_ready = false;
  constexpr int N_MOD = 384, N_FF = 64, N_TR = 6048, N_DFT = 544, N_CACHE = 512;
  constexpr int N_ALL = N_MOD + N_FF + N_TR + N_DFT + N_CACHE;
  for (int it = bid; it < N_ALL; it += nb) {
    int j = it;
    if (j < N_MOD) {
      if (!sc_ready) {
        for (int i = tid; i < 9 * 1024; i += 256) {
          int r = i >> 10, k = i & 1023;
          float c = r < 8 ? P.in[2][r * 1024 + k] : P.in[7][k];
          sc[i] = silu_f(c);
        }
        __syncthreads();
        sc_ready = true;
      }
      const int l = j / 192, n0 = (j % 192) * 32;
      const int cgp = tid & 7, kl = tid >> 3;
      float acc[9][4];
#pragma unroll
      for (int r = 0; r < 9; r++)
#pragma unroll
        for (int c = 0; c < 4; c++) acc[r][c] = 0.f;
      const float* w = P.in[8] + (size_t)l * 1024 * 6144 + n0 + cgp * 4;
#pragma unroll 4
      for (int i = 0; i < 32; i++) {
        const int k = i * 32 + kl;
        const float4 wv = *(const float4*)(w + (size_t)k * 6144);
#pragma unroll
        for (int r = 0; r < 9; r++) {
          const float s = sc[r * 1024 + k];
          acc[r][0] += s * wv.x; acc[r][1] += s * wv.y; acc[r][2] += s * wv.z; acc[r][3] += s * wv.w;
        }
      }
#pragma unroll
      for (int r = 0; r < 9; r++)
#pragma unroll
        for (int c = 0; c < 4; c++) {
          float v = acc[r][c];
          v += __shfl_xor(v, 8); v = xor16_sum(v); v = xor32_sum(v);
          acc[r][c] = v;
        }
      if (lane < 8) {
#pragma unroll
        for (int r = 0; r < 9; r++)
#pragma unroll
          for (int c = 0; c < 4; c++) red[(wave * 9 + r) * 32 + cgp * 4 + c] = acc[r][c];
      }
      __syncthreads();
      float* MOD = (float*)(P.ws + OFF_MOD);
      for (int i = tid; i < 288; i += 256) {
        int r = i >> 5, c = i & 31;
        float s = red[(0 * 9 + r) * 32 + c] + red[(1 * 9 + r) * 32 + c] + red[(2 * 9 + r) * 32 + c] + red[(3 * 9 + r) * 32 + c];
        MOD[(l * 9 + r) * 6144 + n0 + c] = s + P.in[9][l * 6144 + n0 + c];
      }
      __syncthreads();
      continue;
    }
    j -= N_MOD;
    if (j < N_FF) {
      const int g = j >> 4, kt = j & 15;
      if (tid < 64) { tabc[tid] = cospif(tid / 32.0f); tabs[tid] = sinpif(tid / 32.0f); }
      const float* src = P.in[12] + (size_t)(kt * 64) * 1536 + g * 64;
#pragma unroll
      for (int i = 0; i < 4; i++) {
        int r = i * 16 + (tid >> 4), c4 = (tid & 15) * 4;
        float4 v = *(const float4*)(src + (size_t)r * 1536 + c4);
        tile[r * 65 + c4] = v.x; tile[r * 65 + c4 + 1] = v.y; tile[r * 65 + c4 + 2] = v.z; tile[r * 65 + c4 + 3] = v.w;
      }
      __syncthreads();
      const int np = tid & 127, kh = tid >> 7;
      const int wsel = np >> 6, cp = np & 63;
      float acc[32];
#pragma unroll
      for (int i = 0; i < 32; i++) acc[i] = 0.f;
      for (int c = 0; c < 64; c++) {
        const int idx = (c * cp) & 63;
        const float coef = wsel ? tabs[idx] : tabc[idx];
#pragma unroll
        for (int i = 0; i < 32; i++) acc[i] += tile[(kh * 32 + i) * 65 + c] * coef;
      }
      u16* dst = (u16*)(P.ws + OFF_WIE) + (size_t)(g * 128 + np) * 1024 + kt * 64 + kh * 32;
#pragma unroll
      for (int i = 0; i < 4; i++) {
        uint4 o;
        o.x = pack2(acc[i * 8 + 0], acc[i * 8 + 1]); o.y = pack2(acc[i * 8 + 2], acc[i * 8 + 3]);
        o.z = pack2(acc[i * 8 + 4], acc[i * 8 + 5]); o.w = pack2(acc[i * 8 + 6], acc[i * 8 + 7]);
        *(uint4*)(dst + i * 8) = o;
      }
      __syncthreads();
      continue;
    }
    j -= N_FF;
    if (j < N_TR) continue;
    j -= N_TR;
    if (j < N_DFT) {
      if (j < 512) {
        u16* D = (u16*)(P.ws + OFF_D1K);
        const int e0 = j * 4096;
        for (int i = 0; i < 16; i++) {
          int e = e0 + i * 256 + tid;
          int sp = e >> 11, k = e & 2047;
          float v;
          if (k < 1024) { int r = (sp * k) & 1023; v = cospif(r * (1.0f / 512.0f)); }
          else { int r = (sp * (k - 1024)) & 1023; v = -sinpif(r * (1.0f / 512.0f)); }
          D[e] = f2bf(v * (1.0f / 256.0f));
        }
      } else {
        u16* D = (u16*)(P.ws + OFF_D256);
        const int e0 = (j - 512) * 4096;
        for (int i = 0; i < 16; i++) {
          int e = e0 + i * 256 + tid;
          int sp = e >> 9, k = e & 511;
          float v;
          if (k < 256) { int r = (sp * k) & 255; v = cospif(r * (1.0f / 128.0f)); }
          else { int r = (sp * (k - 256)) & 255; v = -sinpif(r * (1.0f / 128.0f)); }
          D[e] = f2bf(v * (1.0f / 128.0f));
        }
      }
      continue;
    }
    j -= N_DFT;
    {
      const bool isv = j >= 256;
      const int e0 = (isv ? j - 256 : j) * 4096;
      const float* src = isv ? P.in[4] : P.in[3];
      u16* KB = (u16*)(P.ws + OFF_KBS);
      u16* VT = (u16*)(P.ws + OFF_VTS);
      for (int i = 0; i < 16; i++) {
        int e = e0 + i * 256 + tid;
        int b = e >> 17, p = (e >> 8) & 511, h = (e >> 6) & 3, d = e & 63;
        u16 v = f2bf(src[e]);
        if (!isv) KB[((size_t)(b * 4 + h) * 1536 + 1024 + p) * 64 + d] = v;
        else VT[((size_t)(b * 4 + h) * 64 + d) * 1536 + 1024 + p] = v;
      }
    }
  }
  for (int j0 = bid; j0 < N_TR; j0 += 2 * nb) {
    const int j1 = j0 + nb;
    const bool has1 = j1 < N_TR;
    const TrDesc d0 = tr_desc(P, j0);
    const TrDesc d1 = tr_desc(P, has1 ? j1 : j0);
    float4 v0[4], v1[4];
    tr_load(d0, tid, v0);
    tr_load(d1, tid, v1);
    tr_emit(d0, tid, v0, tile);
    if (has1) tr_emit(d1, tid, v1, tile);
  }
}

__device__ __forceinline__ void phase_norm(const Params& P, int l, int which) {
  const int tid = threadIdx.x, lane = tid & 63, wave = tid >> 6;
  const float* MOD = (const float*)(P.ws + OFF_MOD);
  const float* gvec = PRM(P, (which ? PRM_NORM_FFN : PRM_NORM_MIX) + l * 1024);
  u16* H = (u16*)(P.ws + OFF_H);
  const int nwaves = gridDim.x * 4;
  const int rpw = (T_ALL + nwaves - 1) / nwaves;
  const int r0 = (blockIdx.x * 4 + wave) * rpw;
  const int r1 = min(r0 + rpw, T_ALL);
  constexpr int NR = 3;
  const int osh = (which ? 3 : 0) * 1024, osc = (which ? 4 : 1) * 1024;
  float4 gm[4], sh[4];
  int cached = -1;
  for (int t0 = r0; t0 < r1; t0 += NR) {
    float4 v[NR][4];
#pragma unroll
    for (int r = 0; r < NR; r++) {
      const int t = min(t0 + r, r1 - 1);
      const float* x = (l == 0 && which == 0) ? xin(P, t) : P.out + (size_t)t * 1024;
#pragma unroll
      for (int j = 0; j < 4; j++) v[r][j] = *(const float4*)(x + j * 256 + lane * 4);
    }
    float ss[NR];
#pragma unroll
    for (int r = 0; r < NR; r++) {
      float a = 0.f;
#pragma unroll
      for (int j = 0; j < 4; j++) a += v[r][j].x * v[r][j].x + v[r][j].y * v[r][j].y + v[r][j].z * v[r][j].z + v[r][j].w * v[r][j].w;
      ss[r] = a;
    }
#pragma unroll
    for (int o = 32; o >= 1; o >>= 1) {
#pragma unroll
      for (int r = 0; r < NR; r++) ss[r] += __shfl_xor(ss[r], o);
    }
#pragma unroll
    for (int r = 0; r < NR; r++) {
      const int t = t0 + r;
      if (t >= r1) continue;
      const int cr = cond_row(t);
      if (cr != cached) {
        cached = cr;
        const float* mb = MOD + (size_t)(l * 9 + cr) * 6144;
#pragma unroll
        for (int j = 0; j < 4; j++) {
          const int c = j * 256 + lane * 4;
          const float4 g = *(const float4*)(gvec + c);
          const float4 cm = *(const float4*)(mb + osc + c);
          sh[j] = *(const float4*)(mb + osh + c);
          gm[j] = make_float4(g.x * (1.f + cm.x), g.y * (1.f + cm.y), g.z * (1.f + cm.z), g.w * (1.f + cm.w));
        }
      }
      const float rs = rsqrtf(ss[r] * (1.0f / 1024.0f) + 1e-6f);
#pragma unroll
      for (int j = 0; j < 4; j++) {
        const int c = j * 256 + lane * 4;
        uint2 o;
        o.x = pack2(v[r][j].x * rs * gm[j].x + sh[j].x, v[r][j].y * rs * gm[j].y + sh[j].y);
        o.y = pack2(v[r][j].z * rs * gm[j].z + sh[j].z, v[r][j].w * rs * gm[j].w + sh[j].w);
        *(uint2*)(H + (size_t)t * 1024 + c) = o;
      }
    }
  }
}

__device__ __forceinline__ void phase_gemm_in_even(const Params& P, char* smem) {
  const int tid = threadIdx.x, lane = tid & 63, wave = tid >> 6;
  const int wm = wave >> 1, wn = wave & 1, fr = lane & 15, fq = lane >> 4;
  const u16* A = (const u16*)(P.ws + OFF_H);
  const u16* W = (const u16*)(P.ws + OFF_WIE);
  constexpr int MT = 96, NT = 14;
  for (TileIter ti(MT * NT); ti.cur < ti.end; ti.cur += ti.step) {
    int mtile, ntile;
    tile_coords(ti.cur, MT, NT, mtile, ntile);
    const int m0 = mtile * 128, n0 = ntile * 128;
    f32x4 acc[4][4];
    const bool swap = (ntile >= 4 && ntile < 12);
    if (swap) gemm_mainloop<true, 4>(A + (size_t)m0 * 1024, 1024, W + (size_t)n0 * 1024, 1024, 1024, (u16*)smem, acc);
    else gemm_mainloop<false, 4>(A + (size_t)m0 * 1024, 1024, W + (size_t)n0 * 1024, 1024, 1024, (u16*)smem, acc);
    const bool smp = m0 >= T_CTX;
    if (ntile < 4) {
      const int g = ntile;
      u16* YT; int S, seq, sbase;
      if (smp) { YT = (u16*)(P.ws + OFF_YTS); S = 1024; seq = (m0 - T_CTX) >> 10; sbase = (m0 - T_CTX) & 1023; }
      else { YT = (u16*)(P.ws + OFF_YTC); S = 256; seq = m0 >> 8; sbase = m0 & 255; }
      u16* base = YT + (size_t)seq * 256 * 2 * S;
#pragma unroll
      for (int mt = 0; mt < 4; mt++)
#pragma unroll
        for (int nt = 0; nt < 4; nt++) {
          const int s = sbase + wm * 64 + mt * 16 + fq * 4;
          const int cp = nt * 16 + fr;
          uint2 o;
          o.x = pack2(acc[mt][nt][0], acc[mt][nt][1]);
          o.y = pack2(acc[mt][nt][2], acc[mt][nt][3]);
          *(uint2*)(base + (size_t)(g * 64 + cp) * 2 * S + wn * S + s) = o;
        }
    } else if (ntile < 12) {
      const bool isq = ntile < 10;
      const int hcol = n0 + wn * 64 - (isq ? 512 : 1280);
      const int head = hcol >> 6;
      const float* gn = PRM(P, isq ? PRM_QN : PRM_KN);
      float gv[4][4];
#pragma unroll
      for (int nt = 0; nt < 4; nt++)
#pragma unroll
        for (int r = 0; r < 4; r++) gv[nt][r] = gn[nt * 16 + fq * 4 + r];
      float fre[4];
#pragma unroll
      for (int r = 0; r < 4; r++) fre[r] = exp2f(-(float)(fq * 4 + r) * (13.287712379549449f / 16.0f));
#pragma unroll
      for (int mt = 0; mt < 4; mt++) {
        const int t = m0 + wm * 64 + mt * 16 + fr;
        float ss = 0.f;
#pragma unroll
        for (int nt = 0; nt < 4; nt++)
#pragma unroll
          for (int r = 0; r < 4; r++) ss += acc[mt][nt][r] * acc[mt][nt][r];
        ss = xor16_sum(ss);
        ss = xor32_sum(ss);
        const float rs = rsqrtf(ss * (1.0f / 64.0f) + 1e-6f);
        float v[4][4];
#pragma unroll
        for (int nt = 0; nt < 4; nt++)
#pragma unroll
          for (int r = 0; r < 4; r++) v[nt][r] = acc[mt][nt][r] * rs * gv[nt][r];
        if (!smp && !isq) {
          float* nk = P.out + 12582912 + (size_t)t * 256 + head * 64;
#pragma unroll
          for (int nt = 0; nt < 4; nt++)
            *(float4*)(nk + nt * 16 + fq * 4) = make_float4(v[nt][0], v[nt][1], v[nt][2], v[nt][3]);
        }
        if (smp) {
          const int s = (t - T_CTX) & 1023;
          const float prow = (float)(s >> 6), pcol = (float)(s & 63);
#pragma unroll
          for (int r = 0; r < 4; r++) {
            const float a0 = prow * fre[r], a1 = pcol * fre[r];
            const float c0 = __cosf(a0), s0 = __sinf(a0), c1 = __cosf(a1), s1 = __sinf(a1);
            const float x1 = v[0][r], x2 = v[1][r];
            v[0][r] = x1 * c0 - x2 * s0; v[1][r] = x2 * c0 + x1 * s0;
            const float y1 = v[2][r], y2 = v[3][r];
            v[2][r] = y1 * c1 - y2 * s1; v[3][r] = y2 * c1 + y1 * s1;
          }
        }
        if (isq) {
          const float qs = 0.125f * LOG2E;
          u16* q = (u16*)(P.ws + OFF_QB) + (size_t)t * 768 + head * 64;
#pragma unroll
          for (int nt = 0; nt < 4; nt++) {
            uint2 o;
            o.x = pack2(v[nt][0] * qs, v[nt][1] * qs);
            o.y = pack2(v[nt][2] * qs, v[nt][3] * qs);
            *(uint2*)(q + nt * 16 + fq * 4) = o;
          }
        } else {
          u16* kb;
          if (smp) { int sq = (t - T_CTX) >> 10, key = (t - T_CTX) & 1023; kb = (u16*)(P.ws + OFF_KBS) + ((size_t)(sq * 4 + head) * 1536 + key) * 64; }
          else { int sq = t >> 8, key = t & 255; kb = (u16*)(P.ws + OFF_KBC) + ((size_t)(sq * 4 + head) * 256 + key) * 64; }
#pragma unroll
          for (int nt = 0; nt < 4; nt++) {
            uint2 o;
            o.x = pack2(v[nt][0], v[nt][1]);
            o.y = pack2(v[nt][2], v[nt][3]);
            *(uint2*)(kb + nt * 16 + fq * 4) = o;
          }
        }
      }
    } else {
      const int head = (n0 + wn * 64 - 1536) >> 6;
#pragma unroll
      for (int mt = 0; mt < 4; mt++) {
        const int t = m0 + wm * 64 + mt * 16 + fq * 4;
#pragma unroll
        for (int nt = 0; nt < 4; nt++) {
          const int d = nt * 16 + fr;
          uint2 o;
          o.x = pack2(acc[mt][nt][0], acc[mt][nt][1]);
          o.y = pack2(acc[mt][nt][2], acc[mt][nt][3]);
          if (smp) {
            int sq = (t - T_CTX) >> 10, key = (t - T_CTX) & 1023;
            *(uint2*)((u16*)(P.ws + OFF_VTS) + ((size_t)(sq * 4 + head) * 64 + d) * 1536 + key) = o;
          } else {
            int sq = t >> 8, key = t & 255;
            *(uint2*)((u16*)(P.ws + OFF_VTC) + ((size_t)(sq * 4 + head) * 64 + d) * 256 + key) = o;
            float* nv = P.out + 13631488 + (size_t)t * 256 + head * 64 + d;
#pragma unroll
            for (int r = 0; r < 4; r++) nv[(size_t)r * 256] = acc[mt][nt][r];
          }
        }
      }
    }
  }
}

__device__ __forceinline__ void phase_gemm_resid(const Params& P, char* smem, const u16* A, int lda, const u16* W, int K,
                                 int l, int gate_idx, bool from_x) {
  const int tid = threadIdx.x, lane = tid & 63, wave = tid >> 6;
  const int wm = wave >> 1, wn = wave & 1, fr = lane & 15, fq = lane >> 4;
  const float* MOD = (const float*)(P.ws + OFF_MOD);
  constexpr int MT = 64, NT = 8;
  for (TileIter ti(MT * NT); ti.cur < ti.end; ti.cur += ti.step) {
    int mtile, ntile;
    tile_coords(ti.cur, MT, NT, mtile, ntile);
    const int m0 = mtile * 192, n0 = ntile * 128;
    f32x4 acc[6][4];
    gemm_mainloop<true, 6>(A + (size_t)m0 * lda, lda, W + (size_t)n0 * K, K, K, (u16*)smem, acc);
#pragma unroll
    for (int mt = 0; mt < 6; mt++) {
      const int t = m0 + wm * 96 + mt * 16 + fr;
      const float* gp = MOD + (size_t)(l * 9 + cond_row(t)) * 6144 + gate_idx * 1024;
      const float* bp = from_x ? xin(P, t) : P.out + (size_t)t * 1024;
      float* op = P.out + (size_t)t * 1024;
#pragma unroll
      for (int nt = 0; nt < 4; nt++) {
        const int n = n0 + wn * 64 + nt * 16 + fq * 4;
        const float4 g = *(const float4*)(gp + n);
        const float4 b = *(const float4*)(bp + n);
        float4 o;
        o.x = b.x + g.x * acc[mt][nt][0]; o.y = b.y + g.y * acc[mt][nt][1];
        o.z = b.z + g.z * acc[mt][nt][2]; o.w = b.w + g.w * acc[mt][nt][3];
        *(float4*)(op + n) = o;
      }
    }
  }
}

template <int MTW>
__device__ __forceinline__ void ffn_up_tile(const u16* A, const u16* W, u16* U, char* smem, int m0, int n0) {
  const int tid = threadIdx.x, lane = tid & 63, wave = tid >> 6;
  const int wm = wave >> 1, wn = wave & 1, fr = lane & 15, fq = lane >> 4;
  f32x4 acc[MTW][4];
  gemm_mainloop<true, MTW>(A + (size_t)m0 * 1024, 1024, W + (size_t)n0 * 1024, 1024, 1024, (u16*)smem, acc);
#pragma unroll
  for (int mt = 0; mt < MTW; mt++) {
    const int t = m0 + wm * (16 * MTW) + mt * 16 + fr;
#pragma unroll
    for (int np = 0; np < 2; np++) {
      const int f = ((n0 + wn * 64) >> 1) + np * 16 + fq * 4;
      float r[4];
#pragma unroll
      for (int q = 0; q < 4; q++) r[q] = silu_f(acc[mt][np * 2][q]) * acc[mt][np * 2 + 1][q];
      uint2 o;
      o.x = pack2(r[0], r[1]); o.y = pack2(r[2], r[3]);
      *(uint2*)(U + (size_t)t * 2816 + f) = o;
    }
  }
}

__device__ __forceinline__ void phase_gemm_ffn_up(const Params& P, char* smem, int l) {
  const u16* A = (const u16*)(P.ws + OFF_H);
  const u16* W = (const u16*)(P.ws + OFF_W13) + (size_t)l * 5632 * 1024;
  u16* U = (u16*)(P.ws + OFF_R1);
  constexpr int MT = 48, NT = 44;
  constexpr int NFULL = 2048;
  for (TileIter ti(NFULL); ti.cur < ti.end; ti.cur += ti.step) {
    int mtile, ntile;
    tile_coords(ti.cur, MT, NT, mtile, ntile);
    ffn_up_tile<8>(A, W, U, smem, mtile * 256, ntile * 128);
  }
  for (TileIter ti((MT * NT - NFULL) * 4); ti.cur < ti.end; ti.cur += ti.step) {
    int mtile, ntile;
    tile_coords(NFULL + (ti.cur >> 2), MT, NT, mtile, ntile);
    ffn_up_tile<2>(A, W, U, smem, mtile * 256 + (ti.cur & 3) * 64, ntile * 128);
  }
}

__device__ __forceinline__ void phase_gemm_in_odd(const Params& P, char* smem) {
  const int tid = threadIdx.x, lane = tid & 63, wave = tid >> 6;
  const int wm = wave >> 1, wn = wave & 1, fr = lane & 15, fq = lane >> 4;
  const u16* A = (const u16*)(P.ws + OFF_H);
  const u16* W = (const u16*)(P.ws + OFF_WIO);
  u16* PO = (u16*)(P.ws + OFF_R1);
  float* DT = (float*)(P.ws + OFF_DT);
  constexpr int MT = 48, NT = 27;
  for (TileIter ti(MT * NT); ti.cur < ti.end; ti.cur += ti.step) {
    int mtile, ntile;
    tile_coords(ti.cur, MT, NT, mtile, ntile);
    const int m0 = mtile * 256, n0 = ntile * 128;
    f32x4 acc[8][4];
    gemm_mainloop<true>(A + (size_t)m0 * 1024, 1024, W + (size_t)n0 * 1024, 1024, 1024, (u16*)smem, acc);
#pragma unroll
    for (int mt = 0; mt < 8; mt++) {
      const int t = m0 + wm * 128 + mt * 16 + fr;
#pragma unroll
      for (int nt = 0; nt < 4; nt++) {
        const int n = n0 + wn * 64 + nt * 16 + fq * 4;
        uint2 o;
        o.x = pack2(acc[mt][nt][0], acc[mt][nt][1]);
        o.y = pack2(acc[mt][nt][2], acc[mt][nt][3]);
        *(uint2*)(PO + (size_t)t * 3456 + n) = o;
        if (n >= 3328 && n < 3360)
          *(float4*)(DT + (size_t)t * 32 + (n - 3328)) = make_float4(acc[mt][nt][0], acc[mt][nt][1], acc[mt][nt][2], acc[mt][nt][3]);
      }
    }
  }
}

__device__ __forceinline__ void fourier_tile(const Params& P, int item, char* smem) {
  const int tid = threadIdx.x, lane = tid & 63, wave = tid >> 6;
  const int wm = wave >> 1, wn = wave & 1, fr = lane & 15, fq = lane >> 4;
  const u16 *D, *YT; int S, tb, mtile, ntile;
  if (item < 128) {
    int seq = item >> 4, r = item & 15; mtile = r >> 1; ntile = r & 1; S = 1024; tb = T_CTX + seq * 1024;
    D = (const u16*)(P.ws + OFF_D1K); YT = (const u16*)(P.ws + OFF_YTS) + (size_t)seq * 256 * 2048;
  } else {
    item -= 128; int seq = item >> 2, r = item & 3; mtile = r >> 1; ntile = r & 1; S = 256; tb = seq * 256;
    D = (const u16*)(P.ws + OFF_D256); YT = (const u16*)(P.ws + OFF_YTC) + (size_t)seq * 256 * 512;
  }
  f32x4 acc[4][4];
  const int K = 2 * S;
  gemm_mainloop<true, 4>(D + (size_t)(mtile * 128) * K, K, YT + (size_t)(ntile * 128) * K, K, K, (u16*)smem, acc);
  u16* MIX = (u16*)(P.ws + OFF_H);
#pragma unroll
  for (int mt = 0; mt < 4; mt++) {
    const int t = tb + mtile * 128 + wm * 64 + mt * 16 + fr;
#pragma unroll
    for (int nt = 0; nt < 4; nt++) {
      const int n = ntile * 128 + wn * 64 + nt * 16 + fq * 4;
      uint2 o;
      o.x = pack2(acc[mt][nt][0], acc[mt][nt][1]);
      o.y = pack2(acc[mt][nt][2], acc[mt][nt][3]);
      *(uint2*)(MIX + (size_t)t * 1024 + n) = o;
    }
  }
}

__device__ __forceinline__ void attn_item(const Params& P, int item, char* smem) {
  const int tid = threadIdx.x, lane = tid & 63, wave = tid >> 6;
  const int fr = lane & 15, fq = lane >> 4;
  bool smp; int seq, head, qb;
  if (item < 768) { smp = true; seq = item / 96; int r = item % 96; head = r >> 3; qb = r & 7; }
  else { item -= 768; smp = false; seq = item / 24; int r = item % 24; head = r >> 1; qb = r & 1; }
  const int nkeys = smp ? 1536 : 256;
  const int tb = smp ? T_CTX + seq * 1024 : seq * 256;
  const int kvh = head / 3;
  const u16* Kp = (const u16*)(P.ws + (smp ? OFF_KBS : OFF_KBC)) + (size_t)((seq * 4 + kvh) * nkeys) * 64;
  const u16* Vp = (const u16*)(P.ws + (smp ? OFF_VTS : OFF_VTC)) + (size_t)((seq * 4 + kvh) * 64) * nkeys;
  const u16* QB = (const u16*)(P.ws + OFF_QB);
  u16* sK = (u16*)smem;
  u16* sV = sK + 2 * 64 * LDT;
  bf16x8 qf[2][2];
  const int qrow0 = tb + qb * 128 + wave * 32;
#pragma unroll
  for (int qt = 0; qt < 2; qt++)
#pragma unroll
    for (int kk = 0; kk < 2; kk++)
      qf[qt][kk] = *(const bf16x8*)(QB + (size_t)(qrow0 + qt * 16 + fr) * 768 + head * 64 + kk * 32 + fq * 8);
  f32x4 ot[2][4];
#pragma unroll
  for (int a = 0; a < 2; a++)
#pragma unroll
    for (int b = 0; b < 4; b++) ot[a][b] = f32x4{0.f, 0.f, 0.f, 0.f};
  float mrun[2] = {-INFINITY, -INFINITY}, lrun[2] = {0.f, 0.f};
  const int lrow = tid >> 3, lcol = (tid & 7) * 8;
  uint4 rk[2], rv[2];
#pragma unroll
  for (int i = 0; i < 2; i++) {
    rk[i] = *(const uint4*)(Kp + (size_t)(lrow + i * 32) * 64 + lcol);
    rv[i] = *(const uint4*)(Vp + (size_t)(lrow + i * 32) * nkeys + lcol);
  }
#pragma unroll
  for (int i = 0; i < 2; i++) {
    *(uint4*)(sK + (lrow + i * 32) * LDT + lcol) = rk[i];
    *(uint4*)(sV + (lrow + i * 32) * LDT + lcol) = rv[i];
  }
  __syncthreads();
  const int nkt = nkeys >> 6;
  for (int kt = 0; kt < nkt; kt++) {
    const int cur = kt & 1;
    const bool more = kt + 1 < nkt;
    if (more) {
      const int key0 = (kt + 1) * 64;
#pragma unroll
      for (int i = 0; i < 2; i++) {
        rk[i] = *(const uint4*)(Kp + (size_t)(key0 + lrow + i * 32) * 64 + lcol);
        rv[i] = *(const uint4*)(Vp + (size_t)(lrow + i * 32) * nkeys + key0 + lcol);
      }
    }
    const u16* cK = sK + cur * 64 * LDT;
    const u16* cV = sV + cur * 64 * LDT;
    f32x4 st[2][4];
#pragma unroll
    for (int k16 = 0; k16 < 4; k16++) {
      const bf16x8 kf0 = *(const bf16x8*)(cK + (k16 * 16 + fr) * LDT + fq * 8);
      const bf16x8 kf1 = *(const bf16x8*)(cK + (k16 * 16 + fr) * LDT + 32 + fq * 8);
#pragma unroll
      for (int qt = 0; qt < 2; qt++) {
        f32x4 z = f32x4{0.f, 0.f, 0.f, 0.f};
        z = MFMA(kf0, qf[qt][0], z);
        st[qt][k16] = MFMA(kf1, qf[qt][1], z);
      }
    }
    bf16x8 pf[2][2];
#pragma unroll
    for (int qt = 0; qt < 2; qt++) {
      float mx = st[qt][0][0];
#pragma unroll
      for (int k16 = 0; k16 < 4; k16++)
#pragma unroll
        for (int r = 0; r < 4; r++) mx = fmaxf(mx, st[qt][k16][r]);
      mx = xor16_max(mx);
      mx = xor32_max(mx);
      if (!__all(mx - mrun[qt] <= 8.0f)) {
        const float mnew = fmaxf(mrun[qt], mx);
        const float alpha = fexp2(mrun[qt] - mnew);
        mrun[qt] = mnew;
        lrun[qt] *= alpha;
#pragma unroll
        for (int dt = 0; dt < 4; dt++)
#pragma unroll
          for (int r = 0; r < 4; r++) ot[qt][dt][r] *= alpha;
      }
      const float mcur = mrun[qt];
      float ps = 0.f;
#pragma unroll
      for (int k16 = 0; k16 < 4; k16++)
#pragma unroll
        for (int r = 0; r < 4; r++) {
          const float p = fexp2(st[qt][k16][r] - mcur);
          st[qt][k16][r] = p;
          ps += p;
        }
      lrun[qt] += ps;
#pragma unroll
      for (int a = 0; a < 2; a++) {
        union { bf16x8 v; unsigned u[4]; } pk;
        pk.u[0] = pack2(st[qt][2 * a][0], st[qt][2 * a][1]);
        pk.u[1] = pack2(st[qt][2 * a][2], st[qt][2 * a][3]);
        pk.u[2] = pack2(st[qt][2 * a + 1][0], st[qt][2 * a + 1][1]);
        pk.u[3] = pack2(st[qt][2 * a + 1][2], st[qt][2 * a + 1][3]);
        pf[qt][a] = pk.v;
      }
    }
#pragma unroll
    for (int a = 0; a < 2; a++)
#pragma unroll
      for (int dt = 0; dt < 4; dt++) {
        union { bf16x8 v; uint2 h[2]; } vf;
        vf.h[0] = *(const uint2*)(cV + (dt * 16 + fr) * LDT + a * 32 + fq * 4);
        vf.h[1] = *(const uint2*)(cV + (dt * 16 + fr) * LDT + a * 32 + 16 + fq * 4);
#pragma unroll
        for (int qt = 0; qt < 2; qt++) ot[qt][dt] = MFMA(vf.v, pf[qt][a], ot[qt][dt]);
      }
    if (more) {
      u16* dK = sK + (cur ^ 1) * 64 * LDT;
      u16* dV = sV + (cur ^ 1) * 64 * LDT;
#pragma unroll
      for (int i = 0; i < 2; i++) {
        *(uint4*)(dK + (lrow + i * 32) * LDT + lcol) = rk[i];
        *(uint4*)(dV + (lrow + i * 32) * LDT + lcol) = rv[i];
      }
    }
    __syncthreads();
  }
  u16* MIX = (u16*)(P.ws + OFF_H);
#pragma unroll
  for (int qt = 0; qt < 2; qt++) {
    float l = lrun[qt];
    l = xor16_sum(l);
    l = xor32_sum(l);
    const float inv = __builtin_amdgcn_rcpf(l);
    const int t = qrow0 + qt * 16 + fr;
#pragma unroll
    for (int dt = 0; dt < 4; dt++) {
      uint2 o;
      o.x = pack2(ot[qt][dt][0] * inv, ot[qt][dt][1] * inv);
      o.y = pack2(ot[qt][dt][2] * inv, ot[qt][dt][3] * inv);
      *(uint2*)(MIX + (size_t)t * 1024 + 256 + head * 64 + dt * 16 + fq * 4) = o;
    }
  }
}

__device__ __forceinline__ void phase_even_mix(const Params& P, char* smem, int* qsh, const int rep) {
  unsigned* ctr = (unsigned*)(P.ws + OFF_Q + rep * 512);
  for (;;) {
    const int it = queue_next(ctr, qsh);
    if (it >= 1344) break;
    if (it < 128) fourier_tile(P, it, smem);
    else if (it < 896) attn_item(P, it - 128, smem);
    else if (it < 960) fourier_tile(P, it - 896 + 128, smem);
    else attn_item(P, it - 960 + 768, smem);
  }
}

__device__ __forceinline__ void ssd_conv8(const u16* __restrict__ PO, int col, const float* __restrict__ cw,
                                          const float* __restrict__ cb, int ch, int tg0, int lo, int hi,
                                          float (&o)[4][8]) {
  uint4 v[7];
#pragma unroll
  for (int r = 0; r < 7; r++) {
    const int t = tg0 - 1 + r;
    v[r] = make_uint4(0u, 0u, 0u, 0u);
    if (t >= lo && t < hi) v[r] = *(const uint4*)(PO + (size_t)t * 3456 + col);
  }
  float w[4][8], b[8];
#pragma unroll
  for (int j = 0; j < 4; j++) {
    const float4 w0 = *(const float4*)(cw + j * 1280 + ch);
    const float4 w1 = *(const float4*)(cw + j * 1280 + ch + 4);
    w[j][0] = w0.x; w[j][1] = w0.y; w[j][2] = w0.z; w[j][3] = w0.w;
    w[j][4] = w1.x; w[j][5] = w1.y; w[j][6] = w1.z; w[j][7] = w1.w;
  }
  {
    const float4 b0 = *(const float4*)(cb + ch);
    const float4 b1 = *(const float4*)(cb + ch + 4);
    b[0] = b0.x; b[1] = b0.y; b[2] = b0.z; b[3] = b0.w; b[4] = b1.x; b[5] = b1.y; b[6] = b1.z; b[7] = b1.w;
  }
#pragma unroll
  for (int tok = 0; tok < 4; tok++)
#pragma unroll
    for (int e = 0; e < 8; e++) o[tok][e] = b[e];
#pragma unroll
  for (int r = 0; r < 7; r++) {
    const unsigned uu[4] = {v[r].x, v[r].y, v[r].z, v[r].w};
#pragma unroll
    for (int e = 0; e < 8; e++) {
      const float x = __uint_as_float((e & 1) ? (uu[e >> 1] & 0xffff0000u) : (uu[e >> 1] << 16));
#pragma unroll
      for (int tok = 0; tok < 4; tok++) {
        const int j = r - tok;
        if (j >= 0 && j < 4) o[tok][e] += w[j][e] * x;
      }
    }
  }
#pragma unroll
  for (int tok = 0; tok < 4; tok++)
#pragma unroll
    for (int e = 0; e < 8; e++) o[tok][e] = silu_f(o[tok][e]);
}


__device__ __forceinline__ void phase_odd_conv(const Params& P) {
  const u16* PO = (const u16*)(P.ws + OFF_R1);
  u16* XC = (u16*)(P.ws + OFF_H);
  const float* cw = PRM(P, PRM_CSW);
  const float* cb = PRM(P, PRM_CSB);
  constexpr int NRUN = T_ALL / 16;
  const int nthr = gridDim.x * 256;
  for (int idx = blockIdx.x * 256 + threadIdx.x; idx < NRUN * 160; idx += nthr) {
    const int c8 = idx % 160, run = idx / 160;
    const int tb16 = run * 16;
    int lo, hi;
    if (tb16 < T_CTX) { lo = tb16 & ~255; hi = lo + 256; }
    else { lo = T_CTX + ((tb16 - T_CTX) & ~1023); hi = lo + 1024; }
    const int ch = c8 * 8;
    float w[4][8], bb[8];
#pragma unroll
    for (int j = 0; j < 4; j++) {
      const float4 w0 = *(const float4*)(cw + j * 1280 + ch);
      const float4 w1 = *(const float4*)(cw + j * 1280 + ch + 4);
      w[j][0] = w0.x; w[j][1] = w0.y; w[j][2] = w0.z; w[j][3] = w0.w;
      w[j][4] = w1.x; w[j][5] = w1.y; w[j][6] = w1.z; w[j][7] = w1.w;
    }
    {
      const float4 b0 = *(const float4*)(cb + ch);
      const float4 b1 = *(const float4*)(cb + ch + 4);
      bb[0] = b0.x; bb[1] = b0.y; bb[2] = b0.z; bb[3] = b0.w; bb[4] = b1.x; bb[5] = b1.y; bb[6] = b1.z; bb[7] = b1.w;
    }
    const u16* src = PO + 2048 + ch;
    u32x4 v[19];
#pragma unroll
    for (int r = 0; r < 19; r++) {
      const int t = tb16 - 1 + r;
      v[r] = u32x4{0u, 0u, 0u, 0u};
      if (t >= lo && t < hi) v[r] = *(const u32x4*)(src + (size_t)t * 3456);
    }
#pragma unroll
    for (int tok = 0; tok < 16; tok++) {
      float o[8];
#pragma unroll
      for (int e = 0; e < 8; e++) o[e] = bb[e];
#pragma unroll
      for (int j = 0; j < 4; j++) {
        const u32x4 vv = v[tok + j];
        const unsigned uu[4] = {vv.x, vv.y, vv.z, vv.w};
#pragma unroll
        for (int e = 0; e < 8; e++) {
          const float x = __uint_as_float((e & 1) ? (uu[e >> 1] & 0xffff0000u) : (uu[e >> 1] << 16));
          o[e] += w[j][e] * x;
        }
      }
      uint4 w4;
      w4.x = pack2(silu_f(o[0]), silu_f(o[1])); w4.y = pack2(silu_f(o[2]), silu_f(o[3]));
      w4.z = pack2(silu_f(o[4]), silu_f(o[5])); w4.w = pack2(silu_f(o[6]), silu_f(o[7]));
      *(uint4*)(XC + (size_t)(tb16 + tok) * 1280 + ch) = w4;
    }
  }
}

__device__ __forceinline__ void ssd_item(const Params& P, int item, char* smem) {
  const int tid = threadIdx.x, lane = tid & 63, wave = tid >> 6;
  const int fr = lane & 15, fq = lane >> 4;
  bool smp; int seq;
  if (item < 256) { smp = true; seq = item >> 5; }
  else { item -= 256; smp = false; seq = item >> 5; }
  const int head = (item & 31) >> 1, dir = item & 1;
  const int nc = smp ? 8 : 2;
  const int tb = smp ? T_CTX + seq * 1024 : seq * 256;
  const int tend = tb + (smp ? 1024 : 256);
  const int g = head >> 3;
  u16* Cs = (u16*)smem;
  u16* Bs = (u16*)(smem + 18432);
  u16* BT = (u16*)(smem + 36864);
  u16* XT = (u16*)(smem + 54272);
  u16* Hb = (u16*)(smem + 71680);
  float* cum2 = (float*)(smem + 79872);
  float* lcs2 = (float*)(smem + 80384);
  float* misc = (float*)(smem + 81408);
  const u16* PO = (const u16*)(P.ws + OFF_R1);
  const float* DT = (const float*)(P.ws + OFF_DT);
  u16* YO = (u16*)(P.ws + OFF_Y) + (size_t)dir * T_ALL * 1024;
  const float Aneg = -__expf(PRM(P, PRM_ALOG)[dir * 16 + head]);
  const float dtb = PRM(P, PRM_DTB)[dir * 16 + head];
  const float Dh = PRM(P, PRM_SSDD)[head];
  f32x4 hacc[4];
#pragma unroll
  for (int nt = 0; nt < 4; nt++) {
#pragma unroll
    for (int r = 0; r < 4; r++) {
      float v = 0.f;
      if (smp) v = P.in[6][(size_t)((seq * 2 + dir) * 16 + head) * 4096 + (wave * 16 + fq * 4 + r) * 64 + nt * 16 + fr];
      hacc[nt][r] = v;
      Hb[(wave * 16 + fq * 4 + r) * 64 + nt * 16 + fr] = f2bf(v);
    }
  }
  const int ch8 = (tid & 7) * 8, rg = tid >> 3;
  const u16* XC = (const u16*)(P.ws + OFF_H);
  u32x4 rx0, rx1, rx2, rx3, rb0, rb1, rb2, rb3;
  float raw_next = 0.f;
  {
    const int c0 = dir ? nc - 1 : 0;
    const u16* xr = XC + (size_t)(tb + c0 * 128 + rg * 4) * 1280 + ch8;
    rx0 = *(const u32x4*)(xr + head * 64); rx1 = *(const u32x4*)(xr + 1280 + head * 64);
    rx2 = *(const u32x4*)(xr + 2560 + head * 64); rx3 = *(const u32x4*)(xr + 3840 + head * 64);
    rb0 = *(const u32x4*)(xr + 1024 + g * 64); rb1 = *(const u32x4*)(xr + 1280 + 1024 + g * 64);
    rb2 = *(const u32x4*)(xr + 2560 + 1024 + g * 64); rb3 = *(const u32x4*)(xr + 3840 + 1024 + g * 64);
    if (tid < 128) raw_next = DT[(size_t)(tb + c0 * 128 + (dir ? 127 - tid : tid)) * 32 + dir * 16 + head];
  }
  for (int ci = 0; ci < nc; ci++) {
    const int c = dir ? nc - 1 - ci : ci;
    const int t0 = tb + c * 128;
    {
      const u16* xrc = XC + (size_t)(t0 + rg * 4) * 1280 + ch8 + 1152 + g * 64;
      const u32x4 rc0 = *(const u32x4*)(xrc), rc1 = *(const u32x4*)(xrc + 1280);
      const u32x4 rc2 = *(const u32x4*)(xrc + 2560), rc3 = *(const u32x4*)(xrc + 3840);
      {
        const unsigned u[4][4] = {{rx0.x, rx0.y, rx0.z, rx0.w}, {rx1.x, rx1.y, rx1.z, rx1.w}, {rx2.x, rx2.y, rx2.z, rx2.w}, {rx3.x, rx3.y, rx3.z, rx3.w}};
#pragma unroll
        for (int q = 0; q < 4; q++) {
          uint2 lo2, hi2;
          lo2.x = (u[0][q] & 0xffffu) | (u[1][q] << 16); lo2.y = (u[2][q] & 0xffffu) | (u[3][q] << 16);
          hi2.x = (u[0][q] >> 16) | (u[1][q] & 0xffff0000u); hi2.y = (u[2][q] >> 16) | (u[3][q] & 0xffff0000u);
          *(uint2*)(XT + (ch8 + 2 * q) * 136 + rg * 4) = lo2;
          *(uint2*)(XT + (ch8 + 2 * q + 1) * 136 + rg * 4) = hi2;
        }
      }
      {
        const unsigned u[4][4] = {{rb0.x, rb0.y, rb0.z, rb0.w}, {rb1.x, rb1.y, rb1.z, rb1.w}, {rb2.x, rb2.y, rb2.z, rb2.w}, {rb3.x, rb3.y, rb3.z, rb3.w}};
#pragma unroll
        for (int q = 0; q < 4; q++) {
          uint2 lo2, hi2;
          lo2.x = (u[0][q] & 0xffffu) | (u[1][q] << 16); lo2.y = (u[2][q] & 0xffffu) | (u[3][q] << 16);
          hi2.x = (u[0][q] >> 16) | (u[1][q] & 0xffff0000u); hi2.y = (u[2][q] >> 16) | (u[3][q] & 0xffff0000u);
          *(uint2*)(BT + (ch8 + 2 * q) * 136 + rg * 4) = lo2;
          *(uint2*)(BT + (ch8 + 2 * q + 1) * 136 + rg * 4) = hi2;
        }
        *(u32x4*)(Bs + (rg * 4 + 0) * LDT + ch8) = rb0;
        *(u32x4*)(Bs + (rg * 4 + 1) * LDT + ch8) = rb1;
        *(u32x4*)(Bs + (rg * 4 + 2) * LDT + ch8) = rb2;
        *(u32x4*)(Bs + (rg * 4 + 3) * LDT + ch8) = rb3;
      }
      *(u32x4*)(Cs + (rg * 4 + 0) * LDT + ch8) = rc0;
      *(u32x4*)(Cs + (rg * 4 + 1) * LDT + ch8) = rc1;
      *(u32x4*)(Cs + (rg * 4 + 2) * LDT + ch8) = rc2;
      *(u32x4*)(Cs + (rg * 4 + 3) * LDT + ch8) = rc3;
    }
    const float raw_cur = raw_next;
    __builtin_amdgcn_sched_barrier(0);
    if (ci + 1 < nc) {
      const int cn = dir ? nc - 2 - ci : ci + 1;
      const u16* xr = XC + (size_t)(tb + cn * 128 + rg * 4) * 1280 + ch8;
      rx0 = *(const u32x4*)(xr + head * 64); rx1 = *(const u32x4*)(xr + 1280 + head * 64);
      rx2 = *(const u32x4*)(xr + 2560 + head * 64); rx3 = *(const u32x4*)(xr + 3840 + head * 64);
      rb0 = *(const u32x4*)(xr + 1024 + g * 64); rb1 = *(const u32x4*)(xr + 1280 + 1024 + g * 64);
      rb2 = *(const u32x4*)(xr + 2560 + 1024 + g * 64); rb3 = *(const u32x4*)(xr + 3840 + 1024 + g * 64);
      if (tid < 128) raw_next = DT[(size_t)(tb + cn * 128 + (dir ? 127 - tid : tid)) * 32 + dir * 16 + head];
    }
    __builtin_amdgcn_sched_barrier(0);
    float sv = 0.f, dtv = 1.f;
    int li = 0;
    if (tid < 128) {
      li = dir ? 127 - tid : tid;
      const float raw = raw_cur + dtb;
      dtv = fmaxf(raw, 0.f) + log1pf(__expf(-fabsf(raw)));
      sv = dtv * Aneg;
#pragma unroll
      for (int o = 1; o < 64; o <<= 1) {
        const float u = __shfl_up(sv, o);
        if (lane >= o) sv += u;
      }
      if (tid == 63) misc[0] = sv;
    }
    __syncthreads();
    if (tid < 128) {
      if (wave == 1) sv += misc[0];
      cum2[li] = sv * LOG2E;
      lcs2[li] = (sv - __logf(dtv)) * LOG2E;
      if (tid == 127) misc[1] = sv * LOG2E;
    }
    __syncthreads();
    const float total2 = misc[1];
#pragma unroll 1
    for (int tt = 0; tt < 2; tt++) {
      const int Tt = wave * 2 + tt;
      const int tl = wave * 32 + tt * 16 + fr;
      bf16x8 cf[2];
#pragma unroll
      for (int kk = 0; kk < 2; kk++) cf[kk] = *(const bf16x8*)(Cs + tl * LDT + kk * 32 + fq * 8);
      f32x4 acc[4];
#pragma unroll
      for (int pt = 0; pt < 4; pt++) {
        const bf16x8 h0 = *(const bf16x8*)(Hb + (pt * 16 + fr) * 64 + fq * 8);
        const bf16x8 h1 = *(const bf16x8*)(Hb + (pt * 16 + fr) * 64 + 32 + fq * 8);
        f32x4 z = f32x4{0.f, 0.f, 0.f, 0.f};
        z = MFMA(h0, cf[0], z);
        acc[pt] = MFMA(h1, cf[1], z);
      }
      const float ct = cum2[tl];
      {
        const float e = fexp2(ct);
#pragma unroll
        for (int pt = 0; pt < 4; pt++)
#pragma unroll
          for (int r = 0; r < 4; r++) acc[pt][r] *= e;
      }
#pragma unroll 1
      for (int a = 0; a < 4; a++) {
        const bool ok = dir ? (2 * a + 1 >= Tt) : (2 * a <= Tt);
        if (!ok) continue;
        f32x4 g0 = f32x4{0.f, 0.f, 0.f, 0.f}, g1 = f32x4{0.f, 0.f, 0.f, 0.f};
#pragma unroll
        for (int kk = 0; kk < 2; kk++) {
          const bf16x8 b0 = *(const bf16x8*)(Bs + ((2 * a) * 16 + fr) * LDT + kk * 32 + fq * 8);
          const bf16x8 b1 = *(const bf16x8*)(Bs + ((2 * a + 1) * 16 + fr) * LDT + kk * 32 + fq * 8);
          g0 = MFMA(b0, cf[kk], g0);
          g1 = MFMA(b1, cf[kk], g1);
        }
        const float4 l0 = *(const float4*)(lcs2 + a * 32 + fq * 4);
        const float4 l1 = *(const float4*)(lcs2 + a * 32 + 16 + fq * 4);
        const float ls0[4] = {l0.x, l0.y, l0.z, l0.w};
        const float ls1[4] = {l1.x, l1.y, l1.z, l1.w};
        float m0[4], m1[4];
#pragma unroll
        for (int r = 0; r < 4; r++) {
          const int s0 = a * 32 + fq * 4 + r, s1 = s0 + 16;
          const bool ok0 = dir ? (s0 >= tl) : (s0 <= tl);
          const bool ok1 = dir ? (s1 >= tl) : (s1 <= tl);
          float v0 = ok0 ? g0[r] * fexp2(ct - ls0[r]) : 0.f;
          float v1 = ok1 ? g1[r] * fexp2(ct - ls1[r]) : 0.f;
          if (!dir && s0 == tl) v0 += Dh;
          if (!dir && s1 == tl) v1 += Dh;
          m0[r] = v0; m1[r] = v1;
        }
        union { bf16x8 v; unsigned u[4]; } pk;
        pk.u[0] = pack2(m0[0], m0[1]); pk.u[1] = pack2(m0[2], m0[3]);
        pk.u[2] = pack2(m1[0], m1[1]); pk.u[3] = pack2(m1[2], m1[3]);
#pragma unroll
        for (int pt = 0; pt < 4; pt++) {
          union { bf16x8 v; uint2 h[2]; } x;
          x.h[0] = *(const uint2*)(XT + (pt * 16 + fr) * 136 + a * 32 + fq * 4);
          x.h[1] = *(const uint2*)(XT + (pt * 16 + fr) * 136 + a * 32 + 16 + fq * 4);
          acc[pt] = MFMA(x.v, pk.v, acc[pt]);
        }
      }
      {
        const int t = t0 + tl;
#pragma unroll
        for (int pt = 0; pt < 4; pt++) {
          uint2 o;
          o.x = pack2(acc[pt][0], acc[pt][1]);
          o.y = pack2(acc[pt][2], acc[pt][3]);
          *(uint2*)(YO + (size_t)t * 1024 + head * 64 + pt * 16 + fq * 4) = o;
        }
      }
    }
    {
      const float et = fexp2(total2);
#pragma unroll
      for (int nt = 0; nt < 4; nt++)
#pragma unroll
        for (int r = 0; r < 4; r++) hacc[nt][r] *= et;
#pragma unroll 1
      for (int ks = 0; ks < 4; ks++) {
        union { bf16x8 v; unsigned u[4]; } xr, xw;
        xr.v = *(const bf16x8*)(XT + (wave * 16 + fr) * 136 + ks * 32 + fq * 8);
        const float4 la = *(const float4*)(lcs2 + ks * 32 + fq * 8);
        const float4 lb = *(const float4*)(lcs2 + ks * 32 + fq * 8 + 4);
        const float lw[8] = {la.x, la.y, la.z, la.w, lb.x, lb.y, lb.z, lb.w};
#pragma unroll
        for (int q = 0; q < 4; q++) {
          const float x0 = __uint_as_float(xr.u[q] << 16) * fexp2(total2 - lw[2 * q]);
          const float x1 = __uint_as_float(xr.u[q] & 0xffff0000u) * fexp2(total2 - lw[2 * q + 1]);
          xw.u[q] = pack2(x0, x1);
        }
#pragma unroll
        for (int nt = 0; nt < 4; nt++) {
          const bf16x8 bt = *(const bf16x8*)(BT + (nt * 16 + fr) * 136 + ks * 32 + fq * 8);
          hacc[nt] = MFMA(xw.v, bt, hacc[nt]);
        }
      }
    }
    __syncthreads();
#pragma unroll
    for (int nt = 0; nt < 4; nt++)
#pragma unroll
      for (int r = 0; r < 4; r++) Hb[(wave * 16 + fq * 4 + r) * 64 + nt * 16 + fr] = f2bf(hacc[nt][r]);
  }
  if (!smp) {
    float* ns = P.out + 14696448 + (size_t)((seq * 2 + dir) * 16 + head) * 4096;
#pragma unroll
    for (int nt = 0; nt < 4; nt++)
#pragma unroll
      for (int r = 0; r < 4; r++) ns[(wave * 16 + fq * 4 + r) * 64 + nt * 16 + fr] = hacc[nt][r];
  }
  __syncthreads();
}

__device__ __forceinline__ void lru_item(const Params& P, int item, char* smem) {
  const int tid = threadIdx.x, lane = tid & 63, wave = tid >> 6;
  const int fr = lane & 15, fq = lane >> 4;
  bool smp; int seq;
  if (item < 128) { smp = true; seq = item >> 4; }
  else { item -= 128; smp = false; seq = item >> 4; }
  const int blk = (item & 15) >> 1, dir = item & 1;
  const int nc = smp ? 16 : 4;
  const int tb = smp ? T_CTX + seq * 1024 : seq * 256;
  const int tend = tb + (smp ? 1024 : 256);
  u16* WaT = (u16*)smem;
  u16* WxT = (u16*)(smem + 9216);
  u16* xcb = (u16*)(smem + 18432);
  float* aL = (float*)(smem + 27648);
  float* bL = (float*)(smem + 45056);
  float* sA = (float*)(smem + 62464);
  float* sH = (float*)(smem + 63488);
  float* hc = (float*)(smem + 64512);
  float* cba = (float*)(smem + 65024);
  float* cbx = (float*)(smem + 65280);
  float* csp = (float*)(smem + 65536);
  const u16* PO = (const u16*)(P.ws + OFF_R1);
  u16* YO = (u16*)(P.ws + OFF_YL) + (size_t)dir * T_ALL * 512;
  {
    const float* wa = PRM(P, PRM_LWA) + (size_t)(dir * 8 + blk) * 4096;
    const float* wx = PRM(P, PRM_LWX) + (size_t)(dir * 8 + blk) * 4096;
    for (int e = tid; e < 4096; e += 256) {
      const int i = e >> 6, j = e & 63;
      WaT[j * LDT + i] = f2bf(wa[e]);
      WxT[j * LDT + i] = f2bf(wx[e]);
    }
    if (tid < 64) {
      const int ch = dir * 512 + blk * 64 + tid;
      cba[tid] = PRM(P, PRM_LBA)[ch];
      cbx[tid] = PRM(P, PRM_LBX)[ch];
      const float lam = -PRM(P, PRM_LAM)[ch];
      csp[tid] = 8.0f * (fmaxf(lam, 0.f) + log1pf(__expf(-fabsf(lam))));
      hc[tid] = smp ? P.in[5][(size_t)(seq * 2 + dir) * 512 + blk * 64 + tid] : 0.f;
    }
  }
  const int ch8 = (tid & 7) * 8, rg = tid >> 3;
  const float* cw = PRM(P, PRM_CLW);
  const float* cb = PRM(P, PRM_CLB);
  u32x4 pv0, pv1, pv2, pv3, pv4;
  {
    const int c0 = dir ? nc - 1 : 0;
    const int tn = tb + c0 * 64 + rg * 2 - 1;
    const int chg = blk * 64 + ch8;
    const u32x4 zz = {0u, 0u, 0u, 0u};
    pv0 = (tn >= tb) ? *(const u32x4*)(PO + (size_t)tn * 3456 + 512 + chg) : zz;
    pv1 = *(const u32x4*)(PO + (size_t)(tn + 1) * 3456 + 512 + chg);
    pv2 = *(const u32x4*)(PO + (size_t)(tn + 2) * 3456 + 512 + chg);
    pv3 = (tn + 3 < tend) ? *(const u32x4*)(PO + (size_t)(tn + 3) * 3456 + 512 + chg) : zz;
    pv4 = (tn + 4 < tend) ? *(const u32x4*)(PO + (size_t)(tn + 4) * 3456 + 512 + chg) : zz;
  }
  for (int ci = 0; ci < nc; ci++) {
    const int c = dir ? nc - 1 - ci : ci;
    const int t0 = tb + c * 64;
    const int cur = ci & 1;
    {
      const int chg = blk * 64 + ch8;
      const u32x4 v[5] = {pv0, pv1, pv2, pv3, pv4};
      if (ci + 1 < nc) {
        const int cn = dir ? nc - 2 - ci : ci + 1;
        const int tn = tb + cn * 64 + rg * 2 - 1;
        const u32x4 zz = {0u, 0u, 0u, 0u};
        pv0 = (tn >= tb) ? *(const u32x4*)(PO + (size_t)tn * 3456 + 512 + chg) : zz;
        pv1 = *(const u32x4*)(PO + (size_t)(tn + 1) * 3456 + 512 + chg);
        pv2 = *(const u32x4*)(PO + (size_t)(tn + 2) * 3456 + 512 + chg);
        pv3 = (tn + 3 < tend) ? *(const u32x4*)(PO + (size_t)(tn + 3) * 3456 + 512 + chg) : zz;
        pv4 = (tn + 4 < tend) ? *(const u32x4*)(PO + (size_t)(tn + 4) * 3456 + 512 + chg) : zz;
      }
      float o[2][8];
      {
        const float4 b0 = *(const float4*)(cb + chg);
        const float4 b1 = *(const float4*)(cb + chg + 4);
        const float bb[8] = {b0.x, b0.y, b0.z, b0.w, b1.x, b1.y, b1.z, b1.w};
#pragma unroll
        for (int e = 0; e < 8; e++) { o[0][e] = bb[e]; o[1][e] = bb[e]; }
      }
#pragma unroll
      for (int j = 0; j < 4; j++) {
        const float4 w0 = *(const float4*)(cw + j * 512 + chg);
        const float4 w1 = *(const float4*)(cw + j * 512 + chg + 4);
        const float ww[8] = {w0.x, w0.y, w0.z, w0.w, w1.x, w1.y, w1.z, w1.w};
#pragma unroll
        for (int tok = 0; tok < 2; tok++) {
          const unsigned uu[4] = {v[tok + j].x, v[tok + j].y, v[tok + j].z, v[tok + j].w};
#pragma unroll
          for (int e = 0; e < 8; e++) {
            const float x = __uint_as_float((e & 1) ? (uu[e >> 1] & 0xffff0000u) : (uu[e >> 1] << 16));
            o[tok][e] += ww[e] * x;
          }
        }
      }
#pragma unroll
      for (int tok = 0; tok < 2; tok++) {
        const int tl = rg * 2 + tok;
        *(float4*)(bL + tl * 68 + ch8) = make_float4(o[tok][0], o[tok][1], o[tok][2], o[tok][3]);
        *(float4*)(bL + tl * 68 + ch8 + 4) = make_float4(o[tok][4], o[tok][5], o[tok][6], o[tok][7]);
        uint4 w4;
        w4.x = pack2(o[tok][0], o[tok][1]); w4.y = pack2(o[tok][2], o[tok][3]);
        w4.z = pack2(o[tok][4], o[tok][5]); w4.w = pack2(o[tok][6], o[tok][7]);
        *(uint4*)(xcb + tl * LDT + ch8) = w4;
      }
    }
    __syncthreads();
    {
      bf16x8 xb[2];
#pragma unroll
      for (int kk = 0; kk < 2; kk++) xb[kk] = *(const bf16x8*)(xcb + (wave * 16 + fr) * LDT + kk * 32 + fq * 8);
      const int tl = wave * 16 + fr;
#pragma unroll
      for (int jt = 0; jt < 4; jt++) {
        f32x4 aR = f32x4{0.f, 0.f, 0.f, 0.f}, aI = f32x4{0.f, 0.f, 0.f, 0.f};
#pragma unroll
        for (int kk = 0; kk < 2; kk++) {
          const bf16x8 wa = *(const bf16x8*)(WaT + (jt * 16 + fr) * LDT + kk * 32 + fq * 8);
          const bf16x8 wx = *(const bf16x8*)(WxT + (jt * 16 + fr) * LDT + kk * 32 + fq * 8);
          aR = MFMA(wa, xb[kk], aR);
          aI = MFMA(wx, xb[kk], aI);
        }
        const int j4 = jt * 16 + fq * 4;
        const float4 xc = *(const float4*)(bL + tl * 68 + j4);
        const float4 ba = *(const float4*)(cba + j4);
        const float4 bx = *(const float4*)(cbx + j4);
        const float4 sp = *(const float4*)(csp + j4);
        const float xcv[4] = {xc.x, xc.y, xc.z, xc.w};
        const float bav[4] = {ba.x, ba.y, ba.z, ba.w};
        const float bxv[4] = {bx.x, bx.y, bx.z, bx.w};
        const float spv[4] = {sp.x, sp.y, sp.z, sp.w};
        float av[4], bv[4];
#pragma unroll
        for (int r = 0; r < 4; r++) {
          const float rr = sigmoid_f(aR[r] + bav[r]);
          const float ii = sigmoid_f(aI[r] + bxv[r]);
          const float la = -rr * spv[r];
          av[r] = __expf(la);
          bv[r] = __builtin_amdgcn_sqrtf(fmaxf(1.0f - av[r] * av[r], 0.f)) * ii * xcv[r];
        }
        *(float4*)(aL + tl * 68 + j4) = make_float4(av[0], av[1], av[2], av[3]);
        *(float4*)(bL + tl * 68 + j4) = make_float4(bv[0], bv[1], bv[2], bv[3]);
      }
    }
    __syncthreads();
    {
      const int j = lane, q = wave;
      float hreg[16], areg[16];
      float h = 0.f, Ap = 1.f;
#pragma unroll
      for (int i = 0; i < 16; i++) {
        const int tl = dir ? 63 - (q * 16 + i) : q * 16 + i;
        const float a = aL[tl * 68 + j], b = bL[tl * 68 + j];
        h = a * h + b;
        Ap *= a;
        hreg[i] = h;
        areg[i] = Ap;
      }
      sA[q * 64 + j] = Ap;
      sH[q * 64 + j] = h;
      __syncthreads();
      float Hin = hc[cur * 64 + j];
      for (int qq = 0; qq < q; qq++) Hin = sA[qq * 64 + j] * Hin + sH[qq * 64 + j];
#pragma unroll
      for (int i = 0; i < 16; i++) {
        const int tl = dir ? 63 - (q * 16 + i) : q * 16 + i;
        const float hv = hreg[i] + areg[i] * Hin;
        YO[(size_t)(t0 + tl) * 512 + blk * 64 + j] = f2bf(hv);
      }
      if (q == 3) hc[(cur ^ 1) * 64 + j] = sA[3 * 64 + j] * Hin + sH[3 * 64 + j];
    }
  }
  __syncthreads();
  if (!smp && tid < 64) {
    P.out[14680064 + (size_t)(seq * 2 + dir) * 512 + blk * 64 + tid] = hc[(nc & 1) * 64 + tid];
  }
  __syncthreads();
}

__device__ __forceinline__ void phase_odd_mix(const Params& P, char* smem, int* qsh, const int rep) {
  unsigned* ctr = (unsigned*)(P.ws + OFF_Q + 256 + rep * 512);
  for (;;) {
    const int it = queue_next(ctr, qsh);
    if (it >= 1152) break;
    bool is_ssd; int idx;
    if (it < 128) { is_ssd = false; idx = it; }
    else if (it < 384) { is_ssd = true; idx = it - 128; }
    else if (it < 640) { is_ssd = false; idx = it - 384 + 128; }
    else { is_ssd = true; idx = it - 640 + 256; }
    if (is_ssd) ssd_item(P, idx, smem);
    else lru_item(P, idx, smem);
  }
}

__device__ __forceinline__ void phase_odd_combine(const Params& P) {
  const int tid = threadIdx.x, lane = tid & 63, wave = tid >> 6;
  const u16* PO = (const u16*)(P.ws + OFF_R1);
  const u16* YSF = (const u16*)(P.ws + OFF_Y);
  const u16* YSB = YSF + (size_t)T_ALL * 1024;
  const u16* YLF = (const u16*)(P.ws + OFF_YL);
  const u16* YLB = YLF + (size_t)T_ALL * 512;
  u16* MIX = (u16*)(P.ws + OFF_H);
  const float* nrm = PRM(P, PRM_SNORM);
  float4 nr[2][2];
#pragma unroll
  for (int hh = 0; hh < 2; hh++) { nr[hh][0] = *(const float4*)(nrm + hh * 512 + lane * 8); nr[hh][1] = *(const float4*)(nrm + hh * 512 + lane * 8 + 4); }
  for (int t = blockIdx.x * 4 + wave; t < T_ALL; t += gridDim.x * 4) {
    {
      const int c = lane * 8;
      const uint4 f = *(const uint4*)(YLF + (size_t)t * 512 + c);
      const uint4 b = *(const uint4*)(YLB + (size_t)t * 512 + c);
      const uint4 gg = *(const uint4*)(PO + (size_t)t * 3456 + c);
      const unsigned fu[4] = {f.x, f.y, f.z, f.w}, bu[4] = {b.x, b.y, b.z, b.w}, gu[4] = {gg.x, gg.y, gg.z, gg.w};
      unsigned ou[4];
#pragma unroll
      for (int q = 0; q < 4; q++) {
        float r[2];
#pragma unroll
        for (int h = 0; h < 2; h++) {
          const float yf = h ? __uint_as_float(fu[q] & 0xffff0000u) : __uint_as_float(fu[q] << 16);
          const float yb = h ? __uint_as_float(bu[q] & 0xffff0000u) : __uint_as_float(bu[q] << 16);
          const float gv = h ? __uint_as_float(gu[q] & 0xffff0000u) : __uint_as_float(gu[q] << 16);
          const float ge = gv * __builtin_amdgcn_rcpf(1.f + __expf(-2.0f * 0.7978845608028654f * (gv + 0.044715f * gv * gv * gv)));
          r[h] = (yf + yb) * ge;
        }
        ou[q] = pack2(r[0], r[1]);
      }
      *(uint4*)(MIX + (size_t)t * 1536 + c) = make_uint4(ou[0], ou[1], ou[2], ou[3]);
    }
    float y[16];
    float ss = 0.f;
#pragma unroll
    for (int hh = 0; hh < 2; hh++) {
      const int c = hh * 512 + lane * 8;
      const uint4 f = *(const uint4*)(YSF + (size_t)t * 1024 + c);
      const uint4 b = *(const uint4*)(YSB + (size_t)t * 1024 + c);
      const uint4 zz = *(const uint4*)(PO + (size_t)t * 3456 + 1024 + c);
      const unsigned fu[4] = {f.x, f.y, f.z, f.w}, bu[4] = {b.x, b.y, b.z, b.w}, zu[4] = {zz.x, zz.y, zz.z, zz.w};
#pragma unroll
      for (int q = 0; q < 4; q++)
#pragma unroll
        for (int h = 0; h < 2; h++) {
          const float yf = h ? __uint_as_float(fu[q] & 0xffff0000u) : __uint_as_float(fu[q] << 16);
          const float yb = h ? __uint_as_float(bu[q] & 0xffff0000u) : __uint_as_float(bu[q] << 16);
          const float zv = h ? __uint_as_float(zu[q] & 0xffff0000u) : __uint_as_float(zu[q] << 16);
          const float v = (yf + yb) * silu_f(zv);
          y[hh * 8 + q * 2 + h] = v;
          ss += v * v;
        }
    }
#pragma unroll
    for (int o = 32; o >= 1; o >>= 1) ss += __shfl_xor(ss, o);
    const float rs = rsqrtf(ss * (1.0f / 1024.0f) + 1e-6f);
#pragma unroll
    for (int hh = 0; hh < 2; hh++) {
      const int c = hh * 512 + lane * 8;
      const float4 n0 = nr[hh][0];
      const float4 n1 = nr[hh][1];
      uint4 o;
      o.x = pack2(y[hh * 8 + 0] * rs * n0.x, y[hh * 8 + 1] * rs * n0.y);
      o.y = pack2(y[hh * 8 + 2] * rs * n0.z, y[hh * 8 + 3] * rs * n0.w);
      o.z = pack2(y[hh * 8 + 4] * rs * n1.x, y[hh * 8 + 5] * rs * n1.y);
      o.w = pack2(y[hh * 8 + 6] * rs * n1.z, y[hh * 8 + 7] * rs * n1.w);
      *(uint4*)(MIX + (size_t)t * 1536 + 512 + c) = o;
    }
  }
}

#ifndef PHMASK
#define PHMASK 0xffffffu
#endif
__device__ __forceinline__ void run_phase(const Params& P, const int ph, char* smem, int* qsh, const int rep = 0) {
  switch (ph) {
    case 0: if (PHMASK & (1u << 0)) phase_prep(P, smem); break;
    case 1: if (PHMASK & (1u << 1)) phase_norm(P, 0, 0); break;
    case 2: if (PHMASK & (1u << 2)) phase_gemm_in_even(P, smem); break;
    case 3: if (PHMASK & (1u << 3)) phase_even_mix(P, smem, qsh, rep); break;
    case 4: if (PHMASK & (1u << 4)) phase_gemm_resid(P, smem, (const u16*)(P.ws + OFF_H), 1024, (const u16*)(P.ws + OFF_WOE), 1024, 0, 2, true); break;
    case 5: if (PHMASK & (1u << 5)) phase_norm(P, 0, 1); break;
    case 6: if (PHMASK & (1u << 6)) phase_gemm_ffn_up(P, smem, 0); break;
    case 7: if (PHMASK & (1u << 7)) phase_gemm_resid(P, smem, (const u16*)(P.ws + OFF_R1), 2816, (const u16*)(P.ws + OFF_W2), 2816, 0, 5, false); break;
    case 8: if (PHMASK & (1u << 8)) phase_norm(P, 1, 0); break;
    case 9: if (PHMASK & (1u << 9)) phase_gemm_in_odd(P, smem); break;
    case 10: if (PHMASK & (1u << 10)) phase_odd_conv(P); break;
    case 11: if (PHMASK & (1u << 11)) phase_odd_mix(P, smem, qsh, rep); break;
    case 12: if (PHMASK & (1u << 12)) phase_odd_combine(P); break;
    case 13: if (PHMASK & (1u << 13)) phase_gemm_resid(P, smem, (const u16*)(P.ws + OFF_H), 1536, (const u16*)(P.ws + OFF_WOO), 1536, 1, 2, false); break;
    case 14: if (PHMASK & (1u << 14)) phase_norm(P, 1, 1); break;
    case 15: if (PHMASK & (1u << 15)) phase_gemm_ffn_up(P, smem, 1); break;
    case 16: if (PHMASK & (1u << 16)) phase_gemm_resid(P, smem, (const u16*)(P.ws + OFF_R1), 2816, (const u16*)(P.ws + OFF_W2) + (size_t)1024 * 2816, 2816, 1, 5, false); break;
    default: break;
  }
}

constexpr int N_PHASES = 17;

__global__ void __launch_bounds__(256, 2) mega_kernel(Params P, int ph_lo, int ph_hi) {
  __shared__ __attribute__((aligned(16))) char smem[SMEM_BYTES];
  __shared__ uint4 xb_words;
  __shared__ int q_item;
  cg::grid_group grid = cg::this_grid();
  if (threadIdx.x == 0) xb_words = make_uint4(0u, 0u, 0u, 0u);
  __syncthreads();
  XcdBarrier xb = xcd_barrier_post((unsigned*)(P.ws + OFF_BAR), (volatile LAS unsigned*)&xb_words);
  if (ph_lo < 0) grid.sync();
#ifndef DUP_PH
#define DUP_PH -1
#endif
#define RUN_PH(ph) if ((ph) >= ph_lo && (ph) < ph_hi) { run_phase(P, (ph), smem, &q_item); if (DUP_PH == (ph)) { xcd_barrier(xb); run_phase(P, (ph), smem, &q_item, 1); } if ((ph) + 1 < ph_hi) xcd_barrier(xb); }
  RUN_PH(0) RUN_PH(1) RUN_PH(2) RUN_PH(3) RUN_PH(4) RUN_PH(5) RUN_PH(6) RUN_PH(7)
  RUN_PH(8) RUN_PH(9) RUN_PH(10) RUN_PH(11) RUN_PH(12) RUN_PH(13) RUN_PH(14) RUN_PH(15) RUN_PH(16)
}

#ifndef MULTI_LAUNCH
#define MULTI_LAUNCH 0
#endif

extern "C" void kernel_launch(void* const* d_in, const int* in_sizes, int n_in, void* d_out, int out_size, void* d_ws,
                              size_t ws_size, hipStream_t stream) {
  static int grid_blocks = 0;
  if (!grid_blocks) {
    int dev = 0, cus = 0, per_cu = 0;
    (void)hipGetDevice(&dev);
    (void)hipDeviceGetAttribute(&cus, hipDeviceAttributeMultiprocessorCount, dev);
    (void)hipOccupancyMaxActiveBlocksPerMultiprocessor(&per_cu, mega_kernel, 256, 0);
    if (per_cu > 2) per_cu = 2;
    if (per_cu < 1) per_cu = 1;
    grid_blocks = cus * per_cu;
  }
  Params p;
  memset(&p, 0, sizeof(p));
  for (int i = 0; i < 34; i++) p.in[i] = (const float*)d_in[i];
  p.out = (float*)d_out;
  p.ws = (char*)d_ws;
#if MULTI_LAUNCH
  for (int ph = 0; ph < N_PHASES; ph++) {
    int lo = ph, hi = ph + 1;
    void* args[] = {&p, &lo, &hi};
    hipError_t e = hipLaunchCooperativeKernel((void*)mega_kernel, dim3(grid_blocks), dim3(256), args, 0, stream);
    if (e != hipSuccess) fprintf(stderr, "launch failed: %s (grid %d)\n", hipGetErrorString(e), grid_blocks);
  }
#else
  (void)hipMemsetAsync((char*)d_ws + OFF_BAR, 0, 17408, stream);
  int lo = 0, hi = N_PHASES;
  void* args[] = {&p, &lo, &hi};
  hipError_t e = hipLaunchCooperativeKernel((void*)mega_kernel, dim3(grid_blocks), dim3(256), args, 0, stream);
  if (e != hipSuccess) fprintf(stderr, "cooperative launch failed: %s (grid %d)\n", hipGetErrorString(e), grid_blocks);
#endif
}
```

```cpp
#include <hip/hip_runtime.h>
#include <hip/hip_bf16.h>
#include <hip/hip_cooperative_groups.h>
#include <cstdio>
#include <cstring>
namespace cg = cooperative_groups;

typedef unsigned short u16;
using bf16x8 = __attribute__((ext_vector_type(8))) short;
using bf16x4 = __attribute__((ext_vector_type(4))) short;
using f32x4 = __attribute__((ext_vector_type(4))) float;

#define MFMA(a, b, c) __builtin_amdgcn_mfma_f32_16x16x32_bf16(a, b, c, 0, 0, 0)
#define LOG2E 1.4426950408889634f

constexpr int T_ALL = 12288;
constexpr int T_CTX = 4096;
constexpr int SMEM_BYTES = 81664;
constexpr int LDT = 72;

constexpr size_t OFF_WIE = 0;
constexpr size_t OFF_WOE = OFF_WIE + 3670016;
constexpr size_t OFF_WIO = OFF_WOE + 2097152;
constexpr size_t OFF_WOO = OFF_WIO + 7077888;
constexpr size_t OFF_W13 = OFF_WOO + 3145728;
constexpr size_t OFF_W2 = OFF_W13 + 23068672;
constexpr size_t OFF_MOD = OFF_W2 + 11534336;
constexpr size_t OFF_D1K = OFF_MOD + 442368;
constexpr size_t OFF_D256 = OFF_D1K + 4194304;
constexpr size_t OFF_H = OFF_D256 + 262144;
constexpr size_t OFF_R1 = OFF_H + 37748736;
constexpr size_t OFF_Y = OFF_R1 + 84934656;
constexpr size_t OFF_YL = OFF_Y + 50331648;
constexpr size_t OFF_DT = OFF_YL + 25165824;
constexpr size_t OFF_BAR = OFF_DT + 1572864;
constexpr size_t OFF_PRM = OFF_BAR + 32768;
constexpr int PRM_NORM_MIX = 0, PRM_NORM_FFN = 2048, PRM_QN = 4096, PRM_KN = 4160, PRM_CLW = 4224, PRM_CLB = 6272,
              PRM_LBA = 6784, PRM_LBX = 7808, PRM_LAM = 8832, PRM_CSW = 9856, PRM_CSB = 14976, PRM_DTB = 16256,
              PRM_ALOG = 16288, PRM_SSDD = 16320, PRM_SNORM = 16384, PRM_LWA = 17408, PRM_LWX = 82944;
#define PRM(P, off) ((const float*)((P).ws + OFF_PRM) + (off))
constexpr size_t OFF_YTS = OFF_Y;
constexpr size_t OFF_YTC = OFF_Y + 8388608;
constexpr size_t OFF_QB = OFF_Y + 12582912;
constexpr size_t OFF_KBS = OFF_Y + 31457280;
constexpr size_t OFF_KBC = OFF_Y + 37748736;
constexpr size_t OFF_VTS = OFF_Y + 39845888;
constexpr size_t OFF_VTC = OFF_Y + 46137344;

struct Params {
  const float* in[34];
  float* out;
  char* ws;
};

typedef __bf16 bf16x2_t __attribute__((ext_vector_type(2)));
typedef float f32x2_t __attribute__((ext_vector_type(2)));
__device__ __forceinline__ unsigned pack2(float a, float b) {
  f32x2_t v = {a, b};
  bf16x2_t r = __builtin_convertvector(v, bf16x2_t);
  return __builtin_bit_cast(unsigned, r);
}
__device__ __forceinline__ u16 f2bf(float f) { return (u16)(pack2(f, 0.f) & 0xffffu); }
__device__ __forceinline__ float bf2f(u16 h) { return __uint_as_float(((unsigned)h) << 16); }
__device__ __forceinline__ float silu_f(float v) { return v * __builtin_amdgcn_rcpf(1.f + __expf(-v)); }
__device__ __forceinline__ float sigmoid_f(float v) { return __builtin_amdgcn_rcpf(1.f + __expf(-v)); }
__device__ __forceinline__ float fexp2(float v) { return __builtin_amdgcn_exp2f(v); }

__device__ __forceinline__ float xor16_sum(float x) {
  const unsigned u = __float_as_uint(x);
  auto r = __builtin_amdgcn_permlane16_swap(u, u, false, false);
  return __uint_as_float(r[0]) + __uint_as_float(r[1]);
}
__device__ __forceinline__ float xor32_sum(float x) {
  const unsigned u = __float_as_uint(x);
  auto r = __builtin_amdgcn_permlane32_swap(u, u, false, false);
  return __uint_as_float(r[0]) + __uint_as_float(r[1]);
}
__device__ __forceinline__ float xor16_max(float x) {
  const unsigned u = __float_as_uint(x);
  auto r = __builtin_amdgcn_permlane16_swap(u, u, false, false);
  return fmaxf(__uint_as_float(r[0]), __uint_as_float(r[1]));
}
__device__ __forceinline__ float xor32_max(float x) {
  const unsigned u = __float_as_uint(x);
  auto r = __builtin_amdgcn_permlane32_swap(u, u, false, false);
  return fmaxf(__uint_as_float(r[0]), __uint_as_float(r[1]));
}
__device__ __forceinline__ int cond_row(int t) { return t < T_CTX ? 8 : ((t - T_CTX) >> 10); }
__device__ __forceinline__ const float* xin(const Params& P, int t) {
  return t < T_CTX ? P.in[0] + (size_t)t * 1024 : P.in[1] + (size_t)(t - T_CTX) * 1024;
}


#define XB_TMO      128
#define XB_XCNT(j)  (256  + 64 * (j))
#define XB_XSUB(j)  (1280 + 64 * (j))
#define XB_XGEN(j)  (2304 + 64 * (j))
#define XB_TOP      3328
#define XB_TOPGEN   3392
#define XCD_BAR_WORDS 3456
#define XB_SPIN_CAP (1u << 22)
#define LAS __attribute__((address_space(3)))
__device__ __forceinline__ unsigned xb_ld(unsigned* p)              { return __hip_atomic_load(p, __ATOMIC_RELAXED, __HIP_MEMORY_SCOPE_AGENT); }
__device__ __forceinline__ unsigned xb_add(unsigned* p, unsigned v) { return __hip_atomic_fetch_add(p, v, __ATOMIC_RELAXED, __HIP_MEMORY_SCOPE_AGENT); }
__device__ __forceinline__ unsigned xb_xcc_id() { return (unsigned)__builtin_amdgcn_s_getreg((3 << 11) | 20) & 0xFu; }
#define XB_SPIN(cond, bar) do { unsigned _sp = 0; while (cond) { __builtin_amdgcn_s_sleep(1); \
    if ((++_sp & 255u) == 0u) { if (xb_ld(&(bar)[XB_TMO])) break; if (_sp > XB_SPIN_CAP) { atomicAdd(&(bar)[XB_TMO], 1u); break; } } } } while (0)
struct XcdBarrier { unsigned* bar; unsigned x; volatile LAS unsigned* st; };
__device__ __forceinline__ XcdBarrier xcd_barrier_post(unsigned* bar, volatile LAS unsigned* st) {
    XcdBarrier b; b.bar = bar; b.x = xb_xcc_id(); b.st = st;
    if (threadIdx.x == 0) (void)xb_add(&bar[XB_XCNT(b.x)], 1u);
    return b;
}
__device__ __forceinline__ void xcd_barrier_complete(unsigned* bar, unsigned x, unsigned& nloc, unsigned& nx) {
    const unsigned G = gridDim.x * gridDim.y * gridDim.z;
    unsigned sum, cnt, mine, sp = 0u;
    for (;;) {
        sum = 0u; cnt = 0u; mine = 0u;
#pragma unroll
        for (unsigned j = 0; j < 16; ++j) { const unsigned c = xb_ld(&bar[XB_XCNT(j)]); sum += c; cnt += (c > 0u) ? 1u : 0u; mine = (j == x) ? c : mine; }
        if (sum == G) break;
        __builtin_amdgcn_s_sleep(1);
        if ((++sp & 255u) == 0u) { if (xb_ld(&bar[XB_TMO])) break; if (sp > XB_SPIN_CAP) { atomicAdd(&bar[XB_TMO], 1u); break; } }
    }
    nloc = mine > 0u ? mine : 1u; nx = cnt > 0u ? cnt : 1u;
}
__device__ __forceinline__ void xcd_barrier(const XcdBarrier& b) {
    asm volatile("s_waitcnt vmcnt(0)" ::: "memory");
    __syncthreads();
    if (threadIdx.x == 0) {
        unsigned* bar = b.bar;
        __builtin_amdgcn_s_waitcnt(0);
        unsigned nloc = b.st[0], nx = b.st[1];
        if (nloc == 0u) { xcd_barrier_complete(bar, b.x, nloc, nx); b.st[0] = nloc; b.st[1] = nx; }
        const unsigned old = xb_add(&bar[XB_XSUB(b.x)], 1u);
        const unsigned gen = old / nloc;
        if (old + 1u == (gen + 1u) * nloc) {
            __builtin_amdgcn_fence(__ATOMIC_RELEASE, "agent");
            asm volatile("s_waitcnt vmcnt(0)" ::: "memory");
            const unsigned og = xb_add(&bar[XB_TOP], 1u);
            const unsigned tg = og / nx;
            if (og + 1u == (tg + 1u) * nx) xb_add(&bar[XB_TOPGEN], 1u);
            else XB_SPIN(xb_ld(&bar[XB_TOPGEN]) == tg, bar);
            __builtin_amdgcn_fence(__ATOMIC_ACQUIRE, "agent");
            xb_add(&bar[XB_XGEN(b.x)], 1u);
            asm volatile("s_waitcnt vmcnt(0)" ::: "memory");
        } else {
            XB_SPIN(xb_ld(&bar[XB_XGEN(b.x)]) == gen, bar);
            __builtin_amdgcn_fence(__ATOMIC_ACQUIRE, "agent");
            asm volatile("s_waitcnt vmcnt(0)" ::: "memory");
        }
    }
    __syncthreads();
}

using u32x4 = __attribute__((ext_vector_type(4))) unsigned int;
struct GRegs { u32x4 a0, a1, a2, a3, b0, b1; };
template <int MTW>
__device__ __forceinline__ void gemm_gload(GRegs& R, const u16* ga, const u16* gb, int lda, int ldb) {
  R.a0 = *(const u32x4*)(ga);
  R.a1 = *(const u32x4*)(ga + (size_t)64 * lda);
  R.a2 = *(const u32x4*)(ga + (size_t)128 * lda);
  if (MTW == 8) R.a3 = *(const u32x4*)(ga + (size_t)192 * lda);
  R.b0 = *(const u32x4*)(gb);
  R.b1 = *(const u32x4*)(gb + (size_t)64 * ldb);
}
template <int MTW>
__device__ __forceinline__ void gemm_swrite(const GRegs& R, u16* dA, u16* dB) {
  *(u32x4*)(dA) = R.a0;
  *(u32x4*)(dA + 64 * 40) = R.a1;
  *(u32x4*)(dA + 128 * 40) = R.a2;
  if (MTW == 8) *(u32x4*)(dA + 192 * 40) = R.a3;
  *(u32x4*)(dB) = R.b0;
  *(u32x4*)(dB + 64 * 40) = R.b1;
}

template <bool SWAP, int MTW>
__device__ __forceinline__ void gemm_compute_tile(const u16* cA, const u16* cB, f32x4 (&acc)[MTW][4]) {
  constexpr int LS = 40;
  constexpr int HM = MTW / 2;
  bf16x8 bfr[4];
#pragma unroll
  for (int j = 0; j < 4; j++) bfr[j] = *(const bf16x8*)(cB + j * 16 * LS);
#pragma unroll
  for (int h = 0; h < 2; h++) {
    bf16x8 af[HM];
#pragma unroll
    for (int i = 0; i < HM; i++) af[i] = *(const bf16x8*)(cA + (h * HM + i) * 16 * LS);
#pragma unroll
    for (int i = 0; i < HM; i++)
#pragma unroll
      for (int j = 0; j < 4; j++) {
        if (SWAP) acc[h * HM + i][j] = MFMA(bfr[j], af[i], acc[h * HM + i][j]);
        else acc[h * HM + i][j] = MFMA(af[i], bfr[j], acc[h * HM + i][j]);
      }
  }
}

template <bool SWAP, int MTW = 8>
__device__ __forceinline__ void gemm_mainloop_reg(const u16* __restrict__ A, int lda, const u16* __restrict__ Bt, int ldb,
                                              int K, u16* sm, f32x4 (&acc)[MTW][4]) {
  constexpr int LS = 40;
  const int tid = threadIdx.x, lane = tid & 63, wave = tid >> 6;
  const int wm = wave >> 1, wn = wave & 1;
  const int fr = lane & 15, fq = lane >> 4;
  u16* sA = sm;
  u16* sB = sm + 2 * 256 * LS;
  const int lr = tid >> 2, lc = (tid & 3) * 8;
  const u16* ga = A + (size_t)lr * lda + lc;
  const u16* gb = Bt + (size_t)lr * ldb + lc;
  GRegs r0, r1;
#define GLOAD(R, KT) gemm_gload<MTW>(R, ga + (KT) * 32, gb + (KT) * 32, lda, ldb);
#define SWRITE(R, BUF) gemm_swrite<MTW>(R, sA + (BUF) * 256 * LS + lr * LS + lc, sB + (BUF) * 128 * LS + lr * LS + lc);
  GLOAD(r0, 0)
  GLOAD(r1, 1)
#pragma unroll
  for (int i = 0; i < MTW; i++)
#pragma unroll
    for (int j = 0; j < 4; j++) acc[i][j] = f32x4{0.f, 0.f, 0.f, 0.f};
  SWRITE(r0, 0)
  __syncthreads();
  const int nk = K >> 5;
  const u16* cA0 = sA + (wm * 16 * MTW + fr) * LS + fq * 8;
  const u16* cB0 = sB + (wn * 64 + fr) * LS + fq * 8;
  for (int kt = 0; kt < nk; kt += 2) {
    GLOAD(r0, min(kt + 2, nk - 1))
    gemm_compute_tile<SWAP, MTW>(cA0, cB0, acc);
    SWRITE(r1, 1)
    __syncthreads();
    GLOAD(r1, min(kt + 3, nk - 1))
    gemm_compute_tile<SWAP, MTW>(cA0 + 256 * LS, cB0 + 128 * LS, acc);
    SWRITE(r0, 0)
    __syncthreads();
  }
#undef GLOAD
#undef SWRITE
}

__device__ __forceinline__ void glds16(const u16* g, char* lds) {
  __builtin_amdgcn_global_load_lds((const unsigned*)g, (unsigned*)lds, 16, 0, 0);
}
#define DSR128(dst, addr, OFF) asm volatile("ds_read_b128 %0, %1 offset:%2" : "=v"(dst) : "v"(addr), "n"(OFF))
template <bool SWAP, int MTW>
__device__ __forceinline__ void gemm_compute_glds(unsigned aA, unsigned aB, f32x4 (&acc)[MTW][4]) {
  bf16x8 bfr[4], af[MTW];
  DSR128(bfr[0], aB, 0); DSR128(bfr[1], aB, 1024); DSR128(bfr[2], aB, 2048); DSR128(bfr[3], aB, 3072);
  if (MTW == 8) {
    DSR128(af[0], aA, 0); DSR128(af[1], aA, 1024); DSR128(af[2], aA, 2048); DSR128(af[3], aA, 3072);
    DSR128(af[4], aA, 4096); DSR128(af[5], aA, 5120); DSR128(af[6], aA, 6144); DSR128(af[7], aA, 7168);
    asm volatile("s_waitcnt lgkmcnt(4)" : "+v"(bfr[0]), "+v"(bfr[1]), "+v"(bfr[2]), "+v"(bfr[3]), "+v"(af[0]), "+v"(af[1]), "+v"(af[2]), "+v"(af[3]));
  } else if (MTW == 6) {
    DSR128(af[0], aA, 0); DSR128(af[1], aA, 1024); DSR128(af[2], aA, 2048);
    DSR128(af[3], aA, 3072); DSR128(af[4], aA, 4096); DSR128(af[5], aA, 5120);
    asm volatile("s_waitcnt lgkmcnt(3)" : "+v"(bfr[0]), "+v"(bfr[1]), "+v"(bfr[2]), "+v"(bfr[3]), "+v"(af[0]), "+v"(af[1]), "+v"(af[2]));
  } else if (MTW == 4) {
    DSR128(af[0], aA, 0); DSR128(af[1], aA, 1024); DSR128(af[2], aA, 2048); DSR128(af[3], aA, 3072);
    asm volatile("s_waitcnt lgkmcnt(2)" : "+v"(bfr[0]), "+v"(bfr[1]), "+v"(bfr[2]), "+v"(bfr[3]), "+v"(af[0]), "+v"(af[1]));
  } else {
    DSR128(af[0], aA, 0); DSR128(af[1], aA, 1024);
    asm volatile("s_waitcnt lgkmcnt(1)" : "+v"(bfr[0]), "+v"(bfr[1]), "+v"(bfr[2]), "+v"(bfr[3]), "+v"(af[0]));
  }
  constexpr int HM = MTW / 2;
#pragma unroll
  for (int i = 0; i < HM; i++)
#pragma unroll
    for (int j = 0; j < 4; j++) {
      if (SWAP) acc[i][j] = MFMA(bfr[j], af[i], acc[i][j]);
      else acc[i][j] = MFMA(af[i], bfr[j], acc[i][j]);
    }
  __builtin_amdgcn_sched_barrier(0);
  if (MTW == 8) asm volatile("s_waitcnt lgkmcnt(0)" : "+v"(af[4]), "+v"(af[5]), "+v"(af[6]), "+v"(af[7]));
  else if (MTW == 6) asm volatile("s_waitcnt lgkmcnt(0)" : "+v"(af[3]), "+v"(af[4]), "+v"(af[5]));
  else if (MTW == 4) asm volatile("s_waitcnt lgkmcnt(0)" : "+v"(af[2]), "+v"(af[3]));
  else asm volatile("s_waitcnt lgkmcnt(0)" : "+v"(af[1]));
  __builtin_amdgcn_sched_barrier(0);
#pragma unroll
  for (int i = HM; i < MTW; i++)
#pragma unroll
    for (int j = 0; j < 4; j++) {
      if (SWAP) acc[i][j] = MFMA(bfr[j], af[i], acc[i][j]);
      else acc[i][j] = MFMA(af[i], bfr[j], acc[i][j]);
    }
}

template <bool SWAP, int MTW = 8>
__device__ __forceinline__ void gemm_mainloop(const u16* __restrict__ A, int lda, const u16* __restrict__ Bt, int ldb,
                                              int K, u16* sm, f32x4 (&acc)[MTW][4]) {
  constexpr int STG = 24576;
  constexpr int AW = MTW / 2;
  constexpr int NL = AW + 2;
  const int tid = threadIdx.x, lane = tid & 63, wave = tid >> 6;
  const int wm = wave >> 1, wn = wave & 1;
  const int fr = lane & 15, fq = lane >> 4;
  char* smc = (char*)sm;
  const int rowl = lane >> 2;
  const int lch = ((lane & 3) ^ (((lane >> 5) & 1) << 1)) * 8;
  const u16* gA = A + (size_t)(wave * AW * 16 + rowl) * lda + lch;
  const u16* gB = Bt + (size_t)(wave * 32 + rowl) * ldb + lch;
  char* dA = smc + (wave * AW) * 1024;
  char* dB = smc + 16384 + (wave * 2) * 1024;
  const int loff = fr * 64 + ((fq ^ (((fr >> 3) & 1) << 1)) * 16);
  const unsigned lds0 = (unsigned)(size_t)((LAS char*)smc);
  const unsigned rA = lds0 + (wm * MTW) * 1024 + loff;
  const unsigned rB = lds0 + 16384 + (wn * 4) * 1024 + loff;
#define GSTAGE(S, KT) { _Pragma("unroll") for (int _i = 0; _i < AW; _i++) glds16(gA + (size_t)(_i * 16) * lda + (KT) * 32, dA + (S) * STG + _i * 1024); \
                        _Pragma("unroll") for (int _i = 0; _i < 2; _i++) glds16(gB + (size_t)(_i * 16) * ldb + (KT) * 32, dB + (S) * STG + _i * 1024); }
#pragma unroll
  for (int i = 0; i < MTW; i++)
#pragma unroll
    for (int j = 0; j < 4; j++) acc[i][j] = f32x4{0.f, 0.f, 0.f, 0.f};
  const int nk = K >> 5;
  GSTAGE(0, 0)
  GSTAGE(1, 1)
  asm volatile("s_waitcnt vmcnt(%0)" ::"n"(NL) : "memory");
  asm volatile("s_waitcnt lgkmcnt(0)" ::: "memory");
  __builtin_amdgcn_s_barrier();
  int cur = 0;
  for (int t = 0; t < nk; t++) {
    int nx2 = cur + 2; if (nx2 >= 3) nx2 -= 3;
    const bool more = (t + 2 < nk);
    if (more) GSTAGE(nx2, t + 2)
    gemm_compute_glds<SWAP, MTW>(rA + cur * STG, rB + cur * STG, acc);
    if (more) asm volatile("s_waitcnt vmcnt(%0)" ::"n"(NL) : "memory");
    else asm volatile("s_waitcnt vmcnt(0)" ::: "memory");
    asm volatile("s_waitcnt lgkmcnt(0)" ::: "memory");
    __builtin_amdgcn_s_barrier();
    cur = (cur == 2) ? 0 : cur + 1;
  }
#undef GSTAGE
}

template <bool SWAP>
__device__ __forceinline__ void gemm_mainloop128(const u16* __restrict__ A, int lda, const u16* __restrict__ Bt, int ldb,
                                              int K, u16* sm, f32x4 (&acc)[4][4]) {
  const int tid = threadIdx.x, lane = tid & 63, wave = tid >> 6;
  const int wm = wave >> 1, wn = wave & 1;
  const int fr = lane & 15, fq = lane >> 4;
  u16* sA = sm;
  u16* sB = sm + 2 * 128 * LDT;
  const int lr = tid >> 3, lc = (tid & 7) * 8;
  const u16* ga = A + (size_t)lr * lda + lc;
  const u16* gb = Bt + (size_t)lr * ldb + lc;
  uint4 ra[4], rb[4];
#pragma unroll
  for (int i = 0; i < 4; i++) {
    ra[i] = *(const uint4*)(ga + (size_t)(i * 32) * lda);
    rb[i] = *(const uint4*)(gb + (size_t)(i * 32) * ldb);
  }
#pragma unroll
  for (int i = 0; i < 4; i++)
#pragma unroll
    for (int j = 0; j < 4; j++) acc[i][j] = f32x4{0.f, 0.f, 0.f, 0.f};
#pragma unroll
  for (int i = 0; i < 4; i++) {
    *(uint4*)(sA + (lr + i * 32) * LDT + lc) = ra[i];
    *(uint4*)(sB + (lr + i * 32) * LDT + lc) = rb[i];
  }
  __syncthreads();
  const int nk = K >> 6;
  for (int kt = 0; kt < nk; kt++) {
    const int cur = kt & 1;
    const bool more = (kt + 1 < nk);
    if (more) {
      const u16* ga2 = ga + (kt + 1) * 64;
      const u16* gb2 = gb + (kt + 1) * 64;
#pragma unroll
      for (int i = 0; i < 4; i++) {
        ra[i] = *(const uint4*)(ga2 + (size_t)(i * 32) * lda);
        rb[i] = *(const uint4*)(gb2 + (size_t)(i * 32) * ldb);
      }
    }
    const u16* cA = sA + cur * 128 * LDT + (wm * 64 + fr) * LDT + fq * 8;
    const u16* cB = sB + cur * 128 * LDT + (wn * 64 + fr) * LDT + fq * 8;
#pragma unroll
    for (int kk = 0; kk < 2; kk++) {
      bf16x8 af[4], bfr[4];
#pragma unroll
      for (int i = 0; i < 4; i++) af[i] = *(const bf16x8*)(cA + i * 16 * LDT + kk * 32);
#pragma unroll
      for (int j = 0; j < 4; j++) bfr[j] = *(const bf16x8*)(cB + j * 16 * LDT + kk * 32);
#pragma unroll
      for (int i = 0; i < 4; i++)
#pragma unroll
        for (int j = 0; j < 4; j++) {
          if (SWAP) acc[i][j] = MFMA(bfr[j], af[i], acc[i][j]);
          else acc[i][j] = MFMA(af[i], bfr[j], acc[i][j]);
        }
    }
    if (more) {
      u16* dA = sA + (cur ^ 1) * 128 * LDT;
      u16* dB = sB + (cur ^ 1) * 128 * LDT;
#pragma unroll
      for (int i = 0; i < 4; i++) {
        *(uint4*)(dA + (lr + i * 32) * LDT + lc) = ra[i];
        *(uint4*)(dB + (lr + i * 32) * LDT + lc) = rb[i];
      }
    }
    __syncthreads();
  }
}

__device__ __forceinline__ void tile_coords(int L, int MT, int NT, int& mt, int& nt) {
  const int full = NT >> 3;
  const int per = MT * 8;
  if (L < full * per) {
    int sc = L / per, r = L - sc * per;
    mt = r >> 3;
    nt = sc * 8 + (r & 7);
  } else {
    int L2 = L - full * per;
    int w = NT - full * 8;
    mt = L2 / w;
    nt = full * 8 + (L2 - mt * w);
  }
}

struct TileIter {
  int cur, end, step;
  __device__ TileIter(int ntiles) {
    int nb = gridDim.x, b = blockIdx.x;
    if ((nb & 7) == 0) {
      int per = (ntiles + 7) >> 3;
      int x = b & 7, j = b >> 3;
      cur = x * per + j;
      end = min((x + 1) * per, ntiles);
      step = nb >> 3;
    } else {
      cur = b; end = ntiles; step = nb;
    }
  }
};


constexpr size_t OFF_Q = OFF_BAR + 16384;
__device__ __forceinline__ int queue_next(unsigned* ctr, int* sh) {
  __syncthreads();
  if (threadIdx.x == 0) *sh = (int)__hip_atomic_fetch_add(ctr, 1u, __ATOMIC_RELAXED, __HIP_MEMORY_SCOPE_AGENT);
  __syncthreads();
  return *sh;
}

struct TrDesc { const float* src; u16* dst; int lds, nvalid, ldd, mode, rowoff, k0, n0; };
__device__ __forceinline__ TrDesc tr_desc(const Params& P, int j) {
  TrDesc d; int ntn; d.mode = 0; d.rowoff = 0;
  if (j < 320) { d.src = P.in[12] + 256; d.lds = 1536; d.nvalid = 1280; d.dst = (u16*)(P.ws + OFF_WIE); d.ldd = 1024; d.rowoff = 512; ntn = 20; }
  else if ((j -= 320) < 256) { d.src = P.in[15]; d.lds = 1024; d.nvalid = 1024; d.dst = (u16*)(P.ws + OFF_WOE); d.ldd = 1024; ntn = 16; }
  else if ((j -= 256) < 864) { d.src = P.in[16]; d.lds = 3360; d.nvalid = 3360; d.dst = (u16*)(P.ws + OFF_WIO); d.ldd = 1024; ntn = 54; }
  else if ((j -= 864) < 384) { d.src = P.in[30]; d.lds = 1024; d.nvalid = 1024; d.dst = (u16*)(P.ws + OFF_WOO); d.ldd = 1536; ntn = 16; }
  else if ((j -= 384) < 2816) {
    int q = j / 704; j -= q * 704; int l = q >> 1, w3 = q & 1;
    d.src = (w3 ? P.in[32] : P.in[31]) + (size_t)l * 1024 * 2816; d.lds = 2816; d.nvalid = 2816;
    d.dst = (u16*)(P.ws + OFF_W13) + (size_t)l * 5632 * 1024; d.ldd = 1024; d.mode = 1; d.rowoff = w3 * 16; ntn = 44;
  } else {
    j -= 2816; int l = j / 704; j -= l * 704;
    d.src = P.in[33] + (size_t)l * 2816 * 1024; d.lds = 1024; d.nvalid = 1024;
    d.dst = (u16*)(P.ws + OFF_W2) + (size_t)l * 1024 * 2816; d.ldd = 2816; ntn = 16;
  }
  const int kt = j / ntn, nt = j - kt * ntn;
  d.k0 = kt * 64; d.n0 = nt * 64;
  return d;
}
__device__ __forceinline__ void tr_load(const TrDesc& d, int tid, float4 (&v)[4]) {
#pragma unroll
  for (int i = 0; i < 4; i++) {
    const int r = i * 16 + (tid >> 4), n = d.n0 + (tid & 15) * 4;
    v[i] = make_float4(0.f, 0.f, 0.f, 0.f);
    if (n < d.nvalid) v[i] = *(const float4*)(d.src + (size_t)(d.k0 + r) * d.lds + n);
  }
}
__device__ __forceinline__ void tr_emit(const TrDesc& d, int tid, const float4 (&v)[4], float* tile) {
#pragma unroll
  for (int i = 0; i < 4; i++) {
    const int r = i * 16 + (tid >> 4), c4 = (tid & 15) * 4;
    tile[r * 65 + c4] = v[i].x; tile[r * 65 + c4 + 1] = v[i].y; tile[r * 65 + c4 + 2] = v[i].z; tile[r * 65 + c4 + 3] = v[i].w;
  }
  __syncthreads();
#pragma unroll
  for (int i = 0; i < 4; i++) {
    const int n = i * 16 + (tid >> 4), k4 = (tid & 15) * 4;
    const int ng = d.n0 + n;
    const int row = d.mode ? ((ng >> 4) * 32 + (ng & 15) + d.rowoff) : (ng + d.rowoff);
    uint2 o;
    o.x = pack2(tile[(k4 + 0) * 65 + n], tile[(k4 + 1) * 65 + n]);
    o.y = pack2(tile[(k4 + 2) * 65 + n], tile[(k4 + 3) * 65 + n]);
    *(uint2*)(d.dst + (size_t)row * d.ldd + d.k0 + k4) = o;
  }
  __syncthreads();
}
__device__ __forceinline__ void phase_prep(const Params& P, char* smem, int* qsh) {
  const int tid = threadIdx.x, nb = gridDim.x, bid = blockIdx.x;
  const int lane = tid & 63, wave = tid >> 6;
  float* tile = (float*)smem;
  float* tabc = (float*)(smem + 16640);
  float* tabs = tabc + 64;
  float* sc = (float*)(smem + 20480);
  float* red = (float*)(smem + 20480 + 36864);
  {
    float* prm = (float*)(P.ws + OFF_PRM);
    const int gt = bid * 256 + tid, gs = nb * 256;
#define PCOPY(SRC, OFF, N) for (int i = gt; i < (N); i += gs) prm[(OFF) + i] = (SRC)[i];
    PCOPY(P.in[10], PRM_NORM_MIX, 2048) PCOPY(P.in[11], PRM_NORM_FFN, 2048) PCOPY(P.in[13], PRM_QN, 64) PCOPY(P.in[14], PRM_KN, 64)
    PCOPY(P.in[17], PRM_CLW, 2048) PCOPY(P.in[18], PRM_CLB, 512) PCOPY(P.in[20], PRM_LBA, 1024) PCOPY(P.in[22], PRM_LBX, 1024)
    PCOPY(P.in[23], PRM_LAM, 1024) PCOPY(P.in[24], PRM_CSW, 5120) PCOPY(P.in[25], PRM_CSB, 1280) PCOPY(P.in[26], PRM_DTB, 32)
    PCOPY(P.in[27], PRM_ALOG, 32) PCOPY(P.in[28], PRM_SSDD, 16) PCOPY(P.in[29], PRM_SNORM, 1024)
    PCOPY(P.in[19], PRM_LWA, 65536) PCOPY(P.in[21], PRM_LWX, 65536)
#undef PCOPY
  }
  bool sc_ready = false;
  constexpr int N_MOD = 384, N_FF = 64, N_TR = 6048, N_DFT = 544, N_CACHE = 512;
  constexpr int N_ALL = N_MOD + N_FF + N_TR + N_DFT + N_CACHE;
  for (int it = bid; it < N_ALL; it += nb) {
    int j = it;
    if (j < N_MOD) {
      if (!sc_ready) {
        for (int i = tid; i < 9 * 1024; i += 256) {
          int r = i >> 10, k = i & 1023;
          float c = r < 8 ? P.in[2][r * 1024 + k] : P.in[7][k];
          sc[i] = silu_f(c);
        }
        __syncthreads();
        sc_ready = true;
      }
      const int l = j / 192, n0 = (j % 192) * 32;
      const int cgp = tid & 7, kl = tid >> 3;
      float acc[9][4];
#pragma unroll
      for (int r = 0; r < 9; r++)
#pragma unroll
        for (int c = 0; c < 4; c++) acc[r][c] = 0.f;
      const float* w = P.in[8] + (size_t)l * 1024 * 6144 + n0 + cgp * 4;
#pragma unroll 4
      for (int i = 0; i < 32; i++) {
        const int k = i * 32 + kl;
        const float4 wv = *(const float4*)(w + (size_t)k * 6144);
#pragma unroll
        for (int r = 0; r < 9; r++) {
          const float s = sc[r * 1024 + k];
          acc[r][0] += s * wv.x; acc[r][1] += s * wv.y; acc[r][2] += s * wv.z; acc[r][3] += s * wv.w;
        }
      }
#pragma unroll
      for (int r = 0; r < 9; r++)
#pragma unroll
        for (int c = 0; c < 4; c++) {
          float v = acc[r][c];
          v += __shfl_xor(v, 8); v = xor16_sum(v); v = xor32_sum(v);
          acc[r][c] = v;
        }
      if (lane < 8) {
#pragma unroll
        for (int r = 0; r < 9; r++)
#pragma unroll
          for (int c = 0; c < 4; c++) red[(wave * 9 + r) * 32 + cgp * 4 + c] = acc[r][c];
      }
      __syncthreads();
      float* MOD = (float*)(P.ws + OFF_MOD);
      for (int i = tid; i < 288; i += 256) {
        int r = i >> 5, c = i & 31;
        float s = red[(0 * 9 + r) * 32 + c] + red[(1 * 9 + r) * 32 + c] + red[(2 * 9 + r) * 32 + c] + red[(3 * 9 + r) * 32 + c];
        MOD[(l * 9 + r) * 6144 + n0 + c] = s + P.in[9][l * 6144 + n0 + c];
      }
      __syncthreads();
      continue;
    }
    j -= N_MOD;
    if (j < N_FF) {
      const int g = j >> 4, kt = j & 15;
      if (tid < 64) { tabc[tid] = cospif(tid / 32.0f); tabs[tid] = sinpif(tid / 32.0f); }
      const float* src = P.in[12] + (size_t)(kt * 64) * 1536 + g * 64;
#pragma unroll
      for (int i = 0; i < 4; i++) {
        int r = i * 16 + (tid >> 4), c4 = (tid & 15) * 4;
        float4 v = *(const float4*)(src + (size_t)r * 1536 + c4);
        tile[r * 65 + c4] = v.x; tile[r * 65 + c4 + 1] = v.y; tile[r * 65 + c4 + 2] = v.z; tile[r * 65 + c4 + 3] = v.w;
      }
      __syncthreads();
      const int np = tid & 127, kh = tid >> 7;
      const int wsel = np >> 6, cp = np & 63;
      float acc[32];
#pragma unroll
      for (int i = 0; i < 32; i++) acc[i] = 0.f;
      for (int c = 0; c < 64; c++) {
        const int idx = (c * cp) & 63;
        const float coef = wsel ? tabs[idx] : tabc[idx];
#pragma unroll
        for (int i = 0; i < 32; i++) acc[i] += tile[(kh * 32 + i) * 65 + c] * coef;
      }
      u16* dst = (u16*)(P.ws + OFF_WIE) + (size_t)(g * 128 + np) * 1024 + kt * 64 + kh * 32;
#pragma unroll
      for (int i = 0; i < 4; i++) {
        uint4 o;
        o.x = pack2(acc[i * 8 + 0], acc[i * 8 + 1]); o.y = pack2(acc[i * 8 + 2], acc[i * 8 + 3]);
        o.z = pack2(acc[i * 8 + 4], acc[i * 8 + 5]); o.w = pack2(acc[i * 8 + 6], acc[i * 8 + 7]);
        *(uint4*)(dst + i * 8) = o;
      }
      __syncthreads();
      continue;
    }
    j -= N_FF;
    if (j < N_TR) continue;
    j -= N_TR;
    if (j < N_DFT) {
      if (j < 512) {
        u16* D = (u16*)(P.ws + OFF_D1K);
        const int e0 = j * 4096;
        for (int i = 0; i < 16; i++) {
          int e = e0 + i * 256 + tid;
          int sp = e >> 11, k = e & 2047;
          float v;
          if (k < 1024) { int r = (sp * k) & 1023; v = cospif(r * (1.0f / 512.0f)); }
          else { int r = (sp * (k - 1024)) & 1023; v = -sinpif(r * (1.0f / 512.0f)); }
          D[e] = f2bf(v * (1.0f / 256.0f));
        }
      } else {
        u16* D = (u16*)(P.ws + OFF_D256);
        const int e0 = (j - 512) * 4096;
        for (int i = 0; i < 16; i++) {
          int e = e0 + i * 256 + tid;
          int sp = e >> 9, k = e & 511;
          float v;
          if (k < 256) { int r = (sp * k) & 255; v = cospif(r * (1.0f / 128.0f)); }
          else { int r = (sp * (k - 256)) & 255; v = -sinpif(r * (1.0f / 128.0f)); }
          D[e] = f2bf(v * (1.0f / 128.0f));
        }
      }
      continue;
    }
    j -= N_DFT;
    {
      const bool isv = j >= 256;
      const int e0 = (isv ? j - 256 : j) * 4096;
      const float* src = isv ? P.in[4] : P.in[3];
      u16* KB = (u16*)(P.ws + OFF_KBS);
      u16* VT = (u16*)(P.ws + OFF_VTS);
      for (int i = 0; i < 16; i++) {
        int e = e0 + i * 256 + tid;
        int b = e >> 17, p = (e >> 8) & 511, h = (e >> 6) & 3, d = e & 63;
        u16 v = f2bf(src[e]);
        if (!isv) KB[((size_t)(b * 4 + h) * 1536 + 1024 + p) * 64 + d] = v;
        else VT[((size_t)(b * 4 + h) * 64 + d) * 1536 + 1024 + p] = v;
      }
    }
  }
  {
    unsigned* ctr = (unsigned*)(P.ws + OFF_BAR + 20480);
    for (;;) {
      const int k = queue_next(ctr, qsh);
      const int j0 = 2 * k;
      if (j0 >= N_TR) break;
      const TrDesc d0 = tr_desc(P, j0);
      const TrDesc d1 = tr_desc(P, j0 + 1);
      float4 v0[4], v1[4];
      tr_load(d0, tid, v0);
      tr_load(d1, tid, v1);
      tr_emit(d0, tid, v0, tile);
      tr_emit(d1, tid, v1, tile);
    }
  }
}

__device__ __forceinline__ void phase_norm(const Params& P, int l, int which) {
  const int tid = threadIdx.x, lane = tid & 63, wave = tid >> 6;
  const float* MOD = (const float*)(P.ws + OFF_MOD);
  const float* gvec = PRM(P, (which ? PRM_NORM_FFN : PRM_NORM_MIX) + l * 1024);
  u16* H = (u16*)(P.ws + OFF_H);
  const int nwaves = gridDim.x * 4;
  const int rpw = (T_ALL + nwaves - 1) / nwaves;
  const int r0 = (blockIdx.x * 4 + wave) * rpw;
  const int r1 = min(r0 + rpw, T_ALL);
  constexpr int NR = 3;
  const int osh = (which ? 3 : 0) * 1024, osc = (which ? 4 : 1) * 1024;
  float4 gm[4], sh[4];
  int cached = -1;
  for (int t0 = r0; t0 < r1; t0 += NR) {
    float4 v[NR][4];
#pragma unroll
    for (int r = 0; r < NR; r++) {
      const int t = min(t0 + r, r1 - 1);
      const float* x = (l == 0 && which == 0) ? xin(P, t) : P.out + (size_t)t * 1024;
#pragma unroll
      for (int j = 0; j < 4; j++) v[r][j] = *(const float4*)(x + j * 256 + lane * 4);
    }
    float ss[NR];
#pragma unroll
    for (int r = 0; r < NR; r++) {
      float a = 0.f;
#pragma unroll
      for (int j = 0; j < 4; j++) a += v[r][j].x * v[r][j].x + v[r][j].y * v[r][j].y + v[r][j].z * v[r][j].z + v[r][j].w * v[r][j].w;
      ss[r] = a;
    }
#pragma unroll
    for (int o = 32; o >= 1; o >>= 1) {
#pragma unroll
      for (int r = 0; r < NR; r++) ss[r] += __shfl_xor(ss[r], o);
    }
#pragma unroll
    for (int r = 0; r < NR; r++) {
      const int t = t0 + r;
      if (t >= r1) continue;
      const int cr = cond_row(t);
      if (cr != cached) {
        cached = cr;
        const float* mb = MOD + (size_t)(l * 9 + cr) * 6144;
#pragma unroll
        for (int j = 0; j < 4; j++) {
          const int c = j * 256 + lane * 4;
          const float4 g = *(const float4*)(gvec + c);
          const float4 cm = *(const float4*)(mb + osc + c);
          sh[j] = *(const float4*)(mb + osh + c);
          gm[j] = make_float4(g.x * (1.f + cm.x), g.y * (1.f + cm.y), g.z * (1.f + cm.z), g.w * (1.f + cm.w));
        }
      }
      const float rs = rsqrtf(ss[r] * (1.0f / 1024.0f) + 1e-6f);
#pragma unroll
      for (int j = 0; j < 4; j++) {
        const int c = j * 256 + lane * 4;
        uint2 o;
        o.x = pack2(v[r][j].x * rs * gm[j].x + sh[j].x, v[r][j].y * rs * gm[j].y + sh[j].y);
        o.y = pack2(v[r][j].z * rs * gm[j].z + sh[j].z, v[r][j].w * rs * gm[j].w + sh[j].w);
        *(uint2*)(H + (size_t)t * 1024 + c) = o;
      }
    }
  }
}

__device__ __forceinline__ void phase_gemm_in_even(const Params& P, char* smem) {
  const int tid = threadIdx.x, lane = tid & 63, wave = tid >> 6;
  const int wm = wave >> 1, wn = wave & 1, fr = lane & 15, fq = lane >> 4;
  const u16* A = (const u16*)(P.ws + OFF_H);
  const u16* W = (const u16*)(P.ws + OFF_WIE);
  constexpr int MT = 96, NT = 14;
  for (TileIter ti(MT * NT); ti.cur < ti.end; ti.cur += ti.step) {
    int mtile, ntile;
    tile_coords(ti.cur, MT, NT, mtile, ntile);
    const int m0 = mtile * 128, n0 = ntile * 128;
    f32x4 acc[4][4];
    const bool swap = (ntile >= 4 && ntile < 12);
    if (swap) gemm_mainloop<true, 4>(A + (size_t)m0 * 1024, 1024, W + (size_t)n0 * 1024, 1024, 1024, (u16*)smem, acc);
    else gemm_mainloop<false, 4>(A + (size_t)m0 * 1024, 1024, W + (size_t)n0 * 1024, 1024, 1024, (u16*)smem, acc);
    const bool smp = m0 >= T_CTX;
    if (ntile < 4) {
      const int g = ntile;
      u16* YT; int S, seq, sbase;
      if (smp) { YT = (u16*)(P.ws + OFF_YTS); S = 1024; seq = (m0 - T_CTX) >> 10; sbase = (m0 - T_CTX) & 1023; }
      else { YT = (u16*)(P.ws + OFF_YTC); S = 256; seq = m0 >> 8; sbase = m0 & 255; }
      u16* base = YT + (size_t)seq * 256 * 2 * S;
#pragma unroll
      for (int mt = 0; mt < 4; mt++)
#pragma unroll
        for (int nt = 0; nt < 4; nt++) {
          const int s = sbase + wm * 64 + mt * 16 + fq * 4;
          const int cp = nt * 16 + fr;
          uint2 o;
          o.x = pack2(acc[mt][nt][0], acc[mt][nt][1]);
          o.y = pack2(acc[mt][nt][2], acc[mt][nt][3]);
          *(uint2*)(base + (size_t)(g * 64 + cp) * 2 * S + wn * S + s) = o;
        }
    } else if (ntile < 12) {
      const bool isq = ntile < 10;
      const int hcol = n0 + wn * 64 - (isq ? 512 : 1280);
      const int head = hcol >> 6;
      const float* gn = PRM(P, isq ? PRM_QN : PRM_KN);
      float gv[4][4];
#pragma unroll
      for (int nt = 0; nt < 4; nt++)
#pragma unroll
        for (int r = 0; r < 4; r++) gv[nt][r] = gn[nt * 16 + fq * 4 + r];
      float fre[4];
#pragma unroll
      for (int r = 0; r < 4; r++) fre[r] = exp2f(-(float)(fq * 4 + r) * (13.287712379549449f / 16.0f));
#pragma unroll
      for (int mt = 0; mt < 4; mt++) {
        const int t = m0 + wm * 64 + mt * 16 + fr;
        float ss = 0.f;
#pragma unroll
        for (int nt = 0; nt < 4; nt++)
#pragma unroll
          for (int r = 0; r < 4; r++) ss += acc[mt][nt][r] * acc[mt][nt][r];
        ss = xor16_sum(ss);
        ss = xor32_sum(ss);
        const float rs = rsqrtf(ss * (1.0f / 64.0f) + 1e-6f);
        float v[4][4];
#pragma unroll
        for (int nt = 0; nt < 4; nt++)
#pragma unroll
          for (int r = 0; r < 4; r++) v[nt][r] = acc[mt][nt][r] * rs * gv[nt][r];
        if (!smp && !isq) {
          float* nk = P.out + 12582912 + (size_t)t * 256 + head * 64;
#pragma unroll
          for (int nt = 0; nt < 4; nt++)
            *(float4*)(nk + nt * 16 + fq * 4) = make_float4(v[nt][0], v[nt][1], v[nt][2], v[nt][3]);
        }
        if (smp) {
          const int s = (t - T_CTX) & 1023;
          const float prow = (float)(s >> 6), pcol = (float)(s & 63);
#pragma unroll
          for (int r = 0; r < 4; r++) {
            const float a0 = prow * fre[r], a1 = pcol * fre[r];
            const float c0 = __cosf(a0), s0 = __sinf(a0), c1 = __cosf(a1), s1 = __sinf(a1);
            const float x1 = v[0][r], x2 = v[1][r];
            v[0][r] = x1 * c0 - x2 * s0; v[1][r] = x2 * c0 + x1 * s0;
            const float y1 = v[2][r], y2 = v[3][r];
            v[2][r] = y1 * c1 - y2 * s1; v[3][r] = y2 * c1 + y1 * s1;
          }
        }
        if (isq) {
          const float qs = 0.125f * LOG2E;
          u16* q = (u16*)(P.ws + OFF_QB) + (size_t)t * 768 + head * 64;
#pragma unroll
          for (int nt = 0; nt < 4; nt++) {
            uint2 o;
            o.x = pack2(v[nt][0] * qs, v[nt][1] * qs);
            o.y = pack2(v[nt][2] * qs, v[nt][3] * qs);
            *(uint2*)(q + nt * 16 + fq * 4) = o;
          }
        } else {
          u16* kb;
          if (smp) { int sq = (t - T_CTX) >> 10, key = (t - T_CTX) & 1023; kb = (u16*)(P.ws + OFF_KBS) + ((size_t)(sq * 4 + head) * 1536 + key) * 64; }
          else { int sq = t >> 8, key = t & 255; kb = (u16*)(P.ws + OFF_KBC) + ((size_t)(sq * 4 + head) * 256 + key) * 64; }
#pragma unroll
          for (int nt = 0; nt < 4; nt++) {
            uint2 o;
            o.x = pack2(v[nt][0], v[nt][1]);
            o.y = pack2(v[nt][2], v[nt][3]);
            *(uint2*)(kb + nt * 16 + fq * 4) = o;
          }
        }
      }
    } else {
      const int head = (n0 + wn * 64 - 1536) >> 6;
#pragma unroll
      for (int mt = 0; mt < 4; mt++) {
        const int t = m0 + wm * 64 + mt * 16 + fq * 4;
#pragma unroll
        for (int nt = 0; nt < 4; nt++) {
          const int d = nt * 16 + fr;
          uint2 o;
          o.x = pack2(acc[mt][nt][0], acc[mt][nt][1]);
          o.y = pack2(acc[mt][nt][2], acc[mt][nt][3]);
          if (smp) {
            int sq = (t - T_CTX) >> 10, key = (t - T_CTX) & 1023;
            *(uint2*)((u16*)(P.ws + OFF_VTS) + ((size_t)(sq * 4 + head) * 64 + d) * 1536 + key) = o;
          } else {
            int sq = t >> 8, key = t & 255;
            *(uint2*)((u16*)(P.ws + OFF_VTC) + ((size_t)(sq * 4 + head) * 64 + d) * 256 + key) = o;
            float* nv = P.out + 13631488 + (size_t)t * 256 + head * 64 + d;
#pragma unroll
            for (int r = 0; r < 4; r++) nv[(size_t)r * 256] = acc[mt][nt][r];
          }
        }
      }
    }
  }
}

__device__ __forceinline__ void phase_gemm_resid(const Params& P, char* smem, const u16* A, int lda, const u16* W, int K,
                                 int l, int gate_idx, bool from_x) {
  const int tid = threadIdx.x, lane = tid & 63, wave = tid >> 6;
  const int wm = wave >> 1, wn = wave & 1, fr = lane & 15, fq = lane >> 4;
  const float* MOD = (const float*)(P.ws + OFF_MOD);
  constexpr int MT = 64, NT = 8;
  for (TileIter ti(MT * NT); ti.cur < ti.end; ti.cur += ti.step) {
    int mtile, ntile;
    tile_coords(ti.cur, MT, NT, mtile, ntile);
    const int m0 = mtile * 192, n0 = ntile * 128;
    f32x4 acc[6][4];
    gemm_mainloop<true, 6>(A + (size_t)m0 * lda, lda, W + (size_t)n0 * K, K, K, (u16*)smem, acc);
#pragma unroll
    for (int mt = 0; mt < 6; mt++) {
      const int t = m0 + wm * 96 + mt * 16 + fr;
      const float* gp = MOD + (size_t)(l * 9 + cond_row(t)) * 6144 + gate_idx * 1024;
      const float* bp = from_x ? xin(P, t) : P.out + (size_t)t * 1024;
      float* op = P.out + (size_t)t * 1024;
#pragma unroll
      for (int nt = 0; nt < 4; nt++) {
        const int n = n0 + wn * 64 + nt * 16 + fq * 4;
        const float4 g = *(const float4*)(gp + n);
        const float4 b = *(const float4*)(bp + n);
        float4 o;
        o.x = b.x + g.x * acc[mt][nt][0]; o.y = b.y + g.y * acc[mt][nt][1];
        o.z = b.z + g.z * acc[mt][nt][2]; o.w = b.w + g.w * acc[mt][nt][3];
        *(float4*)(op + n) = o;
      }
    }
  }
}

template <int MTW>
__device__ __forceinline__ void ffn_up_tile(const u16* A, const u16* W, u16* U, char* smem, int m0, int n0) {
  const int tid = threadIdx.x, lane = tid & 63, wave = tid >> 6;
  const int wm = wave >> 1, wn = wave & 1, fr = lane & 15, fq = lane >> 4;
  f32x4 acc[MTW][4];
  gemm_mainloop<true, MTW>(A + (size_t)m0 * 1024, 1024, W + (size_t)n0 * 1024, 1024, 1024, (u16*)smem, acc);
#pragma unroll
  for (int mt = 0; mt < MTW; mt++) {
    const int t = m0 + wm * (16 * MTW) + mt * 16 + fr;
#pragma unroll
    for (int np = 0; np < 2; np++) {
      const int f = ((n0 + wn * 64) >> 1) + np * 16 + fq * 4;
      float r[4];
#pragma unroll
      for (int q = 0; q < 4; q++) r[q] = silu_f(acc[mt][np * 2][q]) * acc[mt][np * 2 + 1][q];
      uint2 o;
      o.x = pack2(r[0], r[1]); o.y = pack2(r[2], r[3]);
      *(uint2*)(U + (size_t)t * 2816 + f) = o;
    }
  }
}

__device__ __forceinline__ void phase_gemm_ffn_up(const Params& P, char* smem, int l) {
  const u16* A = (const u16*)(P.ws + OFF_H);
  const u16* W = (const u16*)(P.ws + OFF_W13) + (size_t)l * 5632 * 1024;
  u16* U = (u16*)(P.ws + OFF_R1);
  constexpr int MT = 48, NT = 44;
  constexpr int NFULL = 2048;
  for (TileIter ti(NFULL); ti.cur < ti.end; ti.cur += ti.step) {
    int mtile, ntile;
    tile_coords(ti.cur, MT, NT, mtile, ntile);
    ffn_up_tile<8>(A, W, U, smem, mtile * 256, ntile * 128);
  }
  for (TileIter ti((MT * NT - NFULL) * 4); ti.cur < ti.end; ti.cur += ti.step) {
    int mtile, ntile;
    tile_coords(NFULL + (ti.cur >> 2), MT, NT, mtile, ntile);
    ffn_up_tile<2>(A, W, U, smem, mtile * 256 + (ti.cur & 3) * 64, ntile * 128);
  }
}

__device__ __forceinline__ void phase_gemm_in_odd(const Params& P, char* smem) {
  const int tid = threadIdx.x, lane = tid & 63, wave = tid >> 6;
  const int wm = wave >> 1, wn = wave & 1, fr = lane & 15, fq = lane >> 4;
  const u16* A = (const u16*)(P.ws + OFF_H);
  const u16* W = (const u16*)(P.ws + OFF_WIO);
  u16* PO = (u16*)(P.ws + OFF_R1);
  float* DT = (float*)(P.ws + OFF_DT);
  constexpr int MT = 48, NT = 27;
  for (TileIter ti(MT * NT); ti.cur < ti.end; ti.cur += ti.step) {
    int mtile, ntile;
    tile_coords(ti.cur, MT, NT, mtile, ntile);
    const int m0 = mtile * 256, n0 = ntile * 128;
    f32x4 acc[8][4];
    gemm_mainloop<true>(A + (size_t)m0 * 1024, 1024, W + (size_t)n0 * 1024, 1024, 1024, (u16*)smem, acc);
#pragma unroll
    for (int mt = 0; mt < 8; mt++) {
      const int t = m0 + wm * 128 + mt * 16 + fr;
#pragma unroll
      for (int nt = 0; nt < 4; nt++) {
        const int n = n0 + wn * 64 + nt * 16 + fq * 4;
        uint2 o;
        o.x = pack2(acc[mt][nt][0], acc[mt][nt][1]);
        o.y = pack2(acc[mt][nt][2], acc[mt][nt][3]);
        *(uint2*)(PO + (size_t)t * 3456 + n) = o;
        if (n >= 3328 && n < 3360)
          *(float4*)(DT + (size_t)t * 32 + (n - 3328)) = make_float4(acc[mt][nt][0], acc[mt][nt][1], acc[mt][nt][2], acc[mt][nt][3]);
      }
    }
  }
}

__device__ __forceinline__ void fourier_tile(const Params& P, int item, char* smem) {
  const int tid = threadIdx.x, lane = tid & 63, wave = tid >> 6;
  const int wm = wave >> 1, wn = wave & 1, fr = lane & 15, fq = lane >> 4;
  const u16 *D, *YT; int S, tb, mtile, ntile;
  if (item < 128) {
    int seq = item >> 4, r = item & 15; mtile = r >> 1; ntile = r & 1; S = 1024; tb = T_CTX + seq * 1024;
    D = (const u16*)(P.ws + OFF_D1K); YT = (const u16*)(P.ws + OFF_YTS) + (size_t)seq * 256 * 2048;
  } else {
    item -= 128; int seq = item >> 2, r = item & 3; mtile = r >> 1; ntile = r & 1; S = 256; tb = seq * 256;
    D = (const u16*)(P.ws + OFF_D256); YT = (const u16*)(P.ws + OFF_YTC) + (size_t)seq * 256 * 512;
  }
  f32x4 acc[4][4];
  const int K = 2 * S;
  gemm_mainloop<true, 4>(D + (size_t)(mtile * 128) * K, K, YT + (size_t)(ntile * 128) * K, K, K, (u16*)smem, acc);
  u16* MIX = (u16*)(P.ws + OFF_H);
#pragma unroll
  for (int mt = 0; mt < 4; mt++) {
    const int t = tb + mtile * 128 + wm * 64 + mt * 16 + fr;
#pragma unroll
    for (int nt = 0; nt < 4; nt++) {
      const int n = ntile * 128 + wn * 64 + nt * 16 + fq * 4;
      uint2 o;
      o.x = pack2(acc[mt][nt][0], acc[mt][nt][1]);
      o.y = pack2(acc[mt][nt][2], acc[mt][nt][3]);
      *(uint2*)(MIX + (size_t)t * 1024 + n) = o;
    }
  }
}

__device__ __forceinline__ void attn_item(const Params& P, int item, char* smem) {
  const int tid = threadIdx.x, lane = tid & 63, wave = tid >> 6;
  const int fr = lane & 15, fq = lane >> 4;
  bool smp; int seq, head, qb;
  if (item < 768) { smp = true; seq = item / 96; int r = item % 96; head = r >> 3; qb = r & 7; }
  else { item -= 768; smp = false; seq = item / 24; int r = item % 24; head = r >> 1; qb = r & 1; }
  const int nkeys = smp ? 1536 : 256;
  const int tb = smp ? T_CTX + seq * 1024 : seq * 256;
  const int kvh = head / 3;
  const u16* Kp = (const u16*)(P.ws + (smp ? OFF_KBS : OFF_KBC)) + (size_t)((seq * 4 + kvh) * nkeys) * 64;
  const u16* Vp = (const u16*)(P.ws + (smp ? OFF_VTS : OFF_VTC)) + (size_t)((seq * 4 + kvh) * 64) * nkeys;
  const u16* QB = (const u16*)(P.ws + OFF_QB);
  u16* sK = (u16*)smem;
  u16* sV = sK + 2 * 64 * LDT;
  bf16x8 qf[2][2];
  const int qrow0 = tb + qb * 128 + wave * 32;
#pragma unroll
  for (int qt = 0; qt < 2; qt++)
#pragma unroll
    for (int kk = 0; kk < 2; kk++)
      qf[qt][kk] = *(const bf16x8*)(QB + (size_t)(qrow0 + qt * 16 + fr) * 768 + head * 64 + kk * 32 + fq * 8);
  f32x4 ot[2][4];
#pragma unroll
  for (int a = 0; a < 2; a++)
#pragma unroll
    for (int b = 0; b < 4; b++) ot[a][b] = f32x4{0.f, 0.f, 0.f, 0.f};
  float mrun[2] = {-INFINITY, -INFINITY}, lrun[2] = {0.f, 0.f};
  const int lrow = tid >> 3, lcol = (tid & 7) * 8;
  uint4 rk[2], rv[2];
#pragma unroll
  for (int i = 0; i < 2; i++) {
    rk[i] = *(const uint4*)(Kp + (size_t)(lrow + i * 32) * 64 + lcol);
    rv[i] = *(const uint4*)(Vp + (size_t)(lrow + i * 32) * nkeys + lcol);
  }
#pragma unroll
  for (int i = 0; i < 2; i++) {
    *(uint4*)(sK + (lrow + i * 32) * LDT + lcol) = rk[i];
    *(uint4*)(sV + (lrow + i * 32) * LDT + lcol) = rv[i];
  }
  __syncthreads();
  const int nkt = nkeys >> 6;
  for (int kt = 0; kt < nkt; kt++) {
    const int cur = kt & 1;
    const bool more = kt + 1 < nkt;
    if (more) {
      const int key0 = (kt + 1) * 64;
#pragma unroll
      for (int i = 0; i < 2; i++) {
        rk[i] = *(const uint4*)(Kp + (size_t)(key0 + lrow + i * 32) * 64 + lcol);
        rv[i] = *(const uint4*)(Vp + (size_t)(lrow + i * 32) * nkeys + key0 + lcol);
      }
    }
    const u16* cK = sK + cur * 64 * LDT;
    const u16* cV = sV + cur * 64 * LDT;
    f32x4 st[2][4];
#pragma unroll
    for (int k16 = 0; k16 < 4; k16++) {
      const bf16x8 kf0 = *(const bf16x8*)(cK + (k16 * 16 + fr) * LDT + fq * 8);
      const bf16x8 kf1 = *(const bf16x8*)(cK + (k16 * 16 + fr) * LDT + 32 + fq * 8);
#pragma unroll
      for (int qt = 0; qt < 2; qt++) {
        f32x4 z = f32x4{0.f, 0.f, 0.f, 0.f};
        z = MFMA(kf0, qf[qt][0], z);
        st[qt][k16] = MFMA(kf1, qf[qt][1], z);
      }
    }
    bf16x8 pf[2][2];
#pragma unroll
    for (int qt = 0; qt < 2; qt++) {
      float mx = st[qt][0][0];
#pragma unroll
      for (int k16 = 0; k16 < 4; k16++)
#pragma unroll
        for (int r = 0; r < 4; r++) mx = fmaxf(mx, st[qt][k16][r]);
      mx = xor16_max(mx);
      mx = xor32_max(mx);
      if (!__all(mx - mrun[qt] <= 8.0f)) {
        const float mnew = fmaxf(mrun[qt], mx);
        const float alpha = fexp2(mrun[qt] - mnew);
        mrun[qt] = mnew;
        lrun[qt] *= alpha;
#pragma unroll
        for (int dt = 0; dt < 4; dt++)
#pragma unroll
          for (int r = 0; r < 4; r++) ot[qt][dt][r] *= alpha;
      }
      const float mcur = mrun[qt];
      float ps = 0.f;
#pragma unroll
      for (int k16 = 0; k16 < 4; k16++)
#pragma unroll
        for (int r = 0; r < 4; r++) {
          const float p = fexp2(st[qt][k16][r] - mcur);
          st[qt][k16][r] = p;
          ps += p;
        }
      lrun[qt] += ps;
#pragma unroll
      for (int a = 0; a < 2; a++) {
        union { bf16x8 v; unsigned u[4]; } pk;
        pk.u[0] = pack2(st[qt][2 * a][0], st[qt][2 * a][1]);
        pk.u[1] = pack2(st[qt][2 * a][2], st[qt][2 * a][3]);
        pk.u[2] = pack2(st[qt][2 * a + 1][0], st[qt][2 * a + 1][1]);
        pk.u[3] = pack2(st[qt][2 * a + 1][2], st[qt][2 * a + 1][3]);
        pf[qt][a] = pk.v;
      }
    }
#pragma unroll
    for (int a = 0; a < 2; a++)
#pragma unroll
      for (int dt = 0; dt < 4; dt++) {
        union { bf16x8 v; uint2 h[2]; } vf;
        vf.h[0] = *(const uint2*)(cV + (dt * 16 + fr) * LDT + a * 32 + fq * 4);
        vf.h[1] = *(const uint2*)(cV + (dt * 16 + fr) * LDT + a * 32 + 16 + fq * 4);
#pragma unroll
        for (int qt = 0; qt < 2; qt++) ot[qt][dt] = MFMA(vf.v, pf[qt][a], ot[qt][dt]);
      }
    if (more) {
      u16* dK = sK + (cur ^ 1) * 64 * LDT;
      u16* dV = sV + (cur ^ 1) * 64 * LDT;
#pragma unroll
      for (int i = 0; i < 2; i++) {
        *(uint4*)(dK + (lrow + i * 32) * LDT + lcol) = rk[i];
        *(uint4*)(dV + (lrow + i * 32) * LDT + lcol) = rv[i];
      }
    }
    __syncthreads();
  }
  u16* MIX = (u16*)(P.ws + OFF_H);
#pragma unroll
  for (int qt = 0; qt < 2; qt++) {
    float l = lrun[qt];
    l = xor16_sum(l);
    l = xor32_sum(l);
    const float inv = __builtin_amdgcn_rcpf(l);
    const int t = qrow0 + qt * 16 + fr;
#pragma unroll
    for (int dt = 0; dt < 4; dt++) {
      uint2 o;
      o.x = pack2(ot[qt][dt][0] * inv, ot[qt][dt][1] * inv);
      o.y = pack2(ot[qt][dt][2] * inv, ot[qt][dt][3] * inv);
      *(uint2*)(MIX + (size_t)t * 1024 + 256 + head * 64 + dt * 16 + fq * 4) = o;
    }
  }
}

__device__ __forceinline__ void phase_even_mix(const Params& P, char* smem, int* qsh, const int rep) {
  unsigned* ctr = (unsigned*)(P.ws + OFF_Q + rep * 512);
  for (;;) {
    const int it = queue_next(ctr, qsh);
    if (it >= 1344) break;
    if (it < 128) fourier_tile(P, it, smem);
    else if (it < 896) attn_item(P, it - 128, smem);
    else if (it < 960) fourier_tile(P, it - 896 + 128, smem);
    else attn_item(P, it - 960 + 768, smem);
  }
}

__device__ __forceinline__ void ssd_conv8(const u16* __restrict__ PO, int col, const float* __restrict__ cw,
                                          const float* __restrict__ cb, int ch, int tg0, int lo, int hi,
                                          float (&o)[4][8]) {
  uint4 v[7];
#pragma unroll
  for (int r = 0; r < 7; r++) {
    const int t = tg0 - 1 + r;
    v[r] = make_uint4(0u, 0u, 0u, 0u);
    if (t >= lo && t < hi) v[r] = *(const uint4*)(PO + (size_t)t * 3456 + col);
  }
  float w[4][8], b[8];
#pragma unroll
  for (int j = 0; j < 4; j++) {
    const float4 w0 = *(const float4*)(cw + j * 1280 + ch);
    const float4 w1 = *(const float4*)(cw + j * 1280 + ch + 4);
    w[j][0] = w0.x; w[j][1] = w0.y; w[j][2] = w0.z; w[j][3] = w0.w;
    w[j][4] = w1.x; w[j][5] = w1.y; w[j][6] = w1.z; w[j][7] = w1.w;
  }
  {
    const float4 b0 = *(const float4*)(cb + ch);
    const float4 b1 = *(const float4*)(cb + ch + 4);
    b[0] = b0.x; b[1] = b0.y; b[2] = b0.z; b[3] = b0.w; b[4] = b1.x; b[5] = b1.y; b[6] = b1.z; b[7] = b1.w;
  }
#pragma unroll
  for (int tok = 0; tok < 4; tok++)
#pragma unroll
    for (int e = 0; e < 8; e++) o[tok][e] = b[e];
#pragma unroll
  for (int r = 0; r < 7; r++) {
    const unsigned uu[4] = {v[r].x, v[r].y, v[r].z, v[r].w};
#pragma unroll
    for (int e = 0; e < 8; e++) {
      const float x = __uint_as_float((e & 1) ? (uu[e >> 1] & 0xffff0000u) : (uu[e >> 1] << 16));
#pragma unroll
      for (int tok = 0; tok < 4; tok++) {
        const int j = r - tok;
        if (j >= 0 && j < 4) o[tok][e] += w[j][e] * x;
      }
    }
  }
#pragma unroll
  for (int tok = 0; tok < 4; tok++)
#pragma unroll
    for (int e = 0; e < 8; e++) o[tok][e] = silu_f(o[tok][e]);
}


__device__ __forceinline__ void phase_odd_conv(const Params& P) {
  const u16* PO = (const u16*)(P.ws + OFF_R1);
  u16* XC = (u16*)(P.ws + OFF_H);
  const float* cw = PRM(P, PRM_CSW);
  const float* cb = PRM(P, PRM_CSB);
  constexpr int NRUN = T_ALL / 16;
  const int nthr = gridDim.x * 256;
  for (int idx = blockIdx.x * 256 + threadIdx.x; idx < NRUN * 160; idx += nthr) {
    const int c8 = idx % 160, run = idx / 160;
    const int tb16 = run * 16;
    int lo, hi;
    if (tb16 < T_CTX) { lo = tb16 & ~255; hi = lo + 256; }
    else { lo = T_CTX + ((tb16 - T_CTX) & ~1023); hi = lo + 1024; }
    const int ch = c8 * 8;
    float w[4][8], bb[8];
#pragma unroll
    for (int j = 0; j < 4; j++) {
      const float4 w0 = *(const float4*)(cw + j * 1280 + ch);
      const float4 w1 = *(const float4*)(cw + j * 1280 + ch + 4);
      w[j][0] = w0.x; w[j][1] = w0.y; w[j][2] = w0.z; w[j][3] = w0.w;
      w[j][4] = w1.x; w[j][5] = w1.y; w[j][6] = w1.z; w[j][7] = w1.w;
    }
    {
      const float4 b0 = *(const float4*)(cb + ch);
      const float4 b1 = *(const float4*)(cb + ch + 4);
      bb[0] = b0.x; bb[1] = b0.y; bb[2] = b0.z; bb[3] = b0.w; bb[4] = b1.x; bb[5] = b1.y; bb[6] = b1.z; bb[7] = b1.w;
    }
    const u16* src = PO + 2048 + ch;
    u32x4 v[19];
#pragma unroll
    for (int r = 0; r < 19; r++) {
      const int t = tb16 - 1 + r;
      v[r] = u32x4{0u, 0u, 0u, 0u};
      if (t >= lo && t < hi) v[r] = *(const u32x4*)(src + (size_t)t * 3456);
    }
#pragma unroll
    for (int tok = 0; tok < 16; tok++) {
      float o[8];
#pragma unroll
      for (int e = 0; e < 8; e++) o[e] = bb[e];
#pragma unroll
      for (int j = 0; j < 4; j++) {
        const u32x4 vv = v[tok + j];
        const unsigned uu[4] = {vv.x, vv.y, vv.z, vv.w};
#pragma unroll
        for (int e = 0; e < 8; e++) {
          const float x = __uint_as_float((e & 1) ? (uu[e >> 1] & 0xffff0000u) : (uu[e >> 1] << 16));
          o[e] += w[j][e] * x;
        }
      }
      uint4 w4;
      w4.x = pack2(silu_f(o[0]), silu_f(o[1])); w4.y = pack2(silu_f(o[2]), silu_f(o[3]));
      w4.z = pack2(silu_f(o[4]), silu_f(o[5])); w4.w = pack2(silu_f(o[6]), silu_f(o[7]));
      *(uint4*)(XC + (size_t)(tb16 + tok) * 1280 + ch) = w4;
    }
  }
}

__device__ __forceinline__ void ssd_item(const Params& P, int item, char* smem) {
  const int tid = threadIdx.x, lane = tid & 63, wave = tid >> 6;
  const int fr = lane & 15, fq = lane >> 4;
  bool smp; int seq;
  if (item < 256) { smp = true; seq = item >> 5; }
  else { item -= 256; smp = false; seq = item >> 5; }
  const int head = (item & 31) >> 1, dir = item & 1;
  const int nc = smp ? 8 : 2;
  const int tb = smp ? T_CTX + seq * 1024 : seq * 256;
  const int tend = tb + (smp ? 1024 : 256);
  const int g = head >> 3;
  u16* Cs = (u16*)smem;
  u16* Bs = (u16*)(smem + 18432);
  u16* BT = (u16*)(smem + 36864);
  u16* XT = (u16*)(smem + 54272);
  u16* Hb = (u16*)(smem + 71680);
  float* cum2 = (float*)(smem + 79872);
  float* lcs2 = (float*)(smem + 80384);
  float* misc = (float*)(smem + 81408);
  const u16* PO = (const u16*)(P.ws + OFF_R1);
  const float* DT = (const float*)(P.ws + OFF_DT);
  u16* YO = (u16*)(P.ws + OFF_Y) + (size_t)dir * T_ALL * 1024;
  const float Aneg = -__expf(PRM(P, PRM_ALOG)[dir * 16 + head]);
  const float dtb = PRM(P, PRM_DTB)[dir * 16 + head];
  const float Dh = PRM(P, PRM_SSDD)[head];
  f32x4 hacc[4];
#pragma unroll
  for (int nt = 0; nt < 4; nt++) {
#pragma unroll
    for (int r = 0; r < 4; r++) {
      float v = 0.f;
      if (smp) v = P.in[6][(size_t)((seq * 2 + dir) * 16 + head) * 4096 + (wave * 16 + fq * 4 + r) * 64 + nt * 16 + fr];
      hacc[nt][r] = v;
      Hb[(wave * 16 + fq * 4 + r) * 64 + nt * 16 + fr] = f2bf(v);
    }
  }
  const int ch8 = (tid & 7) * 8, rg = tid >> 3;
  const u16* XC = (const u16*)(P.ws + OFF_H);
  u32x4 rx0, rx1, rx2, rx3, rb0, rb1, rb2, rb3;
  float raw_next = 0.f;
  {
    const int c0 = dir ? nc - 1 : 0;
    const u16* xr = XC + (size_t)(tb + c0 * 128 + rg * 4) * 1280 + ch8;
    rx0 = *(const u32x4*)(xr + head * 64); rx1 = *(const u32x4*)(xr + 1280 + head * 64);
    rx2 = *(const u32x4*)(xr + 2560 + head * 64); rx3 = *(const u32x4*)(xr + 3840 + head * 64);
    rb0 = *(const u32x4*)(xr + 1024 + g * 64); rb1 = *(const u32x4*)(xr + 1280 + 1024 + g * 64);
    rb2 = *(const u32x4*)(xr + 2560 + 1024 + g * 64); rb3 = *(const u32x4*)(xr + 3840 + 1024 + g * 64);
    if (tid < 128) raw_next = DT[(size_t)(tb + c0 * 128 + (dir ? 127 - tid : tid)) * 32 + dir * 16 + head];
  }
  for (int ci = 0; ci < nc; ci++) {
    const int c = dir ? nc - 1 - ci : ci;
    const int t0 = tb + c * 128;
    {
      const u16* xrc = XC + (size_t)(t0 + rg * 4) * 1280 + ch8 + 1152 + g * 64;
      const u32x4 rc0 = *(const u32x4*)(xrc), rc1 = *(const u32x4*)(xrc + 1280);
      const u32x4 rc2 = *(const u32x4*)(xrc + 2560), rc3 = *(const u32x4*)(xrc + 3840);
      {
        const unsigned u[4][4] = {{rx0.x, rx0.y, rx0.z, rx0.w}, {rx1.x, rx1.y, rx1.z, rx1.w}, {rx2.x, rx2.y, rx2.z, rx2.w}, {rx3.x, rx3.y, rx3.z, rx3.w}};
#pragma unroll
        for (int q = 0; q < 4; q++) {
          uint2 lo2, hi2;
          lo2.x = (u[0][q] & 0xffffu) | (u[1][q] << 16); lo2.y = (u[2][q] & 0xffffu) | (u[3][q] << 16);
          hi2.x = (u[0][q] >> 16) | (u[1][q] & 0xffff0000u); hi2.y = (u[2][q] >> 16) | (u[3][q] & 0xffff0000u);
          *(uint2*)(XT + (ch8 + 2 * q) * 136 + rg * 4) = lo2;
          *(uint2*)(XT + (ch8 + 2 * q + 1) * 136 + rg * 4) = hi2;
        }
      }
      {
        const unsigned u[4][4] = {{rb0.x, rb0.y, rb0.z, rb0.w}, {rb1.x, rb1.y, rb1.z, rb1.w}, {rb2.x, rb2.y, rb2.z, rb2.w}, {rb3.x, rb3.y, rb3.z, rb3.w}};
#pragma unroll
        for (int q = 0; q < 4; q++) {
          uint2 lo2, hi2;
          lo2.x = (u[0][q] & 0xffffu) | (u[1][q] << 16); lo2.y = (u[2][q] & 0xffffu) | (u[3][q] << 16);
          hi2.x = (u[0][q] >> 16) | (u[1][q] & 0xffff0000u); hi2.y = (u[2][q] >> 16) | (u[3][q] & 0xffff0000u);
          *(uint2*)(BT + (ch8 + 2 * q) * 136 + rg * 4) = lo2;
          *(uint2*)(BT + (ch8 + 2 * q + 1) * 136 + rg * 4) = hi2;
        }
        *(u32x4*)(Bs + (rg * 4 + 0) * LDT + ch8) = rb0;
        *(u32x4*)(Bs + (rg * 4 + 1) * LDT + ch8) = rb1;
        *(u32x4*)(Bs + (rg * 4 + 2) * LDT + ch8) = rb2;
        *(u32x4*)(Bs + (rg * 4 + 3) * LDT + ch8) = rb3;
      }
      *(u32x4*)(Cs + (rg * 4 + 0) * LDT + ch8) = rc0;
      *(u32x4*)(Cs + (rg * 4 + 1) * LDT + ch8) = rc1;
      *(u32x4*)(Cs + (rg * 4 + 2) * LDT + ch8) = rc2;
      *(u32x4*)(Cs + (rg * 4 + 3) * LDT + ch8) = rc3;
    }
    const float raw_cur = raw_next;
    __builtin_amdgcn_sched_barrier(0);
    if (ci + 1 < nc) {
      const int cn = dir ? nc - 2 - ci : ci + 1;
      const u16* xr = XC + (size_t)(tb + cn * 128 + rg * 4) * 1280 + ch8;
      rx0 = *(const u32x4*)(xr + head * 64); rx1 = *(const u32x4*)(xr + 1280 + head * 64);
      rx2 = *(const u32x4*)(xr + 2560 + head * 64); rx3 = *(const u32x4*)(xr + 3840 + head * 64);
      rb0 = *(const u32x4*)(xr + 1024 + g * 64); rb1 = *(const u32x4*)(xr + 1280 + 1024 + g * 64);
      rb2 = *(const u32x4*)(xr + 2560 + 1024 + g * 64); rb3 = *(const u32x4*)(xr + 3840 + 1024 + g * 64);
      if (tid < 128) raw_next = DT[(size_t)(tb + cn * 128 + (dir ? 127 - tid : tid)) * 32 + dir * 16 + head];
    }
    __builtin_amdgcn_sched_barrier(0);
    float sv = 0.f, dtv = 1.f;
    int li = 0;
    if (tid < 128) {
      li = dir ? 127 - tid : tid;
      const float raw = raw_cur + dtb;
      dtv = fmaxf(raw, 0.f) + log1pf(__expf(-fabsf(raw)));
      sv = dtv * Aneg;
#pragma unroll
      for (int o = 1; o < 64; o <<= 1) {
        const float u = __shfl_up(sv, o);
        if (lane >= o) sv += u;
      }
      if (tid == 63) misc[0] = sv;
    }
    __syncthreads();
    if (tid < 128) {
      if (wave == 1) sv += misc[0];
      cum2[li] = sv * LOG2E;
      lcs2[li] = (sv - __logf(dtv)) * LOG2E;
      if (tid == 127) misc[1] = sv * LOG2E;
    }
    __syncthreads();
    const float total2 = misc[1];
#pragma unroll 1
    for (int tt = 0; tt < 2; tt++) {
      const int Tt = wave * 2 + tt;
      const int tl = wave * 32 + tt * 16 + fr;
      bf16x8 cf[2];
#pragma unroll
      for (int kk = 0; kk < 2; kk++) cf[kk] = *(const bf16x8*)(Cs + tl * LDT + kk * 32 + fq * 8);
      f32x4 acc[4];
#pragma unroll
      for (int pt = 0; pt < 4; pt++) {
        const bf16x8 h0 = *(const bf16x8*)(Hb + (pt * 16 + fr) * 64 + fq * 8);
        const bf16x8 h1 = *(const bf16x8*)(Hb + (pt * 16 + fr) * 64 + 32 + fq * 8);
        f32x4 z = f32x4{0.f, 0.f, 0.f, 0.f};
        z = MFMA(h0, cf[0], z);
        acc[pt] = MFMA(h1, cf[1], z);
      }
      const float ct = cum2[tl];
      {
        const float e = fexp2(ct);
#pragma unroll
        for (int pt = 0; pt < 4; pt++)
#pragma unroll
          for (int r = 0; r < 4; r++) acc[pt][r] *= e;
      }
#pragma unroll 1
      for (int a = 0; a < 4; a++) {
        const bool ok = dir ? (2 * a + 1 >= Tt) : (2 * a <= Tt);
        if (!ok) continue;
        f32x4 g0 = f32x4{0.f, 0.f, 0.f, 0.f}, g1 = f32x4{0.f, 0.f, 0.f, 0.f};
#pragma unroll
        for (int kk = 0; kk < 2; kk++) {
          const bf16x8 b0 = *(const bf16x8*)(Bs + ((2 * a) * 16 + fr) * LDT + kk * 32 + fq * 8);
          const bf16x8 b1 = *(const bf16x8*)(Bs + ((2 * a + 1) * 16 + fr) * LDT + kk * 32 + fq * 8);
          g0 = MFMA(b0, cf[kk], g0);
          g1 = MFMA(b1, cf[kk], g1);
        }
        const float4 l0 = *(const float4*)(lcs2 + a * 32 + fq * 4);
        const float4 l1 = *(const float4*)(lcs2 + a * 32 + 16 + fq * 4);
        const float ls0[4] = {l0.x, l0.y, l0.z, l0.w};
        const float ls1[4] = {l1.x, l1.y, l1.z, l1.w};
        float m0[4], m1[4];
#pragma unroll
        for (int r = 0; r < 4; r++) {
          const int s0 = a * 32 + fq * 4 + r, s1 = s0 + 16;
          const bool ok0 = dir ? (s0 >= tl) : (s0 <= tl);
          const bool ok1 = dir ? (s1 >= tl) : (s1 <= tl);
          float v0 = ok0 ? g0[r] * fexp2(ct - ls0[r]) : 0.f;
          float v1 = ok1 ? g1[r] * fexp2(ct - ls1[r]) : 0.f;
          if (!dir && s0 == tl) v0 += Dh;
          if (!dir && s1 == tl) v1 += Dh;
          m0[r] = v0; m1[r] = v1;
        }
        union { bf16x8 v; unsigned u[4]; } pk;
        pk.u[0] = pack2(m0[0], m0[1]); pk.u[1] = pack2(m0[2], m0[3]);
        pk.u[2] = pack2(m1[0], m1[1]); pk.u[3] = pack2(m1[2], m1[3]);
#pragma unroll
        for (int pt = 0; pt < 4; pt++) {
          union { bf16x8 v; uint2 h[2]; } x;
          x.h[0] = *(const uint2*)(XT + (pt * 16 + fr) * 136 + a * 32 + fq * 4);
          x.h[1] = *(const uint2*)(XT + (pt * 16 + fr) * 136 + a * 32 + 16 + fq * 4);
          acc[pt] = MFMA(x.v, pk.v, acc[pt]);
        }
      }
      {
        const int t = t0 + tl;
#pragma unroll
        for (int pt = 0; pt < 4; pt++) {
          uint2 o;
          o.x = pack2(acc[pt][0], acc[pt][1]);
          o.y = pack2(acc[pt][2], acc[pt][3]);
          *(uint2*)(YO + (size_t)t * 1024 + head * 64 + pt * 16 + fq * 4) = o;
        }
      }
    }
    {
      const float et = fexp2(total2);
#pragma unroll
      for (int nt = 0; nt < 4; nt++)
#pragma unroll
        for (int r = 0; r < 4; r++) hacc[nt][r] *= et;
#pragma unroll 1
      for (int ks = 0; ks < 4; ks++) {
        union { bf16x8 v; unsigned u[4]; } xr, xw;
        xr.v = *(const bf16x8*)(XT + (wave * 16 + fr) * 136 + ks * 32 + fq * 8);
        const float4 la = *(const float4*)(lcs2 + ks * 32 + fq * 8);
        const float4 lb = *(const float4*)(lcs2 + ks * 32 + fq * 8 + 4);
        const float lw[8] = {la.x, la.y, la.z, la.w, lb.x, lb.y, lb.z, lb.w};
#pragma unroll
        for (int q = 0; q < 4; q++) {
          const float x0 = __uint_as_float(xr.u[q] << 16) * fexp2(total2 - lw[2 * q]);
          const float x1 = __uint_as_float(xr.u[q] & 0xffff0000u) * fexp2(total2 - lw[2 * q + 1]);
          xw.u[q] = pack2(x0, x1);
        }
#pragma unroll
        for (int nt = 0; nt < 4; nt++) {
          const bf16x8 bt = *(const bf16x8*)(BT + (nt * 16 + fr) * 136 + ks * 32 + fq * 8);
          hacc[nt] = MFMA(xw.v, bt, hacc[nt]);
        }
      }
    }
    __syncthreads();
#pragma unroll
    for (int nt = 0; nt < 4; nt++)
#pragma unroll
      for (int r = 0; r < 4; r++) Hb[(wave * 16 + fq * 4 + r) * 64 + nt * 16 + fr] = f2bf(hacc[nt][r]);
  }
  if (!smp) {
    float* ns = P.out + 14696448 + (size_t)((seq * 2 + dir) * 16 + head) * 4096;
#pragma unroll
    for (int nt = 0; nt < 4; nt++)
#pragma unroll
      for (int r = 0; r < 4; r++) ns[(wave * 16 + fq * 4 + r) * 64 + nt * 16 + fr] = hacc[nt][r];
  }
  __syncthreads();
}

__device__ __forceinline__ void lru_item(const Params& P, int item, char* smem) {
  const int tid = threadIdx.x, lane = tid & 63, wave = tid >> 6;
  const int fr = lane & 15, fq = lane >> 4;
  bool smp; int seq;
  if (item < 128) { smp = true; seq = item >> 4; }
  else { item -= 128; smp = false; seq = item >> 4; }
  const int blk = (item & 15) >> 1, dir = item & 1;
  const int nc = smp ? 16 : 4;
  const int tb = smp ? T_CTX + seq * 1024 : seq * 256;
  const int tend = tb + (smp ? 1024 : 256);
  u16* WaT = (u16*)smem;
  u16* WxT = (u16*)(smem + 9216);
  u16* xcb = (u16*)(smem + 18432);
  float* aL = (float*)(smem + 27648);
  float* bL = (float*)(smem + 45056);
  float* sA = (float*)(smem + 62464);
  float* sH = (float*)(smem + 63488);
  float* hc = (float*)(smem + 64512);
  float* cba = (float*)(smem + 65024);
  float* cbx = (float*)(smem + 65280);
  float* csp = (float*)(smem + 65536);
  const u16* PO = (const u16*)(P.ws + OFF_R1);
  u16* YO = (u16*)(P.ws + OFF_YL) + (size_t)dir * T_ALL * 512;
  {
    const float* wa = PRM(P, PRM_LWA) + (size_t)(dir * 8 + blk) * 4096;
    const float* wx = PRM(P, PRM_LWX) + (size_t)(dir * 8 + blk) * 4096;
    for (int e = tid; e < 4096; e += 256) {
      const int i = e >> 6, j = e & 63;
      WaT[j * LDT + i] = f2bf(wa[e]);
      WxT[j * LDT + i] = f2bf(wx[e]);
    }
    if (tid < 64) {
      const int ch = dir * 512 + blk * 64 + tid;
      cba[tid] = PRM(P, PRM_LBA)[ch];
      cbx[tid] = PRM(P, PRM_LBX)[ch];
      const float lam = -PRM(P, PRM_LAM)[ch];
      csp[tid] = 8.0f * (fmaxf(lam, 0.f) + log1pf(__expf(-fabsf(lam))));
      hc[tid] = smp ? P.in[5][(size_t)(seq * 2 + dir) * 512 + blk * 64 + tid] : 0.f;
    }
  }
  const int ch8 = (tid & 7) * 8, rg = tid >> 3;
  const float* cw = PRM(P, PRM_CLW);
  const float* cb = PRM(P, PRM_CLB);
  u32x4 pv0, pv1, pv2, pv3, pv4;
  {
    const int c0 = dir ? nc - 1 : 0;
    const int tn = tb + c0 * 64 + rg * 2 - 1;
    const int chg = blk * 64 + ch8;
    const u32x4 zz = {0u, 0u, 0u, 0u};
    pv0 = (tn >= tb) ? *(const u32x4*)(PO + (size_t)tn * 3456 + 512 + chg) : zz;
    pv1 = *(const u32x4*)(PO + (size_t)(tn + 1) * 3456 + 512 + chg);
    pv2 = *(const u32x4*)(PO + (size_t)(tn + 2) * 3456 + 512 + chg);
    pv3 = (tn + 3 < tend) ? *(const u32x4*)(PO + (size_t)(tn + 3) * 3456 + 512 + chg) : zz;
    pv4 = (tn + 4 < tend) ? *(const u32x4*)(PO + (size_t)(tn + 4) * 3456 + 512 + chg) : zz;
  }
  for (int ci = 0; ci < nc; ci++) {
    const int c = dir ? nc - 1 - ci : ci;
    const int t0 = tb + c * 64;
    const int cur = ci & 1;
    {
      const int chg = blk * 64 + ch8;
      const u32x4 v[5] = {pv0, pv1, pv2, pv3, pv4};
      if (ci + 1 < nc) {
        const int cn = dir ? nc - 2 - ci : ci + 1;
        const int tn = tb + cn * 64 + rg * 2 - 1;
        const u32x4 zz = {0u, 0u, 0u, 0u};
        pv0 = (tn >= tb) ? *(const u32x4*)(PO + (size_t)tn * 3456 + 512 + chg) : zz;
        pv1 = *(const u32x4*)(PO + (size_t)(tn + 1) * 3456 + 512 + chg);
        pv2 = *(const u32x4*)(PO + (size_t)(tn + 2) * 3456 + 512 + chg);
        pv3 = (tn + 3 < tend) ? *(const u32x4*)(PO + (size_t)(tn + 3) * 3456 + 512 + chg) : zz;
        pv4 = (tn + 4 < tend) ? *(const u32x4*)(PO + (size_t)(tn + 4) * 3456 + 512 + chg) : zz;
      }
      float o[2][8];
      {
        const float4 b0 = *(const float4*)(cb + chg);
        const float4 b1 = *(const float4*)(cb + chg + 4);
        const float bb[8] = {b0.x, b0.y, b0.z, b0.w, b1.x, b1.y, b1.z, b1.w};
#pragma unroll
        for (int e = 0; e < 8; e++) { o[0][e] = bb[e]; o[1][e] = bb[e]; }
      }
#pragma unroll
      for (int j = 0; j < 4; j++) {
        const float4 w0 = *(const float4*)(cw + j * 512 + chg);
        const float4 w1 = *(const float4*)(cw + j * 512 + chg + 4);
        const float ww[8] = {w0.x, w0.y, w0.z, w0.w, w1.x, w1.y, w1.z, w1.w};
#pragma unroll
        for (int tok = 0; tok < 2; tok++) {
          const unsigned uu[4] = {v[tok + j].x, v[tok + j].y, v[tok + j].z, v[tok + j].w};
#pragma unroll
          for (int e = 0; e < 8; e++) {
            const float x = __uint_as_float((e & 1) ? (uu[e >> 1] & 0xffff0000u) : (uu[e >> 1] << 16));
            o[tok][e] += ww[e] * x;
          }
        }
      }
#pragma unroll
      for (int tok = 0; tok < 2; tok++) {
        const int tl = rg * 2 + tok;
        *(float4*)(bL + tl * 68 + ch8) = make_float4(o[tok][0], o[tok][1], o[tok][2], o[tok][3]);
        *(float4*)(bL + tl * 68 + ch8 + 4) = make_float4(o[tok][4], o[tok][5], o[tok][6], o[tok][7]);
        uint4 w4;
        w4.x = pack2(o[tok][0], o[tok][1]); w4.y = pack2(o[tok][2], o[tok][3]);
        w4.z = pack2(o[tok][4], o[tok][5]); w4.w = pack2(o[tok][6], o[tok][7]);
        *(uint4*)(xcb + tl * LDT + ch8) = w4;
      }
    }
    __syncthreads();
    {
      bf16x8 xb[2];
#pragma unroll
      for (int kk = 0; kk < 2; kk++) xb[kk] = *(const bf16x8*)(xcb + (wave * 16 + fr) * LDT + kk * 32 + fq * 8);
      const int tl = wave * 16 + fr;
#pragma unroll
      for (int jt = 0; jt < 4; jt++) {
        f32x4 aR = f32x4{0.f, 0.f, 0.f, 0.f}, aI = f32x4{0.f, 0.f, 0.f, 0.f};
#pragma unroll
        for (int kk = 0; kk < 2; kk++) {
          const bf16x8 wa = *(const bf16x8*)(WaT + (jt * 16 + fr) * LDT + kk * 32 + fq * 8);
          const bf16x8 wx = *(const bf16x8*)(WxT + (jt * 16 + fr) * LDT + kk * 32 + fq * 8);
          aR = MFMA(wa, xb[kk], aR);
          aI = MFMA(wx, xb[kk], aI);
        }
        const int j4 = jt * 16 + fq * 4;
        const float4 xc = *(const float4*)(bL + tl * 68 + j4);
        const float4 ba = *(const float4*)(cba + j4);
        const float4 bx = *(const float4*)(cbx + j4);
        const float4 sp = *(const float4*)(csp + j4);
        const float xcv[4] = {xc.x, xc.y, xc.z, xc.w};
        const float bav[4] = {ba.x, ba.y, ba.z, ba.w};
        const float bxv[4] = {bx.x, bx.y, bx.z, bx.w};
        const float spv[4] = {sp.x, sp.y, sp.z, sp.w};
        float av[4], bv[4];
#pragma unroll
        for (int r = 0; r < 4; r++) {
          const float rr = sigmoid_f(aR[r] + bav[r]);
          const float ii = sigmoid_f(aI[r] + bxv[r]);
          const float la = -rr * spv[r];
          av[r] = __expf(la);
          bv[r] = __builtin_amdgcn_sqrtf(fmaxf(1.0f - av[r] * av[r], 0.f)) * ii * xcv[r];
        }
        *(float4*)(aL + tl * 68 + j4) = make_float4(av[0], av[1], av[2], av[3]);
        *(float4*)(bL + tl * 68 + j4) = make_float4(bv[0], bv[1], bv[2], bv[3]);
      }
    }
    __syncthreads();
    {
      const int j = lane, q = wave;
      float hreg[16], areg[16];
      float h = 0.f, Ap = 1.f;
#pragma unroll
      for (int i = 0; i < 16; i++) {
        const int tl = dir ? 63 - (q * 16 + i) : q * 16 + i;
        const float a = aL[tl * 68 + j], b = bL[tl * 68 + j];
        h = a * h + b;
        Ap *= a;
        hreg[i] = h;
        areg[i] = Ap;
      }
      sA[q * 64 + j] = Ap;
      sH[q * 64 + j] = h;
      __syncthreads();
      float Hin = hc[cur * 64 + j];
      for (int qq = 0; qq < q; qq++) Hin = sA[qq * 64 + j] * Hin + sH[qq * 64 + j];
#pragma unroll
      for (int i = 0; i < 16; i++) {
        const int tl = dir ? 63 - (q * 16 + i) : q * 16 + i;
        const float hv = hreg[i] + areg[i] * Hin;
        YO[(size_t)(t0 + tl) * 512 + blk * 64 + j] = f2bf(hv);
      }
      if (q == 3) hc[(cur ^ 1) * 64 + j] = sA[3 * 64 + j] * Hin + sH[3 * 64 + j];
    }
  }
  __syncthreads();
  if (!smp && tid < 64) {
    P.out[14680064 + (size_t)(seq * 2 + dir) * 512 + blk * 64 + tid] = hc[(nc & 1) * 64 + tid];
  }
  __syncthreads();
}

__device__ __forceinline__ void phase_odd_mix(const Params& P, char* smem, int* qsh, const int rep) {
  unsigned* ctr = (unsigned*)(P.ws + OFF_Q + 256 + rep * 512);
  for (;;) {
    const int it = queue_next(ctr, qsh);
    if (it >= 1152) break;
    bool is_ssd; int idx;
    if (it < 128) { is_ssd = false; idx = it; }
    else if (it < 384) { is_ssd = true; idx = it - 128; }
    else if (it < 640) { is_ssd = false; idx = it - 384 + 128; }
    else { is_ssd = true; idx = it - 640 + 256; }
    if (is_ssd) ssd_item(P, idx, smem);
    else lru_item(P, idx, smem);
  }
}

__device__ __forceinline__ void phase_odd_combine(const Params& P) {
  const int tid = threadIdx.x, lane = tid & 63, wave = tid >> 6;
  const u16* PO = (const u16*)(P.ws + OFF_R1);
  const u16* YSF = (const u16*)(P.ws + OFF_Y);
  const u16* YSB = YSF + (size_t)T_ALL * 1024;
  const u16* YLF = (const u16*)(P.ws + OFF_YL);
  const u16* YLB = YLF + (size_t)T_ALL * 512;
  u16* MIX = (u16*)(P.ws + OFF_H);
  const float* nrm = PRM(P, PRM_SNORM);
  float4 nr[2][2];
#pragma unroll
  for (int hh = 0; hh < 2; hh++) { nr[hh][0] = *(const float4*)(nrm + hh * 512 + lane * 8); nr[hh][1] = *(const float4*)(nrm + hh * 512 + lane * 8 + 4); }
  for (int t = blockIdx.x * 4 + wave; t < T_ALL; t += gridDim.x * 4) {
    {
      const int c = lane * 8;
      const uint4 f = *(const uint4*)(YLF + (size_t)t * 512 + c);
      const uint4 b = *(const uint4*)(YLB + (size_t)t * 512 + c);
      const uint4 gg = *(const uint4*)(PO + (size_t)t * 3456 + c);
      const unsigned fu[4] = {f.x, f.y, f.z, f.w}, bu[4] = {b.x, b.y, b.z, b.w}, gu[4] = {gg.x, gg.y, gg.z, gg.w};
      unsigned ou[4];
#pragma unroll
      for (int q = 0; q < 4; q++) {
        float r[2];
#pragma unroll
        for (int h = 0; h < 2; h++) {
          const float yf = h ? __uint_as_float(fu[q] & 0xffff0000u) : __uint_as_float(fu[q] << 16);
          const float yb = h ? __uint_as_float(bu[q] & 0xffff0000u) : __uint_as_float(bu[q] << 16);
          const float gv = h ? __uint_as_float(gu[q] & 0xffff0000u) : __uint_as_float(gu[q] << 16);
          const float ge = gv * __builtin_amdgcn_rcpf(1.f + __expf(-2.0f * 0.7978845608028654f * (gv + 0.044715f * gv * gv * gv)));
          r[h] = (yf + yb) * ge;
        }
        ou[q] = pack2(r[0], r[1]);
      }
      *(uint4*)(MIX + (size_t)t * 1536 + c) = make_uint4(ou[0], ou[1], ou[2], ou[3]);
    }
    float y[16];
    float ss = 0.f;
#pragma unroll
    for (int hh = 0; hh < 2; hh++) {
      const int c = hh * 512 + lane * 8;
      const uint4 f = *(const uint4*)(YSF + (size_t)t * 1024 + c);
      const uint4 b = *(const uint4*)(YSB + (size_t)t * 1024 + c);
      const uint4 zz = *(const uint4*)(PO + (size_t)t * 3456 + 1024 + c);
      const unsigned fu[4] = {f.x, f.y, f.z, f.w}, bu[4] = {b.x, b.y, b.z, b.w}, zu[4] = {zz.x, zz.y, zz.z, zz.w};
#pragma unroll
      for (int q = 0; q < 4; q++)
#pragma unroll
        for (int h = 0; h < 2; h++) {
          const float yf = h ? __uint_as_float(fu[q] & 0xffff0000u) : __uint_as_float(fu[q] << 16);
          const float yb = h ? __uint_as_float(bu[q] & 0xffff0000u) : __uint_as_float(bu[q] << 16);
          const float zv = h ? __uint_as_float(zu[q] & 0xffff0000u) : __uint_as_float(zu[q] << 16);
          const float v = (yf + yb) * silu_f(zv);
          y[hh * 8 + q * 2 + h] = v;
          ss += v * v;
        }
    }
#pragma unroll
    for (int o = 32; o >= 1; o >>= 1) ss += __shfl_xor(ss, o);
    const float rs = rsqrtf(ss * (1.0f / 1024.0f) + 1e-6f);
#pragma unroll
    for (int hh = 0; hh < 2; hh++) {
      const int c = hh * 512 + lane * 8;
      const float4 n0 = nr[hh][0];
      const float4 n1 = nr[hh][1];
      uint4 o;
      o.x = pack2(y[hh * 8 + 0] * rs * n0.x, y[hh * 8 + 1] * rs * n0.y);
      o.y = pack2(y[hh * 8 + 2] * rs * n0.z, y[hh * 8 + 3] * rs * n0.w);
      o.z = pack2(y[hh * 8 + 4] * rs * n1.x, y[hh * 8 + 5] * rs * n1.y);
      o.w = pack2(y[hh * 8 + 6] * rs * n1.z, y[hh * 8 + 7] * rs * n1.w);
      *(uint4*)(MIX + (size_t)t * 1536 + 512 + c) = o;
    }
  }
}

#ifndef PHMASK
#define PHMASK 0xffffffu
#endif
__device__ __forceinline__ void run_phase(const Params& P, const int ph, char* smem, int* qsh, const int rep = 0) {
  switch (ph) {
    case 0: if (PHMASK & (1u << 0)) phase_prep(P, smem, qsh); break;
    case 1: if (PHMASK & (1u << 1)) phase_norm(P, 0, 0); break;
    case 2: if (PHMASK & (1u << 2)) phase_gemm_in_even(P, smem); break;
    case 3: if (PHMASK & (1u << 3)) phase_even_mix(P, smem, qsh, rep); break;
    case 4: if (PHMASK & (1u << 4)) phase_gemm_resid(P, smem, (const u16*)(P.ws + OFF_H), 1024, (const u16*)(P.ws + OFF_WOE), 1024, 0, 2, true); break;
    case 5: if (PHMASK & (1u << 5)) phase_norm(P, 0, 1); break;
    case 6: if (PHMASK & (1u << 6)) phase_gemm_ffn_up(P, smem, 0); break;
    case 7: if (PHMASK & (1u << 7)) phase_gemm_resid(P, smem, (const u16*)(P.ws + OFF_R1), 2816, (const u16*)(P.ws + OFF_W2), 2816, 0, 5, false); break;
    case 8: if (PHMASK & (1u << 8)) phase_norm(P, 1, 0); break;
    case 9: if (PHMASK & (1u << 9)) phase_gemm_in_odd(P, smem); break;
    case 10: if (PHMASK & (1u << 10)) phase_odd_conv(P); break;
    case 11: if (PHMASK & (1u << 11)) phase_odd_mix(P, smem, qsh, rep); break;
    case 12: if (PHMASK & (1u << 12)) phase_odd_combine(P); break;
    case 13: if (PHMASK & (1u << 13)) phase_gemm_resid(P, smem, (const u16*)(P.ws + OFF_H), 1536, (const u16*)(P.ws + OFF_WOO), 1536, 1, 2, false); break;
    case 14: if (PHMASK & (1u << 14)) phase_norm(P, 1, 1); break;
    case 15: if (PHMASK & (1u << 15)) phase_gemm_ffn_up(P, smem, 1); break;
    case 16: if (PHMASK & (1u << 16)) phase_gemm_resid(P, smem, (const u16*)(P.ws + OFF_R1), 2816, (const u16*)(P.ws + OFF_W2) + (size_t)1024 * 2816, 2816, 1, 5, false); break;
    default: break;
  }
}

constexpr int N_PHASES = 17;

__global__ void __launch_bounds__(256, 2) mega_kernel(Params P, int ph_lo, int ph_hi) {
  __shared__ __attribute__((aligned(16))) char smem[SMEM_BYTES];
  __shared__ uint4 xb_words;
  __shared__ int q_item;
  cg::grid_group grid = cg::this_grid();
  if (threadIdx.x == 0) xb_words = make_uint4(0u, 0u, 0u, 0u);
  __syncthreads();
  XcdBarrier xb = xcd_barrier_post((unsigned*)(P.ws + OFF_BAR), (volatile LAS unsigned*)&xb_words);
  if (ph_lo < 0) grid.sync();
#ifndef DUP_PH
#define DUP_PH -1
#endif
#define RUN_PH(ph) if ((ph) >= ph_lo && (ph) < ph_hi) { run_phase(P, (ph), smem, &q_item); if (DUP_PH == (ph)) { xcd_barrier(xb); run_phase(P, (ph), smem, &q_item, 1); } if ((ph) + 1 < ph_hi) xcd_barrier(xb); }
  RUN_PH(0) RUN_PH(1) RUN_PH(2) RUN_PH(3) RUN_PH(4) RUN_PH(5) RUN_PH(6) RUN_PH(7)
  RUN_PH(8) RUN_PH(9) RUN_PH(10) RUN_PH(11) RUN_PH(12) RUN_PH(13) RUN_PH(14) RUN_PH(15) RUN_PH(16)
}

#ifndef MULTI_LAUNCH
#define MULTI_LAUNCH 0
#endif

extern "C" void kernel_launch(void* const* d_in, const int* in_sizes, int n_in, void* d_out, int out_size, void* d_ws,
                              size_t ws_size, hipStream_t stream) {
  static int grid_blocks = 0;
  if (!grid_blocks) {
    int dev = 0, cus = 0, per_cu = 0;
    (void)hipGetDevice(&dev);
    (void)hipDeviceGetAttribute(&cus, hipDeviceAttributeMultiprocessorCount, dev);
    (void)hipOccupancyMaxActiveBlocksPerMultiprocessor(&per_cu, mega_kernel, 256, 0);
    if (per_cu > 2) per_cu = 2;
    if (per_cu < 1) per_cu = 1;
    grid_blocks = cus * per_cu;
  }
  Params p;
  memset(&p, 0, sizeof(p));
  for (int i = 0; i < 34; i++) p.in[i] = (const float*)d_in[i];
  p.out = (float*)d_out;
  p.ws = (char*)d_ws;
#if MULTI_LAUNCH
  for (int ph = 0; ph < N_PHASES; ph++) {
    int lo = ph, hi = ph + 1;
    void* args[] = {&p, &lo, &hi};
    hipError_t e = hipLaunchCooperativeKernel((void*)mega_kernel, dim3(grid_blocks), dim3(256), args, 0, stream);
    if (e != hipSuccess) fprintf(stderr, "launch failed: %s (grid %d)\n", hipGetErrorString(e), grid_blocks);
  }
#else
  (void)hipMemsetAsync((char*)d_ws + OFF_BAR, 0, 24576, stream);
  int lo = 0, hi = N_PHASES;
  void* args[] = {&p, &lo, &hi};
  hipError_t e = hipLaunchCooperativeKernel((void*)mega_kernel, dim3(grid_blocks), dim3(256), args, 0, stream);
  if (e != hipSuccess) fprintf(stderr, "cooperative launch failed: %s (grid %d)\n", hipGetErrorString(e), grid_blocks);
#endif
}
```

```cpp
#include <hip/hip_runtime.h>
#include <hip/hip_bf16.h>
#include <hip/hip_cooperative_groups.h>
#include <cstdio>
#include <cstring>
namespace cg = cooperative_groups;

typedef unsigned short u16;
using bf16x8 = __attribute__((ext_vector_type(8))) short;
using bf16x4 = __attribute__((ext_vector_type(4))) short;
using f32x4 = __attribute__((ext_vector_type(4))) float;

#define MFMA(a, b, c) __builtin_amdgcn_mfma_f32_16x16x32_bf16(a, b, c, 0, 0, 0)
#define LOG2E 1.4426950408889634f

constexpr int T_ALL = 12288;
constexpr int T_CTX = 4096;
constexpr int SMEM_BYTES = 81664;
constexpr int LDT = 72;

constexpr size_t OFF_WIE = 0;
constexpr size_t OFF_WOE = OFF_WIE + 3670016;
constexpr size_t OFF_WIO = OFF_WOE + 2097152;
constexpr size_t OFF_WOO = OFF_WIO + 7077888;
constexpr size_t OFF_W13 = OFF_WOO + 3145728;
constexpr size_t OFF_W2 = OFF_W13 + 23068672;
constexpr size_t OFF_MOD = OFF_W2 + 11534336;
constexpr size_t OFF_D1K = OFF_MOD + 442368;
constexpr size_t OFF_D256 = OFF_D1K + 4194304;
constexpr size_t OFF_H = OFF_D256 + 262144;
constexpr size_t OFF_R1 = OFF_H + 37748736;
constexpr size_t OFF_Y = OFF_R1 + 84934656;
constexpr size_t OFF_YL = OFF_Y + 50331648;
constexpr size_t OFF_DT = OFF_YL + 25165824;
constexpr size_t OFF_BAR = OFF_DT + 1572864;
constexpr size_t OFF_PRM = OFF_BAR + 32768;
constexpr int PRM_NORM_MIX = 0, PRM_NORM_FFN = 2048, PRM_QN = 4096, PRM_KN = 4160, PRM_CLW = 4224, PRM_CLB = 6272,
              PRM_LBA = 6784, PRM_LBX = 7808, PRM_LAM = 8832, PRM_CSW = 9856, PRM_CSB = 14976, PRM_DTB = 16256,
              PRM_ALOG = 16288, PRM_SSDD = 16320, PRM_SNORM = 16384, PRM_LWA = 17408, PRM_LWX = 82944;
#define PRM(P, off) ((const float*)((P).ws + OFF_PRM) + (off))
constexpr size_t OFF_YTS = OFF_Y;
constexpr size_t OFF_YTC = OFF_Y + 8388608;
constexpr size_t OFF_QB = OFF_Y + 12582912;
constexpr size_t OFF_KBS = OFF_Y + 31457280;
constexpr size_t OFF_KBC = OFF_Y + 37748736;
constexpr size_t OFF_VTS = OFF_Y + 39845888;
constexpr size_t OFF_VTC = OFF_Y + 46137344;

struct Params {
  const float* in[34];
  float* out;
  char* ws;
};

typedef __bf16 bf16x2_t __attribute__((ext_vector_type(2)));
typedef float f32x2_t __attribute__((ext_vector_type(2)));
__device__ __forceinline__ unsigned pack2(float a, float b) {
  f32x2_t v = {a, b};
  bf16x2_t r = __builtin_convertvector(v, bf16x2_t);
  return __builtin_bit_cast(unsigned, r);
}
__device__ __forceinline__ u16 f2bf(float f) { return (u16)(pack2(f, 0.f) & 0xffffu); }
__device__ __forceinline__ float bf2f(u16 h) { return __uint_as_float(((unsigned)h) << 16); }
__device__ __forceinline__ float silu_f(float v) { return v * __builtin_amdgcn_rcpf(1.f + __expf(-v)); }
__device__ __forceinline__ float sigmoid_f(float v) { return __builtin_amdgcn_rcpf(1.f + __expf(-v)); }
__device__ __forceinline__ float fexp2(float v) { return __builtin_amdgcn_exp2f(v); }

__device__ __forceinline__ float xor16_sum(float x) {
  const unsigned u = __float_as_uint(x);
  auto r = __builtin_amdgcn_permlane16_swap(u, u, false, false);
  return __uint_as_float(r[0]) + __uint_as_float(r[1]);
}
__device__ __forceinline__ float xor32_sum(float x) {
  const unsigned u = __float_as_uint(x);
  auto r = __builtin_amdgcn_permlane32_swap(u, u, false, false);
  return __uint_as_float(r[0]) + __uint_as_float(r[1]);
}
__device__ __forceinline__ float xor16_max(float x) {
  const unsigned u = __float_as_uint(x);
  auto r = __builtin_amdgcn_permlane16_swap(u, u, false, false);
  return fmaxf(__uint_as_float(r[0]), __uint_as_float(r[1]));
}
__device__ __forceinline__ float xor32_max(float x) {
  const unsigned u = __float_as_uint(x);
  auto r = __builtin_amdgcn_permlane32_swap(u, u, false, false);
  return fmaxf(__uint_as_float(r[0]), __uint_as_float(r[1]));
}
__device__ __forceinline__ int cond_row(int t) { return t < T_CTX ? 8 : ((t - T_CTX) >> 10); }
__device__ __forceinline__ const float* xin(const Params& P, int t) {
  return t < T_CTX ? P.in[0] + (size_t)t * 1024 : P.in[1] + (size_t)(t - T_CTX) * 1024;
}


#define XB_TMO      128
#define XB_XCNT(j)  (256  + 64 * (j))
#define XB_XSUB(j)  (1280 + 64 * (j))
#define XB_XGEN(j)  (2304 + 64 * (j))
#define XB_TOP      3328
#define XB_TOPGEN   3392
#define XCD_BAR_WORDS 3456
#define XB_SPIN_CAP (1u << 22)
#define LAS __attribute__((address_space(3)))
__device__ __forceinline__ unsigned xb_ld(unsigned* p)              { return __hip_atomic_load(p, __ATOMIC_RELAXED, __HIP_MEMORY_SCOPE_AGENT); }
__device__ __forceinline__ unsigned xb_add(unsigned* p, unsigned v) { return __hip_atomic_fetch_add(p, v, __ATOMIC_RELAXED, __HIP_MEMORY_SCOPE_AGENT); }
__device__ __forceinline__ unsigned xb_xcc_id() { return (unsigned)__builtin_amdgcn_s_getreg((3 << 11) | 20) & 0xFu; }
#define XB_SPIN(cond, bar) do { unsigned _sp = 0; while (cond) { __builtin_amdgcn_s_sleep(1); \
    if ((++_sp & 255u) == 0u) { if (xb_ld(&(bar)[XB_TMO])) break; if (_sp > XB_SPIN_CAP) { atomicAdd(&(bar)[XB_TMO], 1u); break; } } } } while (0)
struct XcdBarrier { unsigned* bar; unsigned x; volatile LAS unsigned* st; };
__device__ __forceinline__ XcdBarrier xcd_barrier_post(unsigned* bar, volatile LAS unsigned* st) {
    XcdBarrier b; b.bar = bar; b.x = xb_xcc_id(); b.st = st;
    if (threadIdx.x == 0) (void)xb_add(&bar[XB_XCNT(b.x)], 1u);
    return b;
}
__device__ __forceinline__ void xcd_barrier_complete(unsigned* bar, unsigned x, unsigned& nloc, unsigned& nx) {
    const unsigned G = gridDim.x * gridDim.y * gridDim.z;
    unsigned sum, cnt, mine, sp = 0u;
    for (;;) {
        sum = 0u; cnt = 0u; mine = 0u;
#pragma unroll
        for (unsigned j = 0; j < 16; ++j) { const unsigned c = xb_ld(&bar[XB_XCNT(j)]); sum += c; cnt += (c > 0u) ? 1u : 0u; mine = (j == x) ? c : mine; }
        if (sum == G) break;
        __builtin_amdgcn_s_sleep(1);
        if ((++sp & 255u) == 0u) { if (xb_ld(&bar[XB_TMO])) break; if (sp > XB_SPIN_CAP) { atomicAdd(&bar[XB_TMO], 1u); break; } }
    }
    nloc = mine > 0u ? mine : 1u; nx = cnt > 0u ? cnt : 1u;
}
__device__ __forceinline__ void xcd_barrier(const XcdBarrier& b) {
    asm volatile("s_waitcnt vmcnt(0)" ::: "memory");
    __syncthreads();
    if (threadIdx.x == 0) {
        unsigned* bar = b.bar;
        __builtin_amdgcn_s_waitcnt(0);
        unsigned nloc = b.st[0], nx = b.st[1];
        if (nloc == 0u) { xcd_barrier_complete(bar, b.x, nloc, nx); b.st[0] = nloc; b.st[1] = nx; }
        const unsigned old = xb_add(&bar[XB_XSUB(b.x)], 1u);
        const unsigned gen = old / nloc;
        if (old + 1u == (gen + 1u) * nloc) {
            __builtin_amdgcn_fence(__ATOMIC_RELEASE, "agent");
            asm volatile("s_waitcnt vmcnt(0)" ::: "memory");
            const unsigned og = xb_add(&bar[XB_TOP], 1u);
            const unsigned tg = og / nx;
            if (og + 1u == (tg + 1u) * nx) xb_add(&bar[XB_TOPGEN], 1u);
            else XB_SPIN(xb_ld(&bar[XB_TOPGEN]) == tg, bar);
            __builtin_amdgcn_fence(__ATOMIC_ACQUIRE, "agent");
            xb_add(&bar[XB_XGEN(b.x)], 1u);
            asm volatile("s_waitcnt vmcnt(0)" ::: "memory");
        } else {
            XB_SPIN(xb_ld(&bar[XB_XGEN(b.x)]) == gen, bar);
            __builtin_amdgcn_fence(__ATOMIC_ACQUIRE, "agent");
            asm volatile("s_waitcnt vmcnt(0)" ::: "memory");
        }
    }
    __syncthreads();
}

using u32x4 = __attribute__((ext_vector_type(4))) unsigned int;
struct GRegs { u32x4 a0, a1, a2, a3, b0, b1; };
template <int MTW>
__device__ __forceinline__ void gemm_gload(GRegs& R, const u16* ga, const u16* gb, int lda, int ldb) {
  R.a0 = *(const u32x4*)(ga);
  R.a1 = *(const u32x4*)(ga + (size_t)64 * lda);
  R.a2 = *(const u32x4*)(ga + (size_t)128 * lda);
  if (MTW == 8) R.a3 = *(const u32x4*)(ga + (size_t)192 * lda);
  R.b0 = *(const u32x4*)(gb);
  R.b1 = *(const u32x4*)(gb + (size_t)64 * ldb);
}
template <int MTW>
__device__ __forceinline__ void gemm_swrite(const GRegs& R, u16* dA, u16* dB) {
  *(u32x4*)(dA) = R.a0;
  *(u32x4*)(dA + 64 * 40) = R.a1;
  *(u32x4*)(dA + 128 * 40) = R.a2;
  if (MTW == 8) *(u32x4*)(dA + 192 * 40) = R.a3;
  *(u32x4*)(dB) = R.b0;
  *(u32x4*)(dB + 64 * 40) = R.b1;
}

template <bool SWAP, int MTW>
__device__ __forceinline__ void gemm_compute_tile(const u16* cA, const u16* cB, f32x4 (&acc)[MTW][4]) {
  constexpr int LS = 40;
  constexpr int HM = MTW / 2;
  bf16x8 bfr[4];
#pragma unroll
  for (int j = 0; j < 4; j++) bfr[j] = *(const bf16x8*)(cB + j * 16 * LS);
#pragma unroll
  for (int h = 0; h < 2; h++) {
    bf16x8 af[HM];
#pragma unroll
    for (int i = 0; i < HM; i++) af[i] = *(const bf16x8*)(cA + (h * HM + i) * 16 * LS);
#pragma unroll
    for (int i = 0; i < HM; i++)
#pragma unroll
      for (int j = 0; j < 4; j++) {
        if (SWAP) acc[h * HM + i][j] = MFMA(bfr[j], af[i], acc[h * HM + i][j]);
        else acc[h * HM + i][j] = MFMA(af[i], bfr[j], acc[h * HM + i][j]);
      }
  }
}

template <bool SWAP, int MTW = 8>
__device__ __forceinline__ void gemm_mainloop_reg(const u16* __restrict__ A, int lda, const u16* __restrict__ Bt, int ldb,
                                              int K, u16* sm, f32x4 (&acc)[MTW][4]) {
  constexpr int LS = 40;
  const int tid = threadIdx.x, lane = tid & 63, wave = tid >> 6;
  const int wm = wave >> 1, wn = wave & 1;
  const int fr = lane & 15, fq = lane >> 4;
  u16* sA = sm;
  u16* sB = sm + 2 * 256 * LS;
  const int lr = tid >> 2, lc = (tid & 3) * 8;
  const u16* ga = A + (size_t)lr * lda + lc;
  const u16* gb = Bt + (size_t)lr * ldb + lc;
  GRegs r0, r1;
#define GLOAD(R, KT) gemm_gload<MTW>(R, ga + (KT) * 32, gb + (KT) * 32, lda, ldb);
#define SWRITE(R, BUF) gemm_swrite<MTW>(R, sA + (BUF) * 256 * LS + lr * LS + lc, sB + (BUF) * 128 * LS + lr * LS + lc);
  GLOAD(r0, 0)
  GLOAD(r1, 1)
#pragma unroll
  for (int i = 0; i < MTW; i++)
#pragma unroll
    for (int j = 0; j < 4; j++) acc[i][j] = f32x4{0.f, 0.f, 0.f, 0.f};
  SWRITE(r0, 0)
  __syncthreads();
  const int nk = K >> 5;
  const u16* cA0 = sA + (wm * 16 * MTW + fr) * LS + fq * 8;
  const u16* cB0 = sB + (wn * 64 + fr) * LS + fq * 8;
  for (int kt = 0; kt < nk; kt += 2) {
    GLOAD(r0, min(kt + 2, nk - 1))
    gemm_compute_tile<SWAP, MTW>(cA0, cB0, acc);
    SWRITE(r1, 1)
    __syncthreads();
    GLOAD(r1, min(kt + 3, nk - 1))
    gemm_compute_tile<SWAP, MTW>(cA0 + 256 * LS, cB0 + 128 * LS, acc);
    SWRITE(r0, 0)
    __syncthreads();
  }
#undef GLOAD
#undef SWRITE
}

__device__ __forceinline__ void glds16(const u16* g, char* lds) {
  __builtin_amdgcn_global_load_lds((const unsigned*)g, (unsigned*)lds, 16, 0, 0);
}
#define DSR128(dst, addr, OFF) asm volatile("ds_read_b128 %0, %1 offset:%2" : "=v"(dst) : "v"(addr), "n"(OFF))
template <bool SWAP, int MTW>
__device__ __forceinline__ void gemm_compute_glds(unsigned aA, unsigned aB, f32x4 (&acc)[MTW][4]) {
  bf16x8 bfr[4], af[MTW];
  DSR128(bfr[0], aB, 0); DSR128(bfr[1], aB, 1024); DSR128(bfr[2], aB, 2048); DSR128(bfr[3], aB, 3072);
  if (MTW == 8) {
    DSR128(af[0], aA, 0); DSR128(af[1], aA, 1024); DSR128(af[2], aA, 2048); DSR128(af[3], aA, 3072);
    DSR128(af[4], aA, 4096); DSR128(af[5], aA, 5120); DSR128(af[6], aA, 6144); DSR128(af[7], aA, 7168);
    asm volatile("s_waitcnt lgkmcnt(4)" : "+v"(bfr[0]), "+v"(bfr[1]), "+v"(bfr[2]), "+v"(bfr[3]), "+v"(af[0]), "+v"(af[1]), "+v"(af[2]), "+v"(af[3]));
  } else if (MTW == 6) {
    DSR128(af[0], aA, 0); DSR128(af[1], aA, 1024); DSR128(af[2], aA, 2048);
    DSR128(af[3], aA, 3072); DSR128(af[4], aA, 4096); DSR128(af[5], aA, 5120);
    asm volatile("s_waitcnt lgkmcnt(3)" : "+v"(bfr[0]), "+v"(bfr[1]), "+v"(bfr[2]), "+v"(bfr[3]), "+v"(af[0]), "+v"(af[1]), "+v"(af[2]));
  } else if (MTW == 4) {
    DSR128(af[0], aA, 0); DSR128(af[1], aA, 1024); DSR128(af[2], aA, 2048); DSR128(af[3], aA, 3072);
    asm volatile("s_waitcnt lgkmcnt(2)" : "+v"(bfr[0]), "+v"(bfr[1]), "+v"(bfr[2]), "+v"(bfr[3]), "+v"(af[0]), "+v"(af[1]));
  } else {
    DSR128(af[0], aA, 0); DSR128(af[1], aA, 1024);
    asm volatile("s_waitcnt lgkmcnt(1)" : "+v"(bfr[0]), "+v"(bfr[1]), "+v"(bfr[2]), "+v"(bfr[3]), "+v"(af[0]));
  }
  constexpr int HM = MTW / 2;
#pragma unroll
  for (int i = 0; i < HM; i++)
#pragma unroll
    for (int j = 0; j < 4; j++) {
      if (SWAP) acc[i][j] = MFMA(bfr[j], af[i], acc[i][j]);
      else acc[i][j] = MFMA(af[i], bfr[j], acc[i][j]);
    }
  __builtin_amdgcn_sched_barrier(0);
  if (MTW == 8) asm volatile("s_waitcnt lgkmcnt(0)" : "+v"(af[4]), "+v"(af[5]), "+v"(af[6]), "+v"(af[7]));
  else if (MTW == 6) asm volatile("s_waitcnt lgkmcnt(0)" : "+v"(af[3]), "+v"(af[4]), "+v"(af[5]));
  else if (MTW == 4) asm volatile("s_waitcnt lgkmcnt(0)" : "+v"(af[2]), "+v"(af[3]));
  else asm volatile("s_waitcnt lgkmcnt(0)" : "+v"(af[1]));
  __builtin_amdgcn_sched_barrier(0);
#pragma unroll
  for (int i = HM; i < MTW; i++)
#pragma unroll
    for (int j = 0; j < 4; j++) {
      if (SWAP) acc[i][j] = MFMA(bfr[j], af[i], acc[i][j]);
      else acc[i][j] = MFMA(af[i], bfr[j], acc[i][j]);
    }
}

template <bool SWAP, int MTW = 8>
__device__ __forceinline__ void gemm_mainloop(const u16* __restrict__ A, int lda, const u16* __restrict__ Bt, int ldb,
                                              int K, u16* sm, f32x4 (&acc)[MTW][4]) {
  constexpr int STG = 24576;
  constexpr int AW = MTW / 2;
  constexpr int NL = AW + 2;
  const int tid = threadIdx.x, lane = tid & 63, wave = tid >> 6;
  const int wm = wave >> 1, wn = wave & 1;
  const int fr = lane & 15, fq = lane >> 4;
  char* smc = (char*)sm;
  const int rowl = lane >> 2;
  const int lch = ((lane & 3) ^ (((lane >> 5) & 1) << 1)) * 8;
  const u16* gA = A + (size_t)(wave * AW * 16 + rowl) * lda + lch;
  const u16* gB = Bt + (size_t)(wave * 32 + rowl) * ldb + lch;
  char* dA = smc + (wave * AW) * 1024;
  char* dB = smc + 16384 + (wave * 2) * 1024;
  const int loff = fr * 64 + ((fq ^ (((fr >> 3) & 1) << 1)) * 16);
  const unsigned lds0 = (unsigned)(size_t)((LAS char*)smc);
  const unsigned rA = lds0 + (wm * MTW) * 1024 + loff;
  const unsigned rB = lds0 + 16384 + (wn * 4) * 1024 + loff;
#define GSTAGE(S, KT) { _Pragma("unroll") for (int _i = 0; _i < AW; _i++) glds16(gA + (size_t)(_i * 16) * lda + (KT) * 32, dA + (S) * STG + _i * 1024); \
                        _Pragma("unroll") for (int _i = 0; _i < 2; _i++) glds16(gB + (size_t)(_i * 16) * ldb + (KT) * 32, dB + (S) * STG + _i * 1024); }
#pragma unroll
  for (int i = 0; i < MTW; i++)
#pragma unroll
    for (int j = 0; j < 4; j++) acc[i][j] = f32x4{0.f, 0.f, 0.f, 0.f};
  const int nk = K >> 5;
  GSTAGE(0, 0)
  GSTAGE(1, 1)
  asm volatile("s_waitcnt vmcnt(%0)" ::"n"(NL) : "memory");
  asm volatile("s_waitcnt lgkmcnt(0)" ::: "memory");
  __builtin_amdgcn_s_barrier();
  int cur = 0;
  for (int t = 0; t < nk; t++) {
    int nx2 = cur + 2; if (nx2 >= 3) nx2 -= 3;
    const bool more = (t + 2 < nk);
    if (more) GSTAGE(nx2, t + 2)
    gemm_compute_glds<SWAP, MTW>(rA + cur * STG, rB + cur * STG, acc);
    if (more) asm volatile("s_waitcnt vmcnt(%0)" ::"n"(NL) : "memory");
    else asm volatile("s_waitcnt vmcnt(0)" ::: "memory");
    asm volatile("s_waitcnt lgkmcnt(0)" ::: "memory");
    __builtin_amdgcn_s_barrier();
    cur = (cur == 2) ? 0 : cur + 1;
  }
#undef GSTAGE
}

template <bool SWAP>
__device__ __forceinline__ void gemm_mainloop128(const u16* __restrict__ A, int lda, const u16* __restrict__ Bt, int ldb,
                                              int K, u16* sm, f32x4 (&acc)[4][4]) {
  const int tid = threadIdx.x, lane = tid & 63, wave = tid >> 6;
  const int wm = wave >> 1, wn = wave & 1;
  const int fr = lane & 15, fq = lane >> 4;
  u16* sA = sm;
  u16* sB = sm + 2 * 128 * LDT;
  const int lr = tid >> 3, lc = (tid & 7) * 8;
  const u16* ga = A + (size_t)lr * lda + lc;
  const u16* gb = Bt + (size_t)lr * ldb + lc;
  uint4 ra[4], rb[4];
#pragma unroll
  for (int i = 0; i < 4; i++) {
    ra[i] = *(const uint4*)(ga + (size_t)(i * 32) * lda);
    rb[i] = *(const uint4*)(gb + (size_t)(i * 32) * ldb);
  }
#pragma unroll
  for (int i = 0; i < 4; i++)
#pragma unroll
    for (int j = 0; j < 4; j++) acc[i][j] = f32x4{0.f, 0.f, 0.f, 0.f};
#pragma unroll
  for (int i = 0; i < 4; i++) {
    *(uint4*)(sA + (lr + i * 32) * LDT + lc) = ra[i];
    *(uint4*)(sB + (lr + i * 32) * LDT + lc) = rb[i];
  }
  __syncthreads();
  const int nk = K >> 6;
  for (int kt = 0; kt < nk; kt++) {
    const int cur = kt & 1;
    const bool more = (kt + 1 < nk);
    if (more) {
      const u16* ga2 = ga + (kt + 1) * 64;
      const u16* gb2 = gb + (kt + 1) * 64;
#pragma unroll
      for (int i = 0; i < 4; i++) {
        ra[i] = *(const uint4*)(ga2 + (size_t)(i * 32) * lda);
        rb[i] = *(const uint4*)(gb2 + (size_t)(i * 32) * ldb);
      }
    }
    const u16* cA = sA + cur * 128 * LDT + (wm * 64 + fr) * LDT + fq * 8;
    const u16* cB = sB + cur * 128 * LDT + (wn * 64 + fr) * LDT + fq * 8;
#pragma unroll
    for (int kk = 0; kk < 2; kk++) {
      bf16x8 af[4], bfr[4];
#pragma unroll
      for (int i = 0; i < 4; i++) af[i] = *(const bf16x8*)(cA + i * 16 * LDT + kk * 32);
#pragma unroll
      for (int j = 0; j < 4; j++) bfr[j] = *(const bf16x8*)(cB + j * 16 * LDT + kk * 32);
#pragma unroll
      for (int i = 0; i < 4; i++)
#pragma unroll
        for (int j = 0; j < 4; j++) {
          if (SWAP) acc[i][j] = MFMA(bfr[j], af[i], acc[i][j]);
          else acc[i][j] = MFMA(af[i], bfr[j], acc[i][j]);
        }
    }
    if (more) {
      u16* dA = sA + (cur ^ 1) * 128 * LDT;
      u16* dB = sB + (cur ^ 1) * 128 * LDT;
#pragma unroll
      for (int i = 0; i < 4; i++) {
        *(uint4*)(dA + (lr + i * 32) * LDT + lc) = ra[i];
        *(uint4*)(dB + (lr + i * 32) * LDT + lc) = rb[i];
      }
    }
    __syncthreads();
  }
}

__device__ __forceinline__ void tile_coords(int L, int MT, int NT, int& mt, int& nt) {
  const int full = NT >> 3;
  const int per = MT * 8;
  if (L < full * per) {
    int sc = L / per, r = L - sc * per;
    mt = r >> 3;
    nt = sc * 8 + (r & 7);
  } else {
    int L2 = L - full * per;
    int w = NT - full * 8;
    mt = L2 / w;
    nt = full * 8 + (L2 - mt * w);
  }
}

struct TileIter {
  int cur, end, step;
  __device__ TileIter(int ntiles) {
    int nb = gridDim.x, b = blockIdx.x;
    if ((nb & 7) == 0) {
      int per = (ntiles + 7) >> 3;
      int x = b & 7, j = b >> 3;
      cur = x * per + j;
      end = min((x + 1) * per, ntiles);
      step = nb >> 3;
    } else {
      cur = b; end = ntiles; step = nb;
    }
  }
};


constexpr size_t OFF_Q = OFF_BAR + 16384;
__device__ __forceinline__ int queue_next(unsigned* ctr, int* sh) {
  __syncthreads();
  if (threadIdx.x == 0) *sh = (int)__hip_atomic_fetch_add(ctr, 1u, __ATOMIC_RELAXED, __HIP_MEMORY_SCOPE_AGENT);
  __syncthreads();
  return *sh;
}

struct TrDesc { const float* src; u16* dst; int lds, nvalid, ldd, mode, rowoff, k0, n0; };
__device__ __forceinline__ TrDesc tr_desc(const Params& P, int j) {
  TrDesc d; int ntn; d.mode = 0; d.rowoff = 0;
  if (j < 320) { d.src = P.in[12] + 256; d.lds = 1536; d.nvalid = 1280; d.dst = (u16*)(P.ws + OFF_WIE); d.ldd = 1024; d.rowoff = 512; ntn = 20; }
  else if ((j -= 320) < 256) { d.src = P.in[15]; d.lds = 1024; d.nvalid = 1024; d.dst = (u16*)(P.ws + OFF_WOE); d.ldd = 1024; ntn = 16; }
  else if ((j -= 256) < 864) { d.src = P.in[16]; d.lds = 3360; d.nvalid = 3360; d.dst = (u16*)(P.ws + OFF_WIO); d.ldd = 1024; ntn = 54; }
  else if ((j -= 864) < 384) { d.src = P.in[30]; d.lds = 1024; d.nvalid = 1024; d.dst = (u16*)(P.ws + OFF_WOO); d.ldd = 1536; ntn = 16; }
  else if ((j -= 384) < 2816) {
    int q = j / 704; j -= q * 704; int l = q >> 1, w3 = q & 1;
    d.src = (w3 ? P.in[32] : P.in[31]) + (size_t)l * 1024 * 2816; d.lds = 2816; d.nvalid = 2816;
    d.dst = (u16*)(P.ws + OFF_W13) + (size_t)l * 5632 * 1024; d.ldd = 1024; d.mode = 1; d.rowoff = w3 * 16; ntn = 44;
  } else {
    j -= 2816; int l = j / 704; j -= l * 704;
    d.src = P.in[33] + (size_t)l * 2816 * 1024; d.lds = 1024; d.nvalid = 1024;
    d.dst = (u16*)(P.ws + OFF_W2) + (size_t)l * 1024 * 2816; d.ldd = 2816; ntn = 16;
  }
  const int kt = j / ntn, nt = j - kt * ntn;
  d.k0 = kt * 64; d.n0 = nt * 64;
  return d;
}
__device__ __forceinline__ void tr_load(const TrDesc& d, int tid, float4 (&v)[4]) {
#pragma unroll
  for (int i = 0; i < 4; i++) {
    const int r = i * 16 + (tid >> 4), n = d.n0 + (tid & 15) * 4;
    v[i] = make_float4(0.f, 0.f, 0.f, 0.f);
    if (n < d.nvalid) v[i] = *(const float4*)(d.src + (size_t)(d.k0 + r) * d.lds + n);
  }
}
__device__ __forceinline__ void tr_emit(const TrDesc& d, int tid, const float4 (&v)[4], float* tile) {
#pragma unroll
  for (int i = 0; i < 4; i++) {
    const int r = i * 16 + (tid >> 4), c4 = (tid & 15) * 4;
    tile[r * 65 + c4] = v[i].x; tile[r * 65 + c4 + 1] = v[i].y; tile[r * 65 + c4 + 2] = v[i].z; tile[r * 65 + c4 + 3] = v[i].w;
  }
  __syncthreads();
#pragma unroll
  for (int i = 0; i < 4; i++) {
    const int n = i * 16 + (tid >> 4), k4 = (tid & 15) * 4;
    const int ng = d.n0 + n;
    const int row = d.mode ? ((ng >> 4) * 32 + (ng & 15) + d.rowoff) : (ng + d.rowoff);
    uint2 o;
    o.x = pack2(tile[(k4 + 0) * 65 + n], tile[(k4 + 1) * 65 + n]);
    o.y = pack2(tile[(k4 + 2) * 65 + n], tile[(k4 + 3) * 65 + n]);
    *(uint2*)(d.dst + (size_t)row * d.ldd + d.k0 + k4) = o;
  }
  __syncthreads();
}
__device__ __forceinline__ void phase_prep(const Params& P, char* smem, int* qsh) {
  const int tid = threadIdx.x, nb = gridDim.x, bid = blockIdx.x;
  const int lane = tid & 63, wave = tid >> 6;
  float* tile = (float*)smem;
  float* tabc = (float*)(smem + 16640);
  float* tabs = tabc + 64;
  float* sc = (float*)(smem + 20480);
  float* red = (float*)(smem + 20480 + 36864);
  {
    float* prm = (float*)(P.ws + OFF_PRM);
    const int gt = bid * 256 + tid, gs = nb * 256;
#define PCOPY(SRC, OFF, N) for (int i = gt; i < (N); i += gs) prm[(OFF) + i] = (SRC)[i];
    PCOPY(P.in[10], PRM_NORM_MIX, 2048) PCOPY(P.in[11], PRM_NORM_FFN, 2048) PCOPY(P.in[13], PRM_QN, 64) PCOPY(P.in[14], PRM_KN, 64)
    PCOPY(P.in[17], PRM_CLW, 2048) PCOPY(P.in[18], PRM_CLB, 512) PCOPY(P.in[20], PRM_LBA, 1024) PCOPY(P.in[22], PRM_LBX, 1024)
    PCOPY(P.in[23], PRM_LAM, 1024) PCOPY(P.in[24], PRM_CSW, 5120) PCOPY(P.in[25], PRM_CSB, 1280) PCOPY(P.in[26], PRM_DTB, 32)
    PCOPY(P.in[27], PRM_ALOG, 32) PCOPY(P.in[28], PRM_SSDD, 16) PCOPY(P.in[29], PRM_SNORM, 1024)
    PCOPY(P.in[19], PRM_LWA, 65536) PCOPY(P.in[21], PRM_LWX, 65536)
#undef PCOPY
  }
  bool sc_ready = false;
  constexpr int N_MOD = 384, N_FF = 64, N_TR = 6048, N_DFT = 544, N_CACHE = 512;
  constexpr int N_ALL = N_MOD + N_FF + N_TR + N_DFT + N_CACHE;
  for (int it = bid; it < N_ALL; it += nb) {
    int j = it;
    if (j < N_MOD) {
      if (!sc_ready) {
        for (int i = tid; i < 9 * 1024; i += 256) {
          int r = i >> 10, k = i & 1023;
          float c = r < 8 ? P.in[2][r * 1024 + k] : P.in[7][k];
          sc[i] = silu_f(c);
        }
        __syncthreads();
        sc_ready = true;
      }
      const int l = j / 192, n0 = (j % 192) * 32;
      const int cgp = tid & 7, kl = tid >> 3;
      float acc[9][4];
#pragma unroll
      for (int r = 0; r < 9; r++)
#pragma unroll
        for (int c = 0; c < 4; c++) acc[r][c] = 0.f;
      const float* w = P.in[8] + (size_t)l * 1024 * 6144 + n0 + cgp * 4;
#pragma unroll 4
      for (int i = 0; i < 32; i++) {
        const int k = i * 32 + kl;
        const float4 wv = *(const float4*)(w + (size_t)k * 6144);
#pragma unroll
        for (int r = 0; r < 9; r++) {
          const float s = sc[r * 1024 + k];
          acc[r][0] += s * wv.x; acc[r][1] += s * wv.y; acc[r][2] += s * wv.z; acc[r][3] += s * wv.w;
        }
      }
#pragma unroll
      for (int r = 0; r < 9; r++)
#pragma unroll
        for (int c = 0; c < 4; c++) {
          float v = acc[r][c];
          v += __shfl_xor(v, 8); v = xor16_sum(v); v = xor32_sum(v);
          acc[r][c] = v;
        }
      if (lane < 8) {
#pragma unroll
        for (int r = 0; r < 9; r++)
#pragma unroll
          for (int c = 0; c < 4; c++) red[(wave * 9 + r) * 32 + cgp * 4 + c] = acc[r][c];
      }
      __syncthreads();
      float* MOD = (float*)(P.ws + OFF_MOD);
      for (int i = tid; i < 288; i += 256) {
        int r = i >> 5, c = i & 31;
        float s = red[(0 * 9 + r) * 32 + c] + red[(1 * 9 + r) * 32 + c] + red[(2 * 9 + r) * 32 + c] + red[(3 * 9 + r) * 32 + c];
        MOD[(l * 9 + r) * 6144 + n0 + c] = s + P.in[9][l * 6144 + n0 + c];
      }
      __syncthreads();
      continue;
    }
    j -= N_MOD;
    if (j < N_FF) {
      const int g = j >> 4, kt = j & 15;
      if (tid < 64) { tabc[tid] = cospif(tid / 32.0f); tabs[tid] = sinpif(tid / 32.0f); }
      const float* src = P.in[12] + (size_t)(kt * 64) * 1536 + g * 64;
#pragma unroll
      for (int i = 0; i < 4; i++) {
        int r = i * 16 + (tid >> 4), c4 = (tid & 15) * 4;
        float4 v = *(const float4*)(src + (size_t)r * 1536 + c4);
        tile[r * 65 + c4] = v.x; tile[r * 65 + c4 + 1] = v.y; tile[r * 65 + c4 + 2] = v.z; tile[r * 65 + c4 + 3] = v.w;
      }
      __syncthreads();
      const int np = tid & 127, kh = tid >> 7;
      const int wsel = np >> 6, cp = np & 63;
      float acc[32];
#pragma unroll
      for (int i = 0; i < 32; i++) acc[i] = 0.f;
      for (int c = 0; c < 64; c++) {
        const int idx = (c * cp) & 63;
        const float coef = wsel ? tabs[idx] : tabc[idx];
#pragma unroll
        for (int i = 0; i < 32; i++) acc[i] += tile[(kh * 32 + i) * 65 + c] * coef;
      }
      u16* dst = (u16*)(P.ws + OFF_WIE) + (size_t)(g * 128 + np) * 1024 + kt * 64 + kh * 32;
#pragma unroll
      for (int i = 0; i < 4; i++) {
        uint4 o;
        o.x = pack2(acc[i * 8 + 0], acc[i * 8 + 1]); o.y = pack2(acc[i * 8 + 2], acc[i * 8 + 3]);
        o.z = pack2(acc[i * 8 + 4], acc[i * 8 + 5]); o.w = pack2(acc[i * 8 + 6], acc[i * 8 + 7]);
        *(uint4*)(dst + i * 8) = o;
      }
      __syncthreads();
      continue;
    }
    j -= N_FF;
    if (j < N_TR) continue;
    j -= N_TR;
    if (j < N_DFT) {
      if (j < 512) {
        u16* D = (u16*)(P.ws + OFF_D1K);
        const int e0 = j * 4096;
        for (int i = 0; i < 16; i++) {
          int e = e0 + i * 256 + tid;
          int sp = e >> 11, k = e & 2047;
          float v;
          if (k < 1024) { int r = (sp * k) & 1023; v = cospif(r * (1.0f / 512.0f)); }
          else { int r = (sp * (k - 1024)) & 1023; v = -sinpif(r * (1.0f / 512.0f)); }
          D[e] = f2bf(v * (1.0f / 256.0f));
        }
      } else {
        u16* D = (u16*)(P.ws + OFF_D256);
        const int e0 = (j - 512) * 4096;
        for (int i = 0; i < 16; i++) {
          int e = e0 + i * 256 + tid;
          int sp = e >> 9, k = e & 511;
          float v;
          if (k < 256) { int r = (sp * k) & 255; v = cospif(r * (1.0f / 128.0f)); }
          else { int r = (sp * (k - 256)) & 255; v = -sinpif(r * (1.0f / 128.0f)); }
          D[e] = f2bf(v * (1.0f / 128.0f));
        }
      }
      continue;
    }
    j -= N_DFT;
    {
      const bool isv = j >= 256;
      const int e0 = (isv ? j - 256 : j) * 4096;
      const float* src = isv ? P.in[4] : P.in[3];
      u16* KB = (u16*)(P.ws + OFF_KBS);
      u16* VT = (u16*)(P.ws + OFF_VTS);
      for (int i = 0; i < 16; i++) {
        int e = e0 + i * 256 + tid;
        int b = e >> 17, p = (e >> 8) & 511, h = (e >> 6) & 3, d = e & 63;
        u16 v = f2bf(src[e]);
        if (!isv) KB[((size_t)(b * 4 + h) * 1536 + 1024 + p) * 64 + d] = v;
        else VT[((size_t)(b * 4 + h) * 64 + d) * 1536 + 1024 + p] = v;
      }
    }
  }
  {
    unsigned* ctr = (unsigned*)(P.ws + OFF_BAR + 20480);
    for (;;) {
      const int k = queue_next(ctr, qsh);
      const int j0 = 2 * k;
      if (j0 >= N_TR) break;
      const TrDesc d0 = tr_desc(P, j0);
      const TrDesc d1 = tr_desc(P, j0 + 1);
      float4 v0[4], v1[4];
      tr_load(d0, tid, v0);
      tr_load(d1, tid, v1);
      tr_emit(d0, tid, v0, tile);
      tr_emit(d1, tid, v1, tile);
    }
  }
}

__device__ __forceinline__ void phase_norm(const Params& P, int l, int which) {
  const int tid = threadIdx.x, lane = tid & 63, wave = tid >> 6;
  const float* MOD = (const float*)(P.ws + OFF_MOD);
  const float* gvec = PRM(P, (which ? PRM_NORM_FFN : PRM_NORM_MIX) + l * 1024);
  u16* H = (u16*)(P.ws + OFF_H);
  const int nwaves = gridDim.x * 4;
  const int rpw = (T_ALL + nwaves - 1) / nwaves;
  const int r0 = (blockIdx.x * 4 + wave) * rpw;
  const int r1 = min(r0 + rpw, T_ALL);
  constexpr int NR = 3;
  const int osh = (which ? 3 : 0) * 1024, osc = (which ? 4 : 1) * 1024;
  float4 gm[4], sh[4];
  int cached = -1;
  for (int t0 = r0; t0 < r1; t0 += NR) {
    float4 v[NR][4];
#pragma unroll
    for (int r = 0; r < NR; r++) {
      const int t = min(t0 + r, r1 - 1);
      const float* x = (l == 0 && which == 0) ? xin(P, t) : P.out + (size_t)t * 1024;
#pragma unroll
      for (int j = 0; j < 4; j++) v[r][j] = *(const float4*)(x + j * 256 + lane * 4);
    }
    float ss[NR];
#pragma unroll
    for (int r = 0; r < NR; r++) {
      float a = 0.f;
#pragma unroll
      for (int j = 0; j < 4; j++) a += v[r][j].x * v[r][j].x + v[r][j].y * v[r][j].y + v[r][j].z * v[r][j].z + v[r][j].w * v[r][j].w;
      ss[r] = a;
    }
#pragma unroll
    for (int o = 32; o >= 1; o >>= 1) {
#pragma unroll
      for (int r = 0; r < NR; r++) ss[r] += __shfl_xor(ss[r], o);
    }
#pragma unroll
    for (int r = 0; r < NR; r++) {
      const int t = t0 + r;
      if (t >= r1) continue;
      const int cr = cond_row(t);
      if (cr != cached) {
        cached = cr;
        const float* mb = MOD + (size_t)(l * 9 + cr) * 6144;
#pragma unroll
        for (int j = 0; j < 4; j++) {
          const int c = j * 256 + lane * 4;
          const float4 g = *(const float4*)(gvec + c);
          const float4 cm = *(const float4*)(mb + osc + c);
          sh[j] = *(const float4*)(mb + osh + c);
          gm[j] = make_float4(g.x * (1.f + cm.x), g.y * (1.f + cm.y), g.z * (1.f + cm.z), g.w * (1.f + cm.w));
        }
      }
      const float rs = rsqrtf(ss[r] * (1.0f / 1024.0f) + 1e-6f);
#pragma unroll
      for (int j = 0; j < 4; j++) {
        const int c = j * 256 + lane * 4;
        uint2 o;
        o.x = pack2(v[r][j].x * rs * gm[j].x + sh[j].x, v[r][j].y * rs * gm[j].y + sh[j].y);
        o.y = pack2(v[r][j].z * rs * gm[j].z + sh[j].z, v[r][j].w * rs * gm[j].w + sh[j].w);
        *(uint2*)(H + (size_t)t * 1024 + c) = o;
      }
    }
  }
}

__device__ __forceinline__ void phase_gemm_in_even(const Params& P, char* smem) {
  const int tid = threadIdx.x, lane = tid & 63, wave = tid >> 6;
  const int wm = wave >> 1, wn = wave & 1, fr = lane & 15, fq = lane >> 4;
  const u16* A = (const u16*)(P.ws + OFF_H);
  const u16* W = (const u16*)(P.ws + OFF_WIE);
  constexpr int MT = 48, NT = 14;
  for (TileIter ti(MT * NT); ti.cur < ti.end; ti.cur += ti.step) {
    int mtile, ntile;
    tile_coords(ti.cur, MT, NT, mtile, ntile);
    const int m0 = mtile * 256, n0 = ntile * 128;
    f32x4 acc[8][4];
    const bool swap = (ntile >= 4 && ntile < 12);
    if (swap) gemm_mainloop<true, 8>(A + (size_t)m0 * 1024, 1024, W + (size_t)n0 * 1024, 1024, 1024, (u16*)smem, acc);
    else gemm_mainloop<false, 8>(A + (size_t)m0 * 1024, 1024, W + (size_t)n0 * 1024, 1024, 1024, (u16*)smem, acc);
    const bool smp = m0 >= T_CTX;
    int fr_e = fr, fq_e = fq;
    asm volatile("" : "+v"(fr_e), "+v"(fq_e));
    if (ntile < 4) {
      const int g = ntile;
      u16* YT; int S, seq, sbase;
      if (smp) { YT = (u16*)(P.ws + OFF_YTS); S = 1024; seq = (m0 - T_CTX) >> 10; sbase = (m0 - T_CTX) & 1023; }
      else { YT = (u16*)(P.ws + OFF_YTC); S = 256; seq = m0 >> 8; sbase = m0 & 255; }
      u16* base = YT + (size_t)seq * 256 * 2 * S;
#pragma unroll
      for (int mt = 0; mt < 8; mt++)
#pragma unroll
        for (int nt = 0; nt < 4; nt++) {
          const int s = sbase + wm * 128 + mt * 16 + fq_e * 4;
          const int cp = nt * 16 + fr_e;
          uint2 o;
          o.x = pack2(acc[mt][nt][0], acc[mt][nt][1]);
          o.y = pack2(acc[mt][nt][2], acc[mt][nt][3]);
          *(uint2*)(base + (size_t)(g * 64 + cp) * 2 * S + wn * S + s) = o;
        }
    } else if (ntile < 12) {
      const bool isq = ntile < 10;
      const int hcol = n0 + wn * 64 - (isq ? 512 : 1280);
      const int head = hcol >> 6;
      const float* gn = PRM(P, isq ? PRM_QN : PRM_KN);
#pragma unroll
      for (int mt = 0; mt < 8; mt++) {
        __builtin_amdgcn_sched_barrier(0);
        const int t = m0 + wm * 128 + mt * 16 + fr_e;
        float ss = 0.f;
#pragma unroll
        for (int nt = 0; nt < 4; nt++)
#pragma unroll
          for (int r = 0; r < 4; r++) ss += acc[mt][nt][r] * acc[mt][nt][r];
        ss = xor16_sum(ss);
        ss = xor32_sum(ss);
        const float rs = rsqrtf(ss * (1.0f / 64.0f) + 1e-6f);
#pragma unroll
        for (int nt = 0; nt < 4; nt++) {
          const float4 g4 = *(const float4*)(gn + nt * 16 + fq_e * 4);
          acc[mt][nt][0] *= rs * g4.x; acc[mt][nt][1] *= rs * g4.y; acc[mt][nt][2] *= rs * g4.z; acc[mt][nt][3] *= rs * g4.w;
        }
        if (!smp && !isq) {
          float* nk = P.out + 12582912 + (size_t)t * 256 + head * 64;
#pragma unroll
          for (int nt = 0; nt < 4; nt++)
            *(float4*)(nk + nt * 16 + fq_e * 4) = make_float4(acc[mt][nt][0], acc[mt][nt][1], acc[mt][nt][2], acc[mt][nt][3]);
        }
        if (smp) {
          const int s = (t - T_CTX) & 1023;
          const float prow = (float)(s >> 6), pcol = (float)(s & 63);
#pragma unroll
          for (int r = 0; r < 4; r++) {
            const float fre = exp2f(-(float)(fq_e * 4 + r) * (13.287712379549449f / 16.0f));
            const float a0 = prow * fre, a1 = pcol * fre;
            const float c0 = __cosf(a0), s0 = __sinf(a0), c1 = __cosf(a1), s1 = __sinf(a1);
            const float x1 = acc[mt][0][r], x2 = acc[mt][1][r];
            acc[mt][0][r] = x1 * c0 - x2 * s0; acc[mt][1][r] = x2 * c0 + x1 * s0;
            const float y1 = acc[mt][2][r], y2 = acc[mt][3][r];
            acc[mt][2][r] = y1 * c1 - y2 * s1; acc[mt][3][r] = y2 * c1 + y1 * s1;
          }
        }
        if (isq) {
          const float qs = 0.125f * LOG2E;
          u16* q = (u16*)(P.ws + OFF_QB) + (size_t)t * 768 + head * 64;
#pragma unroll
          for (int nt = 0; nt < 4; nt++) {
            uint2 o;
            o.x = pack2(acc[mt][nt][0] * qs, acc[mt][nt][1] * qs);
            o.y = pack2(acc[mt][nt][2] * qs, acc[mt][nt][3] * qs);
            *(uint2*)(q + nt * 16 + fq_e * 4) = o;
          }
        } else {
          u16* kb;
          if (smp) { int sq = (t - T_CTX) >> 10, key = (t - T_CTX) & 1023; kb = (u16*)(P.ws + OFF_KBS) + ((size_t)(sq * 4 + head) * 1536 + key) * 64; }
          else { int sq = t >> 8, key = t & 255; kb = (u16*)(P.ws + OFF_KBC) + ((size_t)(sq * 4 + head) * 256 + key) * 64; }
#pragma unroll
          for (int nt = 0; nt < 4; nt++) {
            uint2 o;
            o.x = pack2(acc[mt][nt][0], acc[mt][nt][1]);
            o.y = pack2(acc[mt][nt][2], acc[mt][nt][3]);
            *(uint2*)(kb + nt * 16 + fq_e * 4) = o;
          }
        }
      }
    } else {
      const int head = (n0 + wn * 64 - 1536) >> 6;
#pragma unroll
      for (int mt = 0; mt < 8; mt++) {
        const int t = m0 + wm * 128 + mt * 16 + fq_e * 4;
#pragma unroll
        for (int nt = 0; nt < 4; nt++) {
          const int d = nt * 16 + fr_e;
          uint2 o;
          o.x = pack2(acc[mt][nt][0], acc[mt][nt][1]);
          o.y = pack2(acc[mt][nt][2], acc[mt][nt][3]);
          if (smp) {
            int sq = (t - T_CTX) >> 10, key = (t - T_CTX) & 1023;
            *(uint2*)((u16*)(P.ws + OFF_VTS) + ((size_t)(sq * 4 + head) * 64 + d) * 1536 + key) = o;
          } else {
            int sq = t >> 8, key = t & 255;
            *(uint2*)((u16*)(P.ws + OFF_VTC) + ((size_t)(sq * 4 + head) * 64 + d) * 256 + key) = o;
            float* nv = P.out + 13631488 + (size_t)t * 256 + head * 64 + d;
#pragma unroll
            for (int r = 0; r < 4; r++) nv[(size_t)r * 256] = acc[mt][nt][r];
          }
        }
      }
    }
  }
}

__device__ __forceinline__ void phase_gemm_resid(const Params& P, char* smem, const u16* A, int lda, const u16* W, int K,
                                 int l, int gate_idx, bool from_x) {
  const int tid = threadIdx.x, lane = tid & 63, wave = tid >> 6;
  const int wm = wave >> 1, wn = wave & 1, fr = lane & 15, fq = lane >> 4;
  const float* MOD = (const float*)(P.ws + OFF_MOD);
  constexpr int MT = 64, NT = 8;
  for (TileIter ti(MT * NT); ti.cur < ti.end; ti.cur += ti.step) {
    int mtile, ntile;
    tile_coords(ti.cur, MT, NT, mtile, ntile);
    const int m0 = mtile * 192, n0 = ntile * 128;
    f32x4 acc[6][4];
    gemm_mainloop<true, 6>(A + (size_t)m0 * lda, lda, W + (size_t)n0 * K, K, K, (u16*)smem, acc);
#pragma unroll
    for (int mt = 0; mt < 6; mt++) {
      const int t = m0 + wm * 96 + mt * 16 + fr;
      const float* gp = MOD + (size_t)(l * 9 + cond_row(t)) * 6144 + gate_idx * 1024;
      const float* bp = from_x ? xin(P, t) : P.out + (size_t)t * 1024;
      float* op = P.out + (size_t)t * 1024;
#pragma unroll
      for (int nt = 0; nt < 4; nt++) {
        const int n = n0 + wn * 64 + nt * 16 + fq * 4;
        const float4 g = *(const float4*)(gp + n);
        const float4 b = *(const float4*)(bp + n);
        float4 o;
        o.x = b.x + g.x * acc[mt][nt][0]; o.y = b.y + g.y * acc[mt][nt][1];
        o.z = b.z + g.z * acc[mt][nt][2]; o.w = b.w + g.w * acc[mt][nt][3];
        *(float4*)(op + n) = o;
      }
    }
  }
}

template <int MTW>
__device__ __forceinline__ void ffn_up_tile(const u16* A, const u16* W, u16* U, char* smem, int m0, int n0) {
  const int tid = threadIdx.x, lane = tid & 63, wave = tid >> 6;
  const int wm = wave >> 1, wn = wave & 1, fr = lane & 15, fq = lane >> 4;
  f32x4 acc[MTW][4];
  gemm_mainloop<true, MTW>(A + (size_t)m0 * 1024, 1024, W + (size_t)n0 * 1024, 1024, 1024, (u16*)smem, acc);
#pragma unroll
  for (int mt = 0; mt < MTW; mt++) {
    const int t = m0 + wm * (16 * MTW) + mt * 16 + fr;
#pragma unroll
    for (int np = 0; np < 2; np++) {
      const int f = ((n0 + wn * 64) >> 1) + np * 16 + fq * 4;
      float r[4];
#pragma unroll
      for (int q = 0; q < 4; q++) r[q] = silu_f(acc[mt][np * 2][q]) * acc[mt][np * 2 + 1][q];
      uint2 o;
      o.x = pack2(r[0], r[1]); o.y = pack2(r[2], r[3]);
      *(uint2*)(U + (size_t)t * 2816 + f) = o;
    }
  }
}

__device__ __forceinline__ void phase_gemm_ffn_up(const Params& P, char* smem, int l) {
  const u16* A = (const u16*)(P.ws + OFF_H);
  const u16* W = (const u16*)(P.ws + OFF_W13) + (size_t)l * 5632 * 1024;
  u16* U = (u16*)(P.ws + OFF_R1);
  constexpr int MT = 48, NT = 44;
  constexpr int NFULL = 2048;
  for (TileIter ti(NFULL); ti.cur < ti.end; ti.cur += ti.step) {
    int mtile, ntile;
    tile_coords(ti.cur, MT, NT, mtile, ntile);
    ffn_up_tile<8>(A, W, U, smem, mtile * 256, ntile * 128);
  }
  for (TileIter ti((MT * NT - NFULL) * 4); ti.cur < ti.end; ti.cur += ti.step) {
    int mtile, ntile;
    tile_coords(NFULL + (ti.cur >> 2), MT, NT, mtile, ntile);
    ffn_up_tile<2>(A, W, U, smem, mtile * 256 + (ti.cur & 3) * 64, ntile * 128);
  }
}

__device__ __forceinline__ void phase_gemm_in_odd(const Params& P, char* smem) {
  const int tid = threadIdx.x, lane = tid & 63, wave = tid >> 6;
  const int wm = wave >> 1, wn = wave & 1, fr = lane & 15, fq = lane >> 4;
  const u16* A = (const u16*)(P.ws + OFF_H);
  const u16* W = (const u16*)(P.ws + OFF_WIO);
  u16* PO = (u16*)(P.ws + OFF_R1);
  float* DT = (float*)(P.ws + OFF_DT);
  constexpr int MT = 48, NT = 27;
  for (TileIter ti(MT * NT); ti.cur < ti.end; ti.cur += ti.step) {
    int mtile, ntile;
    tile_coords(ti.cur, MT, NT, mtile, ntile);
    const int m0 = mtile * 256, n0 = ntile * 128;
    f32x4 acc[8][4];
    gemm_mainloop<true>(A + (size_t)m0 * 1024, 1024, W + (size_t)n0 * 1024, 1024, 1024, (u16*)smem, acc);
#pragma unroll
    for (int mt = 0; mt < 8; mt++) {
      const int t = m0 + wm * 128 + mt * 16 + fr;
#pragma unroll
      for (int nt = 0; nt < 4; nt++) {
        const int n = n0 + wn * 64 + nt * 16 + fq * 4;
        uint2 o;
        o.x = pack2(acc[mt][nt][0], acc[mt][nt][1]);
        o.y = pack2(acc[mt][nt][2], acc[mt][nt][3]);
        *(uint2*)(PO + (size_t)t * 3456 + n) = o;
        if (n >= 3328 && n < 3360)
          *(float4*)(DT + (size_t)t * 32 + (n - 3328)) = make_float4(acc[mt][nt][0], acc[mt][nt][1], acc[mt][nt][2], acc[mt][nt][3]);
      }
    }
  }
}

__device__ __forceinline__ void fourier_tile(const Params& P, int item, char* smem) {
  const int tid = threadIdx.x, lane = tid & 63, wave = tid >> 6;
  const int wm = wave >> 1, wn = wave & 1, fr = lane & 15, fq = lane >> 4;
  const u16 *D, *YT; int S, tb, mtile, ntile;
  if (item < 128) {
    int seq = item >> 4, r = item & 15; mtile = r >> 1; ntile = r & 1; S = 1024; tb = T_CTX + seq * 1024;
    D = (const u16*)(P.ws + OFF_D1K); YT = (const u16*)(P.ws + OFF_YTS) + (size_t)seq * 256 * 2048;
  } else {
    item -= 128; int seq = item >> 2, r = item & 3; mtile = r >> 1; ntile = r & 1; S = 256; tb = seq * 256;
    D = (const u16*)(P.ws + OFF_D256); YT = (const u16*)(P.ws + OFF_YTC) + (size_t)seq * 256 * 512;
  }
  f32x4 acc[4][4];
  const int K = 2 * S;
  gemm_mainloop<true, 4>(D + (size_t)(mtile * 128) * K, K, YT + (size_t)(ntile * 128) * K, K, K, (u16*)smem, acc);
  u16* MIX = (u16*)(P.ws + OFF_H);
#pragma unroll
  for (int mt = 0; mt < 4; mt++) {
    const int t = tb + mtile * 128 + wm * 64 + mt * 16 + fr;
#pragma unroll
    for (int nt = 0; nt < 4; nt++) {
      const int n = ntile * 128 + wn * 64 + nt * 16 + fq * 4;
      uint2 o;
      o.x = pack2(acc[mt][nt][0], acc[mt][nt][1]);
      o.y = pack2(acc[mt][nt][2], acc[mt][nt][3]);
      *(uint2*)(MIX + (size_t)t * 1024 + n) = o;
    }
  }
}

__device__ __forceinline__ void attn_item(const Params& P, int item, char* smem) {
  const int tid = threadIdx.x, lane = tid & 63, wave = tid >> 6;
  const int fr = lane & 15, fq = lane >> 4;
  bool smp; int seq, head, qb;
  if (item < 768) { smp = true; seq = item / 96; int r = item % 96; head = r >> 3; qb = r & 7; }
  else { item -= 768; smp = false; seq = item / 24; int r = item % 24; head = r >> 1; qb = r & 1; }
  const int nkeys = smp ? 1536 : 256;
  const int tb = smp ? T_CTX + seq * 1024 : seq * 256;
  const int kvh = head / 3;
  const u16* Kp = (const u16*)(P.ws + (smp ? OFF_KBS : OFF_KBC)) + (size_t)((seq * 4 + kvh) * nkeys) * 64;
  const u16* Vp = (const u16*)(P.ws + (smp ? OFF_VTS : OFF_VTC)) + (size_t)((seq * 4 + kvh) * 64) * nkeys;
  const u16* QB = (const u16*)(P.ws + OFF_QB);
  u16* sK = (u16*)smem;
  u16* sV = sK + 2 * 64 * LDT;
  bf16x8 qf[2][2];
  const int qrow0 = tb + qb * 128 + wave * 32;
#pragma unroll
  for (int qt = 0; qt < 2; qt++)
#pragma unroll
    for (int kk = 0; kk < 2; kk++)
      qf[qt][kk] = *(const bf16x8*)(QB + (size_t)(qrow0 + qt * 16 + fr) * 768 + head * 64 + kk * 32 + fq * 8);
  f32x4 ot[2][4];
#pragma unroll
  for (int a = 0; a < 2; a++)
#pragma unroll
    for (int b = 0; b < 4; b++) ot[a][b] = f32x4{0.f, 0.f, 0.f, 0.f};
  float mrun[2] = {-INFINITY, -INFINITY}, lrun[2] = {0.f, 0.f};
  const int lrow = tid >> 3, lcol = (tid & 7) * 8;
  uint4 rk[2], rv[2];
#pragma unroll
  for (int i = 0; i < 2; i++) {
    rk[i] = *(const uint4*)(Kp + (size_t)(lrow + i * 32) * 64 + lcol);
    rv[i] = *(const uint4*)(Vp + (size_t)(lrow + i * 32) * nkeys + lcol);
  }
#pragma unroll
  for (int i = 0; i < 2; i++) {
    *(uint4*)(sK + (lrow + i * 32) * LDT + lcol) = rk[i];
    *(uint4*)(sV + (lrow + i * 32) * LDT + lcol) = rv[i];
  }
  __syncthreads();
  const int nkt = nkeys >> 6;
  for (int kt = 0; kt < nkt; kt++) {
    const int cur = kt & 1;
    const bool more = kt + 1 < nkt;
    if (more) {
      const int key0 = (kt + 1) * 64;
#pragma unroll
      for (int i = 0; i < 2; i++) {
        rk[i] = *(const uint4*)(Kp + (size_t)(key0 + lrow + i * 32) * 64 + lcol);
        rv[i] = *(const uint4*)(Vp + (size_t)(lrow + i * 32) * nkeys + key0 + lcol);
      }
    }
    const u16* cK = sK + cur * 64 * LDT;
    const u16* cV = sV + cur * 64 * LDT;
    f32x4 st[2][4];
#pragma unroll
    for (int k16 = 0; k16 < 4; k16++) {
      const bf16x8 kf0 = *(const bf16x8*)(cK + (k16 * 16 + fr) * LDT + fq * 8);
      const bf16x8 kf1 = *(const bf16x8*)(cK + (k16 * 16 + fr) * LDT + 32 + fq * 8);
#pragma unroll
      for (int qt = 0; qt < 2; qt++) {
        f32x4 z = f32x4{0.f, 0.f, 0.f, 0.f};
        z = MFMA(kf0, qf[qt][0], z);
        st[qt][k16] = MFMA(kf1, qf[qt][1], z);
      }
    }
    bf16x8 pf[2][2];
#pragma unroll
    for (int qt = 0; qt < 2; qt++) {
      float mx = st[qt][0][0];
#pragma unroll
      for (int k16 = 0; k16 < 4; k16++)
#pragma unroll
        for (int r = 0; r < 4; r++) mx = fmaxf(mx, st[qt][k16][r]);
      mx = xor16_max(mx);
      mx = xor32_max(mx);
      if (!__all(mx - mrun[qt] <= 8.0f)) {
        const float mnew = fmaxf(mrun[qt], mx);
        const float alpha = fexp2(mrun[qt] - mnew);
        mrun[qt] = mnew;
        lrun[qt] *= alpha;
#pragma unroll
        for (int dt = 0; dt < 4; dt++)
#pragma unroll
          for (int r = 0; r < 4; r++) ot[qt][dt][r] *= alpha;
      }
      const float mcur = mrun[qt];
      float ps = 0.f;
#pragma unroll
      for (int k16 = 0; k16 < 4; k16++)
#pragma unroll
        for (int r = 0; r < 4; r++) {
          const float p = fexp2(st[qt][k16][r] - mcur);
          st[qt][k16][r] = p;
          ps += p;
        }
      lrun[qt] += ps;
#pragma unroll
      for (int a = 0; a < 2; a++) {
        union { bf16x8 v; unsigned u[4]; } pk;
        pk.u[0] = pack2(st[qt][2 * a][0], st[qt][2 * a][1]);
        pk.u[1] = pack2(st[qt][2 * a][2], st[qt][2 * a][3]);
        pk.u[2] = pack2(st[qt][2 * a + 1][0], st[qt][2 * a + 1][1]);
        pk.u[3] = pack2(st[qt][2 * a + 1][2], st[qt][2 * a + 1][3]);
        pf[qt][a] = pk.v;
      }
    }
#pragma unroll
    for (int a = 0; a < 2; a++)
#pragma unroll
      for (int dt = 0; dt < 4; dt++) {
        union { bf16x8 v; uint2 h[2]; } vf;
        vf.h[0] = *(const uint2*)(cV + (dt * 16 + fr) * LDT + a * 32 + fq * 4);
        vf.h[1] = *(const uint2*)(cV + (dt * 16 + fr) * LDT + a * 32 + 16 + fq * 4);
#pragma unroll
        for (int qt = 0; qt < 2; qt++) ot[qt][dt] = MFMA(vf.v, pf[qt][a], ot[qt][dt]);
      }
    if (more) {
      u16* dK = sK + (cur ^ 1) * 64 * LDT;
      u16* dV = sV + (cur ^ 1) * 64 * LDT;
#pragma unroll
      for (int i = 0; i < 2; i++) {
        *(uint4*)(dK + (lrow + i * 32) * LDT + lcol) = rk[i];
        *(uint4*)(dV + (lrow + i * 32) * LDT + lcol) = rv[i];
      }
    }
    __syncthreads();
  }
  u16* MIX = (u16*)(P.ws + OFF_H);
#pragma unroll
  for (int qt = 0; qt < 2; qt++) {
    float l = lrun[qt];
    l = xor16_sum(l);
    l = xor32_sum(l);
    const float inv = __builtin_amdgcn_rcpf(l);
    const int t = qrow0 + qt * 16 + fr;
#pragma unroll
    for (int dt = 0; dt < 4; dt++) {
      uint2 o;
      o.x = pack2(ot[qt][dt][0] * inv, ot[qt][dt][1] * inv);
      o.y = pack2(ot[qt][dt][2] * inv, ot[qt][dt][3] * inv);
      *(uint2*)(MIX + (size_t)t * 1024 + 256 + head * 64 + dt * 16 + fq * 4) = o;
    }
  }
}

__device__ __forceinline__ void phase_even_mix(const Params& P, char* smem, int* qsh, const int rep) {
  unsigned* ctr = (unsigned*)(P.ws + OFF_Q + rep * 512);
  for (;;) {
    const int it = queue_next(ctr, qsh);
    if (it >= 1344) break;
    if (it < 128) fourier_tile(P, it, smem);
    else if (it < 896) attn_item(P, it - 128, smem);
    else if (it < 960) fourier_tile(P, it - 896 + 128, smem);
    else attn_item(P, it - 960 + 768, smem);
  }
}

__device__ __forceinline__ void ssd_conv8(const u16* __restrict__ PO, int col, const float* __restrict__ cw,
                                          const float* __restrict__ cb, int ch, int tg0, int lo, int hi,
                                          float (&o)[4][8]) {
  uint4 v[7];
#pragma unroll
  for (int r = 0; r < 7; r++) {
    const int t = tg0 - 1 + r;
    v[r] = make_uint4(0u, 0u, 0u, 0u);
    if (t >= lo && t < hi) v[r] = *(const uint4*)(PO + (size_t)t * 3456 + col);
  }
  float w[4][8], b[8];
#pragma unroll
  for (int j = 0; j < 4; j++) {
    const float4 w0 = *(const float4*)(cw + j * 1280 + ch);
    const float4 w1 = *(const float4*)(cw + j * 1280 + ch + 4);
    w[j][0] = w0.x; w[j][1] = w0.y; w[j][2] = w0.z; w[j][3] = w0.w;
    w[j][4] = w1.x; w[j][5] = w1.y; w[j][6] = w1.z; w[j][7] = w1.w;
  }
  {
    const float4 b0 = *(const float4*)(cb + ch);
    const float4 b1 = *(const float4*)(cb + ch + 4);
    b[0] = b0.x; b[1] = b0.y; b[2] = b0.z; b[3] = b0.w; b[4] = b1.x; b[5] = b1.y; b[6] = b1.z; b[7] = b1.w;
  }
#pragma unroll
  for (int tok = 0; tok < 4; tok++)
#pragma unroll
    for (int e = 0; e < 8; e++) o[tok][e] = b[e];
#pragma unroll
  for (int r = 0; r < 7; r++) {
    const unsigned uu[4] = {v[r].x, v[r].y, v[r].z, v[r].w};
#pragma unroll
    for (int e = 0; e < 8; e++) {
      const float x = __uint_as_float((e & 1) ? (uu[e >> 1] & 0xffff0000u) : (uu[e >> 1] << 16));
#pragma unroll
      for (int tok = 0; tok < 4; tok++) {
        const int j = r - tok;
        if (j >= 0 && j < 4) o[tok][e] += w[j][e] * x;
      }
    }
  }
#pragma unroll
  for (int tok = 0; tok < 4; tok++)
#pragma unroll
    for (int e = 0; e < 8; e++) o[tok][e] = silu_f(o[tok][e]);
}


__device__ __forceinline__ void phase_odd_conv(const Params& P) {
  const u16* PO = (const u16*)(P.ws + OFF_R1);
  u16* XC = (u16*)(P.ws + OFF_H);
  const float* cw = PRM(P, PRM_CSW);
  const float* cb = PRM(P, PRM_CSB);
  constexpr int NRUN = T_ALL / 16;
  const int nthr = gridDim.x * 256;
  for (int idx = blockIdx.x * 256 + threadIdx.x; idx < NRUN * 160; idx += nthr) {
    const int c8 = idx % 160, run = idx / 160;
    const int tb16 = run * 16;
    int lo, hi;
    if (tb16 < T_CTX) { lo = tb16 & ~255; hi = lo + 256; }
    else { lo = T_CTX + ((tb16 - T_CTX) & ~1023); hi = lo + 1024; }
    const int ch = c8 * 8;
    float w[4][8], bb[8];
#pragma unroll
    for (int j = 0; j < 4; j++) {
      const float4 w0 = *(const float4*)(cw + j * 1280 + ch);
      const float4 w1 = *(const float4*)(cw + j * 1280 + ch + 4);
      w[j][0] = w0.x; w[j][1] = w0.y; w[j][2] = w0.z; w[j][3] = w0.w;
      w[j][4] = w1.x; w[j][5] = w1.y; w[j][6] = w1.z; w[j][7] = w1.w;
    }
    {
      const float4 b0 = *(const float4*)(cb + ch);
      const float4 b1 = *(const float4*)(cb + ch + 4);
      bb[0] = b0.x; bb[1] = b0.y; bb[2] = b0.z; bb[3] = b0.w; bb[4] = b1.x; bb[5] = b1.y; bb[6] = b1.z; bb[7] = b1.w;
    }
    const u16* src = PO + 2048 + ch;
    u32x4 v[19];
#pragma unroll
    for (int r = 0; r < 19; r++) {
      const int t = tb16 - 1 + r;
      v[r] = u32x4{0u, 0u, 0u, 0u};
      if (t >= lo && t < hi) v[r] = *(const u32x4*)(src + (size_t)t * 3456);
    }
#pragma unroll
    for (int tok = 0; tok < 16; tok++) {
      float o[8];
#pragma unroll
      for (int e = 0; e < 8; e++) o[e] = bb[e];
#pragma unroll
      for (int j = 0; j < 4; j++) {
        const u32x4 vv = v[tok + j];
        const unsigned uu[4] = {vv.x, vv.y, vv.z, vv.w};
#pragma unroll
        for (int e = 0; e < 8; e++) {
          const float x = __uint_as_float((e & 1) ? (uu[e >> 1] & 0xffff0000u) : (uu[e >> 1] << 16));
          o[e] += w[j][e] * x;
        }
      }
      uint4 w4;
      w4.x = pack2(silu_f(o[0]), silu_f(o[1])); w4.y = pack2(silu_f(o[2]), silu_f(o[3]));
      w4.z = pack2(silu_f(o[4]), silu_f(o[5])); w4.w = pack2(silu_f(o[6]), silu_f(o[7]));
      *(uint4*)(XC + (size_t)(tb16 + tok) * 1280 + ch) = w4;
    }
  }
}

__device__ __forceinline__ void ssd_item(const Params& P, int item, char* smem) {
  const int tid = threadIdx.x, lane = tid & 63, wave = tid >> 6;
  const int fr = lane & 15, fq = lane >> 4;
  bool smp; int seq;
  if (item < 256) { smp = true; seq = item >> 5; }
  else { item -= 256; smp = false; seq = item >> 5; }
  const int head = (item & 31) >> 1, dir = item & 1;
  const int nc = smp ? 8 : 2;
  const int tb = smp ? T_CTX + seq * 1024 : seq * 256;
  const int tend = tb + (smp ? 1024 : 256);
  const int g = head >> 3;
  u16* Cs = (u16*)smem;
  u16* Bs = (u16*)(smem + 18432);
  u16* BT = (u16*)(smem + 36864);
  u16* XT = (u16*)(smem + 54272);
  u16* Hb = (u16*)(smem + 71680);
  float* cum2 = (float*)(smem + 79872);
  float* lcs2 = (float*)(smem + 80384);
  float* misc = (float*)(smem + 81408);
  const u16* PO = (const u16*)(P.ws + OFF_R1);
  const float* DT = (const float*)(P.ws + OFF_DT);
  u16* YO = (u16*)(P.ws + OFF_Y) + (size_t)dir * T_ALL * 1024;
  const float Aneg = -__expf(PRM(P, PRM_ALOG)[dir * 16 + head]);
  const float dtb = PRM(P, PRM_DTB)[dir * 16 + head];
  const float Dh = PRM(P, PRM_SSDD)[head];
  f32x4 hacc[4];
#pragma unroll
  for (int nt = 0; nt < 4; nt++) {
#pragma unroll
    for (int r = 0; r < 4; r++) {
      float v = 0.f;
      if (smp) v = P.in[6][(size_t)((seq * 2 + dir) * 16 + head) * 4096 + (wave * 16 + fq * 4 + r) * 64 + nt * 16 + fr];
      hacc[nt][r] = v;
      Hb[(wave * 16 + fq * 4 + r) * 64 + nt * 16 + fr] = f2bf(v);
    }
  }
  const int ch8 = (tid & 7) * 8, rg = tid >> 3;
  const u16* XC = (const u16*)(P.ws + OFF_H);
  u32x4 rx0, rx1, rx2, rx3, rb0, rb1, rb2, rb3;
  float raw_next = 0.f;
  {
    const int c0 = dir ? nc - 1 : 0;
    const u16* xr = XC + (size_t)(tb + c0 * 128 + rg * 4) * 1280 + ch8;
    rx0 = *(const u32x4*)(xr + head * 64); rx1 = *(const u32x4*)(xr + 1280 + head * 64);
    rx2 = *(const u32x4*)(xr + 2560 + head * 64); rx3 = *(const u32x4*)(xr + 3840 + head * 64);
    rb0 = *(const u32x4*)(xr + 1024 + g * 64); rb1 = *(const u32x4*)(xr + 1280 + 1024 + g * 64);
    rb2 = *(const u32x4*)(xr + 2560 + 1024 + g * 64); rb3 = *(const u32x4*)(xr + 3840 + 1024 + g * 64);
    if (tid < 128) raw_next = DT[(size_t)(tb + c0 * 128 + (dir ? 127 - tid : tid)) * 32 + dir * 16 + head];
  }
  for (int ci = 0; ci < nc; ci++) {
    const int c = dir ? nc - 1 - ci : ci;
    const int t0 = tb + c * 128;
    {
      const u16* xrc = XC + (size_t)(t0 + rg * 4) * 1280 + ch8 + 1152 + g * 64;
      const u32x4 rc0 = *(const u32x4*)(xrc), rc1 = *(const u32x4*)(xrc + 1280);
      const u32x4 rc2 = *(const u32x4*)(xrc + 2560), rc3 = *(const u32x4*)(xrc + 3840);
      {
        const unsigned u[4][4] = {{rx0.x, rx0.y, rx0.z, rx0.w}, {rx1.x, rx1.y, rx1.z, rx1.w}, {rx2.x, rx2.y, rx2.z, rx2.w}, {rx3.x, rx3.y, rx3.z, rx3.w}};
#pragma unroll
        for (int q = 0; q < 4; q++) {
          uint2 lo2, hi2;
          lo2.x = (u[0][q] & 0xffffu) | (u[1][q] << 16); lo2.y = (u[2][q] & 0xffffu) | (u[3][q] << 16);
          hi2.x = (u[0][q] >> 16) | (u[1][q] & 0xffff0000u); hi2.y = (u[2][q] >> 16) | (u[3][q] & 0xffff0000u);
          *(uint2*)(XT + (ch8 + 2 * q) * 136 + rg * 4) = lo2;
          *(uint2*)(XT + (ch8 + 2 * q + 1) * 136 + rg * 4) = hi2;
        }
      }
      {
        const unsigned u[4][4] = {{rb0.x, rb0.y, rb0.z, rb0.w}, {rb1.x, rb1.y, rb1.z, rb1.w}, {rb2.x, rb2.y, rb2.z, rb2.w}, {rb3.x, rb3.y, rb3.z, rb3.w}};
#pragma unroll
        for (int q = 0; q < 4; q++) {
          uint2 lo2, hi2;
          lo2.x = (u[0][q] & 0xffffu) | (u[1][q] << 16); lo2.y = (u[2][q] & 0xffffu) | (u[3][q] << 16);
          hi2.x = (u[0][q] >> 16) | (u[1][q] & 0xffff0000u); hi2.y = (u[2][q] >> 16) | (u[3][q] & 0xffff0000u);
          *(uint2*)(BT + (ch8 + 2 * q) * 136 + rg * 4) = lo2;
          *(uint2*)(BT + (ch8 + 2 * q + 1) * 136 + rg * 4) = hi2;
        }
        *(u32x4*)(Bs + (rg * 4 + 0) * LDT + ch8) = rb0;
        *(u32x4*)(Bs + (rg * 4 + 1) * LDT + ch8) = rb1;
        *(u32x4*)(Bs + (rg * 4 + 2) * LDT + ch8) = rb2;
        *(u32x4*)(Bs + (rg * 4 + 3) * LDT + ch8) = rb3;
      }
      *(u32x4*)(Cs + (rg * 4 + 0) * LDT + ch8) = rc0;
      *(u32x4*)(Cs + (rg * 4 + 1) * LDT + ch8) = rc1;
      *(u32x4*)(Cs + (rg * 4 + 2) * LDT + ch8) = rc2;
      *(u32x4*)(Cs + (rg * 4 + 3) * LDT + ch8) = rc3;
    }
    const float raw_cur = raw_next;
    __builtin_amdgcn_sched_barrier(0);
    if (ci + 1 < nc) {
      const int cn = dir ? nc - 2 - ci : ci + 1;
      const u16* xr = XC + (size_t)(tb + cn * 128 + rg * 4) * 1280 + ch8;
      rx0 = *(const u32x4*)(xr + head * 64); rx1 = *(const u32x4*)(xr + 1280 + head * 64);
      rx2 = *(const u32x4*)(xr + 2560 + head * 64); rx3 = *(const u32x4*)(xr + 3840 + head * 64);
      rb0 = *(const u32x4*)(xr + 1024 + g * 64); rb1 = *(const u32x4*)(xr + 1280 + 1024 + g * 64);
      rb2 = *(const u32x4*)(xr + 2560 + 1024 + g * 64); rb3 = *(const u32x4*)(xr + 3840 + 1024 + g * 64);
      if (tid < 128) raw_next = DT[(size_t)(tb + cn * 128 + (dir ? 127 - tid : tid)) * 32 + dir * 16 + head];
    }
    __builtin_amdgcn_sched_barrier(0);
    float sv = 0.f, dtv = 1.f;
    int li = 0;
    if (tid < 128) {
      li = dir ? 127 - tid : tid;
      const float raw = raw_cur + dtb;
      dtv = fmaxf(raw, 0.f) + log1pf(__expf(-fabsf(raw)));
      sv = dtv * Aneg;
#pragma unroll
      for (int o = 1; o < 64; o <<= 1) {
        const float u = __shfl_up(sv, o);
        if (lane >= o) sv += u;
      }
      if (tid == 63) misc[0] = sv;
    }
    __syncthreads();
    if (tid < 128) {
      if (wave == 1) sv += misc[0];
      cum2[li] = sv * LOG2E;
      lcs2[li] = (sv - __logf(dtv)) * LOG2E;
      if (tid == 127) misc[1] = sv * LOG2E;
    }
    __syncthreads();
    const float total2 = misc[1];
#pragma unroll 1
    for (int tt = 0; tt < 2; tt++) {
      const int Tt = wave * 2 + tt;
      const int tl = wave * 32 + tt * 16 + fr;
      bf16x8 cf[2];
#pragma unroll
      for (int kk = 0; kk < 2; kk++) cf[kk] = *(const bf16x8*)(Cs + tl * LDT + kk * 32 + fq * 8);
      f32x4 acc[4];
#pragma unroll
      for (int pt = 0; pt < 4; pt++) {
        const bf16x8 h0 = *(const bf16x8*)(Hb + (pt * 16 + fr) * 64 + fq * 8);
        const bf16x8 h1 = *(const bf16x8*)(Hb + (pt * 16 + fr) * 64 + 32 + fq * 8);
        f32x4 z = f32x4{0.f, 0.f, 0.f, 0.f};
        z = MFMA(h0, cf[0], z);
        acc[pt] = MFMA(h1, cf[1], z);
      }
      const float ct = cum2[tl];
      {
        const float e = fexp2(ct);
#pragma unroll
        for (int pt = 0; pt < 4; pt++)
#pragma unroll
          for (int r = 0; r < 4; r++) acc[pt][r] *= e;
      }
#pragma unroll 1
      for (int a = 0; a < 4; a++) {
        const bool ok = dir ? (2 * a + 1 >= Tt) : (2 * a <= Tt);
        if (!ok) continue;
        f32x4 g0 = f32x4{0.f, 0.f, 0.f, 0.f}, g1 = f32x4{0.f, 0.f, 0.f, 0.f};
#pragma unroll
        for (int kk = 0; kk < 2; kk++) {
          const bf16x8 b0 = *(const bf16x8*)(Bs + ((2 * a) * 16 + fr) * LDT + kk * 32 + fq * 8);
          const bf16x8 b1 = *(const bf16x8*)(Bs + ((2 * a + 1) * 16 + fr) * LDT + kk * 32 + fq * 8);
          g0 = MFMA(b0, cf[kk], g0);
          g1 = MFMA(b1, cf[kk], g1);
        }
        const float4 l0 = *(const float4*)(lcs2 + a * 32 + fq * 4);
        const float4 l1 = *(const float4*)(lcs2 + a * 32 + 16 + fq * 4);
        const float ls0[4] = {l0.x, l0.y, l0.z, l0.w};
        const float ls1[4] = {l1.x, l1.y, l1.z, l1.w};
        float m0[4], m1[4];
#pragma unroll
        for (int r = 0; r < 4; r++) {
          const int s0 = a * 32 + fq * 4 + r, s1 = s0 + 16;
          const bool ok0 = dir ? (s0 >= tl) : (s0 <= tl);
          const bool ok1 = dir ? (s1 >= tl) : (s1 <= tl);
          float v0 = ok0 ? g0[r] * fexp2(ct - ls0[r]) : 0.f;
          float v1 = ok1 ? g1[r] * fexp2(ct - ls1[r]) : 0.f;
          if (!dir && s0 == tl) v0 += Dh;
          if (!dir && s1 == tl) v1 += Dh;
          m0[r] = v0; m1[r] = v1;
        }
        union { bf16x8 v; unsigned u[4]; } pk;
        pk.u[0] = pack2(m0[0], m0[1]); pk.u[1] = pack2(m0[2], m0[3]);
        pk.u[2] = pack2(m1[0], m1[1]); pk.u[3] = pack2(m1[2], m1[3]);
#pragma unroll
        for (int pt = 0; pt < 4; pt++) {
          union { bf16x8 v; uint2 h[2]; } x;
          x.h[0] = *(const uint2*)(XT + (pt * 16 + fr) * 136 + a * 32 + fq * 4);
          x.h[1] = *(const uint2*)(XT + (pt * 16 + fr) * 136 + a * 32 + 16 + fq * 4);
          acc[pt] = MFMA(x.v, pk.v, acc[pt]);
        }
      }
      {
        const int t = t0 + tl;
#pragma unroll
        for (int pt = 0; pt < 4; pt++) {
          uint2 o;
          o.x = pack2(acc[pt][0], acc[pt][1]);
          o.y = pack2(acc[pt][2], acc[pt][3]);
          *(uint2*)(YO + (size_t)t * 1024 + head * 64 + pt * 16 + fq * 4) = o;
        }
      }
    }
    {
      const float et = fexp2(total2);
#pragma unroll
      for (int nt = 0; nt < 4; nt++)
#pragma unroll
        for (int r = 0; r < 4; r++) hacc[nt][r] *= et;
#pragma unroll 1
      for (int ks = 0; ks < 4; ks++) {
        union { bf16x8 v; unsigned u[4]; } xr, xw;
        xr.v = *(const bf16x8*)(XT + (wave * 16 + fr) * 136 + ks * 32 + fq * 8);
        const float4 la = *(const float4*)(lcs2 + ks * 32 + fq * 8);
        const float4 lb = *(const float4*)(lcs2 + ks * 32 + fq * 8 + 4);
        const float lw[8] = {la.x, la.y, la.z, la.w, lb.x, lb.y, lb.z, lb.w};
#pragma unroll
        for (int q = 0; q < 4; q++) {
          const float x0 = __uint_as_float(xr.u[q] << 16) * fexp2(total2 - lw[2 * q]);
          const float x1 = __uint_as_float(xr.u[q] & 0xffff0000u) * fexp2(total2 - lw[2 * q + 1]);
          xw.u[q] = pack2(x0, x1);
        }
#pragma unroll
        for (int nt = 0; nt < 4; nt++) {
          const bf16x8 bt = *(const bf16x8*)(BT + (nt * 16 + fr) * 136 + ks * 32 + fq * 8);
          hacc[nt] = MFMA(xw.v, bt, hacc[nt]);
        }
      }
    }
    __syncthreads();
#pragma unroll
    for (int nt = 0; nt < 4; nt++)
#pragma unroll
      for (int r = 0; r < 4; r++) Hb[(wave * 16 + fq * 4 + r) * 64 + nt * 16 + fr] = f2bf(hacc[nt][r]);
  }
  if (!smp) {
    float* ns = P.out + 14696448 + (size_t)((seq * 2 + dir) * 16 + head) * 4096;
#pragma unroll
    for (int nt = 0; nt < 4; nt++)
#pragma unroll
      for (int r = 0; r < 4; r++) ns[(wave * 16 + fq * 4 + r) * 64 + nt * 16 + fr] = hacc[nt][r];
  }
  __syncthreads();
}

__device__ __forceinline__ void lru_item(const Params& P, int item, char* smem) {
  const int tid = threadIdx.x, lane = tid & 63, wave = tid >> 6;
  const int fr = lane & 15, fq = lane >> 4;
  bool smp; int seq;
  if (item < 128) { smp = true; seq = item >> 4; }
  else { item -= 128; smp = false; seq = item >> 4; }
  const int blk = (item & 15) >> 1, dir = item & 1;
  const int nc = smp ? 16 : 4;
  const int tb = smp ? T_CTX + seq * 1024 : seq * 256;
  const int tend = tb + (smp ? 1024 : 256);
  u16* WaT = (u16*)smem;
  u16* WxT = (u16*)(smem + 9216);
  u16* xcb = (u16*)(smem + 18432);
  float* aL = (float*)(smem + 27648);
  float* bL = (float*)(smem + 45056);
  float* sA = (float*)(smem + 62464);
  float* sH = (float*)(smem + 63488);
  float* hc = (float*)(smem + 64512);
  float* cba = (float*)(smem + 65024);
  float* cbx = (float*)(smem + 65280);
  float* csp = (float*)(smem + 65536);
  const u16* PO = (const u16*)(P.ws + OFF_R1);
  u16* YO = (u16*)(P.ws + OFF_YL) + (size_t)dir * T_ALL * 512;
  {
    const float* wa = PRM(P, PRM_LWA) + (size_t)(dir * 8 + blk) * 4096;
    const float* wx = PRM(P, PRM_LWX) + (size_t)(dir * 8 + blk) * 4096;
    for (int e = tid; e < 4096; e += 256) {
      const int i = e >> 6, j = e & 63;
      WaT[j * LDT + i] = f2bf(wa[e]);
      WxT[j * LDT + i] = f2bf(wx[e]);
    }
    if (tid < 64) {
      const int ch = dir * 512 + blk * 64 + tid;
      cba[tid] = PRM(P, PRM_LBA)[ch];
      cbx[tid] = PRM(P, PRM_LBX)[ch];
      const float lam = -PRM(P, PRM_LAM)[ch];
      csp[tid] = 8.0f * (fmaxf(lam, 0.f) + log1pf(__expf(-fabsf(lam))));
      hc[tid] = smp ? P.in[5][(size_t)(seq * 2 + dir) * 512 + blk * 64 + tid] : 0.f;
    }
  }
  const int ch8 = (tid & 7) * 8, rg = tid >> 3;
  const float* cw = PRM(P, PRM_CLW);
  const float* cb = PRM(P, PRM_CLB);
  u32x4 pv0, pv1, pv2, pv3, pv4;
  {
    const int c0 = dir ? nc - 1 : 0;
    const int tn = tb + c0 * 64 + rg * 2 - 1;
    const int chg = blk * 64 + ch8;
    const u32x4 zz = {0u, 0u, 0u, 0u};
    pv0 = (tn >= tb) ? *(const u32x4*)(PO + (size_t)tn * 3456 + 512 + chg) : zz;
    pv1 = *(const u32x4*)(PO + (size_t)(tn + 1) * 3456 + 512 + chg);
    pv2 = *(const u32x4*)(PO + (size_t)(tn + 2) * 3456 + 512 + chg);
    pv3 = (tn + 3 < tend) ? *(const u32x4*)(PO + (size_t)(tn + 3) * 3456 + 512 + chg) : zz;
    pv4 = (tn + 4 < tend) ? *(const u32x4*)(PO + (size_t)(tn + 4) * 3456 + 512 + chg) : zz;
  }
  for (int ci = 0; ci < nc; ci++) {
    const int c = dir ? nc - 1 - ci : ci;
    const int t0 = tb + c * 64;
    const int cur = ci & 1;
    {
      const int chg = blk * 64 + ch8;
      const u32x4 v[5] = {pv0, pv1, pv2, pv3, pv4};
      if (ci + 1 < nc) {
        const int cn = dir ? nc - 2 - ci : ci + 1;
        const int tn = tb + cn * 64 + rg * 2 - 1;
        const u32x4 zz = {0u, 0u, 0u, 0u};
        pv0 = (tn >= tb) ? *(const u32x4*)(PO + (size_t)tn * 3456 + 512 + chg) : zz;
        pv1 = *(const u32x4*)(PO + (size_t)(tn + 1) * 3456 + 512 + chg);
        pv2 = *(const u32x4*)(PO + (size_t)(tn + 2) * 3456 + 512 + chg);
        pv3 = (tn + 3 < tend) ? *(const u32x4*)(PO + (size_t)(tn + 3) * 3456 + 512 + chg) : zz;
        pv4 = (tn + 4 < tend) ? *(const u32x4*)(PO + (size_t)(tn + 4) * 3456 + 512 + chg) : zz;
      }
      float o[2][8];
      {
        const float4 b0 = *(const float4*)(cb + chg);
        const float4 b1 = *(const float4*)(cb + chg + 4);
        const float bb[8] = {b0.x, b0.y, b0.z, b0.w, b1.x, b1.y, b1.z, b1.w};
#pragma unroll
        for (int e = 0; e < 8; e++) { o[0][e] = bb[e]; o[1][e] = bb[e]; }
      }
#pragma unroll
      for (int j = 0; j < 4; j++) {
        const float4 w0 = *(const float4*)(cw + j * 512 + chg);
        const float4 w1 = *(const float4*)(cw + j * 512 + chg + 4);
        const float ww[8] = {w0.x, w0.y, w0.z, w0.w, w1.x, w1.y, w1.z, w1.w};
#pragma unroll
        for (int tok = 0; tok < 2; tok++) {
          const unsigned uu[4] = {v[tok + j].x, v[tok + j].y, v[tok + j].z, v[tok + j].w};
#pragma unroll
          for (int e = 0; e < 8; e++) {
            const float x = __uint_as_float((e & 1) ? (uu[e >> 1] & 0xffff0000u) : (uu[e >> 1] << 16));
            o[tok][e] += ww[e] * x;
          }
        }
      }
#pragma unroll
      for (int tok = 0; tok < 2; tok++) {
        const int tl = rg * 2 + tok;
        *(float4*)(bL + tl * 68 + ch8) = make_float4(o[tok][0], o[tok][1], o[tok][2], o[tok][3]);
        *(float4*)(bL + tl * 68 + ch8 + 4) = make_float4(o[tok][4], o[tok][5], o[tok][6], o[tok][7]);
        uint4 w4;
        w4.x = pack2(o[tok][0], o[tok][1]); w4.y = pack2(o[tok][2], o[tok][3]);
        w4.z = pack2(o[tok][4], o[tok][5]); w4.w = pack2(o[tok][6], o[tok][7]);
        *(uint4*)(xcb + tl * LDT + ch8) = w4;
      }
    }
    __syncthreads();
    {
      bf16x8 xb[2];
#pragma unroll
      for (int kk = 0; kk < 2; kk++) xb[kk] = *(const bf16x8*)(xcb + (wave * 16 + fr) * LDT + kk * 32 + fq * 8);
      const int tl = wave * 16 + fr;
#pragma unroll
      for (int jt = 0; jt < 4; jt++) {
        f32x4 aR = f32x4{0.f, 0.f, 0.f, 0.f}, aI = f32x4{0.f, 0.f, 0.f, 0.f};
#pragma unroll
        for (int kk = 0; kk < 2; kk++) {
          const bf16x8 wa = *(const bf16x8*)(WaT + (jt * 16 + fr) * LDT + kk * 32 + fq * 8);
          const bf16x8 wx = *(const bf16x8*)(WxT + (jt * 16 + fr) * LDT + kk * 32 + fq * 8);
          aR = MFMA(wa, xb[kk], aR);
          aI = MFMA(wx, xb[kk], aI);
        }
        const int j4 = jt * 16 + fq * 4;
        const float4 xc = *(const float4*)(bL + tl * 68 + j4);
        const float4 ba = *(const float4*)(cba + j4);
        const float4 bx = *(const float4*)(cbx + j4);
        const float4 sp = *(const float4*)(csp + j4);
        const float xcv[4] = {xc.x, xc.y, xc.z, xc.w};
        const float bav[4] = {ba.x, ba.y, ba.z, ba.w};
        const float bxv[4] = {bx.x, bx.y, bx.z, bx.w};
        const float spv[4] = {sp.x, sp.y, sp.z, sp.w};
        float av[4], bv[4];
#pragma unroll
        for (int r = 0; r < 4; r++) {
          const float rr = sigmoid_f(aR[r] + bav[r]);
          const float ii = sigmoid_f(aI[r] + bxv[r]);
          const float la = -rr * spv[r];
          av[r] = __expf(la);
          bv[r] = __builtin_amdgcn_sqrtf(fmaxf(1.0f - av[r] * av[r], 0.f)) * ii * xcv[r];
        }
        *(float4*)(aL + tl * 68 + j4) = make_float4(av[0], av[1], av[2], av[3]);
        *(float4*)(bL + tl * 68 + j4) = make_float4(bv[0], bv[1], bv[2], bv[3]);
      }
    }
    __syncthreads();
    {
      const int j = lane, q = wave;
      float hreg[16], areg[16];
      float h = 0.f, Ap = 1.f;
#pragma unroll
      for (int i = 0; i < 16; i++) {
        const int tl = dir ? 63 - (q * 16 + i) : q * 16 + i;
        const float a = aL[tl * 68 + j], b = bL[tl * 68 + j];
        h = a * h + b;
        Ap *= a;
        hreg[i] = h;
        areg[i] = Ap;
      }
      sA[q * 64 + j] = Ap;
      sH[q * 64 + j] = h;
      __syncthreads();
      float Hin = hc[cur * 64 + j];
      for (int qq = 0; qq < q; qq++) Hin = sA[qq * 64 + j] * Hin + sH[qq * 64 + j];
#pragma unroll
      for (int i = 0; i < 16; i++) {
        const int tl = dir ? 63 - (q * 16 + i) : q * 16 + i;
        const float hv = hreg[i] + areg[i] * Hin;
        YO[(size_t)(t0 + tl) * 512 + blk * 64 + j] = f2bf(hv);
      }
      if (q == 3) hc[(cur ^ 1) * 64 + j] = sA[3 * 64 + j] * Hin + sH[3 * 64 + j];
    }
  }
  __syncthreads();
  if (!smp && tid < 64) {
    P.out[14680064 + (size_t)(seq * 2 + dir) * 512 + blk * 64 + tid] = hc[(nc & 1) * 64 + tid];
  }
  __syncthreads();
}

__device__ __forceinline__ void phase_odd_mix(const Params& P, char* smem, int* qsh, const int rep) {
  unsigned* ctr = (unsigned*)(P.ws + OFF_Q + 256 + rep * 512);
  for (;;) {
    const int it = queue_next(ctr, qsh);
    if (it >= 1152) break;
    bool is_ssd; int idx;
    if (it < 128) { is_ssd = false; idx = it; }
    else if (it < 384) { is_ssd = true; idx = it - 128; }
    else if (it < 640) { is_ssd = false; idx = it - 384 + 128; }
    else { is_ssd = true; idx = it - 640 + 256; }
    if (is_ssd) ssd_item(P, idx, smem);
    else lru_item(P, idx, smem);
  }
}

__device__ __forceinline__ void phase_odd_combine(const Params& P) {
  const int tid = threadIdx.x, lane = tid & 63, wave = tid >> 6;
  const u16* PO = (const u16*)(P.ws + OFF_R1);
  const u16* YSF = (const u16*)(P.ws + OFF_Y);
  const u16* YSB = YSF + (size_t)T_ALL * 1024;
  const u16* YLF = (const u16*)(P.ws + OFF_YL);
  const u16* YLB = YLF + (size_t)T_ALL * 512;
  u16* MIX = (u16*)(P.ws + OFF_H);
  const float* nrm = PRM(P, PRM_SNORM);
  float4 nr[2][2];
#pragma unroll
  for (int hh = 0; hh < 2; hh++) { nr[hh][0] = *(const float4*)(nrm + hh * 512 + lane * 8); nr[hh][1] = *(const float4*)(nrm + hh * 512 + lane * 8 + 4); }
  for (int t = blockIdx.x * 4 + wave; t < T_ALL; t += gridDim.x * 4) {
    {
      const int c = lane * 8;
      const uint4 f = *(const uint4*)(YLF + (size_t)t * 512 + c);
      const uint4 b = *(const uint4*)(YLB + (size_t)t * 512 + c);
      const uint4 gg = *(const uint4*)(PO + (size_t)t * 3456 + c);
      const unsigned fu[4] = {f.x, f.y, f.z, f.w}, bu[4] = {b.x, b.y, b.z, b.w}, gu[4] = {gg.x, gg.y, gg.z, gg.w};
      unsigned ou[4];
#pragma unroll
      for (int q = 0; q < 4; q++) {
        float r[2];
#pragma unroll
        for (int h = 0; h < 2; h++) {
          const float yf = h ? __uint_as_float(fu[q] & 0xffff0000u) : __uint_as_float(fu[q] << 16);
          const float yb = h ? __uint_as_float(bu[q] & 0xffff0000u) : __uint_as_float(bu[q] << 16);
          const float gv = h ? __uint_as_float(gu[q] & 0xffff0000u) : __uint_as_float(gu[q] << 16);
          const float ge = gv * __builtin_amdgcn_rcpf(1.f + __expf(-2.0f * 0.7978845608028654f * (gv + 0.044715f * gv * gv * gv)));
          r[h] = (yf + yb) * ge;
        }
        ou[q] = pack2(r[0], r[1]);
      }
      *(uint4*)(MIX + (size_t)t * 1536 + c) = make_uint4(ou[0], ou[1], ou[2], ou[3]);
    }
    float y[16];
    float ss = 0.f;
#pragma unroll
    for (int hh = 0; hh < 2; hh++) {
      const int c = hh * 512 + lane * 8;
      const uint4 f = *(const uint4*)(YSF + (size_t)t * 1024 + c);
      const uint4 b = *(const uint4*)(YSB + (size_t)t * 1024 + c);
      const uint4 zz = *(const uint4*)(PO + (size_t)t * 3456 + 1024 + c);
      const unsigned fu[4] = {f.x, f.y, f.z, f.w}, bu[4] = {b.x, b.y, b.z, b.w}, zu[4] = {zz.x, zz.y, zz.z, zz.w};
#pragma unroll
      for (int q = 0; q < 4; q++)
#pragma unroll
        for (int h = 0; h < 2; h++) {
          const float yf = h ? __uint_as_float(fu[q] & 0xffff0000u) : __uint_as_float(fu[q] << 16);
          const float yb = h ? __uint_as_float(bu[q] & 0xffff0000u) : __uint_as_float(bu[q] << 16);
          const float zv = h ? __uint_as_float(zu[q] & 0xffff0000u) : __uint_as_float(zu[q] << 16);
          const float v = (yf + yb) * silu_f(zv);
          y[hh * 8 + q * 2 + h] = v;
          ss += v * v;
        }
    }
#pragma unroll
    for (int o = 32; o >= 1; o >>= 1) ss += __shfl_xor(ss, o);
    const float rs = rsqrtf(ss * (1.0f / 1024.0f) + 1e-6f);
#pragma unroll
    for (int hh = 0; hh < 2; hh++) {
      const int c = hh * 512 + lane * 8;
      const float4 n0 = nr[hh][0];
      const float4 n1 = nr[hh][1];
      uint4 o;
      o.x = pack2(y[hh * 8 + 0] * rs * n0.x, y[hh * 8 + 1] * rs * n0.y);
      o.y = pack2(y[hh * 8 + 2] * rs * n0.z, y[hh * 8 + 3] * rs * n0.w);
      o.z = pack2(y[hh * 8 + 4] * rs * n1.x, y[hh * 8 + 5] * rs * n1.y);
      o.w = pack2(y[hh * 8 + 6] * rs * n1.z, y[hh * 8 + 7] * rs * n1.w);
      *(uint4*)(MIX + (size_t)t * 1536 + 512 + c) = o;
    }
  }
}

#ifndef PHMASK
#define PHMASK 0xffffffu
#endif
__device__ __forceinline__ void run_phase(const Params& P, const int ph, char* smem, int* qsh, const int rep = 0) {
  switch (ph) {
    case 0: if (PHMASK & (1u << 0)) phase_prep(P, smem, qsh); break;
    case 1: if (PHMASK & (1u << 1)) phase_norm(P, 0, 0); break;
    case 2: if (PHMASK & (1u << 2)) phase_gemm_in_even(P, smem); break;
    case 3: if (PHMASK & (1u << 3)) phase_even_mix(P, smem, qsh, rep); break;
    case 4: if (PHMASK & (1u << 4)) phase_gemm_resid(P, smem, (const u16*)(P.ws + OFF_H), 1024, (const u16*)(P.ws + OFF_WOE), 1024, 0, 2, true); break;
    case 5: if (PHMASK & (1u << 5)) phase_norm(P, 0, 1); break;
    case 6: if (PHMASK & (1u << 6)) phase_gemm_ffn_up(P, smem, 0); break;
    case 7: if (PHMASK & (1u << 7)) phase_gemm_resid(P, smem, (const u16*)(P.ws + OFF_R1), 2816, (const u16*)(P.ws + OFF_W2), 2816, 0, 5, false); break;
    case 8: if (PHMASK & (1u << 8)) phase_norm(P, 1, 0); break;
    case 9: if (PHMASK & (1u << 9)) phase_gemm_in_odd(P, smem); break;
    case 10: if (PHMASK & (1u << 10)) phase_odd_conv(P); break;
    case 11: if (PHMASK & (1u << 11)) phase_odd_mix(P, smem, qsh, rep); break;
    case 12: if (PHMASK & (1u << 12)) phase_odd_combine(P); break;
    case 13: if (PHMASK & (1u << 13)) phase_gemm_resid(P, smem, (const u16*)(P.ws + OFF_H), 1536, (const u16*)(P.ws + OFF_WOO), 1536, 1, 2, false); break;
    case 14: if (PHMASK & (1u << 14)) phase_norm(P, 1, 1); break;
    case 15: if (PHMASK & (1u << 15)) phase_gemm_ffn_up(P, smem, 1); break;
    case 16: if (PHMASK & (1u << 16)) phase_gemm_resid(P, smem, (const u16*)(P.ws + OFF_R1), 2816, (const u16*)(P.ws + OFF_W2) + (size_t)1024 * 2816, 2816, 1, 5, false); break;
    default: break;
  }
}

constexpr int N_PHASES = 17;

__global__ void __launch_bounds__(256, 2) mega_kernel(Params P, int ph_lo, int ph_hi) {
  __shared__ __attribute__((aligned(16))) char smem[SMEM_BYTES];
  __shared__ uint4 xb_words;
  __shared__ int q_item;
  cg::grid_group grid = cg::this_grid();
  if (threadIdx.x == 0) xb_words = make_uint4(0u, 0u, 0u, 0u);
  __syncthreads();
  XcdBarrier xb = xcd_barrier_post((unsigned*)(P.ws + OFF_BAR), (volatile LAS unsigned*)&xb_words);
  if (ph_lo < 0) grid.sync();
#ifndef DUP_PH
#define DUP_PH -1
#endif
#define RUN_PH(ph) if ((ph) >= ph_lo && (ph) < ph_hi) { run_phase(P, (ph), smem, &q_item); if (DUP_PH == (ph)) { xcd_barrier(xb); run_phase(P, (ph), smem, &q_item, 1); } if ((ph) + 1 < ph_hi) xcd_barrier(xb); }
  RUN_PH(0) RUN_PH(1) RUN_PH(2) RUN_PH(3) RUN_PH(4) RUN_PH(5) RUN_PH(6) RUN_PH(7)
  RUN_PH(8) RUN_PH(9) RUN_PH(10) RUN_PH(11) RUN_PH(12) RUN_PH(13) RUN_PH(14) RUN_PH(15) RUN_PH(16)
}

#ifndef MULTI_LAUNCH
#define MULTI_LAUNCH 0
#endif

extern "C" void kernel_launch(void* const* d_in, const int* in_sizes, int n_in, void* d_out, int out_size, void* d_ws,
                              size_t ws_size, hipStream_t stream) {
  static int grid_blocks = 0;
  if (!grid_blocks) {
    int dev = 0, cus = 0, per_cu = 0;
    (void)hipGetDevice(&dev);
    (void)hipDeviceGetAttribute(&cus, hipDeviceAttributeMultiprocessorCount, dev);
    (void)hipOccupancyMaxActiveBlocksPerMultiprocessor(&per_cu, mega_kernel, 256, 0);
    if (per_cu > 2) per_cu = 2;
    if (per_cu < 1) per_cu = 1;
    grid_blocks = cus * per_cu;
  }
  Params p;
  memset(&p, 0, sizeof(p));
  for (int i = 0; i < 34; i++) p.in[i] = (const float*)d_in[i];
  p.out = (float*)d_out;
  p.ws = (char*)d_ws;
#if MULTI_LAUNCH
  for (int ph = 0; ph < N_PHASES; ph++) {
    int lo = ph, hi = ph + 1;
    void* args[] = {&p, &lo, &hi};
    hipError_t e = hipLaunchCooperativeKernel((void*)mega_kernel, dim3(grid_blocks), dim3(256), args, 0, stream);
    if (e != hipSuccess) fprintf(stderr, "launch failed: %s (grid %d)\n", hipGetErrorString(e), grid_blocks);
  }
#else
  (void)hipMemsetAsync((char*)d_ws + OFF_BAR, 0, 24576, stream);
  int lo = 0, hi = N_PHASES;
  void* args[] = {&p, &lo, &hi};
  hipError_t e = hipLaunchCooperativeKernel((void*)mega_kernel, dim3(grid_blocks), dim3(256), args, 0, stream);
  if (e != hipSuccess) fprintf(stderr, "cooperative launch failed: %s (grid %d)\n", hipGetErrorString(e), grid_blocks);
#endif
}
```

```cpp
#include <hip/hip_runtime.h>
#include <hip/hip_bf16.h>
#include <hip/hip_cooperative_groups.h>
#include <cstdio>
#include <cstring>
namespace cg = cooperative_groups;

typedef unsigned short u16;
using bf16x8 = __attribute__((ext_vector_type(8))) short;
using bf16x4 = __attribute__((ext_vector_type(4))) short;
using f32x4 = __attribute__((ext_vector_type(4))) float;

#define MFMA(a, b, c) __builtin_amdgcn_mfma_f32_16x16x32_bf16(a, b, c, 0, 0, 0)
#define LOG2E 1.4426950408889634f

constexpr int T_ALL = 12288;
constexpr int T_CTX = 4096;
constexpr int SMEM_BYTES = 81664;
constexpr int LDT = 72;

constexpr size_t OFF_WIE = 0;
constexpr size_t OFF_WOE = OFF_WIE + 3670016;
constexpr size_t OFF_WIO = OFF_WOE + 2097152;
constexpr size_t OFF_WOO = OFF_WIO + 7077888;
constexpr size_t OFF_W13 = OFF_WOO + 3145728;
constexpr size_t OFF_W2 = OFF_W13 + 23068672;
constexpr size_t OFF_MOD = OFF_W2 + 11534336;
constexpr size_t OFF_D1K = OFF_MOD + 442368;
constexpr size_t OFF_D256 = OFF_D1K + 4194304;
constexpr size_t OFF_H = OFF_D256 + 262144;
constexpr size_t OFF_R1 = OFF_H + 37748736;
constexpr size_t OFF_Y = OFF_R1 + 84934656;
constexpr size_t OFF_YL = OFF_Y + 50331648;
constexpr size_t OFF_DT = OFF_YL + 25165824;
constexpr size_t OFF_BAR = OFF_DT + 1572864;
constexpr size_t OFF_PRM = OFF_BAR + 32768;
constexpr int PRM_NORM_MIX = 0, PRM_NORM_FFN = 2048, PRM_QN = 4096, PRM_KN = 4160, PRM_CLW = 4224, PRM_CLB = 6272,
              PRM_LBA = 6784, PRM_LBX = 7808, PRM_LAM = 8832, PRM_CSW = 9856, PRM_CSB = 14976, PRM_DTB = 16256,
              PRM_ALOG = 16288, PRM_SSDD = 16320, PRM_SNORM = 16384, PRM_LWA = 17408, PRM_LWX = 82944;
#define PRM(P, off) ((const float*)((P).ws + OFF_PRM) + (off))
constexpr size_t OFF_YTS = OFF_Y;
constexpr size_t OFF_YTC = OFF_Y + 8388608;
constexpr size_t OFF_QB = OFF_Y + 12582912;
constexpr size_t OFF_KBS = OFF_Y + 31457280;
constexpr size_t OFF_KBC = OFF_Y + 37748736;
constexpr size_t OFF_VTS = OFF_Y + 39845888;
constexpr size_t OFF_VTC = OFF_Y + 46137344;

struct Params {
  const float* in[34];
  float* out;
  char* ws;
};

typedef __bf16 bf16x2_t __attribute__((ext_vector_type(2)));
typedef float f32x2_t __attribute__((ext_vector_type(2)));
__device__ __forceinline__ unsigned pack2(float a, float b) {
  f32x2_t v = {a, b};
  bf16x2_t r = __builtin_convertvector(v, bf16x2_t);
  return __builtin_bit_cast(unsigned, r);
}
__device__ __forceinline__ u16 f2bf(float f) { return (u16)(pack2(f, 0.f) & 0xffffu); }
__device__ __forceinline__ float bf2f(u16 h) { return __uint_as_float(((unsigned)h) << 16); }
__device__ __forceinline__ float silu_f(float v) { return v * __builtin_amdgcn_rcpf(1.f + __expf(-v)); }
__device__ __forceinline__ float sigmoid_f(float v) { return __builtin_amdgcn_rcpf(1.f + __expf(-v)); }
__device__ __forceinline__ float fexp2(float v) { return __builtin_amdgcn_exp2f(v); }

__device__ __forceinline__ float xor16_sum(float x) {
  const unsigned u = __float_as_uint(x);
  auto r = __builtin_amdgcn_permlane16_swap(u, u, false, false);
  return __uint_as_float(r[0]) + __uint_as_float(r[1]);
}
__device__ __forceinline__ float xor32_sum(float x) {
  const unsigned u = __float_as_uint(x);
  auto r = __builtin_amdgcn_permlane32_swap(u, u, false, false);
  return __uint_as_float(r[0]) + __uint_as_float(r[1]);
}
__device__ __forceinline__ float xor16_max(float x) {
  const unsigned u = __float_as_uint(x);
  auto r = __builtin_amdgcn_permlane16_swap(u, u, false, false);
  return fmaxf(__uint_as_float(r[0]), __uint_as_float(r[1]));
}
__device__ __forceinline__ float xor32_max(float x) {
  const unsigned u = __float_as_uint(x);
  auto r = __builtin_amdgcn_permlane32_swap(u, u, false, false);
  return fmaxf(__uint_as_float(r[0]), __uint_as_float(r[1]));
}
__device__ __forceinline__ int cond_row(int t) { return t < T_CTX ? 8 : ((t - T_CTX) >> 10); }
__device__ __forceinline__ const float* xin(const Params& P, int t) {
  return t < T_CTX ? P.in[0] + (size_t)t * 1024 : P.in[1] + (size_t)(t - T_CTX) * 1024;
}


#define XB_TMO      128
#define XB_XCNT(j)  (256  + 64 * (j))
#define XB_XSUB(j)  (1280 + 64 * (j))
#define XB_XGEN(j)  (2304 + 64 * (j))
#define XB_TOP      3328
#define XB_TOPGEN   3392
#define XCD_BAR_WORDS 3456
#define XB_SPIN_CAP (1u << 22)
#define LAS __attribute__((address_space(3)))
__device__ __forceinline__ unsigned xb_ld(unsigned* p)              { return __hip_atomic_load(p, __ATOMIC_RELAXED, __HIP_MEMORY_SCOPE_AGENT); }
__device__ __forceinline__ unsigned xb_add(unsigned* p, unsigned v) { return __hip_atomic_fetch_add(p, v, __ATOMIC_RELAXED, __HIP_MEMORY_SCOPE_AGENT); }
__device__ __forceinline__ unsigned xb_xcc_id() { return (unsigned)__builtin_amdgcn_s_getreg((3 << 11) | 20) & 0xFu; }
#define XB_SPIN(cond, bar) do { unsigned _sp = 0; while (cond) { __builtin_amdgcn_s_sleep(1); \
    if ((++_sp & 255u) == 0u) { if (xb_ld(&(bar)[XB_TMO])) break; if (_sp > XB_SPIN_CAP) { atomicAdd(&(bar)[XB_TMO], 1u); break; } } } } while (0)
struct XcdBarrier { unsigned* bar; unsigned x; volatile LAS unsigned* st; };
__device__ __forceinline__ XcdBarrier xcd_barrier_post(unsigned* bar, volatile LAS unsigned* st) {
    XcdBarrier b; b.bar = bar; b.x = xb_xcc_id(); b.st = st;
    if (threadIdx.x == 0) (void)xb_add(&bar[XB_XCNT(b.x)], 1u);
    return b;
}
__device__ __forceinline__ void xcd_barrier_complete(unsigned* bar, unsigned x, unsigned& nloc, unsigned& nx) {
    const unsigned G = gridDim.x * gridDim.y * gridDim.z;
    unsigned sum, cnt, mine, sp = 0u;
    for (;;) {
        sum = 0u; cnt = 0u; mine = 0u;
#pragma unroll
        for (unsigned j = 0; j < 16; ++j) { const unsigned c = xb_ld(&bar[XB_XCNT(j)]); sum += c; cnt += (c > 0u) ? 1u : 0u; mine = (j == x) ? c : mine; }
        if (sum == G) break;
        __builtin_amdgcn_s_sleep(1);
        if ((++sp & 255u) == 0u) { if (xb_ld(&bar[XB_TMO])) break; if (sp > XB_SPIN_CAP) { atomicAdd(&bar[XB_TMO], 1u); break; } }
    }
    nloc = mine > 0u ? mine : 1u; nx = cnt > 0u ? cnt : 1u;
}
__device__ __forceinline__ void xcd_barrier(const XcdBarrier& b) {
    asm volatile("s_waitcnt vmcnt(0)" ::: "memory");
    __syncthreads();
    if (threadIdx.x == 0) {
        unsigned* bar = b.bar;
        __builtin_amdgcn_s_waitcnt(0);
        unsigned nloc = b.st[0], nx = b.st[1];
        if (nloc == 0u) { xcd_barrier_complete(bar, b.x, nloc, nx); b.st[0] = nloc; b.st[1] = nx; }
        const unsigned old = xb_add(&bar[XB_XSUB(b.x)], 1u);
        const unsigned gen = old / nloc;
        if (old + 1u == (gen + 1u) * nloc) {
            __builtin_amdgcn_fence(__ATOMIC_RELEASE, "agent");
            asm volatile("s_waitcnt vmcnt(0)" ::: "memory");
            const unsigned og = xb_add(&bar[XB_TOP], 1u);
            const unsigned tg = og / nx;
            if (og + 1u == (tg + 1u) * nx) xb_add(&bar[XB_TOPGEN], 1u);
            else XB_SPIN(xb_ld(&bar[XB_TOPGEN]) == tg, bar);
            __builtin_amdgcn_fence(__ATOMIC_ACQUIRE, "agent");
            xb_add(&bar[XB_XGEN(b.x)], 1u);
            asm volatile("s_waitcnt vmcnt(0)" ::: "memory");
        } else {
            XB_SPIN(xb_ld(&bar[XB_XGEN(b.x)]) == gen, bar);
            __builtin_amdgcn_fence(__ATOMIC_ACQUIRE, "agent");
            asm volatile("s_waitcnt vmcnt(0)" ::: "memory");
        }
    }
    __syncthreads();
}

using u32x4 = __attribute__((ext_vector_type(4))) unsigned int;
struct GRegs { u32x4 a0, a1, a2, a3, b0, b1; };
template <int MTW>
__device__ __forceinline__ void gemm_gload(GRegs& R, const u16* ga, const u16* gb, int lda, int ldb) {
  R.a0 = *(const u32x4*)(ga);
  R.a1 = *(const u32x4*)(ga + (size_t)64 * lda);
  R.a2 = *(const u32x4*)(ga + (size_t)128 * lda);
  if (MTW == 8) R.a3 = *(const u32x4*)(ga + (size_t)192 * lda);
  R.b0 = *(const u32x4*)(gb);
  R.b1 = *(const u32x4*)(gb + (size_t)64 * ldb);
}
template <int MTW>
__device__ __forceinline__ void gemm_swrite(const GRegs& R, u16* dA, u16* dB) {
  *(u32x4*)(dA) = R.a0;
  *(u32x4*)(dA + 64 * 40) = R.a1;
  *(u32x4*)(dA + 128 * 40) = R.a2;
  if (MTW == 8) *(u32x4*)(dA + 192 * 40) = R.a3;
  *(u32x4*)(dB) = R.b0;
  *(u32x4*)(dB + 64 * 40) = R.b1;
}

template <bool SWAP, int MTW>
__device__ __forceinline__ void gemm_compute_tile(const u16* cA, const u16* cB, f32x4 (&acc)[MTW][4]) {
  constexpr int LS = 40;
  constexpr int HM = MTW / 2;
  bf16x8 bfr[4];
#pragma unroll
  for (int j = 0; j < 4; j++) bfr[j] = *(const bf16x8*)(cB + j * 16 * LS);
#pragma unroll
  for (int h = 0; h < 2; h++) {
    bf16x8 af[HM];
#pragma unroll
    for (int i = 0; i < HM; i++) af[i] = *(const bf16x8*)(cA + (h * HM + i) * 16 * LS);
#pragma unroll
    for (int i = 0; i < HM; i++)
#pragma unroll
      for (int j = 0; j < 4; j++) {
        if (SWAP) acc[h * HM + i][j] = MFMA(bfr[j], af[i], acc[h * HM + i][j]);
        else acc[h * HM + i][j] = MFMA(af[i], bfr[j], acc[h * HM + i][j]);
      }
  }
}

template <bool SWAP, int MTW = 8>
__device__ __forceinline__ void gemm_mainloop_reg(const u16* __restrict__ A, int lda, const u16* __restrict__ Bt, int ldb,
                                              int K, u16* sm, f32x4 (&acc)[MTW][4]) {
  constexpr int LS = 40;
  const int tid = threadIdx.x, lane = tid & 63, wave = tid >> 6;
  const int wm = wave >> 1, wn = wave & 1;
  const int fr = lane & 15, fq = lane >> 4;
  u16* sA = sm;
  u16* sB = sm + 2 * 256 * LS;
  const int lr = tid >> 2, lc = (tid & 3) * 8;
  const u16* ga = A + (size_t)lr * lda + lc;
  const u16* gb = Bt + (size_t)lr * ldb + lc;
  GRegs r0, r1;
#define GLOAD(R, KT) gemm_gload<MTW>(R, ga + (KT) * 32, gb + (KT) * 32, lda, ldb);
#define SWRITE(R, BUF) gemm_swrite<MTW>(R, sA + (BUF) * 256 * LS + lr * LS + lc, sB + (BUF) * 128 * LS + lr * LS + lc);
  GLOAD(r0, 0)
  GLOAD(r1, 1)
#pragma unroll
  for (int i = 0; i < MTW; i++)
#pragma unroll
    for (int j = 0; j < 4; j++) acc[i][j] = f32x4{0.f, 0.f, 0.f, 0.f};
  SWRITE(r0, 0)
  __syncthreads();
  const int nk = K >> 5;
  const u16* cA0 = sA + (wm * 16 * MTW + fr) * LS + fq * 8;
  const u16* cB0 = sB + (wn * 64 + fr) * LS + fq * 8;
  for (int kt = 0; kt < nk; kt += 2) {
    GLOAD(r0, min(kt + 2, nk - 1))
    gemm_compute_tile<SWAP, MTW>(cA0, cB0, acc);
    SWRITE(r1, 1)
    __syncthreads();
    GLOAD(r1, min(kt + 3, nk - 1))
    gemm_compute_tile<SWAP, MTW>(cA0 + 256 * LS, cB0 + 128 * LS, acc);
    SWRITE(r0, 0)
    __syncthreads();
  }
#undef GLOAD
#undef SWRITE
}

__device__ __forceinline__ void glds16(const u16* g, char* lds) {
  __builtin_amdgcn_global_load_lds((const unsigned*)g, (unsigned*)lds, 16, 0, 0);
}
#define DSR128(dst, addr, OFF) asm volatile("ds_read_b128 %0, %1 offset:%2" : "=v"(dst) : "v"(addr), "n"(OFF))
template <bool SWAP, int MTW>
__device__ __forceinline__ void gemm_compute_glds(unsigned aA, unsigned aB, f32x4 (&acc)[MTW][4]) {
  bf16x8 bfr[4], af[MTW];
  DSR128(bfr[0], aB, 0); DSR128(bfr[1], aB, 1024); DSR128(bfr[2], aB, 2048); DSR128(bfr[3], aB, 3072);
  if (MTW == 8) {
    DSR128(af[0], aA, 0); DSR128(af[1], aA, 1024); DSR128(af[2], aA, 2048); DSR128(af[3], aA, 3072);
    DSR128(af[4], aA, 4096); DSR128(af[5], aA, 5120); DSR128(af[6], aA, 6144); DSR128(af[7], aA, 7168);
    asm volatile("s_waitcnt lgkmcnt(4)" : "+v"(bfr[0]), "+v"(bfr[1]), "+v"(bfr[2]), "+v"(bfr[3]), "+v"(af[0]), "+v"(af[1]), "+v"(af[2]), "+v"(af[3]));
  } else if (MTW == 6) {
    DSR128(af[0], aA, 0); DSR128(af[1], aA, 1024); DSR128(af[2], aA, 2048);
    DSR128(af[3], aA, 3072); DSR128(af[4], aA, 4096); DSR128(af[5], aA, 5120);
    asm volatile("s_waitcnt lgkmcnt(3)" : "+v"(bfr[0]), "+v"(bfr[1]), "+v"(bfr[2]), "+v"(bfr[3]), "+v"(af[0]), "+v"(af[1]), "+v"(af[2]));
  } else if (MTW == 4) {
    DSR128(af[0], aA, 0); DSR128(af[1], aA, 1024); DSR128(af[2], aA, 2048); DSR128(af[3], aA, 3072);
    asm volatile("s_waitcnt lgkmcnt(2)" : "+v"(bfr[0]), "+v"(bfr[1]), "+v"(bfr[2]), "+v"(bfr[3]), "+v"(af[0]), "+v"(af[1]));
  } else {
    DSR128(af[0], aA, 0); DSR128(af[1], aA, 1024);
    asm volatile("s_waitcnt lgkmcnt(1)" : "+v"(bfr[0]), "+v"(bfr[1]), "+v"(bfr[2]), "+v"(bfr[3]), "+v"(af[0]));
  }
  constexpr int HM = MTW / 2;
#pragma unroll
  for (int i = 0; i < HM; i++)
#pragma unroll
    for (int j = 0; j < 4; j++) {
      if (SWAP) acc[i][j] = MFMA(bfr[j], af[i], acc[i][j]);
      else acc[i][j] = MFMA(af[i], bfr[j], acc[i][j]);
    }
  __builtin_amdgcn_sched_barrier(0);
  if (MTW == 8) asm volatile("s_waitcnt lgkmcnt(0)" : "+v"(af[4]), "+v"(af[5]), "+v"(af[6]), "+v"(af[7]));
  else if (MTW == 6) asm volatile("s_waitcnt lgkmcnt(0)" : "+v"(af[3]), "+v"(af[4]), "+v"(af[5]));
  else if (MTW == 4) asm volatile("s_waitcnt lgkmcnt(0)" : "+v"(af[2]), "+v"(af[3]));
  else asm volatile("s_waitcnt lgkmcnt(0)" : "+v"(af[1]));
  __builtin_amdgcn_sched_barrier(0);
#pragma unroll
  for (int i = HM; i < MTW; i++)
#pragma unroll
    for (int j = 0; j < 4; j++) {
      if (SWAP) acc[i][j] = MFMA(bfr[j], af[i], acc[i][j]);
      else acc[i][j] = MFMA(af[i], bfr[j], acc[i][j]);
    }
}

template <bool SWAP, int MTW = 8>
__device__ __forceinline__ void gemm_mainloop(const u16* __restrict__ A, int lda, const u16* __restrict__ Bt, int ldb,
                                              int K, u16* sm, f32x4 (&acc)[MTW][4]) {
  constexpr int STG = 24576;
  constexpr int AW = MTW / 2;
  constexpr int NL = AW + 2;
  const int tid = threadIdx.x, lane = tid & 63, wave = tid >> 6;
  const int wm = wave >> 1, wn = wave & 1;
  const int fr = lane & 15, fq = lane >> 4;
  char* smc = (char*)sm;
  const int rowl = lane >> 2;
  const int lch = ((lane & 3) ^ (((lane >> 5) & 1) << 1)) * 8;
  const u16* gA = A + (size_t)(wave * AW * 16 + rowl) * lda + lch;
  const u16* gB = Bt + (size_t)(wave * 32 + rowl) * ldb + lch;
  char* dA = smc + (wave * AW) * 1024;
  char* dB = smc + 16384 + (wave * 2) * 1024;
  const int loff = fr * 64 + ((fq ^ (((fr >> 3) & 1) << 1)) * 16);
  const unsigned lds0 = (unsigned)(size_t)((LAS char*)smc);
  const unsigned rA = lds0 + (wm * MTW) * 1024 + loff;
  const unsigned rB = lds0 + 16384 + (wn * 4) * 1024 + loff;
#define GSTAGE(S, KT) { _Pragma("unroll") for (int _i = 0; _i < AW; _i++) glds16(gA + (size_t)(_i * 16) * lda + (KT) * 32, dA + (S) * STG + _i * 1024); \
                        _Pragma("unroll") for (int _i = 0; _i < 2; _i++) glds16(gB + (size_t)(_i * 16) * ldb + (KT) * 32, dB + (S) * STG + _i * 1024); }
#pragma unroll
  for (int i = 0; i < MTW; i++)
#pragma unroll
    for (int j = 0; j < 4; j++) acc[i][j] = f32x4{0.f, 0.f, 0.f, 0.f};
  const int nk = K >> 5;
  GSTAGE(0, 0)
  GSTAGE(1, 1)
  asm volatile("s_waitcnt vmcnt(%0)" ::"n"(NL) : "memory");
  asm volatile("s_waitcnt lgkmcnt(0)" ::: "memory");
  __builtin_amdgcn_s_barrier();
  int cur = 0;
  for (int t = 0; t < nk; t++) {
    int nx2 = cur + 2; if (nx2 >= 3) nx2 -= 3;
    const bool more = (t + 2 < nk);
    if (more) GSTAGE(nx2, t + 2)
    gemm_compute_glds<SWAP, MTW>(rA + cur * STG, rB + cur * STG, acc);
    if (more) asm volatile("s_waitcnt vmcnt(%0)" ::"n"(NL) : "memory");
    else asm volatile("s_waitcnt vmcnt(0)" ::: "memory");
    asm volatile("s_waitcnt lgkmcnt(0)" ::: "memory");
    __builtin_amdgcn_s_barrier();
    cur = (cur == 2) ? 0 : cur + 1;
  }
#undef GSTAGE
}

template <bool SWAP>
__device__ __forceinline__ void gemm_mainloop128(const u16* __restrict__ A, int lda, const u16* __restrict__ Bt, int ldb,
                                              int K, u16* sm, f32x4 (&acc)[4][4]) {
  const int tid = threadIdx.x, lane = tid & 63, wave = tid >> 6;
  const int wm = wave >> 1, wn = wave & 1;
  const int fr = lane & 15, fq = lane >> 4;
  u16* sA = sm;
  u16* sB = sm + 2 * 128 * LDT;
  const int lr = tid >> 3, lc = (tid & 7) * 8;
  const u16* ga = A + (size_t)lr * lda + lc;
  const u16* gb = Bt + (size_t)lr * ldb + lc;
  uint4 ra[4], rb[4];
#pragma unroll
  for (int i = 0; i < 4; i++) {
    ra[i] = *(const uint4*)(ga + (size_t)(i * 32) * lda);
    rb[i] = *(const uint4*)(gb + (size_t)(i * 32) * ldb);
  }
#pragma unroll
  for (int i = 0; i < 4; i++)
#pragma unroll
    for (int j = 0; j < 4; j++) acc[i][j] = f32x4{0.f, 0.f, 0.f, 0.f};
#pragma unroll
  for (int i = 0; i < 4; i++) {
    *(uint4*)(sA + (lr + i * 32) * LDT + lc) = ra[i];
    *(uint4*)(sB + (lr + i * 32) * LDT + lc) = rb[i];
  }
  __syncthreads();
  const int nk = K >> 6;
  for (int kt = 0; kt < nk; kt++) {
    const int cur = kt & 1;
    const bool more = (kt + 1 < nk);
    if (more) {
      const u16* ga2 = ga + (kt + 1) * 64;
      const u16* gb2 = gb + (kt + 1) * 64;
#pragma unroll
      for (int i = 0; i < 4; i++) {
        ra[i] = *(const uint4*)(ga2 + (size_t)(i * 32) * lda);
        rb[i] = *(const uint4*)(gb2 + (size_t)(i * 32) * ldb);
      }
    }
    const u16* cA = sA + cur * 128 * LDT + (wm * 64 + fr) * LDT + fq * 8;
    const u16* cB = sB + cur * 128 * LDT + (wn * 64 + fr) * LDT + fq * 8;
#pragma unroll
    for (int kk = 0; kk < 2; kk++) {
      bf16x8 af[4], bfr[4];
#pragma unroll
      for (int i = 0; i < 4; i++) af[i] = *(const bf16x8*)(cA + i * 16 * LDT + kk * 32);
#pragma unroll
      for (int j = 0; j < 4; j++) bfr[j] = *(const bf16x8*)(cB + j * 16 * LDT + kk * 32);
#pragma unroll
      for (int i = 0; i < 4; i++)
#pragma unroll
        for (int j = 0; j < 4; j++) {
          if (SWAP) acc[i][j] = MFMA(bfr[j], af[i], acc[i][j]);
          else acc[i][j] = MFMA(af[i], bfr[j], acc[i][j]);
        }
    }
    if (more) {
      u16* dA = sA + (cur ^ 1) * 128 * LDT;
      u16* dB = sB + (cur ^ 1) * 128 * LDT;
#pragma unroll
      for (int i = 0; i < 4; i++) {
        *(uint4*)(dA + (lr + i * 32) * LDT + lc) = ra[i];
        *(uint4*)(dB + (lr + i * 32) * LDT + lc) = rb[i];
      }
    }
    __syncthreads();
  }
}

__device__ __forceinline__ void tile_coords(int L, int MT, int NT, int& mt, int& nt) {
  const int full = NT >> 3;
  const int per = MT * 8;
  if (L < full * per) {
    int sc = L / per, r = L - sc * per;
    mt = r >> 3;
    nt = sc * 8 + (r & 7);
  } else {
    int L2 = L - full * per;
    int w = NT - full * 8;
    mt = L2 / w;
    nt = full * 8 + (L2 - mt * w);
  }
}

struct TileIter {
  int cur, end, step;
  __device__ TileIter(int ntiles) {
    int nb = gridDim.x, b = blockIdx.x;
    if ((nb & 7) == 0) {
      int per = (ntiles + 7) >> 3;
      int x = b & 7, j = b >> 3;
      cur = x * per + j;
      end = min((x + 1) * per, ntiles);
      step = nb >> 3;
    } else {
      cur = b; end = ntiles; step = nb;
    }
  }
};


constexpr size_t OFF_Q = OFF_BAR + 16384;
__device__ __forceinline__ int queue_next(unsigned* ctr, int* sh) {
  __syncthreads();
  if (threadIdx.x == 0) *sh = (int)__hip_atomic_fetch_add(ctr, 1u, __ATOMIC_RELAXED, __HIP_MEMORY_SCOPE_AGENT);
  __syncthreads();
  return *sh;
}

struct TrDesc { const float* src; u16* dst; int lds, nvalid, ldd, mode, rowoff, k0, n0; };
__device__ __forceinline__ TrDesc tr_desc(const Params& P, int j) {
  TrDesc d; int ntn; d.mode = 0; d.rowoff = 0;
  if (j < 320) { d.src = P.in[12] + 256; d.lds = 1536; d.nvalid = 1280; d.dst = (u16*)(P.ws + OFF_WIE); d.ldd = 1024; d.rowoff = 512; ntn = 20; }
  else if ((j -= 320) < 256) { d.src = P.in[15]; d.lds = 1024; d.nvalid = 1024; d.dst = (u16*)(P.ws + OFF_WOE); d.ldd = 1024; ntn = 16; }
  else if ((j -= 256) < 864) { d.src = P.in[16]; d.lds = 3360; d.nvalid = 3360; d.dst = (u16*)(P.ws + OFF_WIO); d.ldd = 1024; ntn = 54; }
  else if ((j -= 864) < 384) { d.src = P.in[30]; d.lds = 1024; d.nvalid = 1024; d.dst = (u16*)(P.ws + OFF_WOO); d.ldd = 1536; ntn = 16; }
  else if ((j -= 384) < 2816) {
    int q = j / 704; j -= q * 704; int l = q >> 1, w3 = q & 1;
    d.src = (w3 ? P.in[32] : P.in[31]) + (size_t)l * 1024 * 2816; d.lds = 2816; d.nvalid = 2816;
    d.dst = (u16*)(P.ws + OFF_W13) + (size_t)l * 5632 * 1024; d.ldd = 1024; d.mode = 1; d.rowoff = w3 * 16; ntn = 44;
  } else {
    j -= 2816; int l = j / 704; j -= l * 704;
    d.src = P.in[33] + (size_t)l * 2816 * 1024; d.lds = 1024; d.nvalid = 1024;
    d.dst = (u16*)(P.ws + OFF_W2) + (size_t)l * 1024 * 2816; d.ldd = 2816; ntn = 16;
  }
  const int kt = j / ntn, nt = j - kt * ntn;
  d.k0 = kt * 64; d.n0 = nt * 64;
  return d;
}
__device__ __forceinline__ void tr_load(const TrDesc& d, int tid, float4 (&v)[4]) {
#pragma unroll
  for (int i = 0; i < 4; i++) {
    const int r = i * 16 + (tid >> 4), n = d.n0 + (tid & 15) * 4;
    v[i] = make_float4(0.f, 0.f, 0.f, 0.f);
    if (n < d.nvalid) v[i] = *(const float4*)(d.src + (size_t)(d.k0 + r) * d.lds + n);
  }
}
__device__ __forceinline__ void tr_emit(const TrDesc& d, int tid, const float4 (&v)[4], float* tile) {
#pragma unroll
  for (int i = 0; i < 4; i++) {
    const int r = i * 16 + (tid >> 4), c4 = (tid & 15) * 4;
    tile[r * 65 + c4] = v[i].x; tile[r * 65 + c4 + 1] = v[i].y; tile[r * 65 + c4 + 2] = v[i].z; tile[r * 65 + c4 + 3] = v[i].w;
  }
  __syncthreads();
#pragma unroll
  for (int i = 0; i < 4; i++) {
    const int n = i * 16 + (tid >> 4), k4 = (tid & 15) * 4;
    const int ng = d.n0 + n;
    const int row = d.mode ? ((ng >> 4) * 32 + (ng & 15) + d.rowoff) : (ng + d.rowoff);
    uint2 o;
    o.x = pack2(tile[(k4 + 0) * 65 + n], tile[(k4 + 1) * 65 + n]);
    o.y = pack2(tile[(k4 + 2) * 65 + n], tile[(k4 + 3) * 65 + n]);
    *(uint2*)(d.dst + (size_t)row * d.ldd + d.k0 + k4) = o;
  }
  __syncthreads();
}
__device__ __forceinline__ void phase_prep(const Params& P, char* smem, int* qsh) {
  const int tid = threadIdx.x, nb = gridDim.x, bid = blockIdx.x;
  const int lane = tid & 63, wave = tid >> 6;
  float* tile = (float*)smem;
  float* tabc = (float*)(smem + 16640);
  float* tabs = tabc + 64;
  float* sc = (float*)(smem + 20480);
  float* red = (float*)(smem + 20480 + 36864);
  {
    float* prm = (float*)(P.ws + OFF_PRM);
    const int gt = bid * 256 + tid, gs = nb * 256;
#define PCOPY(SRC, OFF, N) for (int i = gt; i < (N); i += gs) prm[(OFF) + i] = (SRC)[i];
    PCOPY(P.in[10], PRM_NORM_MIX, 2048) PCOPY(P.in[11], PRM_NORM_FFN, 2048) PCOPY(P.in[13], PRM_QN, 64) PCOPY(P.in[14], PRM_KN, 64)
    PCOPY(P.in[17], PRM_CLW, 2048) PCOPY(P.in[18], PRM_CLB, 512) PCOPY(P.in[20], PRM_LBA, 1024) PCOPY(P.in[22], PRM_LBX, 1024)
    PCOPY(P.in[23], PRM_LAM, 1024) PCOPY(P.in[24], PRM_CSW, 5120) PCOPY(P.in[25], PRM_CSB, 1280) PCOPY(P.in[26], PRM_DTB, 32)
    PCOPY(P.in[27], PRM_ALOG, 32) PCOPY(P.in[28], PRM_SSDD, 16) PCOPY(P.in[29], PRM_SNORM, 1024)
    PCOPY(P.in[19], PRM_LWA, 65536) PCOPY(P.in[21], PRM_LWX, 65536)
#undef PCOPY
  }
  bool sc_ready = false;
  constexpr int N_MOD = 384, N_FF = 64, N_TR = 6048, N_DFT = 544, N_CACHE = 512;
  constexpr int N_ALL = N_MOD + N_FF + N_TR + N_DFT + N_CACHE;
  for (int it = bid; it < N_ALL; it += nb) {
    int j = it;
    if (j < N_MOD) {
      if (!sc_ready) {
        for (int i = tid; i < 9 * 1024; i += 256) {
          int r = i >> 10, k = i & 1023;
          float c = r < 8 ? P.in[2][r * 1024 + k] : P.in[7][k];
          sc[i] = silu_f(c);
        }
        __syncthreads();
        sc_ready = true;
      }
      const int l = j / 192, n0 = (j % 192) * 32;
      const int cgp = tid & 7, kl = tid >> 3;
      float acc[9][4];
#pragma unroll
      for (int r = 0; r < 9; r++)
#pragma unroll
        for (int c = 0; c < 4; c++) acc[r][c] = 0.f;
      const float* w = P.in[8] + (size_t)l * 1024 * 6144 + n0 + cgp * 4;
#pragma unroll 4
      for (int i = 0; i < 32; i++) {
        const int k = i * 32 + kl;
        const float4 wv = *(const float4*)(w + (size_t)k * 6144);
#pragma unroll
        for (int r = 0; r < 9; r++) {
          const float s = sc[r * 1024 + k];
          acc[r][0] += s * wv.x; acc[r][1] += s * wv.y; acc[r][2] += s * wv.z; acc[r][3] += s * wv.w;
        }
      }
#pragma unroll
      for (int r = 0; r < 9; r++)
#pragma unroll
        for (int c = 0; c < 4; c++) {
          float v = acc[r][c];
          v += __shfl_xor(v, 8); v = xor16_sum(v); v = xor32_sum(v);
          acc[r][c] = v;
        }
      if (lane < 8) {
#pragma unroll
        for (int r = 0; r < 9; r++)
#pragma unroll
          for (int c = 0; c < 4; c++) red[(wave * 9 + r) * 32 + cgp * 4 + c] = acc[r][c];
      }
      __syncthreads();
      float* MOD = (float*)(P.ws + OFF_MOD);
      for (int i = tid; i < 288; i += 256) {
        int r = i >> 5, c = i & 31;
        float s = red[(0 * 9 + r) * 32 + c] + red[(1 * 9 + r) * 32 + c] + red[(2 * 9 + r) * 32 + c] + red[(3 * 9 + r) * 32 + c];
        MOD[(l * 9 + r) * 6144 + n0 + c] = s + P.in[9][l * 6144 + n0 + c];
      }
      __syncthreads();
      continue;
    }
    j -= N_MOD;
    if (j < N_FF) {
      const int g = j >> 4, kt = j & 15;
      if (tid < 64) { tabc[tid] = cospif(tid / 32.0f); tabs[tid] = sinpif(tid / 32.0f); }
      const float* src = P.in[12] + (size_t)(kt * 64) * 1536 + g * 64;
#pragma unroll
      for (int i = 0; i < 4; i++) {
        int r = i * 16 + (tid >> 4), c4 = (tid & 15) * 4;
        float4 v = *(const float4*)(src + (size_t)r * 1536 + c4);
        tile[r * 65 + c4] = v.x; tile[r * 65 + c4 + 1] = v.y; tile[r * 65 + c4 + 2] = v.z; tile[r * 65 + c4 + 3] = v.w;
      }
      __syncthreads();
      const int np = tid & 127, kh = tid >> 7;
      const int wsel = np >> 6, cp = np & 63;
      float acc[32];
#pragma unroll
      for (int i = 0; i < 32; i++) acc[i] = 0.f;
      for (int c = 0; c < 64; c++) {
        const int idx = (c * cp) & 63;
        const float coef = wsel ? tabs[idx] : tabc[idx];
#pragma unroll
        for (int i = 0; i < 32; i++) acc[i] += tile[(kh * 32 + i) * 65 + c] * coef;
      }
      u16* dst = (u16*)(P.ws + OFF_WIE) + (size_t)(g * 128 + np) * 1024 + kt * 64 + kh * 32;
#pragma unroll
      for (int i = 0; i < 4; i++) {
        uint4 o;
        o.x = pack2(acc[i * 8 + 0], acc[i * 8 + 1]); o.y = pack2(acc[i * 8 + 2], acc[i * 8 + 3]);
        o.z = pack2(acc[i * 8 + 4], acc[i * 8 + 5]); o.w = pack2(acc[i * 8 + 6], acc[i * 8 + 7]);
        *(uint4*)(dst + i * 8) = o;
      }
      __syncthreads();
      continue;
    }
    j -= N_FF;
    if (j < N_TR) continue;
    j -= N_TR;
    if (j < N_DFT) {
      if (j < 512) {
        u16* D = (u16*)(P.ws + OFF_D1K);
        const int e0 = j * 4096;
        for (int i = 0; i < 16; i++) {
          int e = e0 + i * 256 + tid;
          int sp = e >> 11, k = e & 2047;
          float v;
          if (k < 1024) { int r = (sp * k) & 1023; v = cospif(r * (1.0f / 512.0f)); }
          else { int r = (sp * (k - 1024)) & 1023; v = -sinpif(r * (1.0f / 512.0f)); }
          D[e] = f2bf(v * (1.0f / 256.0f));
        }
      } else {
        u16* D = (u16*)(P.ws + OFF_D256);
        const int e0 = (j - 512) * 4096;
        for (int i = 0; i < 16; i++) {
          int e = e0 + i * 256 + tid;
          int sp = e >> 9, k = e & 511;
          float v;
          if (k < 256) { int r = (sp * k) & 255; v = cospif(r * (1.0f / 128.0f)); }
          else { int r = (sp * (k - 256)) & 255; v = -sinpif(r * (1.0f / 128.0f)); }
          D[e] = f2bf(v * (1.0f / 128.0f));
        }
      }
      continue;
    }
    j -= N_DFT;
    {
      const bool isv = j >= 256;
      const int e0 = (isv ? j - 256 : j) * 4096;
      const float* src = isv ? P.in[4] : P.in[3];
      u16* KB = (u16*)(P.ws + OFF_KBS);
      u16* VT = (u16*)(P.ws + OFF_VTS);
      for (int i = 0; i < 16; i++) {
        int e = e0 + i * 256 + tid;
        int b = e >> 17, p = (e >> 8) & 511, h = (e >> 6) & 3, d = e & 63;
        u16 v = f2bf(src[e]);
        if (!isv) KB[((size_t)(b * 4 + h) * 1536 + 1024 + p) * 64 + d] = v;
        else VT[((size_t)(b * 4 + h) * 64 + d) * 1536 + 1024 + p] = v;
      }
    }
  }
  {
    unsigned* ctr = (unsigned*)(P.ws + OFF_BAR + 20480);
    for (;;) {
      const int k = queue_next(ctr, qsh);
      const int j0 = 2 * k;
      if (j0 >= N_TR) break;
      const TrDesc d0 = tr_desc(P, j0);
      const TrDesc d1 = tr_desc(P, j0 + 1);
      float4 v0[4], v1[4];
      tr_load(d0, tid, v0);
      tr_load(d1, tid, v1);
      tr_emit(d0, tid, v0, tile);
      tr_emit(d1, tid, v1, tile);
    }
  }
}

__device__ __forceinline__ void phase_norm(const Params& P, int l, int which) {
  const int tid = threadIdx.x, lane = tid & 63, wave = tid >> 6;
  const float* MOD = (const float*)(P.ws + OFF_MOD);
  const float* gvec = PRM(P, (which ? PRM_NORM_FFN : PRM_NORM_MIX) + l * 1024);
  u16* H = (u16*)(P.ws + OFF_H);
  const int nwaves = gridDim.x * 4;
  const int rpw = (T_ALL + nwaves - 1) / nwaves;
  const int r0 = (blockIdx.x * 4 + wave) * rpw;
  const int r1 = min(r0 + rpw, T_ALL);
  constexpr int NR = 3;
  const int osh = (which ? 3 : 0) * 1024, osc = (which ? 4 : 1) * 1024;
  float4 gm[4], sh[4];
  int cached = -1;
  for (int t0 = r0; t0 < r1; t0 += NR) {
    float4 v[NR][4];
#pragma unroll
    for (int r = 0; r < NR; r++) {
      const int t = min(t0 + r, r1 - 1);
      const float* x = (l == 0 && which == 0) ? xin(P, t) : P.out + (size_t)t * 1024;
#pragma unroll
      for (int j = 0; j < 4; j++) v[r][j] = *(const float4*)(x + j * 256 + lane * 4);
    }
    float ss[NR];
#pragma unroll
    for (int r = 0; r < NR; r++) {
      float a = 0.f;
#pragma unroll
      for (int j = 0; j < 4; j++) a += v[r][j].x * v[r][j].x + v[r][j].y * v[r][j].y + v[r][j].z * v[r][j].z + v[r][j].w * v[r][j].w;
      ss[r] = a;
    }
#pragma unroll
    for (int o = 32; o >= 1; o >>= 1) {
#pragma unroll
      for (int r = 0; r < NR; r++) ss[r] += __shfl_xor(ss[r], o);
    }
#pragma unroll
    for (int r = 0; r < NR; r++) {
      const int t = t0 + r;
      if (t >= r1) continue;
      const int cr = cond_row(t);
      if (cr != cached) {
        cached = cr;
        const float* mb = MOD + (size_t)(l * 9 + cr) * 6144;
#pragma unroll
        for (int j = 0; j < 4; j++) {
          const int c = j * 256 + lane * 4;
          const float4 g = *(const float4*)(gvec + c);
          const float4 cm = *(const float4*)(mb + osc + c);
          sh[j] = *(const float4*)(mb + osh + c);
          gm[j] = make_float4(g.x * (1.f + cm.x), g.y * (1.f + cm.y), g.z * (1.f + cm.z), g.w * (1.f + cm.w));
        }
      }
      const float rs = rsqrtf(ss[r] * (1.0f / 1024.0f) + 1e-6f);
#pragma unroll
      for (int j = 0; j < 4; j++) {
        const int c = j * 256 + lane * 4;
        uint2 o;
        o.x = pack2(v[r][j].x * rs * gm[j].x + sh[j].x, v[r][j].y * rs * gm[j].y + sh[j].y);
        o.y = pack2(v[r][j].z * rs * gm[j].z + sh[j].z, v[r][j].w * rs * gm[j].w + sh[j].w);
        *(uint2*)(H + (size_t)t * 1024 + c) = o;
      }
    }
  }
}

__device__ __forceinline__ void phase_gemm_in_even(const Params& P, char* smem) {
  const int tid = threadIdx.x, lane = tid & 63, wave = tid >> 6;
  const int wm = wave >> 1, wn = wave & 1, fr = lane & 15, fq = lane >> 4;
  const u16* A = (const u16*)(P.ws + OFF_H);
  const u16* W = (const u16*)(P.ws + OFF_WIE);
  constexpr int MT = 48, NT = 14;
  for (TileIter ti(MT * NT); ti.cur < ti.end; ti.cur += ti.step) {
    int mtile, ntile;
    tile_coords(ti.cur, MT, NT, mtile, ntile);
    const int m0 = mtile * 256, n0 = ntile * 128;
    f32x4 acc[8][4];
    const bool swap = (ntile >= 4 && ntile < 12);
    if (swap) gemm_mainloop<true, 8>(A + (size_t)m0 * 1024, 1024, W + (size_t)n0 * 1024, 1024, 1024, (u16*)smem, acc);
    else gemm_mainloop<false, 8>(A + (size_t)m0 * 1024, 1024, W + (size_t)n0 * 1024, 1024, 1024, (u16*)smem, acc);
    const bool smp = m0 >= T_CTX;
    int fr_e = fr, fq_e = fq;
    asm volatile("" : "+v"(fr_e), "+v"(fq_e));
    if (ntile < 4) {
      const int g = ntile;
      u16* YT; int S, seq, sbase;
      if (smp) { YT = (u16*)(P.ws + OFF_YTS); S = 1024; seq = (m0 - T_CTX) >> 10; sbase = (m0 - T_CTX) & 1023; }
      else { YT = (u16*)(P.ws + OFF_YTC); S = 256; seq = m0 >> 8; sbase = m0 & 255; }
      u16* base = YT + (size_t)seq * 256 * 2 * S;
#pragma unroll
      for (int mt = 0; mt < 8; mt++)
#pragma unroll
        for (int nt = 0; nt < 4; nt++) {
          const int s = sbase + wm * 128 + mt * 16 + fq_e * 4;
          const int cp = nt * 16 + fr_e;
          uint2 o;
          o.x = pack2(acc[mt][nt][0], acc[mt][nt][1]);
          o.y = pack2(acc[mt][nt][2], acc[mt][nt][3]);
          *(uint2*)(base + (size_t)(g * 64 + cp) * 2 * S + wn * S + s) = o;
        }
    } else if (ntile < 12) {
      const bool isq = ntile < 10;
      const int hcol = n0 + wn * 64 - (isq ? 512 : 1280);
      const int head = hcol >> 6;
      const float* gn = PRM(P, isq ? PRM_QN : PRM_KN);
#pragma unroll
      for (int mt = 0; mt < 8; mt++) {
        __builtin_amdgcn_sched_barrier(0);
        const int t = m0 + wm * 128 + mt * 16 + fr_e;
        float ss = 0.f;
#pragma unroll
        for (int nt = 0; nt < 4; nt++)
#pragma unroll
          for (int r = 0; r < 4; r++) ss += acc[mt][nt][r] * acc[mt][nt][r];
        ss = xor16_sum(ss);
        ss = xor32_sum(ss);
        const float rs = rsqrtf(ss * (1.0f / 64.0f) + 1e-6f);
#pragma unroll
        for (int nt = 0; nt < 4; nt++) {
          const float4 g4 = *(const float4*)(gn + nt * 16 + fq_e * 4);
          acc[mt][nt][0] *= rs * g4.x; acc[mt][nt][1] *= rs * g4.y; acc[mt][nt][2] *= rs * g4.z; acc[mt][nt][3] *= rs * g4.w;
        }
        if (!smp && !isq) {
          float* nk = P.out + 12582912 + (size_t)t * 256 + head * 64;
#pragma unroll
          for (int nt = 0; nt < 4; nt++)
            *(float4*)(nk + nt * 16 + fq_e * 4) = make_float4(acc[mt][nt][0], acc[mt][nt][1], acc[mt][nt][2], acc[mt][nt][3]);
        }
        if (smp) {
          const int s = (t - T_CTX) & 1023;
          const float prow = (float)(s >> 6), pcol = (float)(s & 63);
#pragma unroll
          for (int r = 0; r < 4; r++) {
            const float fre = exp2f(-(float)(fq_e * 4 + r) * (13.287712379549449f / 16.0f));
            const float a0 = prow * fre, a1 = pcol * fre;
            const float c0 = __cosf(a0), s0 = __sinf(a0), c1 = __cosf(a1), s1 = __sinf(a1);
            const float x1 = acc[mt][0][r], x2 = acc[mt][1][r];
            acc[mt][0][r] = x1 * c0 - x2 * s0; acc[mt][1][r] = x2 * c0 + x1 * s0;
            const float y1 = acc[mt][2][r], y2 = acc[mt][3][r];
            acc[mt][2][r] = y1 * c1 - y2 * s1; acc[mt][3][r] = y2 * c1 + y1 * s1;
          }
        }
        if (isq) {
          const float qs = 0.125f * LOG2E;
          u16* q = (u16*)(P.ws + OFF_QB) + (size_t)t * 768 + head * 64;
#pragma unroll
          for (int nt = 0; nt < 4; nt++) {
            uint2 o;
            o.x = pack2(acc[mt][nt][0] * qs, acc[mt][nt][1] * qs);
            o.y = pack2(acc[mt][nt][2] * qs, acc[mt][nt][3] * qs);
            *(uint2*)(q + nt * 16 + fq_e * 4) = o;
          }
        } else {
          u16* kb;
          if (smp) { int sq = (t - T_CTX) >> 10, key = (t - T_CTX) & 1023; kb = (u16*)(P.ws + OFF_KBS) + ((size_t)(sq * 4 + head) * 1536 + key) * 64; }
          else { int sq = t >> 8, key = t & 255; kb = (u16*)(P.ws + OFF_KBC) + ((size_t)(sq * 4 + head) * 256 + key) * 64; }
#pragma unroll
          for (int nt = 0; nt < 4; nt++) {
            uint2 o;
            o.x = pack2(acc[mt][nt][0], acc[mt][nt][1]);
            o.y = pack2(acc[mt][nt][2], acc[mt][nt][3]);
            *(uint2*)(kb + nt * 16 + fq_e * 4) = o;
          }
        }
      }
    } else {
      const int head = (n0 + wn * 64 - 1536) >> 6;
#pragma unroll
      for (int mt = 0; mt < 8; mt++) {
        const int t = m0 + wm * 128 + mt * 16 + fq_e * 4;
#pragma unroll
        for (int nt = 0; nt < 4; nt++) {
          const int d = nt * 16 + fr_e;
          uint2 o;
          o.x = pack2(acc[mt][nt][0], acc[mt][nt][1]);
          o.y = pack2(acc[mt][nt][2], acc[mt][nt][3]);
          if (smp) {
            int sq = (t - T_CTX) >> 10, key = (t - T_CTX) & 1023;
            *(uint2*)((u16*)(P.ws + OFF_VTS) + ((size_t)(sq * 4 + head) * 64 + d) * 1536 + key) = o;
          } else {
            int sq = t >> 8, key = t & 255;
            *(uint2*)((u16*)(P.ws + OFF_VTC) + ((size_t)(sq * 4 + head) * 64 + d) * 256 + key) = o;
            float* nv = P.out + 13631488 + (size_t)t * 256 + head * 64 + d;
#pragma unroll
            for (int r = 0; r < 4; r++) nv[(size_t)r * 256] = acc[mt][nt][r];
          }
        }
      }
    }
  }
}

__device__ __forceinline__ void phase_gemm_resid(const Params& P, char* smem, const u16* A, int lda, const u16* W, int K,
                                 int l, int gate_idx, bool from_x) {
  const int tid = threadIdx.x, lane = tid & 63, wave = tid >> 6;
  const int wm = wave >> 1, wn = wave & 1, fr = lane & 15, fq = lane >> 4;
  const float* MOD = (const float*)(P.ws + OFF_MOD);
  constexpr int MT = 64, NT = 8;
  for (TileIter ti(MT * NT); ti.cur < ti.end; ti.cur += ti.step) {
    int mtile, ntile;
    tile_coords(ti.cur, MT, NT, mtile, ntile);
    const int m0 = mtile * 192, n0 = ntile * 128;
    f32x4 acc[6][4];
    gemm_mainloop<true, 6>(A + (size_t)m0 * lda, lda, W + (size_t)n0 * K, K, K, (u16*)smem, acc);
#pragma unroll
    for (int mt = 0; mt < 6; mt++) {
      const int t = m0 + wm * 96 + mt * 16 + fr;
      const float* gp = MOD + (size_t)(l * 9 + cond_row(t)) * 6144 + gate_idx * 1024;
      const float* bp = from_x ? xin(P, t) : P.out + (size_t)t * 1024;
      float* op = P.out + (size_t)t * 1024;
#pragma unroll
      for (int nt = 0; nt < 4; nt++) {
        const int n = n0 + wn * 64 + nt * 16 + fq * 4;
        const float4 g = *(const float4*)(gp + n);
        const float4 b = *(const float4*)(bp + n);
        float4 o;
        o.x = b.x + g.x * acc[mt][nt][0]; o.y = b.y + g.y * acc[mt][nt][1];
        o.z = b.z + g.z * acc[mt][nt][2]; o.w = b.w + g.w * acc[mt][nt][3];
        *(float4*)(op + n) = o;
      }
    }
  }
}

template <int MTW>
__device__ __forceinline__ void ffn_up_tile(const u16* A, const u16* W, u16* U, char* smem, int m0, int n0) {
  const int tid = threadIdx.x, lane = tid & 63, wave = tid >> 6;
  const int wm = wave >> 1, wn = wave & 1, fr = lane & 15, fq = lane >> 4;
  f32x4 acc[MTW][4];
  gemm_mainloop<true, MTW>(A + (size_t)m0 * 1024, 1024, W + (size_t)n0 * 1024, 1024, 1024, (u16*)smem, acc);
#pragma unroll
  for (int mt = 0; mt < MTW; mt++) {
    const int t = m0 + wm * (16 * MTW) + mt * 16 + fr;
#pragma unroll
    for (int np = 0; np < 2; np++) {
      const int f = ((n0 + wn * 64) >> 1) + np * 16 + fq * 4;
      float r[4];
#pragma unroll
      for (int q = 0; q < 4; q++) r[q] = silu_f(acc[mt][np * 2][q]) * acc[mt][np * 2 + 1][q];
      uint2 o;
      o.x = pack2(r[0], r[1]); o.y = pack2(r[2], r[3]);
      *(uint2*)(U + (size_t)t * 2816 + f) = o;
    }
  }
}

__device__ __forceinline__ void phase_gemm_ffn_up(const Params& P, char* smem, int l) {
  const u16* A = (const u16*)(P.ws + OFF_H);
  const u16* W = (const u16*)(P.ws + OFF_W13) + (size_t)l * 5632 * 1024;
  u16* U = (u16*)(P.ws + OFF_R1);
  constexpr int MT = 48, NT = 44;
  constexpr int NFULL = 2048;
  for (TileIter ti(NFULL); ti.cur < ti.end; ti.cur += ti.step) {
    int mtile, ntile;
    tile_coords(ti.cur, MT, NT, mtile, ntile);
    ffn_up_tile<8>(A, W, U, smem, mtile * 256, ntile * 128);
  }
  for (TileIter ti((MT * NT - NFULL) * 4); ti.cur < ti.end; ti.cur += ti.step) {
    int mtile, ntile;
    tile_coords(NFULL + (ti.cur >> 2), MT, NT, mtile, ntile);
    ffn_up_tile<2>(A, W, U, smem, mtile * 256 + (ti.cur & 3) * 64, ntile * 128);
  }
}

__device__ __forceinline__ void phase_gemm_in_odd(const Params& P, char* smem) {
  const int tid = threadIdx.x, lane = tid & 63, wave = tid >> 6;
  const int wm = wave >> 1, wn = wave & 1, fr = lane & 15, fq = lane >> 4;
  const u16* A = (const u16*)(P.ws + OFF_H);
  const u16* W = (const u16*)(P.ws + OFF_WIO);
  u16* PO = (u16*)(P.ws + OFF_R1);
  float* DT = (float*)(P.ws + OFF_DT);
  constexpr int MT = 48, NT = 27;
  u16* stg = (u16*)smem + wave * (128 * 72);
  for (TileIter ti(MT * NT); ti.cur < ti.end; ti.cur += ti.step) {
    int mtile, ntile;
    tile_coords(ti.cur, MT, NT, mtile, ntile);
    const int m0 = mtile * 256, n0 = ntile * 128;
    f32x4 acc[8][4];
    gemm_mainloop<true>(A + (size_t)m0 * 1024, 1024, W + (size_t)n0 * 1024, 1024, 1024, (u16*)smem, acc);
#pragma unroll
    for (int mt = 0; mt < 8; mt++) {
#pragma unroll
      for (int nt = 0; nt < 4; nt++) {
        uint2 o;
        o.x = pack2(acc[mt][nt][0], acc[mt][nt][1]);
        o.y = pack2(acc[mt][nt][2], acc[mt][nt][3]);
        *(uint2*)(stg + (mt * 16 + fr) * 72 + nt * 16 + fq * 4) = o;
        const int n = n0 + wn * 64 + nt * 16 + fq * 4;
        if (n >= 3328 && n < 3360) {
          const int t = m0 + wm * 128 + mt * 16 + fr;
          *(float4*)(DT + (size_t)t * 32 + (n - 3328)) = make_float4(acc[mt][nt][0], acc[mt][nt][1], acc[mt][nt][2], acc[mt][nt][3]);
        }
      }
    }
    {
      const int rr = lane >> 3, cc = (lane & 7) * 8;
      u16* dst = PO + (size_t)(m0 + wm * 128 + rr) * 3456 + n0 + wn * 64 + cc;
#pragma unroll
      for (int i = 0; i < 16; i++) {
        const u32x4 v = *(const u32x4*)(stg + (i * 8 + rr) * 72 + cc);
        *(u32x4*)(dst + (size_t)(i * 8) * 3456) = v;
      }
    }
    __syncthreads();
  }
}

__device__ __forceinline__ void fourier_tile(const Params& P, int item, char* smem) {
  const int tid = threadIdx.x, lane = tid & 63, wave = tid >> 6;
  const int wm = wave >> 1, wn = wave & 1, fr = lane & 15, fq = lane >> 4;
  const u16 *D, *YT; int S, tb, mtile, ntile;
  if (item < 128) {
    int seq = item >> 4, r = item & 15; mtile = r >> 1; ntile = r & 1; S = 1024; tb = T_CTX + seq * 1024;
    D = (const u16*)(P.ws + OFF_D1K); YT = (const u16*)(P.ws + OFF_YTS) + (size_t)seq * 256 * 2048;
  } else {
    item -= 128; int seq = item >> 2, r = item & 3; mtile = r >> 1; ntile = r & 1; S = 256; tb = seq * 256;
    D = (const u16*)(P.ws + OFF_D256); YT = (const u16*)(P.ws + OFF_YTC) + (size_t)seq * 256 * 512;
  }
  f32x4 acc[4][4];
  const int K = 2 * S;
  gemm_mainloop<true, 4>(D + (size_t)(mtile * 128) * K, K, YT + (size_t)(ntile * 128) * K, K, K, (u16*)smem, acc);
  u16* MIX = (u16*)(P.ws + OFF_H);
#pragma unroll
  for (int mt = 0; mt < 4; mt++) {
    const int t = tb + mtile * 128 + wm * 64 + mt * 16 + fr;
#pragma unroll
    for (int nt = 0; nt < 4; nt++) {
      const int n = ntile * 128 + wn * 64 + nt * 16 + fq * 4;
      uint2 o;
      o.x = pack2(acc[mt][nt][0], acc[mt][nt][1]);
      o.y = pack2(acc[mt][nt][2], acc[mt][nt][3]);
      *(uint2*)(MIX + (size_t)t * 1024 + n) = o;
    }
  }
}

__device__ __forceinline__ void attn_item(const Params& P, int item, char* smem) {
  const int tid = threadIdx.x, lane = tid & 63, wave = tid >> 6;
  const int fr = lane & 15, fq = lane >> 4;
  bool smp; int seq, head, qb;
  if (item < 768) { smp = true; seq = item / 96; int r = item % 96; head = r >> 3; qb = r & 7; }
  else { item -= 768; smp = false; seq = item / 24; int r = item % 24; head = r >> 1; qb = r & 1; }
  const int nkeys = smp ? 1536 : 256;
  const int tb = smp ? T_CTX + seq * 1024 : seq * 256;
  const int kvh = head / 3;
  const u16* Kp = (const u16*)(P.ws + (smp ? OFF_KBS : OFF_KBC)) + (size_t)((seq * 4 + kvh) * nkeys) * 64;
  const u16* Vp = (const u16*)(P.ws + (smp ? OFF_VTS : OFF_VTC)) + (size_t)((seq * 4 + kvh) * 64) * nkeys;
  const u16* QB = (const u16*)(P.ws + OFF_QB);
  u16* sK = (u16*)smem;
  u16* sV = sK + 2 * 64 * LDT;
  bf16x8 qf[2][2];
  const int qrow0 = tb + qb * 128 + wave * 32;
#pragma unroll
  for (int qt = 0; qt < 2; qt++)
#pragma unroll
    for (int kk = 0; kk < 2; kk++)
      qf[qt][kk] = *(const bf16x8*)(QB + (size_t)(qrow0 + qt * 16 + fr) * 768 + head * 64 + kk * 32 + fq * 8);
  f32x4 ot[2][4];
#pragma unroll
  for (int a = 0; a < 2; a++)
#pragma unroll
    for (int b = 0; b < 4; b++) ot[a][b] = f32x4{0.f, 0.f, 0.f, 0.f};
  float mrun[2] = {-INFINITY, -INFINITY}, lrun[2] = {0.f, 0.f};
  const int lrow = tid >> 3, lcol = (tid & 7) * 8;
  uint4 rk[2], rv[2];
#pragma unroll
  for (int i = 0; i < 2; i++) {
    rk[i] = *(const uint4*)(Kp + (size_t)(lrow + i * 32) * 64 + lcol);
    rv[i] = *(const uint4*)(Vp + (size_t)(lrow + i * 32) * nkeys + lcol);
  }
#pragma unroll
  for (int i = 0; i < 2; i++) {
    *(uint4*)(sK + (lrow + i * 32) * LDT + lcol) = rk[i];
    *(uint4*)(sV + (lrow + i * 32) * LDT + lcol) = rv[i];
  }
  __syncthreads();
  const int nkt = nkeys >> 6;
  for (int kt = 0; kt < nkt; kt++) {
    const int cur = kt & 1;
    const bool more = kt + 1 < nkt;
    if (more) {
      const int key0 = (kt + 1) * 64;
#pragma unroll
      for (int i = 0; i < 2; i++) {
        rk[i] = *(const uint4*)(Kp + (size_t)(key0 + lrow + i * 32) * 64 + lcol);
        rv[i] = *(const uint4*)(Vp + (size_t)(lrow + i * 32) * nkeys + key0 + lcol);
      }
    }
    const u16* cK = sK + cur * 64 * LDT;
    const u16* cV = sV + cur * 64 * LDT;
    f32x4 st[2][4];
#pragma unroll
    for (int k16 = 0; k16 < 4; k16++) {
      const bf16x8 kf0 = *(const bf16x8*)(cK + (k16 * 16 + fr) * LDT + fq * 8);
      const bf16x8 kf1 = *(const bf16x8*)(cK + (k16 * 16 + fr) * LDT + 32 + fq * 8);
#pragma unroll
      for (int qt = 0; qt < 2; qt++) {
        f32x4 z = f32x4{0.f, 0.f, 0.f, 0.f};
        z = MFMA(kf0, qf[qt][0], z);
        st[qt][k16] = MFMA(kf1, qf[qt][1], z);
      }
    }
    bf16x8 pf[2][2];
#pragma unroll
    for (int qt = 0; qt < 2; qt++) {
      float mx = st[qt][0][0];
#pragma unroll
      for (int k16 = 0; k16 < 4; k16++)
#pragma unroll
        for (int r = 0; r < 4; r++) mx = fmaxf(mx, st[qt][k16][r]);
      mx = xor16_max(mx);
      mx = xor32_max(mx);
      if (!__all(mx - mrun[qt] <= 8.0f)) {
        const float mnew = fmaxf(mrun[qt], mx);
        const float alpha = fexp2(mrun[qt] - mnew);
        mrun[qt] = mnew;
        lrun[qt] *= alpha;
#pragma unroll
        for (int dt = 0; dt < 4; dt++)
#pragma unroll
          for (int r = 0; r < 4; r++) ot[qt][dt][r] *= alpha;
      }
      const float mcur = mrun[qt];
      float ps = 0.f;
#pragma unroll
      for (int k16 = 0; k16 < 4; k16++)
#pragma unroll
        for (int r = 0; r < 4; r++) {
          const float p = fexp2(st[qt][k16][r] - mcur);
          st[qt][k16][r] = p;
          ps += p;
        }
      lrun[qt] += ps;
#pragma unroll
      for (int a = 0; a < 2; a++) {
        union { bf16x8 v; unsigned u[4]; } pk;
        pk.u[0] = pack2(st[qt][2 * a][0], st[qt][2 * a][1]);
        pk.u[1] = pack2(st[qt][2 * a][2], st[qt][2 * a][3]);
        pk.u[2] = pack2(st[qt][2 * a + 1][0], st[qt][2 * a + 1][1]);
        pk.u[3] = pack2(st[qt][2 * a + 1][2], st[qt][2 * a + 1][3]);
        pf[qt][a] = pk.v;
      }
    }
#pragma unroll
    for (int a = 0; a < 2; a++)
#pragma unroll
      for (int dt = 0; dt < 4; dt++) {
        union { bf16x8 v; uint2 h[2]; } vf;
        vf.h[0] = *(const uint2*)(cV + (dt * 16 + fr) * LDT + a * 32 + fq * 4);
        vf.h[1] = *(const uint2*)(cV + (dt * 16 + fr) * LDT + a * 32 + 16 + fq * 4);
#pragma unroll
        for (int qt = 0; qt < 2; qt++) ot[qt][dt] = MFMA(vf.v, pf[qt][a], ot[qt][dt]);
      }
    if (more) {
      u16* dK = sK + (cur ^ 1) * 64 * LDT;
      u16* dV = sV + (cur ^ 1) * 64 * LDT;
#pragma unroll
      for (int i = 0; i < 2; i++) {
        *(uint4*)(dK + (lrow + i * 32) * LDT + lcol) = rk[i];
        *(uint4*)(dV + (lrow + i * 32) * LDT + lcol) = rv[i];
      }
    }
    __syncthreads();
  }
  u16* MIX = (u16*)(P.ws + OFF_H);
#pragma unroll
  for (int qt = 0; qt < 2; qt++) {
    float l = lrun[qt];
    l = xor16_sum(l);
    l = xor32_sum(l);
    const float inv = __builtin_amdgcn_rcpf(l);
    const int t = qrow0 + qt * 16 + fr;
#pragma unroll
    for (int dt = 0; dt < 4; dt++) {
      uint2 o;
      o.x = pack2(ot[qt][dt][0] * inv, ot[qt][dt][1] * inv);
      o.y = pack2(ot[qt][dt][2] * inv, ot[qt][dt][3] * inv);
      *(uint2*)(MIX + (size_t)t * 1024 + 256 + head * 64 + dt * 16 + fq * 4) = o;
    }
  }
}

__device__ __forceinline__ void phase_even_mix(const Params& P, char* smem, int* qsh, const int rep) {
  unsigned* ctr = (unsigned*)(P.ws + OFF_Q + rep * 512);
  for (;;) {
    const int it = queue_next(ctr, qsh);
    if (it >= 1344) break;
    if (it < 128) fourier_tile(P, it, smem);
    else if (it < 896) attn_item(P, it - 128, smem);
    else if (it < 960) fourier_tile(P, it - 896 + 128, smem);
    else attn_item(P, it - 960 + 768, smem);
  }
}

__device__ __forceinline__ void ssd_conv8(const u16* __restrict__ PO, int col, const float* __restrict__ cw,
                                          const float* __restrict__ cb, int ch, int tg0, int lo, int hi,
                                          float (&o)[4][8]) {
  uint4 v[7];
#pragma unroll
  for (int r = 0; r < 7; r++) {
    const int t = tg0 - 1 + r;
    v[r] = make_uint4(0u, 0u, 0u, 0u);
    if (t >= lo && t < hi) v[r] = *(const uint4*)(PO + (size_t)t * 3456 + col);
  }
  float w[4][8], b[8];
#pragma unroll
  for (int j = 0; j < 4; j++) {
    const float4 w0 = *(const float4*)(cw + j * 1280 + ch);
    const float4 w1 = *(const float4*)(cw + j * 1280 + ch + 4);
    w[j][0] = w0.x; w[j][1] = w0.y; w[j][2] = w0.z; w[j][3] = w0.w;
    w[j][4] = w1.x; w[j][5] = w1.y; w[j][6] = w1.z; w[j][7] = w1.w;
  }
  {
    const float4 b0 = *(const float4*)(cb + ch);
    const float4 b1 = *(const float4*)(cb + ch + 4);
    b[0] = b0.x; b[1] = b0.y; b[2] = b0.z; b[3] = b0.w; b[4] = b1.x; b[5] = b1.y; b[6] = b1.z; b[7] = b1.w;
  }
#pragma unroll
  for (int tok = 0; tok < 4; tok++)
#pragma unroll
    for (int e = 0; e < 8; e++) o[tok][e] = b[e];
#pragma unroll
  for (int r = 0; r < 7; r++) {
    const unsigned uu[4] = {v[r].x, v[r].y, v[r].z, v[r].w};
#pragma unroll
    for (int e = 0; e < 8; e++) {
      const float x = __uint_as_float((e & 1) ? (uu[e >> 1] & 0xffff0000u) : (uu[e >> 1] << 16));
#pragma unroll
      for (int tok = 0; tok < 4; tok++) {
        const int j = r - tok;
        if (j >= 0 && j < 4) o[tok][e] += w[j][e] * x;
      }
    }
  }
#pragma unroll
  for (int tok = 0; tok < 4; tok++)
#pragma unroll
    for (int e = 0; e < 8; e++) o[tok][e] = silu_f(o[tok][e]);
}


__device__ __forceinline__ void phase_odd_conv(const Params& P) {
  const u16* PO = (const u16*)(P.ws + OFF_R1);
  u16* XC = (u16*)(P.ws + OFF_H);
  const float* cw = PRM(P, PRM_CSW);
  const float* cb = PRM(P, PRM_CSB);
  constexpr int NRUN = T_ALL / 16;
  const int nthr = gridDim.x * 256;
  for (int idx = blockIdx.x * 256 + threadIdx.x; idx < NRUN * 160; idx += nthr) {
    const int c8 = idx % 160, run = idx / 160;
    const int tb16 = run * 16;
    int lo, hi;
    if (tb16 < T_CTX) { lo = tb16 & ~255; hi = lo + 256; }
    else { lo = T_CTX + ((tb16 - T_CTX) & ~1023); hi = lo + 1024; }
    const int ch = c8 * 8;
    float w[4][8], bb[8];
#pragma unroll
    for (int j = 0; j < 4; j++) {
      const float4 w0 = *(const float4*)(cw + j * 1280 + ch);
      const float4 w1 = *(const float4*)(cw + j * 1280 + ch + 4);
      w[j][0] = w0.x; w[j][1] = w0.y; w[j][2] = w0.z; w[j][3] = w0.w;
      w[j][4] = w1.x; w[j][5] = w1.y; w[j][6] = w1.z; w[j][7] = w1.w;
    }
    {
      const float4 b0 = *(const float4*)(cb + ch);
      const float4 b1 = *(const float4*)(cb + ch + 4);
      bb[0] = b0.x; bb[1] = b0.y; bb[2] = b0.z; bb[3] = b0.w; bb[4] = b1.x; bb[5] = b1.y; bb[6] = b1.z; bb[7] = b1.w;
    }
    const u16* src = PO + 2048 + ch;
    u32x4 v[19];
#pragma unroll
    for (int r = 0; r < 19; r++) {
      const int t = tb16 - 1 + r;
      v[r] = u32x4{0u, 0u, 0u, 0u};
      if (t >= lo && t < hi) v[r] = *(const u32x4*)(src + (size_t)t * 3456);
    }
#pragma unroll
    for (int tok = 0; tok < 16; tok++) {
      float o[8];
#pragma unroll
      for (int e = 0; e < 8; e++) o[e] = bb[e];
#pragma unroll
      for (int j = 0; j < 4; j++) {
        const u32x4 vv = v[tok + j];
        const unsigned uu[4] = {vv.x, vv.y, vv.z, vv.w};
#pragma unroll
        for (int e = 0; e < 8; e++) {
          const float x = __uint_as_float((e & 1) ? (uu[e >> 1] & 0xffff0000u) : (uu[e >> 1] << 16));
          o[e] += w[j][e] * x;
        }
      }
      uint4 w4;
      w4.x = pack2(silu_f(o[0]), silu_f(o[1])); w4.y = pack2(silu_f(o[2]), silu_f(o[3]));
      w4.z = pack2(silu_f(o[4]), silu_f(o[5])); w4.w = pack2(silu_f(o[6]), silu_f(o[7]));
      *(uint4*)(XC + (size_t)(tb16 + tok) * 1280 + ch) = w4;
    }
  }
}

__device__ __forceinline__ void ssd_item(const Params& P, int item, char* smem) {
  const int tid = threadIdx.x, lane = tid & 63, wave = tid >> 6;
  const int fr = lane & 15, fq = lane >> 4;
  bool smp; int seq;
  if (item < 256) { smp = true; seq = item >> 5; }
  else { item -= 256; smp = false; seq = item >> 5; }
  const int head = (item & 31) >> 1, dir = item & 1;
  const int nc = smp ? 8 : 2;
  const int tb = smp ? T_CTX + seq * 1024 : seq * 256;
  const int tend = tb + (smp ? 1024 : 256);
  const int g = head >> 3;
  u16* Cs = (u16*)smem;
  u16* Bs = (u16*)(smem + 18432);
  u16* BT = (u16*)(smem + 36864);
  u16* XT = (u16*)(smem + 54272);
  u16* Hb = (u16*)(smem + 71680);
  float* cum2 = (float*)(smem + 79872);
  float* lcs2 = (float*)(smem + 80384);
  float* misc = (float*)(smem + 81408);
  const u16* PO = (const u16*)(P.ws + OFF_R1);
  const float* DT = (const float*)(P.ws + OFF_DT);
  u16* YO = (u16*)(P.ws + OFF_Y) + (size_t)dir * T_ALL * 1024;
  const float Aneg = -__expf(PRM(P, PRM_ALOG)[dir * 16 + head]);
  const float dtb = PRM(P, PRM_DTB)[dir * 16 + head];
  const float Dh = PRM(P, PRM_SSDD)[head];
  f32x4 hacc[4];
#pragma unroll
  for (int nt = 0; nt < 4; nt++) {
#pragma unroll
    for (int r = 0; r < 4; r++) {
      float v = 0.f;
      if (smp) v = P.in[6][(size_t)((seq * 2 + dir) * 16 + head) * 4096 + (wave * 16 + fq * 4 + r) * 64 + nt * 16 + fr];
      hacc[nt][r] = v;
      Hb[(wave * 16 + fq * 4 + r) * 64 + nt * 16 + fr] = f2bf(v);
    }
  }
  const int ch8 = (tid & 7) * 8, rg = tid >> 3;
  const u16* XC = (const u16*)(P.ws + OFF_H);
  u32x4 rx0, rx1, rx2, rx3, rb0, rb1, rb2, rb3;
  float raw_next = 0.f;
  {
    const int c0 = dir ? nc - 1 : 0;
    const u16* xr = XC + (size_t)(tb + c0 * 128 + rg * 4) * 1280 + ch8;
    rx0 = *(const u32x4*)(xr + head * 64); rx1 = *(const u32x4*)(xr + 1280 + head * 64);
    rx2 = *(const u32x4*)(xr + 2560 + head * 64); rx3 = *(const u32x4*)(xr + 3840 + head * 64);
    rb0 = *(const u32x4*)(xr + 1024 + g * 64); rb1 = *(const u32x4*)(xr + 1280 + 1024 + g * 64);
    rb2 = *(const u32x4*)(xr + 2560 + 1024 + g * 64); rb3 = *(const u32x4*)(xr + 3840 + 1024 + g * 64);
    if (tid < 128) raw_next = DT[(size_t)(tb + c0 * 128 + (dir ? 127 - tid : tid)) * 32 + dir * 16 + head];
  }
  for (int ci = 0; ci < nc; ci++) {
    const int c = dir ? nc - 1 - ci : ci;
    const int t0 = tb + c * 128;
    {
      const u16* xrc = XC + (size_t)(t0 + rg * 4) * 1280 + ch8 + 1152 + g * 64;
      const u32x4 rc0 = *(const u32x4*)(xrc), rc1 = *(const u32x4*)(xrc + 1280);
      const u32x4 rc2 = *(const u32x4*)(xrc + 2560), rc3 = *(const u32x4*)(xrc + 3840);
      {
        const unsigned u[4][4] = {{rx0.x, rx0.y, rx0.z, rx0.w}, {rx1.x, rx1.y, rx1.z, rx1.w}, {rx2.x, rx2.y, rx2.z, rx2.w}, {rx3.x, rx3.y, rx3.z, rx3.w}};
#pragma unroll
        for (int q = 0; q < 4; q++) {
          uint2 lo2, hi2;
          lo2.x = (u[0][q] & 0xffffu) | (u[1][q] << 16); lo2.y = (u[2][q] & 0xffffu) | (u[3][q] << 16);
          hi2.x = (u[0][q] >> 16) | (u[1][q] & 0xffff0000u); hi2.y = (u[2][q] >> 16) | (u[3][q] & 0xffff0000u);
          *(uint2*)(XT + (ch8 + 2 * q) * 136 + rg * 4) = lo2;
          *(uint2*)(XT + (ch8 + 2 * q + 1) * 136 + rg * 4) = hi2;
        }
      }
      {
        const unsigned u[4][4] = {{rb0.x, rb0.y, rb0.z, rb0.w}, {rb1.x, rb1.y, rb1.z, rb1.w}, {rb2.x, rb2.y, rb2.z, rb2.w}, {rb3.x, rb3.y, rb3.z, rb3.w}};
#pragma unroll
        for (int q = 0; q < 4; q++) {
          uint2 lo2, hi2;
          lo2.x = (u[0][q] & 0xffffu) | (u[1][q] << 16); lo2.y = (u[2][q] & 0xffffu) | (u[3][q] << 16);
          hi2.x = (u[0][q] >> 16) | (u[1][q] & 0xffff0000u); hi2.y = (u[2][q] >> 16) | (u[3][q] & 0xffff0000u);
          *(uint2*)(BT + (ch8 + 2 * q) * 136 + rg * 4) = lo2;
          *(uint2*)(BT + (ch8 + 2 * q + 1) * 136 + rg * 4) = hi2;
        }
        *(u32x4*)(Bs + (rg * 4 + 0) * LDT + ch8) = rb0;
        *(u32x4*)(Bs + (rg * 4 + 1) * LDT + ch8) = rb1;
        *(u32x4*)(Bs + (rg * 4 + 2) * LDT + ch8) = rb2;
        *(u32x4*)(Bs + (rg * 4 + 3) * LDT + ch8) = rb3;
      }
      *(u32x4*)(Cs + (rg * 4 + 0) * LDT + ch8) = rc0;
      *(u32x4*)(Cs + (rg * 4 + 1) * LDT + ch8) = rc1;
      *(u32x4*)(Cs + (rg * 4 + 2) * LDT + ch8) = rc2;
      *(u32x4*)(Cs + (rg * 4 + 3) * LDT + ch8) = rc3;
    }
    const float raw_cur = raw_next;
    __builtin_amdgcn_sched_barrier(0);
    if (ci + 1 < nc) {
      const int cn = dir ? nc - 2 - ci : ci + 1;
      const u16* xr = XC + (size_t)(tb + cn * 128 + rg * 4) * 1280 + ch8;
      rx0 = *(const u32x4*)(xr + head * 64); rx1 = *(const u32x4*)(xr + 1280 + head * 64);
      rx2 = *(const u32x4*)(xr + 2560 + head * 64); rx3 = *(const u32x4*)(xr + 3840 + head * 64);
      rb0 = *(const u32x4*)(xr + 1024 + g * 64); rb1 = *(const u32x4*)(xr + 1280 + 1024 + g * 64);
      rb2 = *(const u32x4*)(xr + 2560 + 1024 + g * 64); rb3 = *(const u32x4*)(xr + 3840 + 1024 + g * 64);
      if (tid < 128) raw_next = DT[(size_t)(tb + cn * 128 + (dir ? 127 - tid : tid)) * 32 + dir * 16 + head];
    }
    __builtin_amdgcn_sched_barrier(0);
    float sv = 0.f, dtv = 1.f;
    int li = 0;
    if (tid < 128) {
      li = dir ? 127 - tid : tid;
      const float raw = raw_cur + dtb;
      dtv = fmaxf(raw, 0.f) + log1pf(__expf(-fabsf(raw)));
      sv = dtv * Aneg;
#pragma unroll
      for (int o = 1; o < 64; o <<= 1) {
        const float u = __shfl_up(sv, o);
        if (lane >= o) sv += u;
      }
      if (tid == 63) misc[0] = sv;
    }
    __syncthreads();
    if (tid < 128) {
      if (wave == 1) sv += misc[0];
      cum2[li] = sv * LOG2E;
      lcs2[li] = (sv - __logf(dtv)) * LOG2E;
      if (tid == 127) misc[1] = sv * LOG2E;
    }
    __syncthreads();
    const float total2 = misc[1];
#pragma unroll 1
    for (int tt = 0; tt < 2; tt++) {
      const int Tt = wave * 2 + tt;
      const int tl = wave * 32 + tt * 16 + fr;
      bf16x8 cf[2];
#pragma unroll
      for (int kk = 0; kk < 2; kk++) cf[kk] = *(const bf16x8*)(Cs + tl * LDT + kk * 32 + fq * 8);
      f32x4 acc[4];
#pragma unroll
      for (int pt = 0; pt < 4; pt++) {
        const bf16x8 h0 = *(const bf16x8*)(Hb + (pt * 16 + fr) * 64 + fq * 8);
        const bf16x8 h1 = *(const bf16x8*)(Hb + (pt * 16 + fr) * 64 + 32 + fq * 8);
        f32x4 z = f32x4{0.f, 0.f, 0.f, 0.f};
        z = MFMA(h0, cf[0], z);
        acc[pt] = MFMA(h1, cf[1], z);
      }
      const float ct = cum2[tl];
      {
        const float e = fexp2(ct);
#pragma unroll
        for (int pt = 0; pt < 4; pt++)
#pragma unroll
          for (int r = 0; r < 4; r++) acc[pt][r] *= e;
      }
#pragma unroll 1
      for (int a = 0; a < 4; a++) {
        const bool ok = dir ? (2 * a + 1 >= Tt) : (2 * a <= Tt);
        if (!ok) continue;
        f32x4 g0 = f32x4{0.f, 0.f, 0.f, 0.f}, g1 = f32x4{0.f, 0.f, 0.f, 0.f};
#pragma unroll
        for (int kk = 0; kk < 2; kk++) {
          const bf16x8 b0 = *(const bf16x8*)(Bs + ((2 * a) * 16 + fr) * LDT + kk * 32 + fq * 8);
          const bf16x8 b1 = *(const bf16x8*)(Bs + ((2 * a + 1) * 16 + fr) * LDT + kk * 32 + fq * 8);
          g0 = MFMA(b0, cf[kk], g0);
          g1 = MFMA(b1, cf[kk], g1);
        }
        const float4 l0 = *(const float4*)(lcs2 + a * 32 + fq * 4);
        const float4 l1 = *(const float4*)(lcs2 + a * 32 + 16 + fq * 4);
        const float ls0[4] = {l0.x, l0.y, l0.z, l0.w};
        const float ls1[4] = {l1.x, l1.y, l1.z, l1.w};
        float m0[4], m1[4];
#pragma unroll
        for (int r = 0; r < 4; r++) {
          const int s0 = a * 32 + fq * 4 + r, s1 = s0 + 16;
          const bool ok0 = dir ? (s0 >= tl) : (s0 <= tl);
          const bool ok1 = dir ? (s1 >= tl) : (s1 <= tl);
          float v0 = ok0 ? g0[r] * fexp2(ct - ls0[r]) : 0.f;
          float v1 = ok1 ? g1[r] * fexp2(ct - ls1[r]) : 0.f;
          if (!dir && s0 == tl) v0 += Dh;
          if (!dir && s1 == tl) v1 += Dh;
          m0[r] = v0; m1[r] = v1;
        }
        union { bf16x8 v; unsigned u[4]; } pk;
        pk.u[0] = pack2(m0[0], m0[1]); pk.u[1] = pack2(m0[2], m0[3]);
        pk.u[2] = pack2(m1[0], m1[1]); pk.u[3] = pack2(m1[2], m1[3]);
#pragma unroll
        for (int pt = 0; pt < 4; pt++) {
          union { bf16x8 v; uint2 h[2]; } x;
          x.h[0] = *(const uint2*)(XT + (pt * 16 + fr) * 136 + a * 32 + fq * 4);
          x.h[1] = *(const uint2*)(XT + (pt * 16 + fr) * 136 + a * 32 + 16 + fq * 4);
          acc[pt] = MFMA(x.v, pk.v, acc[pt]);
        }
      }
      {
        const int t = t0 + tl;
#pragma unroll
        for (int pt = 0; pt < 4; pt++) {
          uint2 o;
          o.x = pack2(acc[pt][0], acc[pt][1]);
          o.y = pack2(acc[pt][2], acc[pt][3]);
          *(uint2*)(YO + (size_t)t * 1024 + head * 64 + pt * 16 + fq * 4) = o;
        }
      }
    }
    {
      const float et = fexp2(total2);
#pragma unroll
      for (int nt = 0; nt < 4; nt++)
#pragma unroll
        for (int r = 0; r < 4; r++) hacc[nt][r] *= et;
#pragma unroll 1
      for (int ks = 0; ks < 4; ks++) {
        union { bf16x8 v; unsigned u[4]; } xr, xw;
        xr.v = *(const bf16x8*)(XT + (wave * 16 + fr) * 136 + ks * 32 + fq * 8);
        const float4 la = *(const float4*)(lcs2 + ks * 32 + fq * 8);
        const float4 lb = *(const float4*)(lcs2 + ks * 32 + fq * 8 + 4);
        const float lw[8] = {la.x, la.y, la.z, la.w, lb.x, lb.y, lb.z, lb.w};
#pragma unroll
        for (int q = 0; q < 4; q++) {
          const float x0 = __uint_as_float(xr.u[q] << 16) * fexp2(total2 - lw[2 * q]);
          const float x1 = __uint_as_float(xr.u[q] & 0xffff0000u) * fexp2(total2 - lw[2 * q + 1]);
          xw.u[q] = pack2(x0, x1);
        }
#pragma unroll
        for (int nt = 0; nt < 4; nt++) {
          const bf16x8 bt = *(const bf16x8*)(BT + (nt * 16 + fr) * 136 + ks * 32 + fq * 8);
          hacc[nt] = MFMA(xw.v, bt, hacc[nt]);
        }
      }
    }
    __syncthreads();
#pragma unroll
    for (int nt = 0; nt < 4; nt++)
#pragma unroll
      for (int r = 0; r < 4; r++) Hb[(wave * 16 + fq * 4 + r) * 64 + nt * 16 + fr] = f2bf(hacc[nt][r]);
  }
  if (!smp) {
    float* ns = P.out + 14696448 + (size_t)((seq * 2 + dir) * 16 + head) * 4096;
#pragma unroll
    for (int nt = 0; nt < 4; nt++)
#pragma unroll
      for (int r = 0; r < 4; r++) ns[(wave * 16 + fq * 4 + r) * 64 + nt * 16 + fr] = hacc[nt][r];
  }
  __syncthreads();
}

__device__ __forceinline__ void lru_item(const Params& P, int item, char* smem) {
  const int tid = threadIdx.x, lane = tid & 63, wave = tid >> 6;
  const int fr = lane & 15, fq = lane >> 4;
  bool smp; int seq;
  if (item < 128) { smp = true; seq = item >> 4; }
  else { item -= 128; smp = false; seq = item >> 4; }
  const int blk = (item & 15) >> 1, dir = item & 1;
  const int nc = smp ? 16 : 4;
  const int tb = smp ? T_CTX + seq * 1024 : seq * 256;
  const int tend = tb + (smp ? 1024 : 256);
  u16* WaT = (u16*)smem;
  u16* WxT = (u16*)(smem + 9216);
  u16* xcb = (u16*)(smem + 18432);
  float* aL = (float*)(smem + 27648);
  float* bL = (float*)(smem + 45056);
  float* sA = (float*)(smem + 62464);
  float* sH = (float*)(smem + 63488);
  float* hc = (float*)(smem + 64512);
  float* cba = (float*)(smem + 65024);
  float* cbx = (float*)(smem + 65280);
  float* csp = (float*)(smem + 65536);
  const u16* PO = (const u16*)(P.ws + OFF_R1);
  u16* YO = (u16*)(P.ws + OFF_YL) + (size_t)dir * T_ALL * 512;
  {
    const float* wa = PRM(P, PRM_LWA) + (size_t)(dir * 8 + blk) * 4096;
    const float* wx = PRM(P, PRM_LWX) + (size_t)(dir * 8 + blk) * 4096;
    for (int e = tid; e < 4096; e += 256) {
      const int i = e >> 6, j = e & 63;
      WaT[j * LDT + i] = f2bf(wa[e]);
      WxT[j * LDT + i] = f2bf(wx[e]);
    }
    if (tid < 64) {
      const int ch = dir * 512 + blk * 64 + tid;
      cba[tid] = PRM(P, PRM_LBA)[ch];
      cbx[tid] = PRM(P, PRM_LBX)[ch];
      const float lam = -PRM(P, PRM_LAM)[ch];
      csp[tid] = 8.0f * (fmaxf(lam, 0.f) + log1pf(__expf(-fabsf(lam))));
      hc[tid] = smp ? P.in[5][(size_t)(seq * 2 + dir) * 512 + blk * 64 + tid] : 0.f;
    }
  }
  const int ch8 = (tid & 7) * 8, rg = tid >> 3;
  const float* cw = PRM(P, PRM_CLW);
  const float* cb = PRM(P, PRM_CLB);
  u32x4 pv0, pv1, pv2, pv3, pv4;
  {
    const int c0 = dir ? nc - 1 : 0;
    const int tn = tb + c0 * 64 + rg * 2 - 1;
    const int chg = blk * 64 + ch8;
    const u32x4 zz = {0u, 0u, 0u, 0u};
    pv0 = (tn >= tb) ? *(const u32x4*)(PO + (size_t)tn * 3456 + 512 + chg) : zz;
    pv1 = *(const u32x4*)(PO + (size_t)(tn + 1) * 3456 + 512 + chg);
    pv2 = *(const u32x4*)(PO + (size_t)(tn + 2) * 3456 + 512 + chg);
    pv3 = (tn + 3 < tend) ? *(const u32x4*)(PO + (size_t)(tn + 3) * 3456 + 512 + chg) : zz;
    pv4 = (tn + 4 < tend) ? *(const u32x4*)(PO + (size_t)(tn + 4) * 3456 + 512 + chg) : zz;
  }
  for (int ci = 0; ci < nc; ci++) {
    const int c = dir ? nc - 1 - ci : ci;
    const int t0 = tb + c * 64;
    const int cur = ci & 1;
    {
      const int chg = blk * 64 + ch8;
      const u32x4 v[5] = {pv0, pv1, pv2, pv3, pv4};
      if (ci + 1 < nc) {
        const int cn = dir ? nc - 2 - ci : ci + 1;
        const int tn = tb + cn * 64 + rg * 2 - 1;
        const u32x4 zz = {0u, 0u, 0u, 0u};
        pv0 = (tn >= tb) ? *(const u32x4*)(PO + (size_t)tn * 3456 + 512 + chg) : zz;
        pv1 = *(const u32x4*)(PO + (size_t)(tn + 1) * 3456 + 512 + chg);
        pv2 = *(const u32x4*)(PO + (size_t)(tn + 2) * 3456 + 512 + chg);
        pv3 = (tn + 3 < tend) ? *(const u32x4*)(PO + (size_t)(tn + 3) * 3456 + 512 + chg) : zz;
        pv4 = (tn + 4 < tend) ? *(const u32x4*)(PO + (size_t)(tn + 4) * 3456 + 512 + chg) : zz;
      }
      float o[2][8];
      {
        const float4 b0 = *(const float4*)(cb + chg);
        const float4 b1 = *(const float4*)(cb + chg + 4);
        const float bb[8] = {b0.x, b0.y, b0.z, b0.w, b1.x, b1.y, b1.z, b1.w};
#pragma unroll
        for (int e = 0; e < 8; e++) { o[0][e] = bb[e]; o[1][e] = bb[e]; }
      }
#pragma unroll
      for (int j = 0; j < 4; j++) {
        const float4 w0 = *(const float4*)(cw + j * 512 + chg);
        const float4 w1 = *(const float4*)(cw + j * 512 + chg + 4);
        const float ww[8] = {w0.x, w0.y, w0.z, w0.w, w1.x, w1.y, w1.z, w1.w};
#pragma unroll
        for (int tok = 0; tok < 2; tok++) {
          const unsigned uu[4] = {v[tok + j].x, v[tok + j].y, v[tok + j].z, v[tok + j].w};
#pragma unroll
          for (int e = 0; e < 8; e++) {
            const float x = __uint_as_float((e & 1) ? (uu[e >> 1] & 0xffff0000u) : (uu[e >> 1] << 16));
            o[tok][e] += ww[e] * x;
          }
        }
      }
#pragma unroll
      for (int tok = 0; tok < 2; tok++) {
        const int tl = rg * 2 + tok;
        *(float4*)(bL + tl * 68 + ch8) = make_float4(o[tok][0], o[tok][1], o[tok][2], o[tok][3]);
        *(float4*)(bL + tl * 68 + ch8 + 4) = make_float4(o[tok][4], o[tok][5], o[tok][6], o[tok][7]);
        uint4 w4;
        w4.x = pack2(o[tok][0], o[tok][1]); w4.y = pack2(o[tok][2], o[tok][3]);
        w4.z = pack2(o[tok][4], o[tok][5]); w4.w = pack2(o[tok][6], o[tok][7]);
        *(uint4*)(xcb + tl * LDT + ch8) = w4;
      }
    }
    __syncthreads();
    {
      bf16x8 xb[2];
#pragma unroll
      for (int kk = 0; kk < 2; kk++) xb[kk] = *(const bf16x8*)(xcb + (wave * 16 + fr) * LDT + kk * 32 + fq * 8);
      const int tl = wave * 16 + fr;
#pragma unroll
      for (int jt = 0; jt < 4; jt++) {
        f32x4 aR = f32x4{0.f, 0.f, 0.f, 0.f}, aI = f32x4{0.f, 0.f, 0.f, 0.f};
#pragma unroll
        for (int kk = 0; kk < 2; kk++) {
          const bf16x8 wa = *(const bf16x8*)(WaT + (jt * 16 + fr) * LDT + kk * 32 + fq * 8);
          const bf16x8 wx = *(const bf16x8*)(WxT + (jt * 16 + fr) * LDT + kk * 32 + fq * 8);
          aR = MFMA(wa, xb[kk], aR);
          aI = MFMA(wx, xb[kk], aI);
        }
        const int j4 = jt * 16 + fq * 4;
        const float4 xc = *(const float4*)(bL + tl * 68 + j4);
        const float4 ba = *(const float4*)(cba + j4);
        const float4 bx = *(const float4*)(cbx + j4);
        const float4 sp = *(const float4*)(csp + j4);
        const float xcv[4] = {xc.x, xc.y, xc.z, xc.w};
        const float bav[4] = {ba.x, ba.y, ba.z, ba.w};
        const float bxv[4] = {bx.x, bx.y, bx.z, bx.w};
        const float spv[4] = {sp.x, sp.y, sp.z, sp.w};
        float av[4], bv[4];
#pragma unroll
        for (int r = 0; r < 4; r++) {
          const float rr = sigmoid_f(aR[r] + bav[r]);
          const float ii = sigmoid_f(aI[r] + bxv[r]);
          const float la = -rr * spv[r];
          av[r] = __expf(la);
          bv[r] = __builtin_amdgcn_sqrtf(fmaxf(1.0f - av[r] * av[r], 0.f)) * ii * xcv[r];
        }
        *(float4*)(aL + tl * 68 + j4) = make_float4(av[0], av[1], av[2], av[3]);
        *(float4*)(bL + tl * 68 + j4) = make_float4(bv[0], bv[1], bv[2], bv[3]);
      }
    }
    __syncthreads();
    {
      const int j = lane, q = wave;
      float hreg[16], areg[16];
      float h = 0.f, Ap = 1.f;
#pragma unroll
      for (int i = 0; i < 16; i++) {
        const int tl = dir ? 63 - (q * 16 + i) : q * 16 + i;
        const float a = aL[tl * 68 + j], b = bL[tl * 68 + j];
        h = a * h + b;
        Ap *= a;
        hreg[i] = h;
        areg[i] = Ap;
      }
      sA[q * 64 + j] = Ap;
      sH[q * 64 + j] = h;
      __syncthreads();
      float Hin = hc[cur * 64 + j];
      for (int qq = 0; qq < q; qq++) Hin = sA[qq * 64 + j] * Hin + sH[qq * 64 + j];
#pragma unroll
      for (int i = 0; i < 16; i++) {
        const int tl = dir ? 63 - (q * 16 + i) : q * 16 + i;
        const float hv = hreg[i] + areg[i] * Hin;
        YO[(size_t)(t0 + tl) * 512 + blk * 64 + j] = f2bf(hv);
      }
      if (q == 3) hc[(cur ^ 1) * 64 + j] = sA[3 * 64 + j] * Hin + sH[3 * 64 + j];
    }
  }
  __syncthreads();
  if (!smp && tid < 64) {
    P.out[14680064 + (size_t)(seq * 2 + dir) * 512 + blk * 64 + tid] = hc[(nc & 1) * 64 + tid];
  }
  __syncthreads();
}

__device__ __forceinline__ void phase_odd_mix(const Params& P, char* smem, int* qsh, const int rep) {
  unsigned* ctr = (unsigned*)(P.ws + OFF_Q + 256 + rep * 512);
  for (;;) {
    const int it = queue_next(ctr, qsh);
    if (it >= 1152) break;
    bool is_ssd; int idx;
    if (it < 128) { is_ssd = false; idx = it; }
    else if (it < 384) { is_ssd = true; idx = it - 128; }
    else if (it < 640) { is_ssd = false; idx = it - 384 + 128; }
    else { is_ssd = true; idx = it - 640 + 256; }
    if (is_ssd) ssd_item(P, idx, smem);
    else lru_item(P, idx, smem);
  }
}

__device__ __forceinline__ void phase_odd_combine(const Params& P) {
  const int tid = threadIdx.x, lane = tid & 63, wave = tid >> 6;
  const u16* PO = (const u16*)(P.ws + OFF_R1);
  const u16* YSF = (const u16*)(P.ws + OFF_Y);
  const u16* YSB = YSF + (size_t)T_ALL * 1024;
  const u16* YLF = (const u16*)(P.ws + OFF_YL);
  const u16* YLB = YLF + (size_t)T_ALL * 512;
  u16* MIX = (u16*)(P.ws + OFF_H);
  const float* nrm = PRM(P, PRM_SNORM);
  float4 nr[2][2];
#pragma unroll
  for (int hh = 0; hh < 2; hh++) { nr[hh][0] = *(const float4*)(nrm + hh * 512 + lane * 8); nr[hh][1] = *(const float4*)(nrm + hh * 512 + lane * 8 + 4); }
  for (int t = blockIdx.x * 4 + wave; t < T_ALL; t += gridDim.x * 4) {
    {
      const int c = lane * 8;
      const uint4 f = *(const uint4*)(YLF + (size_t)t * 512 + c);
      const uint4 b = *(const uint4*)(YLB + (size_t)t * 512 + c);
      const uint4 gg = *(const uint4*)(PO + (size_t)t * 3456 + c);
      const unsigned fu[4] = {f.x, f.y, f.z, f.w}, bu[4] = {b.x, b.y, b.z, b.w}, gu[4] = {gg.x, gg.y, gg.z, gg.w};
      unsigned ou[4];
#pragma unroll
      for (int q = 0; q < 4; q++) {
        float r[2];
#pragma unroll
        for (int h = 0; h < 2; h++) {
          const float yf = h ? __uint_as_float(fu[q] & 0xffff0000u) : __uint_as_float(fu[q] << 16);
          const float yb = h ? __uint_as_float(bu[q] & 0xffff0000u) : __uint_as_float(bu[q] << 16);
          const float gv = h ? __uint_as_float(gu[q] & 0xffff0000u) : __uint_as_float(gu[q] << 16);
          const float ge = gv * __builtin_amdgcn_rcpf(1.f + __expf(-2.0f * 0.7978845608028654f * (gv + 0.044715f * gv * gv * gv)));
          r[h] = (yf + yb) * ge;
        }
        ou[q] = pack2(r[0], r[1]);
      }
      *(uint4*)(MIX + (size_t)t * 1536 + c) = make_uint4(ou[0], ou[1], ou[2], ou[3]);
    }
    float y[16];
    float ss = 0.f;
#pragma unroll
    for (int hh = 0; hh < 2; hh++) {
      const int c = hh * 512 + lane * 8;
      const uint4 f = *(const uint4*)(YSF + (size_t)t * 1024 + c);
      const uint4 b = *(const uint4*)(YSB + (size_t)t * 1024 + c);
      const uint4 zz = *(const uint4*)(PO + (size_t)t * 3456 + 1024 + c);
      const unsigned fu[4] = {f.x, f.y, f.z, f.w}, bu[4] = {b.x, b.y, b.z, b.w}, zu[4] = {zz.x, zz.y, zz.z, zz.w};
#pragma unroll
      for (int q = 0; q < 4; q++)
#pragma unroll
        for (int h = 0; h < 2; h++) {
          const float yf = h ? __uint_as_float(fu[q] & 0xffff0000u) : __uint_as_float(fu[q] << 16);
          const float yb = h ? __uint_as_float(bu[q] & 0xffff0000u) : __uint_as_float(bu[q] << 16);
          const float zv = h ? __uint_as_float(zu[q] & 0xffff0000u) : __uint_as_float(zu[q] << 16);
          const float v = (yf + yb) * silu_f(zv);
          y[hh * 8 + q * 2 + h] = v;
          ss += v * v;
        }
    }
#pragma unroll
    for (int o = 32; o >= 1; o >>= 1) ss += __shfl_xor(ss, o);
    const float rs = rsqrtf(ss * (1.0f / 1024.0f) + 1e-6f);
#pragma unroll
    for (int hh = 0; hh < 2; hh++) {
      const int c = hh * 512 + lane * 8;
      const float4 n0 = nr[hh][0];
      const float4 n1 = nr[hh][1];
      uint4 o;
      o.x = pack2(y[hh * 8 + 0] * rs * n0.x, y[hh * 8 + 1] * rs * n0.y);
      o.y = pack2(y[hh * 8 + 2] * rs * n0.z, y[hh * 8 + 3] * rs * n0.w);
      o.z = pack2(y[hh * 8 + 4] * rs * n1.x, y[hh * 8 + 5] * rs * n1.y);
      o.w = pack2(y[hh * 8 + 6] * rs * n1.z, y[hh * 8 + 7] * rs * n1.w);
      *(uint4*)(MIX + (size_t)t * 1536 + 512 + c) = o;
    }
  }
}

#ifndef PHMASK
#define PHMASK 0xffffffu
#endif
__device__ __forceinline__ void run_phase(const Params& P, const int ph, char* smem, int* qsh, const int rep = 0) {
  switch (ph) {
    case 0: if (PHMASK & (1u << 0)) phase_prep(P, smem, qsh); break;
    case 1: if (PHMASK & (1u << 1)) phase_norm(P, 0, 0); break;
    case 2: if (PHMASK & (1u << 2)) phase_gemm_in_even(P, smem); break;
    case 3: if (PHMASK & (1u << 3)) phase_even_mix(P, smem, qsh, rep); break;
    case 4: if (PHMASK & (1u << 4)) phase_gemm_resid(P, smem, (const u16*)(P.ws + OFF_H), 1024, (const u16*)(P.ws + OFF_WOE), 1024, 0, 2, true); break;
    case 5: if (PHMASK & (1u << 5)) phase_norm(P, 0, 1); break;
    case 6: if (PHMASK & (1u << 6)) phase_gemm_ffn_up(P, smem, 0); break;
    case 7: if (PHMASK & (1u << 7)) phase_gemm_resid(P, smem, (const u16*)(P.ws + OFF_R1), 2816, (const u16*)(P.ws + OFF_W2), 2816, 0, 5, false); break;
    case 8: if (PHMASK & (1u << 8)) phase_norm(P, 1, 0); break;
    case 9: if (PHMASK & (1u << 9)) phase_gemm_in_odd(P, smem); break;
    case 10: if (PHMASK & (1u << 10)) phase_odd_conv(P); break;
    case 11: if (PHMASK & (1u << 11)) phase_odd_mix(P, smem, qsh, rep); break;
    case 12: if (PHMASK & (1u << 12)) phase_odd_combine(P); break;
    case 13: if (PHMASK & (1u << 13)) phase_gemm_resid(P, smem, (const u16*)(P.ws + OFF_H), 1536, (const u16*)(P.ws + OFF_WOO), 1536, 1, 2, false); break;
    case 14: if (PHMASK & (1u << 14)) phase_norm(P, 1, 1); break;
    case 15: if (PHMASK & (1u << 15)) phase_gemm_ffn_up(P, smem, 1); break;
    case 16: if (PHMASK & (1u << 16)) phase_gemm_resid(P, smem, (const u16*)(P.ws + OFF_R1), 2816, (const u16*)(P.ws + OFF_W2) + (size_t)1024 * 2816, 2816, 1, 5, false); break;
    default: break;
  }
}

constexpr int N_PHASES = 17;

__global__ void __launch_bounds__(256, 2) mega_kernel(Params P, int ph_lo, int ph_hi) {
  __shared__ __attribute__((aligned(16))) char smem[SMEM_BYTES];
  __shared__ uint4 xb_words;
  __shared__ int q_item;
  cg::grid_group grid = cg::this_grid();
  if (threadIdx.x == 0) xb_words = make_uint4(0u, 0u, 0u, 0u);
  __syncthreads();
  XcdBarrier xb = xcd_barrier_post((unsigned*)(P.ws + OFF_BAR), (volatile LAS unsigned*)&xb_words);
  if (ph_lo < 0) grid.sync();
#ifndef DUP_PH
#define DUP_PH -1
#endif
#define RUN_PH(ph) if ((ph) >= ph_lo && (ph) < ph_hi) { run_phase(P, (ph), smem, &q_item); if (DUP_PH == (ph)) { xcd_barrier(xb); run_phase(P, (ph), smem, &q_item, 1); } if ((ph) + 1 < ph_hi) xcd_barrier(xb); }
  RUN_PH(0) RUN_PH(1) RUN_PH(2) RUN_PH(3) RUN_PH(4) RUN_PH(5) RUN_PH(6) RUN_PH(7)
  RUN_PH(8) RUN_PH(9) RUN_PH(10) RUN_PH(11) RUN_PH(12) RUN_PH(13) RUN_PH(14) RUN_PH(15) RUN_PH(16)
}

#ifndef MULTI_LAUNCH
#define MULTI_LAUNCH 0
#endif

extern "C" void kernel_launch(void* const* d_in, const int* in_sizes, int n_in, void* d_out, int out_size, void* d_ws,
                              size_t ws_size, hipStream_t stream) {
  static int grid_blocks = 0;
  if (!grid_blocks) {
    int dev = 0, cus = 0, per_cu = 0;
    (void)hipGetDevice(&dev);
    (void)hipDeviceGetAttribute(&cus, hipDeviceAttributeMultiprocessorCount, dev);
    (void)hipOccupancyMaxActiveBlocksPerMultiprocessor(&per_cu, mega_kernel, 256, 0);
    if (per_cu > 2) per_cu = 2;
    if (per_cu < 1) per_cu = 1;
    grid_blocks = cus * per_cu;
  }
  Params p;
  memset(&p, 0, sizeof(p));
  for (int i = 0; i < 34; i++) p.in[i] = (const float*)d_in[i];
  p.out = (float*)d_out;
  p.ws = (char*)d_ws;
#if MULTI_LAUNCH
  for (int ph = 0; ph < N_PHASES; ph++) {
    int lo = ph, hi = ph + 1;
    void* args[] = {&p, &lo, &hi};
    hipError_t e = hipLaunchCooperativeKernel((void*)mega_kernel, dim3(grid_blocks), dim3(256), args, 0, stream);
    if (e != hipSuccess) fprintf(stderr, "launch failed: %s (grid %d)\n", hipGetErrorString(e), grid_blocks);
  }
#else
  (void)hipMemsetAsync((char*)d_ws + OFF_BAR, 0, 24576, stream);
  int lo = 0, hi = N_PHASES;
  void* args[] = {&p, &lo, &hi};
  hipError_t e = hipLaunchCooperativeKernel((void*)mega_kernel, dim3(grid_blocks), dim3(256), args, 0, stream);
  if (e != hipSuccess) fprintf(stderr, "cooperative launch failed: %s (grid %d)\n", hipGetErrorString(e), grid_blocks);
#endif
}
```

```cpp
#include <hip/hip_runtime.h>
#include <hip/hip_bf16.h>
#include <hip/hip_cooperative_groups.h>
#include <cstdio>
#include <cstring>
namespace cg = cooperative_groups;

typedef unsigned short u16;
using bf16x8 = __attribute__((ext_vector_type(8))) short;
using bf16x4 = __attribute__((ext_vector_type(4))) short;
using f32x4 = __attribute__((ext_vector_type(4))) float;

#define MFMA(a, b, c) __builtin_amdgcn_mfma_f32_16x16x32_bf16(a, b, c, 0, 0, 0)
#define LOG2E 1.4426950408889634f

constexpr int T_ALL = 12288;
constexpr int T_CTX = 4096;
constexpr int SMEM_BYTES = 81664;
constexpr int LDT = 72;

constexpr size_t OFF_WIE = 0;
constexpr size_t OFF_WOE = OFF_WIE + 3670016;
constexpr size_t OFF_WIO = OFF_WOE + 2097152;
constexpr size_t OFF_WOO = OFF_WIO + 7077888;
constexpr size_t OFF_W13 = OFF_WOO + 3145728;
constexpr size_t OFF_W2 = OFF_W13 + 23068672;
constexpr size_t OFF_MOD = OFF_W2 + 11534336;
constexpr size_t OFF_D1K = OFF_MOD + 442368;
constexpr size_t OFF_D256 = OFF_D1K + 4194304;
constexpr size_t OFF_H = OFF_D256 + 262144;
constexpr size_t OFF_R1 = OFF_H + 37748736;
constexpr size_t OFF_Y = OFF_R1 + 84934656;
constexpr size_t OFF_YL = OFF_Y + 50331648;
constexpr size_t OFF_DT = OFF_YL + 25165824;
constexpr size_t OFF_BAR = OFF_DT + 1572864;
constexpr size_t OFF_PRM = OFF_BAR + 32768;
constexpr int PRM_NORM_MIX = 0, PRM_NORM_FFN = 2048, PRM_QN = 4096, PRM_KN = 4160, PRM_CLW = 4224, PRM_CLB = 6272,
              PRM_LBA = 6784, PRM_LBX = 7808, PRM_LAM = 8832, PRM_CSW = 9856, PRM_CSB = 14976, PRM_DTB = 16256,
              PRM_ALOG = 16288, PRM_SSDD = 16320, PRM_SNORM = 16384, PRM_LWA = 17408, PRM_LWX = 82944;
#define PRM(P, off) ((const float*)((P).ws + OFF_PRM) + (off))
constexpr size_t OFF_YTS = OFF_Y;
constexpr size_t OFF_YTC = OFF_Y + 8388608;
constexpr size_t OFF_QB = OFF_Y + 12582912;
constexpr size_t OFF_KBS = OFF_Y + 31457280;
constexpr size_t OFF_KBC = OFF_Y + 37748736;
constexpr size_t OFF_VTS = OFF_Y + 39845888;
constexpr size_t OFF_VTC = OFF_Y + 46137344;

struct Params {
  const float* in[34];
  float* out;
  char* ws;
};

typedef __bf16 bf16x2_t __attribute__((ext_vector_type(2)));
typedef float f32x2_t __attribute__((ext_vector_type(2)));
__device__ __forceinline__ unsigned pack2(float a, float b) {
  f32x2_t v = {a, b};
  bf16x2_t r = __builtin_convertvector(v, bf16x2_t);
  return __builtin_bit_cast(unsigned, r);
}
__device__ __forceinline__ u16 f2bf(float f) { return (u16)(pack2(f, 0.f) & 0xffffu); }
__device__ __forceinline__ float bf2f(u16 h) { return __uint_as_float(((unsigned)h) << 16); }
__device__ __forceinline__ float silu_f(float v) { return v * __builtin_amdgcn_rcpf(1.f + __expf(-v)); }
__device__ __forceinline__ float sigmoid_f(float v) { return __builtin_amdgcn_rcpf(1.f + __expf(-v)); }
__device__ __forceinline__ float fexp2(float v) { return __builtin_amdgcn_exp2f(v); }

__device__ __forceinline__ float xor16_sum(float x) {
  const unsigned u = __float_as_uint(x);
  auto r = __builtin_amdgcn_permlane16_swap(u, u, false, false);
  return __uint_as_float(r[0]) + __uint_as_float(r[1]);
}
__device__ __forceinline__ float xor32_sum(float x) {
  const unsigned u = __float_as_uint(x);
  auto r = __builtin_amdgcn_permlane32_swap(u, u, false, false);
  return __uint_as_float(r[0]) + __uint_as_float(r[1]);
}
__device__ __forceinline__ float xor16_max(float x) {
  const unsigned u = __float_as_uint(x);
  auto r = __builtin_amdgcn_permlane16_swap(u, u, false, false);
  return fmaxf(__uint_as_float(r[0]), __uint_as_float(r[1]));
}
__device__ __forceinline__ float xor32_max(float x) {
  const unsigned u = __float_as_uint(x);
  auto r = __builtin_amdgcn_permlane32_swap(u, u, false, false);
  return fmaxf(__uint_as_float(r[0]), __uint_as_float(r[1]));
}
__device__ __forceinline__ int cond_row(int t) { return t < T_CTX ? 8 : ((t - T_CTX) >> 10); }
__device__ __forceinline__ const float* xin(const Params& P, int t) {
  return t < T_CTX ? P.in[0] + (size_t)t * 1024 : P.in[1] + (size_t)(t - T_CTX) * 1024;
}


#define XB_TMO      128
#define XB_XCNT(j)  (256  + 64 * (j))
#define XB_XSUB(j)  (1280 + 64 * (j))
#define XB_XGEN(j)  (2304 + 64 * (j))
#define XB_TOP      3328
#define XB_TOPGEN   3392
#define XCD_BAR_WORDS 3456
#define XB_SPIN_CAP (1u << 22)
#define LAS __attribute__((address_space(3)))
__device__ __forceinline__ unsigned xb_ld(unsigned* p)              { return __hip_atomic_load(p, __ATOMIC_RELAXED, __HIP_MEMORY_SCOPE_AGENT); }
__device__ __forceinline__ unsigned xb_add(unsigned* p, unsigned v) { return __hip_atomic_fetch_add(p, v, __ATOMIC_RELAXED, __HIP_MEMORY_SCOPE_AGENT); }
__device__ __forceinline__ unsigned xb_xcc_id() { return (unsigned)__builtin_amdgcn_s_getreg((3 << 11) | 20) & 0xFu; }
#define XB_SPIN(cond, bar) do { unsigned _sp = 0; while (cond) { __builtin_amdgcn_s_sleep(1); \
    if ((++_sp & 255u) == 0u) { if (xb_ld(&(bar)[XB_TMO])) break; if (_sp > XB_SPIN_CAP) { atomicAdd(&(bar)[XB_TMO], 1u); break; } } } } while (0)
struct XcdBarrier { unsigned* bar; unsigned x; volatile LAS unsigned* st; };
__device__ __forceinline__ XcdBarrier xcd_barrier_post(unsigned* bar, volatile LAS unsigned* st) {
    XcdBarrier b; b.bar = bar; b.x = xb_xcc_id(); b.st = st;
    if (threadIdx.x == 0) (void)xb_add(&bar[XB_XCNT(b.x)], 1u);
    return b;
}
__device__ __forceinline__ void xcd_barrier_complete(unsigned* bar, unsigned x, unsigned& nloc, unsigned& nx) {
    const unsigned G = gridDim.x * gridDim.y * gridDim.z;
    unsigned sum, cnt, mine, sp = 0u;
    for (;;) {
        sum = 0u; cnt = 0u; mine = 0u;
#pragma unroll
        for (unsigned j = 0; j < 16; ++j) { const unsigned c = xb_ld(&bar[XB_XCNT(j)]); sum += c; cnt += (c > 0u) ? 1u : 0u; mine = (j == x) ? c : mine; }
        if (sum == G) break;
        __builtin_amdgcn_s_sleep(1);
        if ((++sp & 255u) == 0u) { if (xb_ld(&bar[XB_TMO])) break; if (sp > XB_SPIN_CAP) { atomicAdd(&bar[XB_TMO], 1u); break; } }
    }
    nloc = mine > 0u ? mine : 1u; nx = cnt > 0u ? cnt : 1u;
}
__device__ __forceinline__ void xcd_barrier(const XcdBarrier& b) {
    asm volatile("s_waitcnt vmcnt(0)" ::: "memory");
    __syncthreads();
    if (threadIdx.x == 0) {
        unsigned* bar = b.bar;
        __builtin_amdgcn_s_waitcnt(0);
        unsigned nloc = b.st[0], nx = b.st[1];
        if (nloc == 0u) { xcd_barrier_complete(bar, b.x, nloc, nx); b.st[0] = nloc; b.st[1] = nx; }
        const unsigned old = xb_add(&bar[XB_XSUB(b.x)], 1u);
        const unsigned gen = old / nloc;
        if (old + 1u == (gen + 1u) * nloc) {
            __builtin_amdgcn_fence(__ATOMIC_RELEASE, "agent");
            asm volatile("s_waitcnt vmcnt(0)" ::: "memory");
            const unsigned og = xb_add(&bar[XB_TOP], 1u);
            const unsigned tg = og / nx;
            if (og + 1u == (tg + 1u) * nx) xb_add(&bar[XB_TOPGEN], 1u);
            else XB_SPIN(xb_ld(&bar[XB_TOPGEN]) == tg, bar);
            __builtin_amdgcn_fence(__ATOMIC_ACQUIRE, "agent");
            xb_add(&bar[XB_XGEN(b.x)], 1u);
            asm volatile("s_waitcnt vmcnt(0)" ::: "memory");
        } else {
            XB_SPIN(xb_ld(&bar[XB_XGEN(b.x)]) == gen, bar);
            __builtin_amdgcn_fence(__ATOMIC_ACQUIRE, "agent");
            asm volatile("s_waitcnt vmcnt(0)" ::: "memory");
        }
    }
    __syncthreads();
}

using u32x4 = __attribute__((ext_vector_type(4))) unsigned int;
struct GRegs { u32x4 a0, a1, a2, a3, b0, b1; };
template <int MTW>
__device__ __forceinline__ void gemm_gload(GRegs& R, const u16* ga, const u16* gb, int lda, int ldb) {
  R.a0 = *(const u32x4*)(ga);
  R.a1 = *(const u32x4*)(ga + (size_t)64 * lda);
  R.a2 = *(const u32x4*)(ga + (size_t)128 * lda);
  if (MTW == 8) R.a3 = *(const u32x4*)(ga + (size_t)192 * lda);
  R.b0 = *(const u32x4*)(gb);
  R.b1 = *(const u32x4*)(gb + (size_t)64 * ldb);
}
template <int MTW>
__device__ __forceinline__ void gemm_swrite(const GRegs& R, u16* dA, u16* dB) {
  *(u32x4*)(dA) = R.a0;
  *(u32x4*)(dA + 64 * 40) = R.a1;
  *(u32x4*)(dA + 128 * 40) = R.a2;
  if (MTW == 8) *(u32x4*)(dA + 192 * 40) = R.a3;
  *(u32x4*)(dB) = R.b0;
  *(u32x4*)(dB + 64 * 40) = R.b1;
}

template <bool SWAP, int MTW>
__device__ __forceinline__ void gemm_compute_tile(const u16* cA, const u16* cB, f32x4 (&acc)[MTW][4]) {
  constexpr int LS = 40;
  constexpr int HM = MTW / 2;
  bf16x8 bfr[4];
#pragma unroll
  for (int j = 0; j < 4; j++) bfr[j] = *(const bf16x8*)(cB + j * 16 * LS);
#pragma unroll
  for (int h = 0; h < 2; h++) {
    bf16x8 af[HM];
#pragma unroll
    for (int i = 0; i < HM; i++) af[i] = *(const bf16x8*)(cA + (h * HM + i) * 16 * LS);
#pragma unroll
    for (int i = 0; i < HM; i++)
#pragma unroll
      for (int j = 0; j < 4; j++) {
        if (SWAP) acc[h * HM + i][j] = MFMA(bfr[j], af[i], acc[h * HM + i][j]);
        else acc[h * HM + i][j] = MFMA(af[i], bfr[j], acc[h * HM + i][j]);
      }
  }
}

template <bool SWAP, int MTW = 8>
__device__ __forceinline__ void gemm_mainloop_reg(const u16* __restrict__ A, int lda, const u16* __restrict__ Bt, int ldb,
                                              int K, u16* sm, f32x4 (&acc)[MTW][4]) {
  constexpr int LS = 40;
  const int tid = threadIdx.x, lane = tid & 63, wave = tid >> 6;
  const int wm = wave >> 1, wn = wave & 1;
  const int fr = lane & 15, fq = lane >> 4;
  u16* sA = sm;
  u16* sB = sm + 2 * 256 * LS;
  const int lr = tid >> 2, lc = (tid & 3) * 8;
  const u16* ga = A + (size_t)lr * lda + lc;
  const u16* gb = Bt + (size_t)lr * ldb + lc;
  GRegs r0, r1;
#define GLOAD(R, KT) gemm_gload<MTW>(R, ga + (KT) * 32, gb + (KT) * 32, lda, ldb);
#define SWRITE(R, BUF) gemm_swrite<MTW>(R, sA + (BUF) * 256 * LS + lr * LS + lc, sB + (BUF) * 128 * LS + lr * LS + lc);
  GLOAD(r0, 0)
  GLOAD(r1, 1)
#pragma unroll
  for (int i = 0; i < MTW; i++)
#pragma unroll
    for (int j = 0; j < 4; j++) acc[i][j] = f32x4{0.f, 0.f, 0.f, 0.f};
  SWRITE(r0, 0)
  __syncthreads();
  const int nk = K >> 5;
  const u16* cA0 = sA + (wm * 16 * MTW + fr) * LS + fq * 8;
  const u16* cB0 = sB + (wn * 64 + fr) * LS + fq * 8;
  for (int kt = 0; kt < nk; kt += 2) {
    GLOAD(r0, min(kt + 2, nk - 1))
    gemm_compute_tile<SWAP, MTW>(cA0, cB0, acc);
    SWRITE(r1, 1)
    __syncthreads();
    GLOAD(r1, min(kt + 3, nk - 1))
    gemm_compute_tile<SWAP, MTW>(cA0 + 256 * LS, cB0 + 128 * LS, acc);
    SWRITE(r0, 0)
    __syncthreads();
  }
#undef GLOAD
#undef SWRITE
}

__device__ __forceinline__ void glds16(const u16* g, char* lds) {
  __builtin_amdgcn_global_load_lds((const unsigned*)g, (unsigned*)lds, 16, 0, 0);
}
#define DSR128(dst, addr, OFF) asm volatile("ds_read_b128 %0, %1 offset:%2" : "=v"(dst) : "v"(addr), "n"(OFF))
template <bool SWAP, int MTW>
__device__ __forceinline__ void gemm_compute_glds(unsigned aA, unsigned aB, f32x4 (&acc)[MTW][4]) {
  bf16x8 bfr[4], af[MTW];
  DSR128(bfr[0], aB, 0); DSR128(bfr[1], aB, 1024); DSR128(bfr[2], aB, 2048); DSR128(bfr[3], aB, 3072);
  if (MTW == 8) {
    DSR128(af[0], aA, 0); DSR128(af[1], aA, 1024); DSR128(af[2], aA, 2048); DSR128(af[3], aA, 3072);
    DSR128(af[4], aA, 4096); DSR128(af[5], aA, 5120); DSR128(af[6], aA, 6144); DSR128(af[7], aA, 7168);
    asm volatile("s_waitcnt lgkmcnt(4)" : "+v"(bfr[0]), "+v"(bfr[1]), "+v"(bfr[2]), "+v"(bfr[3]), "+v"(af[0]), "+v"(af[1]), "+v"(af[2]), "+v"(af[3]));
  } else if (MTW == 6) {
    DSR128(af[0], aA, 0); DSR128(af[1], aA, 1024); DSR128(af[2], aA, 2048);
    DSR128(af[3], aA, 3072); DSR128(af[4], aA, 4096); DSR128(af[5], aA, 5120);
    asm volatile("s_waitcnt lgkmcnt(3)" : "+v"(bfr[0]), "+v"(bfr[1]), "+v"(bfr[2]), "+v"(bfr[3]), "+v"(af[0]), "+v"(af[1]), "+v"(af[2]));
  } else if (MTW == 4) {
    DSR128(af[0], aA, 0); DSR128(af[1], aA, 1024); DSR128(af[2], aA, 2048); DSR128(af[3], aA, 3072);
    asm volatile("s_waitcnt lgkmcnt(2)" : "+v"(bfr[0]), "+v"(bfr[1]), "+v"(bfr[2]), "+v"(bfr[3]), "+v"(af[0]), "+v"(af[1]));
  } else {
    DSR128(af[0], aA, 0); DSR128(af[1], aA, 1024);
    asm volatile("s_waitcnt lgkmcnt(1)" : "+v"(bfr[0]), "+v"(bfr[1]), "+v"(bfr[2]), "+v"(bfr[3]), "+v"(af[0]));
  }
  constexpr int HM = MTW / 2;
#pragma unroll
  for (int i = 0; i < HM; i++)
#pragma unroll
    for (int j = 0; j < 4; j++) {
      if (SWAP) acc[i][j] = MFMA(bfr[j], af[i], acc[i][j]);
      else acc[i][j] = MFMA(af[i], bfr[j], acc[i][j]);
    }
  __builtin_amdgcn_sched_barrier(0);
  if (MTW == 8) asm volatile("s_waitcnt lgkmcnt(0)" : "+v"(af[4]), "+v"(af[5]), "+v"(af[6]), "+v"(af[7]));
  else if (MTW == 6) asm volatile("s_waitcnt lgkmcnt(0)" : "+v"(af[3]), "+v"(af[4]), "+v"(af[5]));
  else if (MTW == 4) asm volatile("s_waitcnt lgkmcnt(0)" : "+v"(af[2]), "+v"(af[3]));
  else asm volatile("s_waitcnt lgkmcnt(0)" : "+v"(af[1]));
  __builtin_amdgcn_sched_barrier(0);
#pragma unroll
  for (int i = HM; i < MTW; i++)
#pragma unroll
    for (int j = 0; j < 4; j++) {
      if (SWAP) acc[i][j] = MFMA(bfr[j], af[i], acc[i][j]);
      else acc[i][j] = MFMA(af[i], bfr[j], acc[i][j]);
    }
}

template <bool SWAP, int MTW = 8>
__device__ __forceinline__ void gemm_mainloop(const u16* __restrict__ A, int lda, const u16* __restrict__ Bt, int ldb,
                                              int K, u16* sm, f32x4 (&acc)[MTW][4]) {
  constexpr int STG = 24576;
  constexpr int AW = MTW / 2;
  constexpr int NL = AW + 2;
  const int tid = threadIdx.x, lane = tid & 63, wave = tid >> 6;
  const int wm = wave >> 1, wn = wave & 1;
  const int fr = lane & 15, fq = lane >> 4;
  char* smc = (char*)sm;
  const int rowl = lane >> 2;
  const int lch = ((lane & 3) ^ (((lane >> 5) & 1) << 1)) * 8;
  const u16* gA = A + (size_t)(wave * AW * 16 + rowl) * lda + lch;
  const u16* gB = Bt + (size_t)(wave * 32 + rowl) * ldb + lch;
  char* dA = smc + (wave * AW) * 1024;
  char* dB = smc + 16384 + (wave * 2) * 1024;
  const int loff = fr * 64 + ((fq ^ (((fr >> 3) & 1) << 1)) * 16);
  const unsigned lds0 = (unsigned)(size_t)((LAS char*)smc);
  const unsigned rA = lds0 + (wm * MTW) * 1024 + loff;
  const unsigned rB = lds0 + 16384 + (wn * 4) * 1024 + loff;
#define GSTAGE(S, KT) { _Pragma("unroll") for (int _i = 0; _i < AW; _i++) glds16(gA + (size_t)(_i * 16) * lda + (KT) * 32, dA + (S) * STG + _i * 1024); \
                        _Pragma("unroll") for (int _i = 0; _i < 2; _i++) glds16(gB + (size_t)(_i * 16) * ldb + (KT) * 32, dB + (S) * STG + _i * 1024); }
#pragma unroll
  for (int i = 0; i < MTW; i++)
#pragma unroll
    for (int j = 0; j < 4; j++) acc[i][j] = f32x4{0.f, 0.f, 0.f, 0.f};
  const int nk = K >> 5;
  GSTAGE(0, 0)
  GSTAGE(1, 1)
  asm volatile("s_waitcnt vmcnt(%0)" ::"n"(NL) : "memory");
  asm volatile("s_waitcnt lgkmcnt(0)" ::: "memory");
  __builtin_amdgcn_s_barrier();
  int cur = 0;
  for (int t = 0; t < nk; t++) {
    int nx2 = cur + 2; if (nx2 >= 3) nx2 -= 3;
    const bool more = (t + 2 < nk);
    if (more) GSTAGE(nx2, t + 2)
    gemm_compute_glds<SWAP, MTW>(rA + cur * STG, rB + cur * STG, acc);
    if (more) asm volatile("s_waitcnt vmcnt(%0)" ::"n"(NL) : "memory");
    else asm volatile("s_waitcnt vmcnt(0)" ::: "memory");
    asm volatile("s_waitcnt lgkmcnt(0)" ::: "memory");
    __builtin_amdgcn_s_barrier();
    cur = (cur == 2) ? 0 : cur + 1;
  }
#undef GSTAGE
}

template <bool SWAP>
__device__ __forceinline__ void gemm_mainloop128(const u16* __restrict__ A, int lda, const u16* __restrict__ Bt, int ldb,
                                              int K, u16* sm, f32x4 (&acc)[4][4]) {
  const int tid = threadIdx.x, lane = tid & 63, wave = tid >> 6;
  const int wm = wave >> 1, wn = wave & 1;
  const int fr = lane & 15, fq = lane >> 4;
  u16* sA = sm;
  u16* sB = sm + 2 * 128 * LDT;
  const int lr = tid >> 3, lc = (tid & 7) * 8;
  const u16* ga = A + (size_t)lr * lda + lc;
  const u16* gb = Bt + (size_t)lr * ldb + lc;
  uint4 ra[4], rb[4];
#pragma unroll
  for (int i = 0; i < 4; i++) {
    ra[i] = *(const uint4*)(ga + (size_t)(i * 32) * lda);
    rb[i] = *(const uint4*)(gb + (size_t)(i * 32) * ldb);
  }
#pragma unroll
  for (int i = 0; i < 4; i++)
#pragma unroll
    for (int j = 0; j < 4; j++) acc[i][j] = f32x4{0.f, 0.f, 0.f, 0.f};
#pragma unroll
  for (int i = 0; i < 4; i++) {
    *(uint4*)(sA + (lr + i * 32) * LDT + lc) = ra[i];
    *(uint4*)(sB + (lr + i * 32) * LDT + lc) = rb[i];
  }
  __syncthreads();
  const int nk = K >> 6;
  for (int kt = 0; kt < nk; kt++) {
    const int cur = kt & 1;
    const bool more = (kt + 1 < nk);
    if (more) {
      const u16* ga2 = ga + (kt + 1) * 64;
      const u16* gb2 = gb + (kt + 1) * 64;
#pragma unroll
      for (int i = 0; i < 4; i++) {
        ra[i] = *(const uint4*)(ga2 + (size_t)(i * 32) * lda);
        rb[i] = *(const uint4*)(gb2 + (size_t)(i * 32) * ldb);
      }
    }
    const u16* cA = sA + cur * 128 * LDT + (wm * 64 + fr) * LDT + fq * 8;
    const u16* cB = sB + cur * 128 * LDT + (wn * 64 + fr) * LDT + fq * 8;
#pragma unroll
    for (int kk = 0; kk < 2; kk++) {
      bf16x8 af[4], bfr[4];
#pragma unroll
      for (int i = 0; i < 4; i++) af[i] = *(const bf16x8*)(cA + i * 16 * LDT + kk * 32);
#pragma unroll
      for (int j = 0; j < 4; j++) bfr[j] = *(const bf16x8*)(cB + j * 16 * LDT + kk * 32);
#pragma unroll
      for (int i = 0; i < 4; i++)
#pragma unroll
        for (int j = 0; j < 4; j++) {
          if (SWAP) acc[i][j] = MFMA(bfr[j], af[i], acc[i][j]);
          else acc[i][j] = MFMA(af[i], bfr[j], acc[i][j]);
        }
    }
    if (more) {
      u16* dA = sA + (cur ^ 1) * 128 * LDT;
      u16* dB = sB + (cur ^ 1) * 128 * LDT;
#pragma unroll
      for (int i = 0; i < 4; i++) {
        *(uint4*)(dA + (lr + i * 32) * LDT + lc) = ra[i];
        *(uint4*)(dB + (lr + i * 32) * LDT + lc) = rb[i];
      }
    }
    __syncthreads();
  }
}

__device__ __forceinline__ void tile_coords(int L, int MT, int NT, int& mt, int& nt) {
  const int full = NT >> 3;
  const int per = MT * 8;
  if (L < full * per) {
    int sc = L / per, r = L - sc * per;
    mt = r >> 3;
    nt = sc * 8 + (r & 7);
  } else {
    int L2 = L - full * per;
    int w = NT - full * 8;
    mt = L2 / w;
    nt = full * 8 + (L2 - mt * w);
  }
}

struct TileIter {
  int cur, end, step;
  __device__ TileIter(int ntiles) {
    int nb = gridDim.x, b = blockIdx.x;
    if ((nb & 7) == 0) {
      int per = (ntiles + 7) >> 3;
      int x = b & 7, j = b >> 3;
      cur = x * per + j;
      end = min((x + 1) * per, ntiles);
      step = nb >> 3;
    } else {
      cur = b; end = ntiles; step = nb;
    }
  }
};


constexpr size_t OFF_Q = OFF_BAR + 16384;
__device__ __forceinline__ int queue_next(unsigned* ctr, int* sh) {
  __syncthreads();
  if (threadIdx.x == 0) *sh = (int)__hip_atomic_fetch_add(ctr, 1u, __ATOMIC_RELAXED, __HIP_MEMORY_SCOPE_AGENT);
  __syncthreads();
  return *sh;
}

struct TrDesc { const float* src; u16* dst; int lds, nvalid, ldd, mode, rowoff, k0, n0; };
__device__ __forceinline__ TrDesc tr_desc(const Params& P, int j) {
  TrDesc d; int ntn; d.mode = 0; d.rowoff = 0;
  if (j < 320) { d.src = P.in[12] + 256; d.lds = 1536; d.nvalid = 1280; d.dst = (u16*)(P.ws + OFF_WIE); d.ldd = 1024; d.rowoff = 512; ntn = 20; }
  else if ((j -= 320) < 256) { d.src = P.in[15]; d.lds = 1024; d.nvalid = 1024; d.dst = (u16*)(P.ws + OFF_WOE); d.ldd = 1024; ntn = 16; }
  else if ((j -= 256) < 864) { d.src = P.in[16]; d.lds = 3360; d.nvalid = 3360; d.dst = (u16*)(P.ws + OFF_WIO); d.ldd = 1024; ntn = 54; }
  else if ((j -= 864) < 384) { d.src = P.in[30]; d.lds = 1024; d.nvalid = 1024; d.dst = (u16*)(P.ws + OFF_WOO); d.ldd = 1536; ntn = 16; }
  else if ((j -= 384) < 2816) {
    int q = j / 704; j -= q * 704; int l = q >> 1, w3 = q & 1;
    d.src = (w3 ? P.in[32] : P.in[31]) + (size_t)l * 1024 * 2816; d.lds = 2816; d.nvalid = 2816;
    d.dst = (u16*)(P.ws + OFF_W13) + (size_t)l * 5632 * 1024; d.ldd = 1024; d.mode = 1; d.rowoff = w3 * 16; ntn = 44;
  } else {
    j -= 2816; int l = j / 704; j -= l * 704;
    d.src = P.in[33] + (size_t)l * 2816 * 1024; d.lds = 1024; d.nvalid = 1024;
    d.dst = (u16*)(P.ws + OFF_W2) + (size_t)l * 1024 * 2816; d.ldd = 2816; ntn = 16;
  }
  const int kt = j / ntn, nt = j - kt * ntn;
  d.k0 = kt * 64; d.n0 = nt * 64;
  return d;
}
__device__ __forceinline__ void tr_load(const TrDesc& d, int tid, float4 (&v)[4]) {
#pragma unroll
  for (int i = 0; i < 4; i++) {
    const int r = i * 16 + (tid >> 4), n = d.n0 + (tid & 15) * 4;
    v[i] = make_float4(0.f, 0.f, 0.f, 0.f);
    if (n < d.nvalid) v[i] = *(const float4*)(d.src + (size_t)(d.k0 + r) * d.lds + n);
  }
}
__device__ __forceinline__ void tr_emit(const TrDesc& d, int tid, const float4 (&v)[4], float* tile) {
#pragma unroll
  for (int i = 0; i < 4; i++) {
    const int r = i * 16 + (tid >> 4), c4 = (tid & 15) * 4;
    tile[r * 65 + c4] = v[i].x; tile[r * 65 + c4 + 1] = v[i].y; tile[r * 65 + c4 + 2] = v[i].z; tile[r * 65 + c4 + 3] = v[i].w;
  }
  __syncthreads();
#pragma unroll
  for (int i = 0; i < 4; i++) {
    const int n = i * 16 + (tid >> 4), k4 = (tid & 15) * 4;
    const int ng = d.n0 + n;
    const int row = d.mode ? ((ng >> 4) * 32 + (ng & 15) + d.rowoff) : (ng + d.rowoff);
    uint2 o;
    o.x = pack2(tile[(k4 + 0) * 65 + n], tile[(k4 + 1) * 65 + n]);
    o.y = pack2(tile[(k4 + 2) * 65 + n], tile[(k4 + 3) * 65 + n]);
    *(uint2*)(d.dst + (size_t)row * d.ldd + d.k0 + k4) = o;
  }
  __syncthreads();
}
__device__ __forceinline__ void phase_prep(const Params& P, char* smem, int* qsh) {
  const int tid = threadIdx.x, nb = gridDim.x, bid = blockIdx.x;
  const int lane = tid & 63, wave = tid >> 6;
  float* tile = (float*)smem;
  float* tabc = (float*)(smem + 16640);
  float* tabs = tabc + 64;
  float* sc = (float*)(smem + 20480);
  float* red = (float*)(smem + 20480 + 36864);
  {
    float* prm = (float*)(P.ws + OFF_PRM);
    const int gt = bid * 256 + tid, gs = nb * 256;
#define PCOPY(SRC, OFF, N) for (int i = gt; i < (N); i += gs) prm[(OFF) + i] = (SRC)[i];
    PCOPY(P.in[10], PRM_NORM_MIX, 2048) PCOPY(P.in[11], PRM_NORM_FFN, 2048) PCOPY(P.in[13], PRM_QN, 64) PCOPY(P.in[14], PRM_KN, 64)
    PCOPY(P.in[17], PRM_CLW, 2048) PCOPY(P.in[18], PRM_CLB, 512) PCOPY(P.in[20], PRM_LBA, 1024) PCOPY(P.in[22], PRM_LBX, 1024)
    PCOPY(P.in[23], PRM_LAM, 1024) PCOPY(P.in[24], PRM_CSW, 5120) PCOPY(P.in[25], PRM_CSB, 1280) PCOPY(P.in[26], PRM_DTB, 32)
    PCOPY(P.in[27], PRM_ALOG, 32) PCOPY(P.in[28], PRM_SSDD, 16) PCOPY(P.in[29], PRM_SNORM, 1024)
    PCOPY(P.in[19], PRM_LWA, 65536) PCOPY(P.in[21], PRM_LWX, 65536)
#undef PCOPY
  }
  bool sc_ready = false;
  constexpr int N_MOD = 384, N_FF = 64, N_TR = 6048, N_DFT = 544, N_CACHE = 512;
  constexpr int N_ALL = N_MOD + N_FF + N_TR + N_DFT + N_CACHE;
  for (int it = bid; it < N_ALL; it += nb) {
    int j = it;
    if (j < N_MOD) {
      if (!sc_ready) {
        for (int i = tid; i < 9 * 1024; i += 256) {
          int r = i >> 10, k = i & 1023;
          float c = r < 8 ? P.in[2][r * 1024 + k] : P.in[7][k];
          sc[i] = silu_f(c);
        }
        __syncthreads();
        sc_ready = true;
      }
      const int l = j / 192, n0 = (j % 192) * 32;
      const int cgp = tid & 7, kl = tid >> 3;
      float acc[9][4];
#pragma unroll
      for (int r = 0; r < 9; r++)
#pragma unroll
        for (int c = 0; c < 4; c++) acc[r][c] = 0.f;
      const float* w = P.in[8] + (size_t)l * 1024 * 6144 + n0 + cgp * 4;
#pragma unroll 4
      for (int i = 0; i < 32; i++) {
        const int k = i * 32 + kl;
        const float4 wv = *(const float4*)(w + (size_t)k * 6144);
#pragma unroll
        for (int r = 0; r < 9; r++) {
          const float s = sc[r * 1024 + k];
          acc[r][0] += s * wv.x; acc[r][1] += s * wv.y; acc[r][2] += s * wv.z; acc[r][3] += s * wv.w;
        }
      }
#pragma unroll
      for (int r = 0; r < 9; r++)
#pragma unroll
        for (int c = 0; c < 4; c++) {
          float v = acc[r][c];
          v += __shfl_xor(v, 8); v = xor16_sum(v); v = xor32_sum(v);
          acc[r][c] = v;
        }
      if (lane < 8) {
#pragma unroll
        for (int r = 0; r < 9; r++)
#pragma unroll
          for (int c = 0; c < 4; c++) red[(wave * 9 + r) * 32 + cgp * 4 + c] = acc[r][c];
      }
      __syncthreads();
      float* MOD = (float*)(P.ws + OFF_MOD);
      for (int i = tid; i < 288; i += 256) {
        int r = i >> 5, c = i & 31;
        float s = red[(0 * 9 + r) * 32 + c] + red[(1 * 9 + r) * 32 + c] + red[(2 * 9 + r) * 32 + c] + red[(3 * 9 + r) * 32 + c];
        MOD[(l * 9 + r) * 6144 + n0 + c] = s + P.in[9][l * 6144 + n0 + c];
      }
      __syncthreads();
      continue;
    }
    j -= N_MOD;
    if (j < N_FF) {
      const int g = j >> 4, kt = j & 15;
      if (tid < 64) { tabc[tid] = cospif(tid / 32.0f); tabs[tid] = sinpif(tid / 32.0f); }
      const float* src = P.in[12] + (size_t)(kt * 64) * 1536 + g * 64;
#pragma unroll
      for (int i = 0; i < 4; i++) {
        int r = i * 16 + (tid >> 4), c4 = (tid & 15) * 4;
        float4 v = *(const float4*)(src + (size_t)r * 1536 + c4);
        tile[r * 65 + c4] = v.x; tile[r * 65 + c4 + 1] = v.y; tile[r * 65 + c4 + 2] = v.z; tile[r * 65 + c4 + 3] = v.w;
      }
      __syncthreads();
      const int np = tid & 127, kh = tid >> 7;
      const int wsel = np >> 6, cp = np & 63;
      float acc[32];
#pragma unroll
      for (int i = 0; i < 32; i++) acc[i] = 0.f;
      for (int c = 0; c < 64; c++) {
        const int idx = (c * cp) & 63;
        const float coef = wsel ? tabs[idx] : tabc[idx];
#pragma unroll
        for (int i = 0; i < 32; i++) acc[i] += tile[(kh * 32 + i) * 65 + c] * coef;
      }
      u16* dst = (u16*)(P.ws + OFF_WIE) + (size_t)(g * 128 + np) * 1024 + kt * 64 + kh * 32;
#pragma unroll
      for (int i = 0; i < 4; i++) {
        uint4 o;
        o.x = pack2(acc[i * 8 + 0], acc[i * 8 + 1]); o.y = pack2(acc[i * 8 + 2], acc[i * 8 + 3]);
        o.z = pack2(acc[i * 8 + 4], acc[i * 8 + 5]); o.w = pack2(acc[i * 8 + 6], acc[i * 8 + 7]);
        *(uint4*)(dst + i * 8) = o;
      }
      __syncthreads();
      continue;
    }
    j -= N_FF;
    if (j < N_TR) continue;
    j -= N_TR;
    if (j < N_DFT) {
      if (j < 512) {
        u16* D = (u16*)(P.ws + OFF_D1K);
        const int e0 = j * 4096;
        for (int i = 0; i < 16; i++) {
          int e = e0 + i * 256 + tid;
          int sp = e >> 11, k = e & 2047;
          float v;
          if (k < 1024) { int r = (sp * k) & 1023; v = cospif(r * (1.0f / 512.0f)); }
          else { int r = (sp * (k - 1024)) & 1023; v = -sinpif(r * (1.0f / 512.0f)); }
          D[e] = f2bf(v * (1.0f / 256.0f));
        }
      } else {
        u16* D = (u16*)(P.ws + OFF_D256);
        const int e0 = (j - 512) * 4096;
        for (int i = 0; i < 16; i++) {
          int e = e0 + i * 256 + tid;
          int sp = e >> 9, k = e & 511;
          float v;
          if (k < 256) { int r = (sp * k) & 255; v = cospif(r * (1.0f / 128.0f)); }
          else { int r = (sp * (k - 256)) & 255; v = -sinpif(r * (1.0f / 128.0f)); }
          D[e] = f2bf(v * (1.0f / 128.0f));
        }
      }
      continue;
    }
    j -= N_DFT;
    {
      const bool isv = j >= 256;
      const int e0 = (isv ? j - 256 : j) * 4096;
      const float* src = isv ? P.in[4] : P.in[3];
      u16* KB = (u16*)(P.ws + OFF_KBS);
      u16* VT = (u16*)(P.ws + OFF_VTS);
      for (int i = 0; i < 16; i++) {
        int e = e0 + i * 256 + tid;
        int b = e >> 17, p = (e >> 8) & 511, h = (e >> 6) & 3, d = e & 63;
        u16 v = f2bf(src[e]);
        if (!isv) KB[((size_t)(b * 4 + h) * 1536 + 1024 + p) * 64 + d] = v;
        else VT[((size_t)(b * 4 + h) * 64 + d) * 1536 + 1024 + p] = v;
      }
    }
  }
  {
    unsigned* ctr = (unsigned*)(P.ws + OFF_BAR + 20480);
    for (;;) {
      const int k = queue_next(ctr, qsh);
      const int j0 = 2 * k;
      if (j0 >= N_TR) break;
      const TrDesc d0 = tr_desc(P, j0);
      const TrDesc d1 = tr_desc(P, j0 + 1);
      float4 v0[4], v1[4];
      tr_load(d0, tid, v0);
      tr_load(d1, tid, v1);
      tr_emit(d0, tid, v0, tile);
      tr_emit(d1, tid, v1, tile);
    }
  }
}

__device__ __forceinline__ void phase_norm(const Params& P, int l, int which) {
  const int tid = threadIdx.x, lane = tid & 63, wave = tid >> 6;
  const float* MOD = (const float*)(P.ws + OFF_MOD);
  const float* gvec = PRM(P, (which ? PRM_NORM_FFN : PRM_NORM_MIX) + l * 1024);
  u16* H = (u16*)(P.ws + OFF_H);
  const int nwaves = gridDim.x * 4;
  const int rpw = (T_ALL + nwaves - 1) / nwaves;
  const int r0 = (blockIdx.x * 4 + wave) * rpw;
  const int r1 = min(r0 + rpw, T_ALL);
  constexpr int NR = 3;
  const int osh = (which ? 3 : 0) * 1024, osc = (which ? 4 : 1) * 1024;
  float4 gm[4], sh[4];
  int cached = -1;
  for (int t0 = r0; t0 < r1; t0 += NR) {
    float4 v[NR][4];
#pragma unroll
    for (int r = 0; r < NR; r++) {
      const int t = min(t0 + r, r1 - 1);
      const float* x = (l == 0 && which == 0) ? xin(P, t) : P.out + (size_t)t * 1024;
#pragma unroll
      for (int j = 0; j < 4; j++) v[r][j] = *(const float4*)(x + j * 256 + lane * 4);
    }
    float ss[NR];
#pragma unroll
    for (int r = 0; r < NR; r++) {
      float a = 0.f;
#pragma unroll
      for (int j = 0; j < 4; j++) a += v[r][j].x * v[r][j].x + v[r][j].y * v[r][j].y + v[r][j].z * v[r][j].z + v[r][j].w * v[r][j].w;
      ss[r] = a;
    }
#pragma unroll
    for (int o = 32; o >= 1; o >>= 1) {
#pragma unroll
      for (int r = 0; r < NR; r++) ss[r] += __shfl_xor(ss[r], o);
    }
#pragma unroll
    for (int r = 0; r < NR; r++) {
      const int t = t0 + r;
      if (t >= r1) continue;
      const int cr = cond_row(t);
      if (cr != cached) {
        cached = cr;
        const float* mb = MOD + (size_t)(l * 9 + cr) * 6144;
#pragma unroll
        for (int j = 0; j < 4; j++) {
          const int c = j * 256 + lane * 4;
          const float4 g = *(const float4*)(gvec + c);
          const float4 cm = *(const float4*)(mb + osc + c);
          sh[j] = *(const float4*)(mb + osh + c);
          gm[j] = make_float4(g.x * (1.f + cm.x), g.y * (1.f + cm.y), g.z * (1.f + cm.z), g.w * (1.f + cm.w));
        }
      }
      const float rs = rsqrtf(ss[r] * (1.0f / 1024.0f) + 1e-6f);
#pragma unroll
      for (int j = 0; j < 4; j++) {
        const int c = j * 256 + lane * 4;
        uint2 o;
        o.x = pack2(v[r][j].x * rs * gm[j].x + sh[j].x, v[r][j].y * rs * gm[j].y + sh[j].y);
        o.y = pack2(v[r][j].z * rs * gm[j].z + sh[j].z, v[r][j].w * rs * gm[j].w + sh[j].w);
        *(uint2*)(H + (size_t)t * 1024 + c) = o;
      }
    }
  }
}

__device__ __forceinline__ void phase_gemm_in_even(const Params& P, char* smem) {
  const int tid = threadIdx.x, lane = tid & 63, wave = tid >> 6;
  const int wm = wave >> 1, wn = wave & 1, fr = lane & 15, fq = lane >> 4;
  const u16* A = (const u16*)(P.ws + OFF_H);
  const u16* W = (const u16*)(P.ws + OFF_WIE);
  constexpr int MT = 48, NT = 14;
  for (TileIter ti(MT * NT); ti.cur < ti.end; ti.cur += ti.step) {
    int mtile, ntile;
    tile_coords(ti.cur, MT, NT, mtile, ntile);
    const int m0 = mtile * 256, n0 = ntile * 128;
    f32x4 acc[8][4];
    const bool swap = (ntile >= 4 && ntile < 12);
    if (swap) gemm_mainloop<true, 8>(A + (size_t)m0 * 1024, 1024, W + (size_t)n0 * 1024, 1024, 1024, (u16*)smem, acc);
    else gemm_mainloop<false, 8>(A + (size_t)m0 * 1024, 1024, W + (size_t)n0 * 1024, 1024, 1024, (u16*)smem, acc);
    const bool smp = m0 >= T_CTX;
    int fr_e = fr, fq_e = fq;
    asm volatile("" : "+v"(fr_e), "+v"(fq_e));
    u16* stg = (u16*)smem + wave * (128 * 72);
    if (ntile < 4) {
      const int g = ntile;
      u16* YT; int S, seq, sbase;
      if (smp) { YT = (u16*)(P.ws + OFF_YTS); S = 1024; seq = (m0 - T_CTX) >> 10; sbase = (m0 - T_CTX) & 1023; }
      else { YT = (u16*)(P.ws + OFF_YTC); S = 256; seq = m0 >> 8; sbase = m0 & 255; }
      u16* base = YT + (size_t)seq * 256 * 2 * S;
      u16* stgT = (u16*)smem + wave * (64 * 136);
#pragma unroll
      for (int mt = 0; mt < 8; mt++)
#pragma unroll
        for (int nt = 0; nt < 4; nt++) {
          uint2 o;
          o.x = pack2(acc[mt][nt][0], acc[mt][nt][1]);
          o.y = pack2(acc[mt][nt][2], acc[mt][nt][3]);
          *(uint2*)(stgT + (nt * 16 + fr_e) * 136 + mt * 16 + fq_e * 4) = o;
        }
      {
        const int rr = lane >> 4, cc = (lane & 15) * 8;
        u16* dst = base + (size_t)(g * 64 + rr) * 2 * S + wn * S + sbase + wm * 128 + cc;
#pragma unroll
        for (int i = 0; i < 16; i++) {
          const u32x4 v = *(const u32x4*)(stgT + (i * 4 + rr) * 136 + cc);
          *(u32x4*)(dst + (size_t)(i * 4) * 2 * S) = v;
        }
      }
    } else if (ntile < 12) {
      const bool isq = ntile < 10;
      const int hcol = n0 + wn * 64 - (isq ? 512 : 1280);
      const int head = hcol >> 6;
      const float* gn = PRM(P, isq ? PRM_QN : PRM_KN);
#pragma unroll
      for (int mt = 0; mt < 8; mt++) {
        __builtin_amdgcn_sched_barrier(0);
        const int t = m0 + wm * 128 + mt * 16 + fr_e;
        float ss = 0.f;
#pragma unroll
        for (int nt = 0; nt < 4; nt++)
#pragma unroll
          for (int r = 0; r < 4; r++) ss += acc[mt][nt][r] * acc[mt][nt][r];
        ss = xor16_sum(ss);
        ss = xor32_sum(ss);
        const float rs = rsqrtf(ss * (1.0f / 64.0f) + 1e-6f);
#pragma unroll
        for (int nt = 0; nt < 4; nt++) {
          const float4 g4 = *(const float4*)(gn + nt * 16 + fq_e * 4);
          acc[mt][nt][0] *= rs * g4.x; acc[mt][nt][1] *= rs * g4.y; acc[mt][nt][2] *= rs * g4.z; acc[mt][nt][3] *= rs * g4.w;
        }
        if (!smp && !isq) {
          float* nk = P.out + 12582912 + (size_t)t * 256 + head * 64;
#pragma unroll
          for (int nt = 0; nt < 4; nt++)
            *(float4*)(nk + nt * 16 + fq_e * 4) = make_float4(acc[mt][nt][0], acc[mt][nt][1], acc[mt][nt][2], acc[mt][nt][3]);
        }
        if (smp) {
          const int s = (t - T_CTX) & 1023;
          const float prow = (float)(s >> 6), pcol = (float)(s & 63);
#pragma unroll
          for (int r = 0; r < 4; r++) {
            const float fre = exp2f(-(float)(fq_e * 4 + r) * (13.287712379549449f / 16.0f));
            const float a0 = prow * fre, a1 = pcol * fre;
            const float c0 = __cosf(a0), s0 = __sinf(a0), c1 = __cosf(a1), s1 = __sinf(a1);
            const float x1 = acc[mt][0][r], x2 = acc[mt][1][r];
            acc[mt][0][r] = x1 * c0 - x2 * s0; acc[mt][1][r] = x2 * c0 + x1 * s0;
            const float y1 = acc[mt][2][r], y2 = acc[mt][3][r];
            acc[mt][2][r] = y1 * c1 - y2 * s1; acc[mt][3][r] = y2 * c1 + y1 * s1;
          }
        }
        {
          const float qs = isq ? 0.125f * LOG2E : 1.0f;
#pragma unroll
          for (int nt = 0; nt < 4; nt++) {
            uint2 o;
            o.x = pack2(acc[mt][nt][0] * qs, acc[mt][nt][1] * qs);
            o.y = pack2(acc[mt][nt][2] * qs, acc[mt][nt][3] * qs);
            *(uint2*)(stg + (mt * 16 + fr_e) * 72 + nt * 16 + fq_e * 4) = o;
          }
        }
      }
      {
        const int rr = lane >> 3, cc = (lane & 7) * 8;
        const int tr0 = m0 + wm * 128;
        u16* dst;
        size_t rstride;
        if (isq) { dst = (u16*)(P.ws + OFF_QB) + (size_t)tr0 * 768 + head * 64; rstride = 768; }
        else if (smp) { const int sq = (tr0 - T_CTX) >> 10, key = (tr0 - T_CTX) & 1023; dst = (u16*)(P.ws + OFF_KBS) + ((size_t)(sq * 4 + head) * 1536 + key) * 64; rstride = 64; }
        else { const int sq = tr0 >> 8, key = tr0 & 255; dst = (u16*)(P.ws + OFF_KBC) + ((size_t)(sq * 4 + head) * 256 + key) * 64; rstride = 64; }
        dst += (size_t)rr * rstride + cc;
#pragma unroll
        for (int i = 0; i < 16; i++) {
          const u32x4 v = *(const u32x4*)(stg + (i * 8 + rr) * 72 + cc);
          *(u32x4*)(dst + (size_t)(i * 8) * rstride) = v;
        }
      }
    } else {
      const int head = (n0 + wn * 64 - 1536) >> 6;
      u16* stgT = (u16*)smem + wave * (64 * 136);
#pragma unroll
      for (int mt = 0; mt < 8; mt++) {
        const int t = m0 + wm * 128 + mt * 16 + fq_e * 4;
#pragma unroll
        for (int nt = 0; nt < 4; nt++) {
          const int d = nt * 16 + fr_e;
          uint2 o;
          o.x = pack2(acc[mt][nt][0], acc[mt][nt][1]);
          o.y = pack2(acc[mt][nt][2], acc[mt][nt][3]);
          *(uint2*)(stgT + d * 136 + mt * 16 + fq_e * 4) = o;
          if (!smp) {
            float* nv = P.out + 13631488 + (size_t)t * 256 + head * 64 + d;
#pragma unroll
            for (int r = 0; r < 4; r++) nv[(size_t)r * 256] = acc[mt][nt][r];
          }
        }
      }
      {
        const int rr = lane >> 4, cc = (lane & 15) * 8;
        const int tr0 = m0 + wm * 128;
        u16* dst; size_t rstride;
        if (smp) { const int sq = (tr0 - T_CTX) >> 10, key = (tr0 - T_CTX) & 1023; dst = (u16*)(P.ws + OFF_VTS) + ((size_t)(sq * 4 + head) * 64) * 1536 + key; rstride = 1536; }
        else { const int sq = tr0 >> 8, key = tr0 & 255; dst = (u16*)(P.ws + OFF_VTC) + ((size_t)(sq * 4 + head) * 64) * 256 + key; rstride = 256; }
        dst += (size_t)rr * rstride + cc;
#pragma unroll
        for (int i = 0; i < 16; i++) {
          const u32x4 v = *(const u32x4*)(stgT + (i * 4 + rr) * 136 + cc);
          *(u32x4*)(dst + (size_t)(i * 4) * rstride) = v;
        }
      }
    }
    __syncthreads();
  }
}

__device__ __forceinline__ void phase_gemm_resid(const Params& P, char* smem, const u16* A, int lda, const u16* W, int K,
                                 int l, int gate_idx, bool from_x) {
  const int tid = threadIdx.x, lane = tid & 63, wave = tid >> 6;
  const int wm = wave >> 1, wn = wave & 1, fr = lane & 15, fq = lane >> 4;
  const float* MOD = (const float*)(P.ws + OFF_MOD);
  constexpr int MT = 64, NT = 8;
  float* stg = (float*)smem + wave * (48 * 68);
  for (TileIter ti(MT * NT); ti.cur < ti.end; ti.cur += ti.step) {
    int mtile, ntile;
    tile_coords(ti.cur, MT, NT, mtile, ntile);
    const int m0 = mtile * 192, n0 = ntile * 128;
    f32x4 acc[6][4];
    gemm_mainloop<true, 6>(A + (size_t)m0 * lda, lda, W + (size_t)n0 * K, K, K, (u16*)smem, acc);
#pragma unroll
    for (int h = 0; h < 2; h++) {
#pragma unroll
      for (int mt = 0; mt < 3; mt++)
#pragma unroll
        for (int nt = 0; nt < 4; nt++)
          *(f32x4*)(stg + (mt * 16 + fr) * 68 + nt * 16 + fq * 4) = acc[h * 3 + mt][nt];
      const int rr = lane >> 4, c4 = (lane & 15) * 4;
      const int n = n0 + wn * 64 + c4;
#pragma unroll
      for (int i = 0; i < 12; i++) {
        const int row = i * 4 + rr;
        const int t = m0 + wm * 96 + h * 48 + row;
        const float4 a4 = *(const float4*)(stg + row * 68 + c4);
        const float4 g = *(const float4*)(MOD + (size_t)(l * 9 + cond_row(t)) * 6144 + gate_idx * 1024 + n);
        const float* bp = from_x ? xin(P, t) : P.out + (size_t)t * 1024;
        const float4 bsv = *(const float4*)(bp + n);
        float4 o;
        o.x = bsv.x + g.x * a4.x; o.y = bsv.y + g.y * a4.y; o.z = bsv.z + g.z * a4.z; o.w = bsv.w + g.w * a4.w;
        *(float4*)(P.out + (size_t)t * 1024 + n) = o;
      }
    }
    __syncthreads();
  }
}

template <int MTW>
__device__ __forceinline__ void ffn_up_tile(const u16* A, const u16* W, u16* U, char* smem, int m0, int n0) {
  const int tid = threadIdx.x, lane = tid & 63, wave = tid >> 6;
  const int wm = wave >> 1, wn = wave & 1, fr = lane & 15, fq = lane >> 4;
  f32x4 acc[MTW][4];
  gemm_mainloop<true, MTW>(A + (size_t)m0 * 1024, 1024, W + (size_t)n0 * 1024, 1024, 1024, (u16*)smem, acc);
  constexpr int R = 16 * MTW;
  u16* stg = (u16*)smem + wm * (R * 72);
#pragma unroll
  for (int mt = 0; mt < MTW; mt++) {
#pragma unroll
    for (int np = 0; np < 2; np++) {
      float r[4];
#pragma unroll
      for (int q = 0; q < 4; q++) r[q] = silu_f(acc[mt][np * 2][q]) * acc[mt][np * 2 + 1][q];
      uint2 o;
      o.x = pack2(r[0], r[1]); o.y = pack2(r[2], r[3]);
      *(uint2*)(stg + (mt * 16 + fr) * 72 + wn * 32 + np * 16 + fq * 4) = o;
    }
  }
  __syncthreads();
  {
    const int rr = lane >> 3, cc = (lane & 7) * 8;
    const int row0 = wn * (R / 2) + rr;
    u16* dst = U + (size_t)(m0 + wm * R + row0) * 2816 + (n0 >> 1) + cc;
#pragma unroll
    for (int i = 0; i < MTW; i++) {
      const u32x4 v = *(const u32x4*)(stg + (row0 + i * 8) * 72 + cc);
      *(u32x4*)(dst + (size_t)(i * 8) * 2816) = v;
    }
  }
  __syncthreads();
}

__device__ __forceinline__ void phase_gemm_ffn_up(const Params& P, char* smem, int l) {
  const u16* A = (const u16*)(P.ws + OFF_H);
  const u16* W = (const u16*)(P.ws + OFF_W13) + (size_t)l * 5632 * 1024;
  u16* U = (u16*)(P.ws + OFF_R1);
  constexpr int MT = 48, NT = 44;
  constexpr int NFULL = 2048;
  for (TileIter ti(NFULL); ti.cur < ti.end; ti.cur += ti.step) {
    int mtile, ntile;
    tile_coords(ti.cur, MT, NT, mtile, ntile);
    ffn_up_tile<8>(A, W, U, smem, mtile * 256, ntile * 128);
  }
  for (TileIter ti((MT * NT - NFULL) * 4); ti.cur < ti.end; ti.cur += ti.step) {
    int mtile, ntile;
    tile_coords(NFULL + (ti.cur >> 2), MT, NT, mtile, ntile);
    ffn_up_tile<2>(A, W, U, smem, mtile * 256 + (ti.cur & 3) * 64, ntile * 128);
  }
}

__device__ __forceinline__ void phase_gemm_in_odd(const Params& P, char* smem) {
  const int tid = threadIdx.x, lane = tid & 63, wave = tid >> 6;
  const int wm = wave >> 1, wn = wave & 1, fr = lane & 15, fq = lane >> 4;
  const u16* A = (const u16*)(P.ws + OFF_H);
  const u16* W = (const u16*)(P.ws + OFF_WIO);
  u16* PO = (u16*)(P.ws + OFF_R1);
  float* DT = (float*)(P.ws + OFF_DT);
  constexpr int MT = 48, NT = 27;
  u16* stg = (u16*)smem + wave * (128 * 72);
  for (TileIter ti(MT * NT); ti.cur < ti.end; ti.cur += ti.step) {
    int mtile, ntile;
    tile_coords(ti.cur, MT, NT, mtile, ntile);
    const int m0 = mtile * 256, n0 = ntile * 128;
    f32x4 acc[8][4];
    gemm_mainloop<true>(A + (size_t)m0 * 1024, 1024, W + (size_t)n0 * 1024, 1024, 1024, (u16*)smem, acc);
#pragma unroll
    for (int mt = 0; mt < 8; mt++) {
#pragma unroll
      for (int nt = 0; nt < 4; nt++) {
        uint2 o;
        o.x = pack2(acc[mt][nt][0], acc[mt][nt][1]);
        o.y = pack2(acc[mt][nt][2], acc[mt][nt][3]);
        *(uint2*)(stg + (mt * 16 + fr) * 72 + nt * 16 + fq * 4) = o;
        const int n = n0 + wn * 64 + nt * 16 + fq * 4;
        if (n >= 3328 && n < 3360) {
          const int t = m0 + wm * 128 + mt * 16 + fr;
          *(float4*)(DT + (size_t)t * 32 + (n - 3328)) = make_float4(acc[mt][nt][0], acc[mt][nt][1], acc[mt][nt][2], acc[mt][nt][3]);
        }
      }
    }
    {
      const int rr = lane >> 3, cc = (lane & 7) * 8;
      u16* dst = PO + (size_t)(m0 + wm * 128 + rr) * 3456 + n0 + wn * 64 + cc;
#pragma unroll
      for (int i = 0; i < 16; i++) {
        const u32x4 v = *(const u32x4*)(stg + (i * 8 + rr) * 72 + cc);
        *(u32x4*)(dst + (size_t)(i * 8) * 3456) = v;
      }
    }
    __syncthreads();
  }
}

__device__ __forceinline__ void fourier_tile(const Params& P, int item, char* smem) {
  const int tid = threadIdx.x, lane = tid & 63, wave = tid >> 6;
  const int wm = wave >> 1, wn = wave & 1, fr = lane & 15, fq = lane >> 4;
  const u16 *D, *YT; int S, tb, mtile, ntile;
  if (item < 128) {
    int seq = item >> 4, r = item & 15; mtile = r >> 1; ntile = r & 1; S = 1024; tb = T_CTX + seq * 1024;
    D = (const u16*)(P.ws + OFF_D1K); YT = (const u16*)(P.ws + OFF_YTS) + (size_t)seq * 256 * 2048;
  } else {
    item -= 128; int seq = item >> 2, r = item & 3; mtile = r >> 1; ntile = r & 1; S = 256; tb = seq * 256;
    D = (const u16*)(P.ws + OFF_D256); YT = (const u16*)(P.ws + OFF_YTC) + (size_t)seq * 256 * 512;
  }
  f32x4 acc[4][4];
  const int K = 2 * S;
  gemm_mainloop<true, 4>(D + (size_t)(mtile * 128) * K, K, YT + (size_t)(ntile * 128) * K, K, K, (u16*)smem, acc);
  u16* MIX = (u16*)(P.ws + OFF_H);
#pragma unroll
  for (int mt = 0; mt < 4; mt++) {
    const int t = tb + mtile * 128 + wm * 64 + mt * 16 + fr;
#pragma unroll
    for (int nt = 0; nt < 4; nt++) {
      const int n = ntile * 128 + wn * 64 + nt * 16 + fq * 4;
      uint2 o;
      o.x = pack2(acc[mt][nt][0], acc[mt][nt][1]);
      o.y = pack2(acc[mt][nt][2], acc[mt][nt][3]);
      *(uint2*)(MIX + (size_t)t * 1024 + n) = o;
    }
  }
}

__device__ __forceinline__ void attn_item(const Params& P, int item, char* smem) {
  const int tid = threadIdx.x, lane = tid & 63, wave = tid >> 6;
  const int fr = lane & 15, fq = lane >> 4;
  bool smp; int seq, head, qb;
  if (item < 768) { smp = true; seq = item / 96; int r = item % 96; head = r >> 3; qb = r & 7; }
  else { item -= 768; smp = false; seq = item / 24; int r = item % 24; head = r >> 1; qb = r & 1; }
  const int nkeys = smp ? 1536 : 256;
  const int tb = smp ? T_CTX + seq * 1024 : seq * 256;
  const int kvh = head / 3;
  const u16* Kp = (const u16*)(P.ws + (smp ? OFF_KBS : OFF_KBC)) + (size_t)((seq * 4 + kvh) * nkeys) * 64;
  const u16* Vp = (const u16*)(P.ws + (smp ? OFF_VTS : OFF_VTC)) + (size_t)((seq * 4 + kvh) * 64) * nkeys;
  const u16* QB = (const u16*)(P.ws + OFF_QB);
  u16* sK = (u16*)smem;
  u16* sV = sK + 2 * 64 * LDT;
  bf16x8 qf[2][2];
  const int qrow0 = tb + qb * 128 + wave * 32;
#pragma unroll
  for (int qt = 0; qt < 2; qt++)
#pragma unroll
    for (int kk = 0; kk < 2; kk++)
      qf[qt][kk] = *(const bf16x8*)(QB + (size_t)(qrow0 + qt * 16 + fr) * 768 + head * 64 + kk * 32 + fq * 8);
  f32x4 ot[2][4];
#pragma unroll
  for (int a = 0; a < 2; a++)
#pragma unroll
    for (int b = 0; b < 4; b++) ot[a][b] = f32x4{0.f, 0.f, 0.f, 0.f};
  float mrun[2] = {-INFINITY, -INFINITY}, lrun[2] = {0.f, 0.f};
  const int lrow = tid >> 3, lcol = (tid & 7) * 8;
  uint4 rk[2], rv[2];
#pragma unroll
  for (int i = 0; i < 2; i++) {
    rk[i] = *(const uint4*)(Kp + (size_t)(lrow + i * 32) * 64 + lcol);
    rv[i] = *(const uint4*)(Vp + (size_t)(lrow + i * 32) * nkeys + lcol);
  }
#pragma unroll
  for (int i = 0; i < 2; i++) {
    *(uint4*)(sK + (lrow + i * 32) * LDT + lcol) = rk[i];
    *(uint4*)(sV + (lrow + i * 32) * LDT + lcol) = rv[i];
  }
  __syncthreads();
  const int nkt = nkeys >> 6;
  for (int kt = 0; kt < nkt; kt++) {
    const int cur = kt & 1;
    const bool more = kt + 1 < nkt;
    if (more) {
      const int key0 = (kt + 1) * 64;
#pragma unroll
      for (int i = 0; i < 2; i++) {
        rk[i] = *(const uint4*)(Kp + (size_t)(key0 + lrow + i * 32) * 64 + lcol);
        rv[i] = *(const uint4*)(Vp + (size_t)(lrow + i * 32) * nkeys + key0 + lcol);
      }
    }
    const u16* cK = sK + cur * 64 * LDT;
    const u16* cV = sV + cur * 64 * LDT;
    f32x4 st[2][4];
#pragma unroll
    for (int k16 = 0; k16 < 4; k16++) {
      const bf16x8 kf0 = *(const bf16x8*)(cK + (k16 * 16 + fr) * LDT + fq * 8);
      const bf16x8 kf1 = *(const bf16x8*)(cK + (k16 * 16 + fr) * LDT + 32 + fq * 8);
#pragma unroll
      for (int qt = 0; qt < 2; qt++) {
        f32x4 z = f32x4{0.f, 0.f, 0.f, 0.f};
        z = MFMA(kf0, qf[qt][0], z);
        st[qt][k16] = MFMA(kf1, qf[qt][1], z);
      }
    }
    bf16x8 pf[2][2];
#pragma unroll
    for (int qt = 0; qt < 2; qt++) {
      float mx = st[qt][0][0];
#pragma unroll
      for (int k16 = 0; k16 < 4; k16++)
#pragma unroll
        for (int r = 0; r < 4; r++) mx = fmaxf(mx, st[qt][k16][r]);
      mx = xor16_max(mx);
      mx = xor32_max(mx);
      if (!__all(mx - mrun[qt] <= 8.0f)) {
        const float mnew = fmaxf(mrun[qt], mx);
        const float alpha = fexp2(mrun[qt] - mnew);
        mrun[qt] = mnew;
        lrun[qt] *= alpha;
#pragma unroll
        for (int dt = 0; dt < 4; dt++)
#pragma unroll
          for (int r = 0; r < 4; r++) ot[qt][dt][r] *= alpha;
      }
      const float mcur = mrun[qt];
      float ps = 0.f;
#pragma unroll
      for (int k16 = 0; k16 < 4; k16++)
#pragma unroll
        for (int r = 0; r < 4; r++) {
          const float p = fexp2(st[qt][k16][r] - mcur);
          st[qt][k16][r] = p;
          ps += p;
        }
      lrun[qt] += ps;
#pragma unroll
      for (int a = 0; a < 2; a++) {
        union { bf16x8 v; unsigned u[4]; } pk;
        pk.u[0] = pack2(st[qt][2 * a][0], st[qt][2 * a][1]);
        pk.u[1] = pack2(st[qt][2 * a][2], st[qt][2 * a][3]);
        pk.u[2] = pack2(st[qt][2 * a + 1][0], st[qt][2 * a + 1][1]);
        pk.u[3] = pack2(st[qt][2 * a + 1][2], st[qt][2 * a + 1][3]);
        pf[qt][a] = pk.v;
      }
    }
#pragma unroll
    for (int a = 0; a < 2; a++)
#pragma unroll
      for (int dt = 0; dt < 4; dt++) {
        union { bf16x8 v; uint2 h[2]; } vf;
        vf.h[0] = *(const uint2*)(cV + (dt * 16 + fr) * LDT + a * 32 + fq * 4);
        vf.h[1] = *(const uint2*)(cV + (dt * 16 + fr) * LDT + a * 32 + 16 + fq * 4);
#pragma unroll
        for (int qt = 0; qt < 2; qt++) ot[qt][dt] = MFMA(vf.v, pf[qt][a], ot[qt][dt]);
      }
    if (more) {
      u16* dK = sK + (cur ^ 1) * 64 * LDT;
      u16* dV = sV + (cur ^ 1) * 64 * LDT;
#pragma unroll
      for (int i = 0; i < 2; i++) {
        *(uint4*)(dK + (lrow + i * 32) * LDT + lcol) = rk[i];
        *(uint4*)(dV + (lrow + i * 32) * LDT + lcol) = rv[i];
      }
    }
    __syncthreads();
  }
  u16* MIX = (u16*)(P.ws + OFF_H);
#pragma unroll
  for (int qt = 0; qt < 2; qt++) {
    float l = lrun[qt];
    l = xor16_sum(l);
    l = xor32_sum(l);
    const float inv = __builtin_amdgcn_rcpf(l);
    const int t = qrow0 + qt * 16 + fr;
#pragma unroll
    for (int dt = 0; dt < 4; dt++) {
      uint2 o;
      o.x = pack2(ot[qt][dt][0] * inv, ot[qt][dt][1] * inv);
      o.y = pack2(ot[qt][dt][2] * inv, ot[qt][dt][3] * inv);
      *(uint2*)(MIX + (size_t)t * 1024 + 256 + head * 64 + dt * 16 + fq * 4) = o;
    }
  }
}

__device__ __forceinline__ void phase_even_mix(const Params& P, char* smem, int* qsh, const int rep) {
  unsigned* ctr = (unsigned*)(P.ws + OFF_Q + rep * 512);
  for (;;) {
    const int it = queue_next(ctr, qsh);
    if (it >= 1344) break;
    if (it < 128) fourier_tile(P, it, smem);
    else if (it < 896) attn_item(P, it - 128, smem);
    else if (it < 960) fourier_tile(P, it - 896 + 128, smem);
    else attn_item(P, it - 960 + 768, smem);
  }
}

__device__ __forceinline__ void ssd_conv8(const u16* __restrict__ PO, int col, const float* __restrict__ cw,
                                          const float* __restrict__ cb, int ch, int tg0, int lo, int hi,
                                          float (&o)[4][8]) {
  uint4 v[7];
#pragma unroll
  for (int r = 0; r < 7; r++) {
    const int t = tg0 - 1 + r;
    v[r] = make_uint4(0u, 0u, 0u, 0u);
    if (t >= lo && t < hi) v[r] = *(const uint4*)(PO + (size_t)t * 3456 + col);
  }
  float w[4][8], b[8];
#pragma unroll
  for (int j = 0; j < 4; j++) {
    const float4 w0 = *(const float4*)(cw + j * 1280 + ch);
    const float4 w1 = *(const float4*)(cw + j * 1280 + ch + 4);
    w[j][0] = w0.x; w[j][1] = w0.y; w[j][2] = w0.z; w[j][3] = w0.w;
    w[j][4] = w1.x; w[j][5] = w1.y; w[j][6] = w1.z; w[j][7] = w1.w;
  }
  {
    const float4 b0 = *(const float4*)(cb + ch);
    const float4 b1 = *(const float4*)(cb + ch + 4);
    b[0] = b0.x; b[1] = b0.y; b[2] = b0.z; b[3] = b0.w; b[4] = b1.x; b[5] = b1.y; b[6] = b1.z; b[7] = b1.w;
  }
#pragma unroll
  for (int tok = 0; tok < 4; tok++)
#pragma unroll
    for (int e = 0; e < 8; e++) o[tok][e] = b[e];
#pragma unroll
  for (int r = 0; r < 7; r++) {
    const unsigned uu[4] = {v[r].x, v[r].y, v[r].z, v[r].w};
#pragma unroll
    for (int e = 0; e < 8; e++) {
      const float x = __uint_as_float((e & 1) ? (uu[e >> 1] & 0xffff0000u) : (uu[e >> 1] << 16));
#pragma unroll
      for (int tok = 0; tok < 4; tok++) {
        const int j = r - tok;
        if (j >= 0 && j < 4) o[tok][e] += w[j][e] * x;
      }
    }
  }
#pragma unroll
  for (int tok = 0; tok < 4; tok++)
#pragma unroll
    for (int e = 0; e < 8; e++) o[tok][e] = silu_f(o[tok][e]);
}


__device__ __forceinline__ void phase_odd_conv(const Params& P) {
  const u16* PO = (const u16*)(P.ws + OFF_R1);
  u16* XC = (u16*)(P.ws + OFF_H);
  const float* cw = PRM(P, PRM_CSW);
  const float* cb = PRM(P, PRM_CSB);
  constexpr int NRUN = T_ALL / 16;
  const int nthr = gridDim.x * 256;
  for (int idx = blockIdx.x * 256 + threadIdx.x; idx < NRUN * 160; idx += nthr) {
    const int c8 = idx % 160, run = idx / 160;
    const int tb16 = run * 16;
    int lo, hi;
    if (tb16 < T_CTX) { lo = tb16 & ~255; hi = lo + 256; }
    else { lo = T_CTX + ((tb16 - T_CTX) & ~1023); hi = lo + 1024; }
    const int ch = c8 * 8;
    float w[4][8], bb[8];
#pragma unroll
    for (int j = 0; j < 4; j++) {
      const float4 w0 = *(const float4*)(cw + j * 1280 + ch);
      const float4 w1 = *(const float4*)(cw + j * 1280 + ch + 4);
      w[j][0] = w0.x; w[j][1] = w0.y; w[j][2] = w0.z; w[j][3] = w0.w;
      w[j][4] = w1.x; w[j][5] = w1.y; w[j][6] = w1.z; w[j][7] = w1.w;
    }
    {
      const float4 b0 = *(const float4*)(cb + ch);
      const float4 b1 = *(const float4*)(cb + ch + 4);
      bb[0] = b0.x; bb[1] = b0.y; bb[2] = b0.z; bb[3] = b0.w; bb[4] = b1.x; bb[5] = b1.y; bb[6] = b1.z; bb[7] = b1.w;
    }
    const u16* src = PO + 2048 + ch;
    u32x4 v[19];
#pragma unroll
    for (int r = 0; r < 19; r++) {
      const int t = tb16 - 1 + r;
      v[r] = u32x4{0u, 0u, 0u, 0u};
      if (t >= lo && t < hi) v[r] = *(const u32x4*)(src + (size_t)t * 3456);
    }
#pragma unroll
    for (int tok = 0; tok < 16; tok++) {
      float o[8];
#pragma unroll
      for (int e = 0; e < 8; e++) o[e] = bb[e];
#pragma unroll
      for (int j = 0; j < 4; j++) {
        const u32x4 vv = v[tok + j];
        const unsigned uu[4] = {vv.x, vv.y, vv.z, vv.w};
#pragma unroll
        for (int e = 0; e < 8; e++) {
          const float x = __uint_as_float((e & 1) ? (uu[e >> 1] & 0xffff0000u) : (uu[e >> 1] << 16));
          o[e] += w[j][e] * x;
        }
      }
      uint4 w4;
      w4.x = pack2(silu_f(o[0]), silu_f(o[1])); w4.y = pack2(silu_f(o[2]), silu_f(o[3]));
      w4.z = pack2(silu_f(o[4]), silu_f(o[5])); w4.w = pack2(silu_f(o[6]), silu_f(o[7]));
      *(uint4*)(XC + (size_t)(tb16 + tok) * 1280 + ch) = w4;
    }
  }
}

__device__ __forceinline__ void ssd_item(const Params& P, int item, char* smem) {
  const int tid = threadIdx.x, lane = tid & 63, wave = tid >> 6;
  const int fr = lane & 15, fq = lane >> 4;
  bool smp; int seq;
  if (item < 256) { smp = true; seq = item >> 5; }
  else { item -= 256; smp = false; seq = item >> 5; }
  const int head = (item & 31) >> 1, dir = item & 1;
  const int nc = smp ? 8 : 2;
  const int tb = smp ? T_CTX + seq * 1024 : seq * 256;
  const int tend = tb + (smp ? 1024 : 256);
  const int g = head >> 3;
  u16* Cs = (u16*)smem;
  u16* Bs = (u16*)(smem + 18432);
  u16* BT = (u16*)(smem + 36864);
  u16* XT = (u16*)(smem + 54272);
  u16* Hb = (u16*)(smem + 71680);
  float* cum2 = (float*)(smem + 79872);
  float* lcs2 = (float*)(smem + 80384);
  float* misc = (float*)(smem + 81408);
  const u16* PO = (const u16*)(P.ws + OFF_R1);
  const float* DT = (const float*)(P.ws + OFF_DT);
  u16* YO = (u16*)(P.ws + OFF_Y) + (size_t)dir * T_ALL * 1024;
  const float Aneg = -__expf(PRM(P, PRM_ALOG)[dir * 16 + head]);
  const float dtb = PRM(P, PRM_DTB)[dir * 16 + head];
  const float Dh = PRM(P, PRM_SSDD)[head];
  f32x4 hacc[4];
#pragma unroll
  for (int nt = 0; nt < 4; nt++) {
#pragma unroll
    for (int r = 0; r < 4; r++) {
      float v = 0.f;
      if (smp) v = P.in[6][(size_t)((seq * 2 + dir) * 16 + head) * 4096 + (wave * 16 + fq * 4 + r) * 64 + nt * 16 + fr];
      hacc[nt][r] = v;
      Hb[(wave * 16 + fq * 4 + r) * 64 + nt * 16 + fr] = f2bf(v);
    }
  }
  const int ch8 = (tid & 7) * 8, rg = tid >> 3;
  const u16* XC = (const u16*)(P.ws + OFF_H);
  u32x4 rx0, rx1, rx2, rx3, rb0, rb1, rb2, rb3;
  float raw_next = 0.f;
  {
    const int c0 = dir ? nc - 1 : 0;
    const u16* xr = XC + (size_t)(tb + c0 * 128 + rg * 4) * 1280 + ch8;
    rx0 = *(const u32x4*)(xr + head * 64); rx1 = *(const u32x4*)(xr + 1280 + head * 64);
    rx2 = *(const u32x4*)(xr + 2560 + head * 64); rx3 = *(const u32x4*)(xr + 3840 + head * 64);
    rb0 = *(const u32x4*)(xr + 1024 + g * 64); rb1 = *(const u32x4*)(xr + 1280 + 1024 + g * 64);
    rb2 = *(const u32x4*)(xr + 2560 + 1024 + g * 64); rb3 = *(const u32x4*)(xr + 3840 + 1024 + g * 64);
    if (tid < 128) raw_next = DT[(size_t)(tb + c0 * 128 + (dir ? 127 - tid : tid)) * 32 + dir * 16 + head];
  }
  for (int ci = 0; ci < nc; ci++) {
    const int c = dir ? nc - 1 - ci : ci;
    const int t0 = tb + c * 128;
    {
      const u16* xrc = XC + (size_t)(t0 + rg * 4) * 1280 + ch8 + 1152 + g * 64;
      const u32x4 rc0 = *(const u32x4*)(xrc), rc1 = *(const u32x4*)(xrc + 1280);
      const u32x4 rc2 = *(const u32x4*)(xrc + 2560), rc3 = *(const u32x4*)(xrc + 3840);
      {
        const unsigned u[4][4] = {{rx0.x, rx0.y, rx0.z, rx0.w}, {rx1.x, rx1.y, rx1.z, rx1.w}, {rx2.x, rx2.y, rx2.z, rx2.w}, {rx3.x, rx3.y, rx3.z, rx3.w}};
#pragma unroll
        for (int q = 0; q < 4; q++) {
          uint2 lo2, hi2;
          lo2.x = (u[0][q] & 0xffffu) | (u[1][q] << 16); lo2.y = (u[2][q] & 0xffffu) | (u[3][q] << 16);
          hi2.x = (u[0][q] >> 16) | (u[1][q] & 0xffff0000u); hi2.y = (u[2][q] >> 16) | (u[3][q] & 0xffff0000u);
          *(uint2*)(XT + (ch8 + 2 * q) * 136 + rg * 4) = lo2;
          *(uint2*)(XT + (ch8 + 2 * q + 1) * 136 + rg * 4) = hi2;
        }
      }
      {
        const unsigned u[4][4] = {{rb0.x, rb0.y, rb0.z, rb0.w}, {rb1.x, rb1.y, rb1.z, rb1.w}, {rb2.x, rb2.y, rb2.z, rb2.w}, {rb3.x, rb3.y, rb3.z, rb3.w}};
#pragma unroll
        for (int q = 0; q < 4; q++) {
          uint2 lo2, hi2;
          lo2.x = (u[0][q] & 0xffffu) | (u[1][q] << 16); lo2.y = (u[2][q] & 0xffffu) | (u[3][q] << 16);
          hi2.x = (u[0][q] >> 16) | (u[1][q] & 0xffff0000u); hi2.y = (u[2][q] >> 16) | (u[3][q] & 0xffff0000u);
          *(uint2*)(BT + (ch8 + 2 * q) * 136 + rg * 4) = lo2;
          *(uint2*)(BT + (ch8 + 2 * q + 1) * 136 + rg * 4) = hi2;
        }
        *(u32x4*)(Bs + (rg * 4 + 0) * LDT + ch8) = rb0;
        *(u32x4*)(Bs + (rg * 4 + 1) * LDT + ch8) = rb1;
        *(u32x4*)(Bs + (rg * 4 + 2) * LDT + ch8) = rb2;
        *(u32x4*)(Bs + (rg * 4 + 3) * LDT + ch8) = rb3;
      }
      *(u32x4*)(Cs + (rg * 4 + 0) * LDT + ch8) = rc0;
      *(u32x4*)(Cs + (rg * 4 + 1) * LDT + ch8) = rc1;
      *(u32x4*)(Cs + (rg * 4 + 2) * LDT + ch8) = rc2;
      *(u32x4*)(Cs + (rg * 4 + 3) * LDT + ch8) = rc3;
    }
    const float raw_cur = raw_next;
    __builtin_amdgcn_sched_barrier(0);
    if (ci + 1 < nc) {
      const int cn = dir ? nc - 2 - ci : ci + 1;
      const u16* xr = XC + (size_t)(tb + cn * 128 + rg * 4) * 1280 + ch8;
      rx0 = *(const u32x4*)(xr + head * 64); rx1 = *(const u32x4*)(xr + 1280 + head * 64);
      rx2 = *(const u32x4*)(xr + 2560 + head * 64); rx3 = *(const u32x4*)(xr + 3840 + head * 64);
      rb0 = *(const u32x4*)(xr + 1024 + g * 64); rb1 = *(const u32x4*)(xr + 1280 + 1024 + g * 64);
      rb2 = *(const u32x4*)(xr + 2560 + 1024 + g * 64); rb3 = *(const u32x4*)(xr + 3840 + 1024 + g * 64);
      if (tid < 128) raw_next = DT[(size_t)(tb + cn * 128 + (dir ? 127 - tid : tid)) * 32 + dir * 16 + head];
    }
    __builtin_amdgcn_sched_barrier(0);
    float sv = 0.f, dtv = 1.f;
    int li = 0;
    if (tid < 128) {
      li = dir ? 127 - tid : tid;
      const float raw = raw_cur + dtb;
      dtv = fmaxf(raw, 0.f) + log1pf(__expf(-fabsf(raw)));
      sv = dtv * Aneg;
#pragma unroll
      for (int o = 1; o < 64; o <<= 1) {
        const float u = __shfl_up(sv, o);
        if (lane >= o) sv += u;
      }
      if (tid == 63) misc[0] = sv;
    }
    __syncthreads();
    if (tid < 128) {
      if (wave == 1) sv += misc[0];
      cum2[li] = sv * LOG2E;
      lcs2[li] = (sv - __logf(dtv)) * LOG2E;
      if (tid == 127) misc[1] = sv * LOG2E;
    }
    __syncthreads();
    const float total2 = misc[1];
#pragma unroll 1
    for (int tt = 0; tt < 2; tt++) {
      const int Tt = wave * 2 + tt;
      const int tl = wave * 32 + tt * 16 + fr;
      bf16x8 cf[2];
#pragma unroll
      for (int kk = 0; kk < 2; kk++) cf[kk] = *(const bf16x8*)(Cs + tl * LDT + kk * 32 + fq * 8);
      f32x4 acc[4];
#pragma unroll
      for (int pt = 0; pt < 4; pt++) {
        const bf16x8 h0 = *(const bf16x8*)(Hb + (pt * 16 + fr) * 64 + fq * 8);
        const bf16x8 h1 = *(const bf16x8*)(Hb + (pt * 16 + fr) * 64 + 32 + fq * 8);
        f32x4 z = f32x4{0.f, 0.f, 0.f, 0.f};
        z = MFMA(h0, cf[0], z);
        acc[pt] = MFMA(h1, cf[1], z);
      }
      const float ct = cum2[tl];
      {
        const float e = fexp2(ct);
#pragma unroll
        for (int pt = 0; pt < 4; pt++)
#pragma unroll
          for (int r = 0; r < 4; r++) acc[pt][r] *= e;
      }
#pragma unroll 1
      for (int a = 0; a < 4; a++) {
        const bool ok = dir ? (2 * a + 1 >= Tt) : (2 * a <= Tt);
        if (!ok) continue;
        f32x4 g0 = f32x4{0.f, 0.f, 0.f, 0.f}, g1 = f32x4{0.f, 0.f, 0.f, 0.f};
#pragma unroll
        for (int kk = 0; kk < 2; kk++) {
          const bf16x8 b0 = *(const bf16x8*)(Bs + ((2 * a) * 16 + fr) * LDT + kk * 32 + fq * 8);
          const bf16x8 b1 = *(const bf16x8*)(Bs + ((2 * a + 1) * 16 + fr) * LDT + kk * 32 + fq * 8);
          g0 = MFMA(b0, cf[kk], g0);
          g1 = MFMA(b1, cf[kk], g1);
        }
        const float4 l0 = *(const float4*)(lcs2 + a * 32 + fq * 4);
        const float4 l1 = *(const float4*)(lcs2 + a * 32 + 16 + fq * 4);
        const float ls0[4] = {l0.x, l0.y, l0.z, l0.w};
        const float ls1[4] = {l1.x, l1.y, l1.z, l1.w};
        float m0[4], m1[4];
#pragma unroll
        for (int r = 0; r < 4; r++) {
          const int s0 = a * 32 + fq * 4 + r, s1 = s0 + 16;
          const bool ok0 = dir ? (s0 >= tl) : (s0 <= tl);
          const bool ok1 = dir ? (s1 >= tl) : (s1 <= tl);
          float v0 = ok0 ? g0[r] * fexp2(ct - ls0[r]) : 0.f;
          float v1 = ok1 ? g1[r] * fexp2(ct - ls1[r]) : 0.f;
          if (!dir && s0 == tl) v0 += Dh;
          if (!dir && s1 == tl) v1 += Dh;
          m0[r] = v0; m1[r] = v1;
        }
        union { bf16x8 v; unsigned u[4]; } pk;
        pk.u[0] = pack2(m0[0], m0[1]); pk.u[1] = pack2(m0[2], m0[3]);
        pk.u[2] = pack2(m1[0], m1[1]); pk.u[3] = pack2(m1[2], m1[3]);
#pragma unroll
        for (int pt = 0; pt < 4; pt++) {
          union { bf16x8 v; uint2 h[2]; } x;
          x.h[0] = *(const uint2*)(XT + (pt * 16 + fr) * 136 + a * 32 + fq * 4);
          x.h[1] = *(const uint2*)(XT + (pt * 16 + fr) * 136 + a * 32 + 16 + fq * 4);
          acc[pt] = MFMA(x.v, pk.v, acc[pt]);
        }
      }
      {
        const int t = t0 + tl;
#pragma unroll
        for (int pt = 0; pt < 4; pt++) {
          uint2 o;
          o.x = pack2(acc[pt][0], acc[pt][1]);
          o.y = pack2(acc[pt][2], acc[pt][3]);
          *(uint2*)(YO + (size_t)t * 1024 + head * 64 + pt * 16 + fq * 4) = o;
        }
      }
    }
    {
      const float et = fexp2(total2);
#pragma unroll
      for (int nt = 0; nt < 4; nt++)
#pragma unroll
        for (int r = 0; r < 4; r++) hacc[nt][r] *= et;
#pragma unroll 1
      for (int ks = 0; ks < 4; ks++) {
        union { bf16x8 v; unsigned u[4]; } xr, xw;
        xr.v = *(const bf16x8*)(XT + (wave * 16 + fr) * 136 + ks * 32 + fq * 8);
        const float4 la = *(const float4*)(lcs2 + ks * 32 + fq * 8);
        const float4 lb = *(const float4*)(lcs2 + ks * 32 + fq * 8 + 4);
        const float lw[8] = {la.x, la.y, la.z, la.w, lb.x, lb.y, lb.z, lb.w};
#pragma unroll
        for (int q = 0; q < 4; q++) {
          const float x0 = __uint_as_float(xr.u[q] << 16) * fexp2(total2 - lw[2 * q]);
          const float x1 = __uint_as_float(xr.u[q] & 0xffff0000u) * fexp2(total2 - lw[2 * q + 1]);
          xw.u[q] = pack2(x0, x1);
        }
#pragma unroll
        for (int nt = 0; nt < 4; nt++) {
          const bf16x8 bt = *(const bf16x8*)(BT + (nt * 16 + fr) * 136 + ks * 32 + fq * 8);
          hacc[nt] = MFMA(xw.v, bt, hacc[nt]);
        }
      }
    }
    __syncthreads();
#pragma unroll
    for (int nt = 0; nt < 4; nt++)
#pragma unroll
      for (int r = 0; r < 4; r++) Hb[(wave * 16 + fq * 4 + r) * 64 + nt * 16 + fr] = f2bf(hacc[nt][r]);
  }
  if (!smp) {
    float* ns = P.out + 14696448 + (size_t)((seq * 2 + dir) * 16 + head) * 4096;
#pragma unroll
    for (int nt = 0; nt < 4; nt++)
#pragma unroll
      for (int r = 0; r < 4; r++) ns[(wave * 16 + fq * 4 + r) * 64 + nt * 16 + fr] = hacc[nt][r];
  }
  __syncthreads();
}

__device__ __forceinline__ void lru_item(const Params& P, int item, char* smem) {
  const int tid = threadIdx.x, lane = tid & 63, wave = tid >> 6;
  const int fr = lane & 15, fq = lane >> 4;
  bool smp; int seq;
  if (item < 128) { smp = true; seq = item >> 4; }
  else { item -= 128; smp = false; seq = item >> 4; }
  const int blk = (item & 15) >> 1, dir = item & 1;
  const int nc = smp ? 16 : 4;
  const int tb = smp ? T_CTX + seq * 1024 : seq * 256;
  const int tend = tb + (smp ? 1024 : 256);
  u16* WaT = (u16*)smem;
  u16* WxT = (u16*)(smem + 9216);
  u16* xcb = (u16*)(smem + 18432);
  float* aL = (float*)(smem + 27648);
  float* bL = (float*)(smem + 45056);
  float* sA = (float*)(smem + 62464);
  float* sH = (float*)(smem + 63488);
  float* hc = (float*)(smem + 64512);
  float* cba = (float*)(smem + 65024);
  float* cbx = (float*)(smem + 65280);
  float* csp = (float*)(smem + 65536);
  const u16* PO = (const u16*)(P.ws + OFF_R1);
  u16* YO = (u16*)(P.ws + OFF_YL) + (size_t)dir * T_ALL * 512;
  {
    const float* wa = PRM(P, PRM_LWA) + (size_t)(dir * 8 + blk) * 4096;
    const float* wx = PRM(P, PRM_LWX) + (size_t)(dir * 8 + blk) * 4096;
    for (int e = tid; e < 4096; e += 256) {
      const int i = e >> 6, j = e & 63;
      WaT[j * LDT + i] = f2bf(wa[e]);
      WxT[j * LDT + i] = f2bf(wx[e]);
    }
    if (tid < 64) {
      const int ch = dir * 512 + blk * 64 + tid;
      cba[tid] = PRM(P, PRM_LBA)[ch];
      cbx[tid] = PRM(P, PRM_LBX)[ch];
      const float lam = -PRM(P, PRM_LAM)[ch];
      csp[tid] = 8.0f * (fmaxf(lam, 0.f) + log1pf(__expf(-fabsf(lam))));
      hc[tid] = smp ? P.in[5][(size_t)(seq * 2 + dir) * 512 + blk * 64 + tid] : 0.f;
    }
  }
  const int ch8 = (tid & 7) * 8, rg = tid >> 3;
  const float* cw = PRM(P, PRM_CLW);
  const float* cb = PRM(P, PRM_CLB);
  u32x4 pv0, pv1, pv2, pv3, pv4;
  {
    const int c0 = dir ? nc - 1 : 0;
    const int tn = tb + c0 * 64 + rg * 2 - 1;
    const int chg = blk * 64 + ch8;
    const u32x4 zz = {0u, 0u, 0u, 0u};
    pv0 = (tn >= tb) ? *(const u32x4*)(PO + (size_t)tn * 3456 + 512 + chg) : zz;
    pv1 = *(const u32x4*)(PO + (size_t)(tn + 1) * 3456 + 512 + chg);
    pv2 = *(const u32x4*)(PO + (size_t)(tn + 2) * 3456 + 512 + chg);
    pv3 = (tn + 3 < tend) ? *(const u32x4*)(PO + (size_t)(tn + 3) * 3456 + 512 + chg) : zz;
    pv4 = (tn + 4 < tend) ? *(const u32x4*)(PO + (size_t)(tn + 4) * 3456 + 512 + chg) : zz;
  }
  for (int ci = 0; ci < nc; ci++) {
    const int c = dir ? nc - 1 - ci : ci;
    const int t0 = tb + c * 64;
    const int cur = ci & 1;
    {
      const int chg = blk * 64 + ch8;
      const u32x4 v[5] = {pv0, pv1, pv2, pv3, pv4};
      if (ci + 1 < nc) {
        const int cn = dir ? nc - 2 - ci : ci + 1;
        const int tn = tb + cn * 64 + rg * 2 - 1;
        const u32x4 zz = {0u, 0u, 0u, 0u};
        pv0 = (tn >= tb) ? *(const u32x4*)(PO + (size_t)tn * 3456 + 512 + chg) : zz;
        pv1 = *(const u32x4*)(PO + (size_t)(tn + 1) * 3456 + 512 + chg);
        pv2 = *(const u32x4*)(PO + (size_t)(tn + 2) * 3456 + 512 + chg);
        pv3 = (tn + 3 < tend) ? *(const u32x4*)(PO + (size_t)(tn + 3) * 3456 + 512 + chg) : zz;
        pv4 = (tn + 4 < tend) ? *(const u32x4*)(PO + (size_t)(tn + 4) * 3456 + 512 + chg) : zz;
      }
      float o[2][8];
      {
        const float4 b0 = *(const float4*)(cb + chg);
        const float4 b1 = *(const float4*)(cb + chg + 4);
        const float bb[8] = {b0.x, b0.y, b0.z, b0.w, b1.x, b1.y, b1.z, b1.w};
#pragma unroll
        for (int e = 0; e < 8; e++) { o[0][e] = bb[e]; o[1][e] = bb[e]; }
      }
#pragma unroll
      for (int j = 0; j < 4; j++) {
        const float4 w0 = *(const float4*)(cw + j * 512 + chg);
        const float4 w1 = *(const float4*)(cw + j * 512 + chg + 4);
        const float ww[8] = {w0.x, w0.y, w0.z, w0.w, w1.x, w1.y, w1.z, w1.w};
#pragma unroll
        for (int tok = 0; tok < 2; tok++) {
          const unsigned uu[4] = {v[tok + j].x, v[tok + j].y, v[tok + j].z, v[tok + j].w};
#pragma unroll
          for (int e = 0; e < 8; e++) {
            const float x = __uint_as_float((e & 1) ? (uu[e >> 1] & 0xffff0000u) : (uu[e >> 1] << 16));
            o[tok][e] += ww[e] * x;
          }
        }
      }
#pragma unroll
      for (int tok = 0; tok < 2; tok++) {
        const int tl = rg * 2 + tok;
        *(float4*)(bL + tl * 68 + ch8) = make_float4(o[tok][0], o[tok][1], o[tok][2], o[tok][3]);
        *(float4*)(bL + tl * 68 + ch8 + 4) = make_float4(o[tok][4], o[tok][5], o[tok][6], o[tok][7]);
        uint4 w4;
        w4.x = pack2(o[tok][0], o[tok][1]); w4.y = pack2(o[tok][2], o[tok][3]);
        w4.z = pack2(o[tok][4], o[tok][5]); w4.w = pack2(o[tok][6], o[tok][7]);
        *(uint4*)(xcb + tl * LDT + ch8) = w4;
      }
    }
    __syncthreads();
    {
      bf16x8 xb[2];
#pragma unroll
      for (int kk = 0; kk < 2; kk++) xb[kk] = *(const bf16x8*)(xcb + (wave * 16 + fr) * LDT + kk * 32 + fq * 8);
      const int tl = wave * 16 + fr;
#pragma unroll
      for (int jt = 0; jt < 4; jt++) {
        f32x4 aR = f32x4{0.f, 0.f, 0.f, 0.f}, aI = f32x4{0.f, 0.f, 0.f, 0.f};
#pragma unroll
        for (int kk = 0; kk < 2; kk++) {
          const bf16x8 wa = *(const bf16x8*)(WaT + (jt * 16 + fr) * LDT + kk * 32 + fq * 8);
          const bf16x8 wx = *(const bf16x8*)(WxT + (jt * 16 + fr) * LDT + kk * 32 + fq * 8);
          aR = MFMA(wa, xb[kk], aR);
          aI = MFMA(wx, xb[kk], aI);
        }
        const int j4 = jt * 16 + fq * 4;
        const float4 xc = *(const float4*)(bL + tl * 68 + j4);
        const float4 ba = *(const float4*)(cba + j4);
        const float4 bx = *(const float4*)(cbx + j4);
        const float4 sp = *(const float4*)(csp + j4);
        const float xcv[4] = {xc.x, xc.y, xc.z, xc.w};
        const float bav[4] = {ba.x, ba.y, ba.z, ba.w};
        const float bxv[4] = {bx.x, bx.y, bx.z, bx.w};
        const float spv[4] = {sp.x, sp.y, sp.z, sp.w};
        float av[4], bv[4];
#pragma unroll
        for (int r = 0; r < 4; r++) {
          const float rr = sigmoid_f(aR[r] + bav[r]);
          const float ii = sigmoid_f(aI[r] + bxv[r]);
          const float la = -rr * spv[r];
          av[r] = __expf(la);
          bv[r] = __builtin_amdgcn_sqrtf(fmaxf(1.0f - av[r] * av[r], 0.f)) * ii * xcv[r];
        }
        *(float4*)(aL + tl * 68 + j4) = make_float4(av[0], av[1], av[2], av[3]);
        *(float4*)(bL + tl * 68 + j4) = make_float4(bv[0], bv[1], bv[2], bv[3]);
      }
    }
    __syncthreads();
    {
      const int j = lane, q = wave;
      float hreg[16], areg[16];
      float h = 0.f, Ap = 1.f;
#pragma unroll
      for (int i = 0; i < 16; i++) {
        const int tl = dir ? 63 - (q * 16 + i) : q * 16 + i;
        const float a = aL[tl * 68 + j], b = bL[tl * 68 + j];
        h = a * h + b;
        Ap *= a;
        hreg[i] = h;
        areg[i] = Ap;
      }
      sA[q * 64 + j] = Ap;
      sH[q * 64 + j] = h;
      __syncthreads();
      float Hin = hc[cur * 64 + j];
      for (int qq = 0; qq < q; qq++) Hin = sA[qq * 64 + j] * Hin + sH[qq * 64 + j];
#pragma unroll
      for (int i = 0; i < 16; i++) {
        const int tl = dir ? 63 - (q * 16 + i) : q * 16 + i;
        const float hv = hreg[i] + areg[i] * Hin;
        YO[(size_t)(t0 + tl) * 512 + blk * 64 + j] = f2bf(hv);
      }
      if (q == 3) hc[(cur ^ 1) * 64 + j] = sA[3 * 64 + j] * Hin + sH[3 * 64 + j];
    }
  }
  __syncthreads();
  if (!smp && tid < 64) {
    P.out[14680064 + (size_t)(seq * 2 + dir) * 512 + blk * 64 + tid] = hc[(nc & 1) * 64 + tid];
  }
  __syncthreads();
}

__device__ __forceinline__ void phase_odd_mix(const Params& P, char* smem, int* qsh, const int rep) {
  unsigned* ctr = (unsigned*)(P.ws + OFF_Q + 256 + rep * 512);
  for (;;) {
    const int it = queue_next(ctr, qsh);
    if (it >= 1152) break;
    bool is_ssd; int idx;
    if (it < 128) { is_ssd = false; idx = it; }
    else if (it < 384) { is_ssd = true; idx = it - 128; }
    else if (it < 640) { is_ssd = false; idx = it - 384 + 128; }
    else { is_ssd = true; idx = it - 640 + 256; }
    if (is_ssd) ssd_item(P, idx, smem);
    else lru_item(P, idx, smem);
  }
}

__device__ __forceinline__ void phase_odd_combine(const Params& P) {
  const int tid = threadIdx.x, lane = tid & 63, wave = tid >> 6;
  const u16* PO = (const u16*)(P.ws + OFF_R1);
  const u16* YSF = (const u16*)(P.ws + OFF_Y);
  const u16* YSB = YSF + (size_t)T_ALL * 1024;
  const u16* YLF = (const u16*)(P.ws + OFF_YL);
  const u16* YLB = YLF + (size_t)T_ALL * 512;
  u16* MIX = (u16*)(P.ws + OFF_H);
  const float* nrm = PRM(P, PRM_SNORM);
  float4 nr[2][2];
#pragma unroll
  for (int hh = 0; hh < 2; hh++) { nr[hh][0] = *(const float4*)(nrm + hh * 512 + lane * 8); nr[hh][1] = *(const float4*)(nrm + hh * 512 + lane * 8 + 4); }
  for (int t = blockIdx.x * 4 + wave; t < T_ALL; t += gridDim.x * 4) {
    {
      const int c = lane * 8;
      const uint4 f = *(const uint4*)(YLF + (size_t)t * 512 + c);
      const uint4 b = *(const uint4*)(YLB + (size_t)t * 512 + c);
      const uint4 gg = *(const uint4*)(PO + (size_t)t * 3456 + c);
      const unsigned fu[4] = {f.x, f.y, f.z, f.w}, bu[4] = {b.x, b.y, b.z, b.w}, gu[4] = {gg.x, gg.y, gg.z, gg.w};
      unsigned ou[4];
#pragma unroll
      for (int q = 0; q < 4; q++) {
        float r[2];
#pragma unroll
        for (int h = 0; h < 2; h++) {
          const float yf = h ? __uint_as_float(fu[q] & 0xffff0000u) : __uint_as_float(fu[q] << 16);
          const float yb = h ? __uint_as_float(bu[q] & 0xffff0000u) : __uint_as_float(bu[q] << 16);
          const float gv = h ? __uint_as_float(gu[q] & 0xffff0000u) : __uint_as_float(gu[q] << 16);
          const float ge = gv * __builtin_amdgcn_rcpf(1.f + __expf(-2.0f * 0.7978845608028654f * (gv + 0.044715f * gv * gv * gv)));
          r[h] = (yf + yb) * ge;
        }
        ou[q] = pack2(r[0], r[1]);
      }
      *(uint4*)(MIX + (size_t)t * 1536 + c) = make_uint4(ou[0], ou[1], ou[2], ou[3]);
    }
    float y[16];
    float ss = 0.f;
#pragma unroll
    for (int hh = 0; hh < 2; hh++) {
      const int c = hh * 512 + lane * 8;
      const uint4 f = *(const uint4*)(YSF + (size_t)t * 1024 + c);
      const uint4 b = *(const uint4*)(YSB + (size_t)t * 1024 + c);
      const uint4 zz = *(const uint4*)(PO + (size_t)t * 3456 + 1024 + c);
      const unsigned fu[4] = {f.x, f.y, f.z, f.w}, bu[4] = {b.x, b.y, b.z, b.w}, zu[4] = {zz.x, zz.y, zz.z, zz.w};
#pragma unroll
      for (int q = 0; q < 4; q++)
#pragma unroll
        for (int h = 0; h < 2; h++) {
          const float yf = h ? __uint_as_float(fu[q] & 0xffff0000u) : __uint_as_float(fu[q] << 16);
          const float yb = h ? __uint_as_float(bu[q] & 0xffff0000u) : __uint_as_float(bu[q] << 16);
          const float zv = h ? __uint_as_float(zu[q] & 0xffff0000u) : __uint_as_float(zu[q] << 16);
          const float v = (yf + yb) * silu_f(zv);
          y[hh * 8 + q * 2 + h] = v;
          ss += v * v;
        }
    }
#pragma unroll
    for (int o = 32; o >= 1; o >>= 1) ss += __shfl_xor(ss, o);
    const float rs = rsqrtf(ss * (1.0f / 1024.0f) + 1e-6f);
#pragma unroll
    for (int hh = 0; hh < 2; hh++) {
      const int c = hh * 512 + lane * 8;
      const float4 n0 = nr[hh][0];
      const float4 n1 = nr[hh][1];
      uint4 o;
      o.x = pack2(y[hh * 8 + 0] * rs * n0.x, y[hh * 8 + 1] * rs * n0.y);
      o.y = pack2(y[hh * 8 + 2] * rs * n0.z, y[hh * 8 + 3] * rs * n0.w);
      o.z = pack2(y[hh * 8 + 4] * rs * n1.x, y[hh * 8 + 5] * rs * n1.y);
      o.w = pack2(y[hh * 8 + 6] * rs * n1.z, y[hh * 8 + 7] * rs * n1.w);
      *(uint4*)(MIX + (size_t)t * 1536 + 512 + c) = o;
    }
  }
}

#ifndef PHMASK
#define PHMASK 0xffffffu
#endif
__device__ __forceinline__ void run_phase(const Params& P, const int ph, char* smem, int* qsh, const int rep = 0) {
  switch (ph) {
    case 0: if (PHMASK & (1u << 0)) phase_prep(P, smem, qsh); break;
    case 1: if (PHMASK & (1u << 1)) phase_norm(P, 0, 0); break;
    case 2: if (PHMASK & (1u << 2)) phase_gemm_in_even(P, smem); break;
    case 3: if (PHMASK & (1u << 3)) phase_even_mix(P, smem, qsh, rep); break;
    case 4: if (PHMASK & (1u << 4)) phase_gemm_resid(P, smem, (const u16*)(P.ws + OFF_H), 1024, (const u16*)(P.ws + OFF_WOE), 1024, 0, 2, true); break;
    case 5: if (PHMASK & (1u << 5)) phase_norm(P, 0, 1); break;
    case 6: if (PHMASK & (1u << 6)) phase_gemm_ffn_up(P, smem, 0); break;
    case 7: if (PHMASK & (1u << 7)) phase_gemm_resid(P, smem, (const u16*)(P.ws + OFF_R1), 2816, (const u16*)(P.ws + OFF_W2), 2816, 0, 5, false); break;
    case 8: if (PHMASK & (1u << 8)) phase_norm(P, 1, 0); break;
    case 9: if (PHMASK & (1u << 9)) phase_gemm_in_odd(P, smem); break;
    case 10: if (PHMASK & (1u << 10)) phase_odd_conv(P); break;
    case 11: if (PHMASK & (1u << 11)) phase_odd_mix(P, smem, qsh, rep); break;
    case 12: if (PHMASK & (1u << 12)) phase_odd_combine(P); break;
    case 13: if (PHMASK & (1u << 13)) phase_gemm_resid(P, smem, (const u16*)(P.ws + OFF_H), 1536, (const u16*)(P.ws + OFF_WOO), 1536, 1, 2, false); break;
    case 14: if (PHMASK & (1u << 14)) phase_norm(P, 1, 1); break;
    case 15: if (PHMASK & (1u << 15)) phase_gemm_ffn_up(P, smem, 1); break;
    case 16: if (PHMASK & (1u << 16)) phase_gemm_resid(P, smem, (const u16*)(P.ws + OFF_R1), 2816, (const u16*)(P.ws + OFF_W2) + (size_t)1024 * 2816, 2816, 1, 5, false); break;
    default: break;
  }
}

constexpr int N_PHASES = 17;

__global__ void __launch_bounds__(256, 2) mega_kernel(Params P, int ph_lo, int ph_hi) {
  __shared__ __attribute__((aligned(16))) char smem[SMEM_BYTES];
  __shared__ uint4 xb_words;
  __shared__ int q_item;
  cg::grid_group grid = cg::this_grid();
  if (threadIdx.x == 0) xb_words = make_uint4(0u, 0u, 0u, 0u);
  __syncthreads();
  XcdBarrier xb = xcd_barrier_post((unsigned*)(P.ws + OFF_BAR), (volatile LAS unsigned*)&xb_words);
  if (ph_lo < 0) grid.sync();
#ifndef DUP_PH
#define DUP_PH -1
#endif
#define RUN_PH(ph) if ((ph) >= ph_lo && (ph) < ph_hi) { run_phase(P, (ph), smem, &q_item); if (DUP_PH == (ph)) { xcd_barrier(xb); run_phase(P, (ph), smem, &q_item, 1); } if ((ph) + 1 < ph_hi) xcd_barrier(xb); }
  RUN_PH(0) RUN_PH(1) RUN_PH(2) RUN_PH(3) RUN_PH(4) RUN_PH(5) RUN_PH(6) RUN_PH(7)
  RUN_PH(8) RUN_PH(9) RUN_PH(10) RUN_PH(11) RUN_PH(12) RUN_PH(13) RUN_PH(14) RUN_PH(15) RUN_PH(16)
}

#ifndef MULTI_LAUNCH
#define MULTI_LAUNCH 0
#endif

extern "C" void kernel_launch(void* const* d_in, const int* in_sizes, int n_in, void* d_out, int out_size, void* d_ws,
                              size_t ws_size, hipStream_t stream) {
  static int grid_blocks = 0;
  if (!grid_blocks) {
    int dev = 0, cus = 0, per_cu = 0;
    (void)hipGetDevice(&dev);
    (void)hipDeviceGetAttribute(&cus, hipDeviceAttributeMultiprocessorCount, dev);
    (void)hipOccupancyMaxActiveBlocksPerMultiprocessor(&per_cu, mega_kernel, 256, 0);
    if (per_cu > 2) per_cu = 2;
    if (per_cu < 1) per_cu = 1;
    grid_blocks = cus * per_cu;
  }
  Params p;
  memset(&p, 0, sizeof(p));
  for (int i = 0; i < 34; i++) p.in[i] = (const float*)d_in[i];
  p.out = (float*)d_out;
  p.ws = (char*)d_ws;
#if MULTI_LAUNCH
  for (int ph = 0; ph < N_PHASES; ph++) {
    int lo = ph, hi = ph + 1;
    void* args[] = {&p, &lo, &hi};
    hipError_t e = hipLaunchCooperativeKernel((void*)mega_kernel, dim3(grid_blocks), dim3(256), args, 0, stream);
    if (e != hipSuccess) fprintf(stderr, "launch failed: %s (grid %d)\n", hipGetErrorString(e), grid_blocks);
  }
#else
  (void)hipMemsetAsync((char*)d_ws + OFF_BAR, 0, 24576, stream);
  int lo = 0, hi = N_PHASES;
  void* args[] = {&p, &lo, &hi};
  hipError_t e = hipLaunchCooperativeKernel((void*)mega_kernel, dim3(grid_blocks), dim3(256), args, 0, stream);
  if (e != hipSuccess) fprintf(stderr, "cooperative launch failed: %s (grid %d)\n", hipGetErrorString(e), grid_blocks);
#endif
}
```

```cpp
#include <hip/hip_runtime.h>
#include <hip/hip_bf16.h>
#include <hip/hip_cooperative_groups.h>
#include <cstdio>
#include <cstring>
namespace cg = cooperative_groups;

typedef unsigned short u16;
using bf16x8 = __attribute__((ext_vector_type(8))) short;
using bf16x4 = __attribute__((ext_vector_type(4))) short;
using f32x4 = __attribute__((ext_vector_type(4))) float;

#define MFMA(a, b, c) __builtin_amdgcn_mfma_f32_16x16x32_bf16(a, b, c, 0, 0, 0)
#define LOG2E 1.4426950408889634f

constexpr int T_ALL = 12288;
constexpr int T_CTX = 4096;
constexpr int SMEM_BYTES = 81664;
constexpr int LDT = 72;

constexpr size_t OFF_WIE = 0;
constexpr size_t OFF_WOE = OFF_WIE + 3670016;
constexpr size_t OFF_WIO = OFF_WOE + 2097152;
constexpr size_t OFF_WOO = OFF_WIO + 7077888;
constexpr size_t OFF_W13 = OFF_WOO + 3145728;
constexpr size_t OFF_W2 = OFF_W13 + 23068672;
constexpr size_t OFF_MOD = OFF_W2 + 11534336;
constexpr size_t OFF_D1K = OFF_MOD + 442368;
constexpr size_t OFF_D256 = OFF_D1K + 4194304;
constexpr size_t OFF_H = OFF_D256 + 262144;
constexpr size_t OFF_R1 = OFF_H + 37748736;
constexpr size_t OFF_Y = OFF_R1 + 84934656;
constexpr size_t OFF_YL = OFF_Y + 50331648;
constexpr size_t OFF_DT = OFF_YL + 25165824;
constexpr size_t OFF_BAR = OFF_DT + 1572864;
constexpr size_t OFF_PRM = OFF_BAR + 32768;
constexpr int PRM_NORM_MIX = 0, PRM_NORM_FFN = 2048, PRM_QN = 4096, PRM_KN = 4160, PRM_CLW = 4224, PRM_CLB = 6272,
              PRM_LBA = 6784, PRM_LBX = 7808, PRM_LAM = 8832, PRM_CSW = 9856, PRM_CSB = 14976, PRM_DTB = 16256,
              PRM_ALOG = 16288, PRM_SSDD = 16320, PRM_SNORM = 16384, PRM_LWA = 17408, PRM_LWX = 82944;
#define PRM(P, off) ((const float*)((P).ws + OFF_PRM) + (off))
constexpr size_t OFF_YTS = OFF_Y;
constexpr size_t OFF_YTC = OFF_Y + 8388608;
constexpr size_t OFF_QB = OFF_Y + 12582912;
constexpr size_t OFF_KBS = OFF_Y + 31457280;
constexpr size_t OFF_KBC = OFF_Y + 37748736;
constexpr size_t OFF_VTS = OFF_Y + 39845888;
constexpr size_t OFF_VTC = OFF_Y + 46137344;

struct Params {
  const float* in[34];
  float* out;
  char* ws;
};

typedef __bf16 bf16x2_t __attribute__((ext_vector_type(2)));
typedef float f32x2_t __attribute__((ext_vector_type(2)));
__device__ __forceinline__ unsigned pack2(float a, float b) {
  f32x2_t v = {a, b};
  bf16x2_t r = __builtin_convertvector(v, bf16x2_t);
  return __builtin_bit_cast(unsigned, r);
}
__device__ __forceinline__ u16 f2bf(float f) { return (u16)(pack2(f, 0.f) & 0xffffu); }
__device__ __forceinline__ float bf2f(u16 h) { return __uint_as_float(((unsigned)h) << 16); }
__device__ __forceinline__ float silu_f(float v) { return v * __builtin_amdgcn_rcpf(1.f + __expf(-v)); }
__device__ __forceinline__ float sigmoid_f(float v) { return __builtin_amdgcn_rcpf(1.f + __expf(-v)); }
__device__ __forceinline__ float fexp2(float v) { return __builtin_amdgcn_exp2f(v); }

__device__ __forceinline__ float xor16_sum(float x) {
  const unsigned u = __float_as_uint(x);
  auto r = __builtin_amdgcn_permlane16_swap(u, u, false, false);
  return __uint_as_float(r[0]) + __uint_as_float(r[1]);
}
__device__ __forceinline__ float xor32_sum(float x) {
  const unsigned u = __float_as_uint(x);
  auto r = __builtin_amdgcn_permlane32_swap(u, u, false, false);
  return __uint_as_float(r[0]) + __uint_as_float(r[1]);
}
__device__ __forceinline__ float xor16_max(float x) {
  const unsigned u = __float_as_uint(x);
  auto r = __builtin_amdgcn_permlane16_swap(u, u, false, false);
  return fmaxf(__uint_as_float(r[0]), __uint_as_float(r[1]));
}
__device__ __forceinline__ float xor32_max(float x) {
  const unsigned u = __float_as_uint(x);
  auto r = __builtin_amdgcn_permlane32_swap(u, u, false, false);
  return fmaxf(__uint_as_float(r[0]), __uint_as_float(r[1]));
}
__device__ __forceinline__ int cond_row(int t) { return t < T_CTX ? 8 : ((t - T_CTX) >> 10); }
__device__ __forceinline__ const float* xin(const Params& P, int t) {
  return t < T_CTX ? P.in[0] + (size_t)t * 1024 : P.in[1] + (size_t)(t - T_CTX) * 1024;
}


#define XB_TMO      128
#define XB_XCNT(j)  (256  + 64 * (j))
#define XB_XSUB(j)  (1280 + 64 * (j))
#define XB_XGEN(j)  (2304 + 64 * (j))
#define XB_TOP      3328
#define XB_TOPGEN   3392
#define XCD_BAR_WORDS 3456
#define XB_SPIN_CAP (1u << 22)
#define LAS __attribute__((address_space(3)))
__device__ __forceinline__ unsigned xb_ld(unsigned* p)              { return __hip_atomic_load(p, __ATOMIC_RELAXED, __HIP_MEMORY_SCOPE_AGENT); }
__device__ __forceinline__ unsigned xb_add(unsigned* p, unsigned v) { return __hip_atomic_fetch_add(p, v, __ATOMIC_RELAXED, __HIP_MEMORY_SCOPE_AGENT); }
__device__ __forceinline__ unsigned xb_xcc_id() { return (unsigned)__builtin_amdgcn_s_getreg((3 << 11) | 20) & 0xFu; }
#define XB_SPIN(cond, bar) do { unsigned _sp = 0; while (cond) { __builtin_amdgcn_s_sleep(1); \
    if ((++_sp & 255u) == 0u) { if (xb_ld(&(bar)[XB_TMO])) break; if (_sp > XB_SPIN_CAP) { atomicAdd(&(bar)[XB_TMO], 1u); break; } } } } while (0)
struct XcdBarrier { unsigned* bar; unsigned x; volatile LAS unsigned* st; };
__device__ __forceinline__ XcdBarrier xcd_barrier_post(unsigned* bar, volatile LAS unsigned* st) {
    XcdBarrier b; b.bar = bar; b.x = xb_xcc_id(); b.st = st;
    if (threadIdx.x == 0) (void)xb_add(&bar[XB_XCNT(b.x)], 1u);
    return b;
}
__device__ __forceinline__ void xcd_barrier_complete(unsigned* bar, unsigned x, unsigned& nloc, unsigned& nx) {
    const unsigned G = gridDim.x * gridDim.y * gridDim.z;
    unsigned sum, cnt, mine, sp = 0u;
    for (;;) {
        sum = 0u; cnt = 0u; mine = 0u;
#pragma unroll
        for (unsigned j = 0; j < 16; ++j) { const unsigned c = xb_ld(&bar[XB_XCNT(j)]); sum += c; cnt += (c > 0u) ? 1u : 0u; mine = (j == x) ? c : mine; }
        if (sum == G) break;
        __builtin_amdgcn_s_sleep(1);
        if ((++sp & 255u) == 0u) { if (xb_ld(&bar[XB_TMO])) break; if (sp > XB_SPIN_CAP) { atomicAdd(&bar[XB_TMO], 1u); break; } }
    }
    nloc = mine > 0u ? mine : 1u; nx = cnt > 0u ? cnt : 1u;
}
__device__ __forceinline__ void xcd_barrier(const XcdBarrier& b) {
    asm volatile("s_waitcnt vmcnt(0)" ::: "memory");
    __syncthreads();
    if (threadIdx.x == 0) {
        unsigned* bar = b.bar;
        __builtin_amdgcn_s_waitcnt(0);
        unsigned nloc = b.st[0], nx = b.st[1];
        if (nloc == 0u) { xcd_barrier_complete(bar, b.x, nloc, nx); b.st[0] = nloc; b.st[1] = nx; }
        const unsigned old = xb_add(&bar[XB_XSUB(b.x)], 1u);
        const unsigned gen = old / nloc;
        if (old + 1u == (gen + 1u) * nloc) {
            __builtin_amdgcn_fence(__ATOMIC_RELEASE, "agent");
            asm volatile("s_waitcnt vmcnt(0)" ::: "memory");
            const unsigned og = xb_add(&bar[XB_TOP], 1u);
            const unsigned tg = og / nx;
            if (og + 1u == (tg + 1u) * nx) xb_add(&bar[XB_TOPGEN], 1u);
            else XB_SPIN(xb_ld(&bar[XB_TOPGEN]) == tg, bar);
            __builtin_amdgcn_fence(__ATOMIC_ACQUIRE, "agent");
            xb_add(&bar[XB_XGEN(b.x)], 1u);
            asm volatile("s_waitcnt vmcnt(0)" ::: "memory");
        } else {
            XB_SPIN(xb_ld(&bar[XB_XGEN(b.x)]) == gen, bar);
            __builtin_amdgcn_fence(__ATOMIC_ACQUIRE, "agent");
            asm volatile("s_waitcnt vmcnt(0)" ::: "memory");
        }
    }
    __syncthreads();
}

using u32x4 = __attribute__((ext_vector_type(4))) unsigned int;
struct GRegs { u32x4 a0, a1, a2, a3, b0, b1; };
template <int MTW>
__device__ __forceinline__ void gemm_gload(GRegs& R, const u16* ga, const u16* gb, int lda, int ldb) {
  R.a0 = *(const u32x4*)(ga);
  R.a1 = *(const u32x4*)(ga + (size_t)64 * lda);
  R.a2 = *(const u32x4*)(ga + (size_t)128 * lda);
  if (MTW == 8) R.a3 = *(const u32x4*)(ga + (size_t)192 * lda);
  R.b0 = *(const u32x4*)(gb);
  R.b1 = *(const u32x4*)(gb + (size_t)64 * ldb);
}
template <int MTW>
__device__ __forceinline__ void gemm_swrite(const GRegs& R, u16* dA, u16* dB) {
  *(u32x4*)(dA) = R.a0;
  *(u32x4*)(dA + 64 * 40) = R.a1;
  *(u32x4*)(dA + 128 * 40) = R.a2;
  if (MTW == 8) *(u32x4*)(dA + 192 * 40) = R.a3;
  *(u32x4*)(dB) = R.b0;
  *(u32x4*)(dB + 64 * 40) = R.b1;
}

template <bool SWAP, int MTW>
__device__ __forceinline__ void gemm_compute_tile(const u16* cA, const u16* cB, f32x4 (&acc)[MTW][4]) {
  constexpr int LS = 40;
  constexpr int HM = MTW / 2;
  bf16x8 bfr[4];
#pragma unroll
  for (int j = 0; j < 4; j++) bfr[j] = *(const bf16x8*)(cB + j * 16 * LS);
#pragma unroll
  for (int h = 0; h < 2; h++) {
    bf16x8 af[HM];
#pragma unroll
    for (int i = 0; i < HM; i++) af[i] = *(const bf16x8*)(cA + (h * HM + i) * 16 * LS);
#pragma unroll
    for (int i = 0; i < HM; i++)
#pragma unroll
      for (int j = 0; j < 4; j++) {
        if (SWAP) acc[h * HM + i][j] = MFMA(bfr[j], af[i], acc[h * HM + i][j]);
        else acc[h * HM + i][j] = MFMA(af[i], bfr[j], acc[h * HM + i][j]);
      }
  }
}

template <bool SWAP, int MTW = 8>
__device__ __forceinline__ void gemm_mainloop_reg(const u16* __restrict__ A, int lda, const u16* __restrict__ Bt, int ldb,
                                              int K, u16* sm, f32x4 (&acc)[MTW][4]) {
  constexpr int LS = 40;
  const int tid = threadIdx.x, lane = tid & 63, wave = tid >> 6;
  const int wm = wave >> 1, wn = wave & 1;
  const int fr = lane & 15, fq = lane >> 4;
  u16* sA = sm;
  u16* sB = sm + 2 * 256 * LS;
  const int lr = tid >> 2, lc = (tid & 3) * 8;
  const u16* ga = A + (size_t)lr * lda + lc;
  const u16* gb = Bt + (size_t)lr * ldb + lc;
  GRegs r0, r1;
#define GLOAD(R, KT) gemm_gload<MTW>(R, ga + (KT) * 32, gb + (KT) * 32, lda, ldb);
#define SWRITE(R, BUF) gemm_swrite<MTW>(R, sA + (BUF) * 256 * LS + lr * LS + lc, sB + (BUF) * 128 * LS + lr * LS + lc);
  GLOAD(r0, 0)
  GLOAD(r1, 1)
#pragma unroll
  for (int i = 0; i < MTW; i++)
#pragma unroll
    for (int j = 0; j < 4; j++) acc[i][j] = f32x4{0.f, 0.f, 0.f, 0.f};
  SWRITE(r0, 0)
  __syncthreads();
  const int nk = K >> 5;
  const u16* cA0 = sA + (wm * 16 * MTW + fr) * LS + fq * 8;
  const u16* cB0 = sB + (wn * 64 + fr) * LS + fq * 8;
  for (int kt = 0; kt < nk; kt += 2) {
    GLOAD(r0, min(kt + 2, nk - 1))
    gemm_compute_tile<SWAP, MTW>(cA0, cB0, acc);
    SWRITE(r1, 1)
    __syncthreads();
    GLOAD(r1, min(kt + 3, nk - 1))
    gemm_compute_tile<SWAP, MTW>(cA0 + 256 * LS, cB0 + 128 * LS, acc);
    SWRITE(r0, 0)
    __syncthreads();
  }
#undef GLOAD
#undef SWRITE
}

__device__ __forceinline__ void glds16(const u16* g, char* lds) {
  __builtin_amdgcn_global_load_lds((const unsigned*)g, (unsigned*)lds, 16, 0, 0);
}
#define DSR128(dst, addr, OFF) asm volatile("ds_read_b128 %0, %1 offset:%2" : "=v"(dst) : "v"(addr), "n"(OFF))
template <bool SWAP, int MTW>
__device__ __forceinline__ void gemm_compute_glds(unsigned aA, unsigned aB, f32x4 (&acc)[MTW][4]) {
  bf16x8 bfr[4], af[MTW];
  DSR128(bfr[0], aB, 0); DSR128(bfr[1], aB, 1024); DSR128(bfr[2], aB, 2048); DSR128(bfr[3], aB, 3072);
  if (MTW == 8) {
    DSR128(af[0], aA, 0); DSR128(af[1], aA, 1024); DSR128(af[2], aA, 2048); DSR128(af[3], aA, 3072);
    DSR128(af[4], aA, 4096); DSR128(af[5], aA, 5120); DSR128(af[6], aA, 6144); DSR128(af[7], aA, 7168);
    asm volatile("s_waitcnt lgkmcnt(4)" : "+v"(bfr[0]), "+v"(bfr[1]), "+v"(bfr[2]), "+v"(bfr[3]), "+v"(af[0]), "+v"(af[1]), "+v"(af[2]), "+v"(af[3]));
  } else if (MTW == 6) {
    DSR128(af[0], aA, 0); DSR128(af[1], aA, 1024); DSR128(af[2], aA, 2048);
    DSR128(af[3], aA, 3072); DSR128(af[4], aA, 4096); DSR128(af[5], aA, 5120);
    asm volatile("s_waitcnt lgkmcnt(3)" : "+v"(bfr[0]), "+v"(bfr[1]), "+v"(bfr[2]), "+v"(bfr[3]), "+v"(af[0]), "+v"(af[1]), "+v"(af[2]));
  } else if (MTW == 4) {
    DSR128(af[0], aA, 0); DSR128(af[1], aA, 1024); DSR128(af[2], aA, 2048); DSR128(af[3], aA, 3072);
    asm volatile("s_waitcnt lgkmcnt(2)" : "+v"(bfr[0]), "+v"(bfr[1]), "+v"(bfr[2]), "+v"(bfr[3]), "+v"(af[0]), "+v"(af[1]));
  } else {
    DSR128(af[0], aA, 0); DSR128(af[1], aA, 1024);
    asm volatile("s_waitcnt lgkmcnt(1)" : "+v"(bfr[0]), "+v"(bfr[1]), "+v"(bfr[2]), "+v"(bfr[3]), "+v"(af[0]));
  }
  constexpr int HM = MTW / 2;
#pragma unroll
  for (int i = 0; i < HM; i++)
#pragma unroll
    for (int j = 0; j < 4; j++) {
      if (SWAP) acc[i][j] = MFMA(bfr[j], af[i], acc[i][j]);
      else acc[i][j] = MFMA(af[i], bfr[j], acc[i][j]);
    }
  __builtin_amdgcn_sched_barrier(0);
  if (MTW == 8) asm volatile("s_waitcnt lgkmcnt(0)" : "+v"(af[4]), "+v"(af[5]), "+v"(af[6]), "+v"(af[7]));
  else if (MTW == 6) asm volatile("s_waitcnt lgkmcnt(0)" : "+v"(af[3]), "+v"(af[4]), "+v"(af[5]));
  else if (MTW == 4) asm volatile("s_waitcnt lgkmcnt(0)" : "+v"(af[2]), "+v"(af[3]));
  else asm volatile("s_waitcnt lgkmcnt(0)" : "+v"(af[1]));
  __builtin_amdgcn_sched_barrier(0);
#pragma unroll
  for (int i = HM; i < MTW; i++)
#pragma unroll
    for (int j = 0; j < 4; j++) {
      if (SWAP) acc[i][j] = MFMA(bfr[j], af[i], acc[i][j]);
      else acc[i][j] = MFMA(af[i], bfr[j], acc[i][j]);
    }
}

template <bool SWAP, int MTW = 8>
__device__ __forceinline__ void gemm_mainloop(const u16* __restrict__ A, int lda, const u16* __restrict__ Bt, int ldb,
                                              int K, u16* sm, f32x4 (&acc)[MTW][4]) {
  constexpr int STG = 24576;
  constexpr int AW = MTW / 2;
  constexpr int NL = AW + 2;
  const int tid = threadIdx.x, lane = tid & 63, wave = tid >> 6;
  const int wm = wave >> 1, wn = wave & 1;
  const int fr = lane & 15, fq = lane >> 4;
  char* smc = (char*)sm;
  const int rowl = lane >> 2;
  const int lch = ((lane & 3) ^ (((lane >> 5) & 1) << 1)) * 8;
  const u16* gA = A + (size_t)(wave * AW * 16 + rowl) * lda + lch;
  const u16* gB = Bt + (size_t)(wave * 32 + rowl) * ldb + lch;
  char* dA = smc + (wave * AW) * 1024;
  char* dB = smc + 16384 + (wave * 2) * 1024;
  const int loff = fr * 64 + ((fq ^ (((fr >> 3) & 1) << 1)) * 16);
  const unsigned lds0 = (unsigned)(size_t)((LAS char*)smc);
  const unsigned rA = lds0 + (wm * MTW) * 1024 + loff;
  const unsigned rB = lds0 + 16384 + (wn * 4) * 1024 + loff;
#define GSTAGE(S, KT) { _Pragma("unroll") for (int _i = 0; _i < AW; _i++) glds16(gA + (size_t)(_i * 16) * lda + (KT) * 32, dA + (S) * STG + _i * 1024); \
                        _Pragma("unroll") for (int _i = 0; _i < 2; _i++) glds16(gB + (size_t)(_i * 16) * ldb + (KT) * 32, dB + (S) * STG + _i * 1024); }
#pragma unroll
  for (int i = 0; i < MTW; i++)
#pragma unroll
    for (int j = 0; j < 4; j++) acc[i][j] = f32x4{0.f, 0.f, 0.f, 0.f};
  const int nk = K >> 5;
  GSTAGE(0, 0)
  GSTAGE(1, 1)
  asm volatile("s_waitcnt vmcnt(%0)" ::"n"(NL) : "memory");
  asm volatile("s_waitcnt lgkmcnt(0)" ::: "memory");
  __builtin_amdgcn_s_barrier();
  int cur = 0;
  for (int t = 0; t < nk; t++) {
    int nx2 = cur + 2; if (nx2 >= 3) nx2 -= 3;
    const bool more = (t + 2 < nk);
    if (more) GSTAGE(nx2, t + 2)
    gemm_compute_glds<SWAP, MTW>(rA + cur * STG, rB + cur * STG, acc);
    if (more) asm volatile("s_waitcnt vmcnt(%0)" ::"n"(NL) : "memory");
    else asm volatile("s_waitcnt vmcnt(0)" ::: "memory");
    asm volatile("s_waitcnt lgkmcnt(0)" ::: "memory");
    __builtin_amdgcn_s_barrier();
    cur = (cur == 2) ? 0 : cur + 1;
  }
#undef GSTAGE
}

template <bool SWAP>
__device__ __forceinline__ void gemm_mainloop128(const u16* __restrict__ A, int lda, const u16* __restrict__ Bt, int ldb,
                                              int K, u16* sm, f32x4 (&acc)[4][4]) {
  const int tid = threadIdx.x, lane = tid & 63, wave = tid >> 6;
  const int wm = wave >> 1, wn = wave & 1;
  const int fr = lane & 15, fq = lane >> 4;
  u16* sA = sm;
  u16* sB = sm + 2 * 128 * LDT;
  const int lr = tid >> 3, lc = (tid & 7) * 8;
  const u16* ga = A + (size_t)lr * lda + lc;
  const u16* gb = Bt + (size_t)lr * ldb + lc;
  uint4 ra[4], rb[4];
#pragma unroll
  for (int i = 0; i < 4; i++) {
    ra[i] = *(const uint4*)(ga + (size_t)(i * 32) * lda);
    rb[i] = *(const uint4*)(gb + (size_t)(i * 32) * ldb);
  }
#pragma unroll
  for (int i = 0; i < 4; i++)
#pragma unroll
    for (int j = 0; j < 4; j++) acc[i][j] = f32x4{0.f, 0.f, 0.f, 0.f};
#pragma unroll
  for (int i = 0; i < 4; i++) {
    *(uint4*)(sA + (lr + i * 32) * LDT + lc) = ra[i];
    *(uint4*)(sB + (lr + i * 32) * LDT + lc) = rb[i];
  }
  __syncthreads();
  const int nk = K >> 6;
  for (int kt = 0; kt < nk; kt++) {
    const int cur = kt & 1;
    const bool more = (kt + 1 < nk);
    if (more) {
      const u16* ga2 = ga + (kt + 1) * 64;
      const u16* gb2 = gb + (kt + 1) * 64;
#pragma unroll
      for (int i = 0; i < 4; i++) {
        ra[i] = *(const uint4*)(ga2 + (size_t)(i * 32) * lda);
        rb[i] = *(const uint4*)(gb2 + (size_t)(i * 32) * ldb);
      }
    }
    const u16* cA = sA + cur * 128 * LDT + (wm * 64 + fr) * LDT + fq * 8;
    const u16* cB = sB + cur * 128 * LDT + (wn * 64 + fr) * LDT + fq * 8;
#pragma unroll
    for (int kk = 0; kk < 2; kk++) {
      bf16x8 af[4], bfr[4];
#pragma unroll
      for (int i = 0; i < 4; i++) af[i] = *(const bf16x8*)(cA + i * 16 * LDT + kk * 32);
#pragma unroll
      for (int j = 0; j < 4; j++) bfr[j] = *(const bf16x8*)(cB + j * 16 * LDT + kk * 32);
#pragma unroll
      for (int i = 0; i < 4; i++)
#pragma unroll
        for (int j = 0; j < 4; j++) {
          if (SWAP) acc[i][j] = MFMA(bfr[j], af[i], acc[i][j]);
          else acc[i][j] = MFMA(af[i], bfr[j], acc[i][j]);
        }
    }
    if (more) {
      u16* dA = sA + (cur ^ 1) * 128 * LDT;
      u16* dB = sB + (cur ^ 1) * 128 * LDT;
#pragma unroll
      for (int i = 0; i < 4; i++) {
        *(uint4*)(dA + (lr + i * 32) * LDT + lc) = ra[i];
        *(uint4*)(dB + (lr + i * 32) * LDT + lc) = rb[i];
      }
    }
    __syncthreads();
  }
}

__device__ __forceinline__ void tile_coords(int L, int MT, int NT, int& mt, int& nt) {
  const int full = NT >> 3;
  const int per = MT * 8;
  if (L < full * per) {
    int sc = L / per, r = L - sc * per;
    mt = r >> 3;
    nt = sc * 8 + (r & 7);
  } else {
    int L2 = L - full * per;
    int w = NT - full * 8;
    mt = L2 / w;
    nt = full * 8 + (L2 - mt * w);
  }
}

struct TileIter {
  int cur, end, step;
  __device__ TileIter(int ntiles) {
    int nb = gridDim.x, b = blockIdx.x;
    if ((nb & 7) == 0) {
      int per = (ntiles + 7) >> 3;
      int x = b & 7, j = b >> 3;
      cur = x * per + j;
      end = min((x + 1) * per, ntiles);
      step = nb >> 3;
    } else {
      cur = b; end = ntiles; step = nb;
    }
  }
};


constexpr size_t OFF_Q = OFF_BAR + 16384;
__device__ __forceinline__ int queue_next(unsigned* ctr, int* sh) {
  __syncthreads();
  if (threadIdx.x == 0) *sh = (int)__hip_atomic_fetch_add(ctr, 1u, __ATOMIC_RELAXED, __HIP_MEMORY_SCOPE_AGENT);
  __syncthreads();
  return *sh;
}

struct TrDesc { const float* src; u16* dst; int lds, nvalid, ldd, mode, rowoff, k0, n0; };
__device__ __forceinline__ TrDesc tr_desc(const Params& P, int j) {
  TrDesc d; int ntn; d.mode = 0; d.rowoff = 0;
  if (j < 320) { d.src = P.in[12] + 256; d.lds = 1536; d.nvalid = 1280; d.dst = (u16*)(P.ws + OFF_WIE); d.ldd = 1024; d.rowoff = 512; ntn = 20; }
  else if ((j -= 320) < 256) { d.src = P.in[15]; d.lds = 1024; d.nvalid = 1024; d.dst = (u16*)(P.ws + OFF_WOE); d.ldd = 1024; ntn = 16; }
  else if ((j -= 256) < 864) { d.src = P.in[16]; d.lds = 3360; d.nvalid = 3360; d.dst = (u16*)(P.ws + OFF_WIO); d.ldd = 1024; ntn = 54; }
  else if ((j -= 864) < 384) { d.src = P.in[30]; d.lds = 1024; d.nvalid = 1024; d.dst = (u16*)(P.ws + OFF_WOO); d.ldd = 1536; ntn = 16; }
  else if ((j -= 384) < 2816) {
    int q = j / 704; j -= q * 704; int l = q >> 1, w3 = q & 1;
    d.src = (w3 ? P.in[32] : P.in[31]) + (size_t)l * 1024 * 2816; d.lds = 2816; d.nvalid = 2816;
    d.dst = (u16*)(P.ws + OFF_W13) + (size_t)l * 5632 * 1024; d.ldd = 1024; d.mode = 1; d.rowoff = w3 * 16; ntn = 44;
  } else {
    j -= 2816; int l = j / 704; j -= l * 704;
    d.src = P.in[33] + (size_t)l * 2816 * 1024; d.lds = 1024; d.nvalid = 1024;
    d.dst = (u16*)(P.ws + OFF_W2) + (size_t)l * 1024 * 2816; d.ldd = 2816; ntn = 16;
  }
  const int kt = j / ntn, nt = j - kt * ntn;
  d.k0 = kt * 64; d.n0 = nt * 64;
  return d;
}
__device__ __forceinline__ void tr_load(const TrDesc& d, int tid, float4 (&v)[4]) {
#pragma unroll
  for (int i = 0; i < 4; i++) {
    const int r = i * 16 + (tid >> 4), n = d.n0 + (tid & 15) * 4;
    v[i] = make_float4(0.f, 0.f, 0.f, 0.f);
    if (n < d.nvalid) v[i] = *(const float4*)(d.src + (size_t)(d.k0 + r) * d.lds + n);
  }
}
__device__ __forceinline__ void tr_emit(const TrDesc& d, int tid, const float4 (&v)[4], float* tile) {
#pragma unroll
  for (int i = 0; i < 4; i++) {
    const int r = i * 16 + (tid >> 4), c4 = (tid & 15) * 4;
    tile[r * 65 + c4] = v[i].x; tile[r * 65 + c4 + 1] = v[i].y; tile[r * 65 + c4 + 2] = v[i].z; tile[r * 65 + c4 + 3] = v[i].w;
  }
  __syncthreads();
#pragma unroll
  for (int i = 0; i < 4; i++) {
    const int n = i * 16 + (tid >> 4), k4 = (tid & 15) * 4;
    const int ng = d.n0 + n;
    const int row = d.mode ? ((ng >> 4) * 32 + (ng & 15) + d.rowoff) : (ng + d.rowoff);
    uint2 o;
    o.x = pack2(tile[(k4 + 0) * 65 + n], tile[(k4 + 1) * 65 + n]);
    o.y = pack2(tile[(k4 + 2) * 65 + n], tile[(k4 + 3) * 65 + n]);
    *(uint2*)(d.dst + (size_t)row * d.ldd + d.k0 + k4) = o;
  }
  __syncthreads();
}
__device__ __forceinline__ void phase_prep(const Params& P, char* smem, int* qsh) {
  const int tid = threadIdx.x, nb = gridDim.x, bid = blockIdx.x;
  const int lane = tid & 63, wave = tid >> 6;
  float* tile = (float*)smem;
  float* tabc = (float*)(smem + 16640);
  float* tabs = tabc + 64;
  float* sc = (float*)(smem + 20480);
  float* red = (float*)(smem + 20480 + 36864);
  {
    float* prm = (float*)(P.ws + OFF_PRM);
    const int gt = bid * 256 + tid, gs = nb * 256;
#define PCOPY(SRC, OFF, N) for (int i = gt; i < (N); i += gs) prm[(OFF) + i] = (SRC)[i];
    PCOPY(P.in[10], PRM_NORM_MIX, 2048) PCOPY(P.in[11], PRM_NORM_FFN, 2048) PCOPY(P.in[13], PRM_QN, 64) PCOPY(P.in[14], PRM_KN, 64)
    PCOPY(P.in[17], PRM_CLW, 2048) PCOPY(P.in[18], PRM_CLB, 512) PCOPY(P.in[20], PRM_LBA, 1024) PCOPY(P.in[22], PRM_LBX, 1024)
    PCOPY(P.in[23], PRM_LAM, 1024) PCOPY(P.in[24], PRM_CSW, 5120) PCOPY(P.in[25], PRM_CSB, 1280) PCOPY(P.in[26], PRM_DTB, 32)
    PCOPY(P.in[27], PRM_ALOG, 32) PCOPY(P.in[28], PRM_SSDD, 16) PCOPY(P.in[29], PRM_SNORM, 1024)
    PCOPY(P.in[19], PRM_LWA, 65536) PCOPY(P.in[21], PRM_LWX, 65536)
#undef PCOPY
  }
  bool sc_ready = false;
  constexpr int N_MOD = 384, N_FF = 64, N_TR = 6048, N_DFT = 544, N_CACHE = 512;
  constexpr int N_ALL = N_MOD + N_FF + N_TR + N_DFT + N_CACHE;
  for (int it = bid; it < N_ALL; it += nb) {
    int j = it;
    if (j < N_MOD) {
      if (!sc_ready) {
        for (int i = tid; i < 9 * 1024; i += 256) {
          int r = i >> 10, k = i & 1023;
          float c = r < 8 ? P.in[2][r * 1024 + k] : P.in[7][k];
          sc[i] = silu_f(c);
        }
        __syncthreads();
        sc_ready = true;
      }
      const int l = j / 192, n0 = (j % 192) * 32;
      const int cgp = tid & 7, kl = tid >> 3;
      float acc[9][4];
#pragma unroll
      for (int r = 0; r < 9; r++)
#pragma unroll
        for (int c = 0; c < 4; c++) acc[r][c] = 0.f;
      const float* w = P.in[8] + (size_t)l * 1024 * 6144 + n0 + cgp * 4;
#pragma unroll 4
      for (int i = 0; i < 32; i++) {
        const int k = i * 32 + kl;
        const float4 wv = *(const float4*)(w + (size_t)k * 6144);
#pragma unroll
        for (int r = 0; r < 9; r++) {
          const float s = sc[r * 1024 + k];
          acc[r][0] += s * wv.x; acc[r][1] += s * wv.y; acc[r][2] += s * wv.z; acc[r][3] += s * wv.w;
        }
      }
#pragma unroll
      for (int r = 0; r < 9; r++)
#pragma unroll
        for (int c = 0; c < 4; c++) {
          float v = acc[r][c];
          v += __shfl_xor(v, 8); v = xor16_sum(v); v = xor32_sum(v);
          acc[r][c] = v;
        }
      if (lane < 8) {
#pragma unroll
        for (int r = 0; r < 9; r++)
#pragma unroll
          for (int c = 0; c < 4; c++) red[(wave * 9 + r) * 32 + cgp * 4 + c] = acc[r][c];
      }
      __syncthreads();
      float* MOD = (float*)(P.ws + OFF_MOD);
      for (int i = tid; i < 288; i += 256) {
        int r = i >> 5, c = i & 31;
        float s = red[(0 * 9 + r) * 32 + c] + red[(1 * 9 + r) * 32 + c] + red[(2 * 9 + r) * 32 + c] + red[(3 * 9 + r) * 32 + c];
        MOD[(l * 9 + r) * 6144 + n0 + c] = s + P.in[9][l * 6144 + n0 + c];
      }
      __syncthreads();
      continue;
    }
    j -= N_MOD;
    if (j < N_FF) {
      const int g = j >> 4, kt = j & 15;
      if (tid < 64) { tabc[tid] = cospif(tid / 32.0f); tabs[tid] = sinpif(tid / 32.0f); }
      const float* src = P.in[12] + (size_t)(kt * 64) * 1536 + g * 64;
#pragma unroll
      for (int i = 0; i < 4; i++) {
        int r = i * 16 + (tid >> 4), c4 = (tid & 15) * 4;
        float4 v = *(const float4*)(src + (size_t)r * 1536 + c4);
        tile[r * 65 + c4] = v.x; tile[r * 65 + c4 + 1] = v.y; tile[r * 65 + c4 + 2] = v.z; tile[r * 65 + c4 + 3] = v.w;
      }
      __syncthreads();
      const int np = tid & 127, kh = tid >> 7;
      const int wsel = np >> 6, cp = np & 63;
      float acc[32];
#pragma unroll
      for (int i = 0; i < 32; i++) acc[i] = 0.f;
      for (int c = 0; c < 64; c++) {
        const int idx = (c * cp) & 63;
        const float coef = wsel ? tabs[idx] : tabc[idx];
#pragma unroll
        for (int i = 0; i < 32; i++) acc[i] += tile[(kh * 32 + i) * 65 + c] * coef;
      }
      u16* dst = (u16*)(P.ws + OFF_WIE) + (size_t)(g * 128 + np) * 1024 + kt * 64 + kh * 32;
#pragma unroll
      for (int i = 0; i < 4; i++) {
        uint4 o;
        o.x = pack2(acc[i * 8 + 0], acc[i * 8 + 1]); o.y = pack2(acc[i * 8 + 2], acc[i * 8 + 3]);
        o.z = pack2(acc[i * 8 + 4], acc[i * 8 + 5]); o.w = pack2(acc[i * 8 + 6], acc[i * 8 + 7]);
        *(uint4*)(dst + i * 8) = o;
      }
      __syncthreads();
      continue;
    }
    j -= N_FF;
    if (j < N_TR) continue;
    j -= N_TR;
    if (j < N_DFT) {
      if (j < 512) {
        u16* D = (u16*)(P.ws + OFF_D1K);
        const int e0 = j * 4096;
        for (int i = 0; i < 16; i++) {
          int e = e0 + i * 256 + tid;
          int sp = e >> 11, k = e & 2047;
          float v;
          if (k < 1024) { int r = (sp * k) & 1023; v = cospif(r * (1.0f / 512.0f)); }
          else { int r = (sp * (k - 1024)) & 1023; v = -sinpif(r * (1.0f / 512.0f)); }
          D[e] = f2bf(v * (1.0f / 256.0f));
        }
      } else {
        u16* D = (u16*)(P.ws + OFF_D256);
        const int e0 = (j - 512) * 4096;
        for (int i = 0; i < 16; i++) {
          int e = e0 + i * 256 + tid;
          int sp = e >> 9, k = e & 511;
          float v;
          if (k < 256) { int r = (sp * k) & 255; v = cospif(r * (1.0f / 128.0f)); }
          else { int r = (sp * (k - 256)) & 255; v = -sinpif(r * (1.0f / 128.0f)); }
          D[e] = f2bf(v * (1.0f / 128.0f));
        }
      }
      continue;
    }
    j -= N_DFT;
    if (j < 256) {
      const int e0 = j * 4096;
      const float* src = P.in[3];
      u16* KB = (u16*)(P.ws + OFF_KBS);
      for (int i = 0; i < 16; i++) {
        int e = e0 + i * 256 + tid;
        int b = e >> 17, p = (e >> 8) & 511, h = (e >> 6) & 3, d = e & 63;
        KB[((size_t)(b * 4 + h) * 1536 + 1024 + p) * 64 + d] = f2bf(src[e]);
      }
    } else {
      const int it2 = j - 256;
      const int b = it2 >> 5, h = (it2 >> 3) & 3, pc = it2 & 7;
      const float* src = P.in[4];
      u16* VT = (u16*)(P.ws + OFF_VTS);
#pragma unroll
      for (int i = 0; i < 4; i++) {
        const int r = i * 16 + (tid >> 4), c4 = (tid & 15) * 4;
        const float4 v = *(const float4*)(src + ((size_t)(b * 512 + pc * 64 + r) * 4 + h) * 64 + c4);
        tile[r * 65 + c4] = v.x; tile[r * 65 + c4 + 1] = v.y; tile[r * 65 + c4 + 2] = v.z; tile[r * 65 + c4 + 3] = v.w;
      }
      __syncthreads();
#pragma unroll
      for (int i = 0; i < 4; i++) {
        const int d = i * 16 + (tid >> 4), p4 = (tid & 15) * 4;
        uint2 o;
        o.x = pack2(tile[(p4 + 0) * 65 + d], tile[(p4 + 1) * 65 + d]);
        o.y = pack2(tile[(p4 + 2) * 65 + d], tile[(p4 + 3) * 65 + d]);
        *(uint2*)(VT + ((size_t)(b * 4 + h) * 64 + d) * 1536 + 1024 + pc * 64 + p4) = o;
      }
      __syncthreads();
    }
  }
  {
    unsigned* ctr = (unsigned*)(P.ws + OFF_BAR + 20480);
    for (;;) {
      const int k = queue_next(ctr, qsh);
      const int j0 = 2 * k;
      if (j0 >= N_TR) break;
      const TrDesc d0 = tr_desc(P, j0);
      const TrDesc d1 = tr_desc(P, j0 + 1);
      float4 v0[4], v1[4];
      tr_load(d0, tid, v0);
      tr_load(d1, tid, v1);
      tr_emit(d0, tid, v0, tile);
      tr_emit(d1, tid, v1, tile);
    }
  }
}

__device__ __forceinline__ void phase_norm(const Params& P, int l, int which) {
  const int tid = threadIdx.x, lane = tid & 63, wave = tid >> 6;
  const float* MOD = (const float*)(P.ws + OFF_MOD);
  const float* gvec = PRM(P, (which ? PRM_NORM_FFN : PRM_NORM_MIX) + l * 1024);
  u16* H = (u16*)(P.ws + OFF_H);
  const int nwaves = gridDim.x * 4;
  const int rpw = (T_ALL + nwaves - 1) / nwaves;
  const int r0 = (blockIdx.x * 4 + wave) * rpw;
  const int r1 = min(r0 + rpw, T_ALL);
  constexpr int NR = 3;
  const int osh = (which ? 3 : 0) * 1024, osc = (which ? 4 : 1) * 1024;
  float4 gm[4], sh[4];
  int cached = -1;
  for (int t0 = r0; t0 < r1; t0 += NR) {
    float4 v[NR][4];
#pragma unroll
    for (int r = 0; r < NR; r++) {
      const int t = min(t0 + r, r1 - 1);
      const float* x = (l == 0 && which == 0) ? xin(P, t) : P.out + (size_t)t * 1024;
#pragma unroll
      for (int j = 0; j < 4; j++) v[r][j] = *(const float4*)(x + j * 256 + lane * 4);
    }
    float ss[NR];
#pragma unroll
    for (int r = 0; r < NR; r++) {
      float a = 0.f;
#pragma unroll
      for (int j = 0; j < 4; j++) a += v[r][j].x * v[r][j].x + v[r][j].y * v[r][j].y + v[r][j].z * v[r][j].z + v[r][j].w * v[r][j].w;
      ss[r] = a;
    }
#pragma unroll
    for (int o = 32; o >= 1; o >>= 1) {
#pragma unroll
      for (int r = 0; r < NR; r++) ss[r] += __shfl_xor(ss[r], o);
    }
#pragma unroll
    for (int r = 0; r < NR; r++) {
      const int t = t0 + r;
      if (t >= r1) continue;
      const int cr = cond_row(t);
      if (cr != cached) {
        cached = cr;
        const float* mb = MOD + (size_t)(l * 9 + cr) * 6144;
#pragma unroll
        for (int j = 0; j < 4; j++) {
          const int c = j * 256 + lane * 4;
          const float4 g = *(const float4*)(gvec + c);
          const float4 cm = *(const float4*)(mb + osc + c);
          sh[j] = *(const float4*)(mb + osh + c);
          gm[j] = make_float4(g.x * (1.f + cm.x), g.y * (1.f + cm.y), g.z * (1.f + cm.z), g.w * (1.f + cm.w));
        }
      }
      const float rs = rsqrtf(ss[r] * (1.0f / 1024.0f) + 1e-6f);
#pragma unroll
      for (int j = 0; j < 4; j++) {
        const int c = j * 256 + lane * 4;
        uint2 o;
        o.x = pack2(v[r][j].x * rs * gm[j].x + sh[j].x, v[r][j].y * rs * gm[j].y + sh[j].y);
        o.y = pack2(v[r][j].z * rs * gm[j].z + sh[j].z, v[r][j].w * rs * gm[j].w + sh[j].w);
        *(uint2*)(H + (size_t)t * 1024 + c) = o;
      }
    }
  }
}

__device__ __forceinline__ void phase_gemm_in_even(const Params& P, char* smem) {
  const int tid = threadIdx.x, lane = tid & 63, wave = tid >> 6;
  const int wm = wave >> 1, wn = wave & 1, fr = lane & 15, fq = lane >> 4;
  const u16* A = (const u16*)(P.ws + OFF_H);
  const u16* W = (const u16*)(P.ws + OFF_WIE);
  constexpr int MT = 48, NT = 14;
  for (TileIter ti(MT * NT); ti.cur < ti.end; ti.cur += ti.step) {
    int mtile, ntile;
    tile_coords(ti.cur, MT, NT, mtile, ntile);
    const int m0 = mtile * 256, n0 = ntile * 128;
    f32x4 acc[8][4];
    const bool swap = (ntile >= 4 && ntile < 12);
    if (swap) gemm_mainloop<true, 8>(A + (size_t)m0 * 1024, 1024, W + (size_t)n0 * 1024, 1024, 1024, (u16*)smem, acc);
    else gemm_mainloop<false, 8>(A + (size_t)m0 * 1024, 1024, W + (size_t)n0 * 1024, 1024, 1024, (u16*)smem, acc);
    const bool smp = m0 >= T_CTX;
    int fr_e = fr, fq_e = fq;
    asm volatile("" : "+v"(fr_e), "+v"(fq_e));
    u16* stg = (u16*)smem + wave * (128 * 72);
    if (ntile < 4) {
      const int g = ntile;
      u16* YT; int S, seq, sbase;
      if (smp) { YT = (u16*)(P.ws + OFF_YTS); S = 1024; seq = (m0 - T_CTX) >> 10; sbase = (m0 - T_CTX) & 1023; }
      else { YT = (u16*)(P.ws + OFF_YTC); S = 256; seq = m0 >> 8; sbase = m0 & 255; }
      u16* base = YT + (size_t)seq * 256 * 2 * S;
      u16* stgT = (u16*)smem + wave * (64 * 136);
#pragma unroll
      for (int mt = 0; mt < 8; mt++)
#pragma unroll
        for (int nt = 0; nt < 4; nt++) {
          uint2 o;
          o.x = pack2(acc[mt][nt][0], acc[mt][nt][1]);
          o.y = pack2(acc[mt][nt][2], acc[mt][nt][3]);
          *(uint2*)(stgT + (nt * 16 + fr_e) * 136 + mt * 16 + fq_e * 4) = o;
        }
      {
        const int rr = lane >> 4, cc = (lane & 15) * 8;
        u16* dst = base + (size_t)(g * 64 + rr) * 2 * S + wn * S + sbase + wm * 128 + cc;
#pragma unroll
        for (int i = 0; i < 16; i++) {
          const u32x4 v = *(const u32x4*)(stgT + (i * 4 + rr) * 136 + cc);
          *(u32x4*)(dst + (size_t)(i * 4) * 2 * S) = v;
        }
      }
    } else if (ntile < 12) {
      const bool isq = ntile < 10;
      const int hcol = n0 + wn * 64 - (isq ? 512 : 1280);
      const int head = hcol >> 6;
      const float* gn = PRM(P, isq ? PRM_QN : PRM_KN);
#pragma unroll
      for (int mt = 0; mt < 8; mt++) {
        __builtin_amdgcn_sched_barrier(0);
        const int t = m0 + wm * 128 + mt * 16 + fr_e;
        float ss = 0.f;
#pragma unroll
        for (int nt = 0; nt < 4; nt++)
#pragma unroll
          for (int r = 0; r < 4; r++) ss += acc[mt][nt][r] * acc[mt][nt][r];
        ss = xor16_sum(ss);
        ss = xor32_sum(ss);
        const float rs = rsqrtf(ss * (1.0f / 64.0f) + 1e-6f);
#pragma unroll
        for (int nt = 0; nt < 4; nt++) {
          const float4 g4 = *(const float4*)(gn + nt * 16 + fq_e * 4);
          acc[mt][nt][0] *= rs * g4.x; acc[mt][nt][1] *= rs * g4.y; acc[mt][nt][2] *= rs * g4.z; acc[mt][nt][3] *= rs * g4.w;
        }
        if (!smp && !isq) {
          float* nk = P.out + 12582912 + (size_t)t * 256 + head * 64;
#pragma unroll
          for (int nt = 0; nt < 4; nt++)
            *(float4*)(nk + nt * 16 + fq_e * 4) = make_float4(acc[mt][nt][0], acc[mt][nt][1], acc[mt][nt][2], acc[mt][nt][3]);
        }
        if (smp) {
          const int s = (t - T_CTX) & 1023;
          const float prow = (float)(s >> 6), pcol = (float)(s & 63);
#pragma unroll
          for (int r = 0; r < 4; r++) {
            const float fre = exp2f(-(float)(fq_e * 4 + r) * (13.287712379549449f / 16.0f));
            const float a0 = prow * fre, a1 = pcol * fre;
            const float c0 = __cosf(a0), s0 = __sinf(a0), c1 = __cosf(a1), s1 = __sinf(a1);
            const float x1 = acc[mt][0][r], x2 = acc[mt][1][r];
            acc[mt][0][r] = x1 * c0 - x2 * s0; acc[mt][1][r] = x2 * c0 + x1 * s0;
            const float y1 = acc[mt][2][r], y2 = acc[mt][3][r];
            acc[mt][2][r] = y1 * c1 - y2 * s1; acc[mt][3][r] = y2 * c1 + y1 * s1;
          }
        }
        {
          const float qs = isq ? 0.125f * LOG2E : 1.0f;
#pragma unroll
          for (int nt = 0; nt < 4; nt++) {
            uint2 o;
            o.x = pack2(acc[mt][nt][0] * qs, acc[mt][nt][1] * qs);
            o.y = pack2(acc[mt][nt][2] * qs, acc[mt][nt][3] * qs);
            *(uint2*)(stg + (mt * 16 + fr_e) * 72 + nt * 16 + fq_e * 4) = o;
          }
        }
      }
      {
        const int rr = lane >> 3, cc = (lane & 7) * 8;
        const int tr0 = m0 + wm * 128;
        u16* dst;
        size_t rstride;
        if (isq) { dst = (u16*)(P.ws + OFF_QB) + (size_t)tr0 * 768 + head * 64; rstride = 768; }
        else if (smp) { const int sq = (tr0 - T_CTX) >> 10, key = (tr0 - T_CTX) & 1023; dst = (u16*)(P.ws + OFF_KBS) + ((size_t)(sq * 4 + head) * 1536 + key) * 64; rstride = 64; }
        else { const int sq = tr0 >> 8, key = tr0 & 255; dst = (u16*)(P.ws + OFF_KBC) + ((size_t)(sq * 4 + head) * 256 + key) * 64; rstride = 64; }
        dst += (size_t)rr * rstride + cc;
#pragma unroll
        for (int i = 0; i < 16; i++) {
          const u32x4 v = *(const u32x4*)(stg + (i * 8 + rr) * 72 + cc);
          *(u32x4*)(dst + (size_t)(i * 8) * rstride) = v;
        }
      }
    } else {
      const int head = (n0 + wn * 64 - 1536) >> 6;
      u16* stgT = (u16*)smem + wave * (64 * 136);
#pragma unroll
      for (int mt = 0; mt < 8; mt++) {
        const int t = m0 + wm * 128 + mt * 16 + fq_e * 4;
#pragma unroll
        for (int nt = 0; nt < 4; nt++) {
          const int d = nt * 16 + fr_e;
          uint2 o;
          o.x = pack2(acc[mt][nt][0], acc[mt][nt][1]);
          o.y = pack2(acc[mt][nt][2], acc[mt][nt][3]);
          *(uint2*)(stgT + d * 136 + mt * 16 + fq_e * 4) = o;
          if (!smp) {
            float* nv = P.out + 13631488 + (size_t)t * 256 + head * 64 + d;
#pragma unroll
            for (int r = 0; r < 4; r++) nv[(size_t)r * 256] = acc[mt][nt][r];
          }
        }
      }
      {
        const int rr = lane >> 4, cc = (lane & 15) * 8;
        const int tr0 = m0 + wm * 128;
        u16* dst; size_t rstride;
        if (smp) { const int sq = (tr0 - T_CTX) >> 10, key = (tr0 - T_CTX) & 1023; dst = (u16*)(P.ws + OFF_VTS) + ((size_t)(sq * 4 + head) * 64) * 1536 + key; rstride = 1536; }
        else { const int sq = tr0 >> 8, key = tr0 & 255; dst = (u16*)(P.ws + OFF_VTC) + ((size_t)(sq * 4 + head) * 64) * 256 + key; rstride = 256; }
        dst += (size_t)rr * rstride + cc;
#pragma unroll
        for (int i = 0; i < 16; i++) {
          const u32x4 v = *(const u32x4*)(stgT + (i * 4 + rr) * 136 + cc);
          *(u32x4*)(dst + (size_t)(i * 4) * rstride) = v;
        }
      }
    }
    __syncthreads();
  }
}

__device__ __forceinline__ void phase_gemm_resid(const Params& P, char* smem, const u16* A, int lda, const u16* W, int K,
                                 int l, int gate_idx, bool from_x) {
  const int tid = threadIdx.x, lane = tid & 63, wave = tid >> 6;
  const int wm = wave >> 1, wn = wave & 1, fr = lane & 15, fq = lane >> 4;
  const float* MOD = (const float*)(P.ws + OFF_MOD);
  constexpr int MT = 64, NT = 8;
  float* stg = (float*)smem + wave * (48 * 68);
  for (TileIter ti(MT * NT); ti.cur < ti.end; ti.cur += ti.step) {
    int mtile, ntile;
    tile_coords(ti.cur, MT, NT, mtile, ntile);
    const int m0 = mtile * 192, n0 = ntile * 128;
    f32x4 acc[6][4];
    gemm_mainloop<true, 6>(A + (size_t)m0 * lda, lda, W + (size_t)n0 * K, K, K, (u16*)smem, acc);
#pragma unroll
    for (int h = 0; h < 2; h++) {
#pragma unroll
      for (int mt = 0; mt < 3; mt++)
#pragma unroll
        for (int nt = 0; nt < 4; nt++)
          *(f32x4*)(stg + (mt * 16 + fr) * 68 + nt * 16 + fq * 4) = acc[h * 3 + mt][nt];
      const int rr = lane >> 4, c4 = (lane & 15) * 4;
      const int n = n0 + wn * 64 + c4;
#pragma unroll
      for (int i = 0; i < 12; i++) {
        const int row = i * 4 + rr;
        const int t = m0 + wm * 96 + h * 48 + row;
        const float4 a4 = *(const float4*)(stg + row * 68 + c4);
        const float4 g = *(const float4*)(MOD + (size_t)(l * 9 + cond_row(t)) * 6144 + gate_idx * 1024 + n);
        const float* bp = from_x ? xin(P, t) : P.out + (size_t)t * 1024;
        const float4 bsv = *(const float4*)(bp + n);
        float4 o;
        o.x = bsv.x + g.x * a4.x; o.y = bsv.y + g.y * a4.y; o.z = bsv.z + g.z * a4.z; o.w = bsv.w + g.w * a4.w;
        *(float4*)(P.out + (size_t)t * 1024 + n) = o;
      }
    }
    __syncthreads();
  }
}

template <int MTW>
__device__ __forceinline__ void ffn_up_tile(const u16* A, const u16* W, u16* U, char* smem, int m0, int n0) {
  const int tid = threadIdx.x, lane = tid & 63, wave = tid >> 6;
  const int wm = wave >> 1, wn = wave & 1, fr = lane & 15, fq = lane >> 4;
  f32x4 acc[MTW][4];
  gemm_mainloop<true, MTW>(A + (size_t)m0 * 1024, 1024, W + (size_t)n0 * 1024, 1024, 1024, (u16*)smem, acc);
  constexpr int R = 16 * MTW;
  u16* stg = (u16*)smem + wm * (R * 72);
#pragma unroll
  for (int mt = 0; mt < MTW; mt++) {
#pragma unroll
    for (int np = 0; np < 2; np++) {
      float r[4];
#pragma unroll
      for (int q = 0; q < 4; q++) r[q] = silu_f(acc[mt][np * 2][q]) * acc[mt][np * 2 + 1][q];
      uint2 o;
      o.x = pack2(r[0], r[1]); o.y = pack2(r[2], r[3]);
      *(uint2*)(stg + (mt * 16 + fr) * 72 + wn * 32 + np * 16 + fq * 4) = o;
    }
  }
  __syncthreads();
  {
    const int rr = lane >> 3, cc = (lane & 7) * 8;
    const int row0 = wn * (R / 2) + rr;
    u16* dst = U + (size_t)(m0 + wm * R + row0) * 2816 + (n0 >> 1) + cc;
#pragma unroll
    for (int i = 0; i < MTW; i++) {
      const u32x4 v = *(const u32x4*)(stg + (row0 + i * 8) * 72 + cc);
      *(u32x4*)(dst + (size_t)(i * 8) * 2816) = v;
    }
  }
  __syncthreads();
}

__device__ __forceinline__ void phase_gemm_ffn_up(const Params& P, char* smem, int l) {
  const u16* A = (const u16*)(P.ws + OFF_H);
  const u16* W = (const u16*)(P.ws + OFF_W13) + (size_t)l * 5632 * 1024;
  u16* U = (u16*)(P.ws + OFF_R1);
  constexpr int MT = 48, NT = 44;
  constexpr int NFULL = 2048;
  for (TileIter ti(NFULL); ti.cur < ti.end; ti.cur += ti.step) {
    int mtile, ntile;
    tile_coords(ti.cur, MT, NT, mtile, ntile);
    ffn_up_tile<8>(A, W, U, smem, mtile * 256, ntile * 128);
  }
  for (TileIter ti((MT * NT - NFULL) * 4); ti.cur < ti.end; ti.cur += ti.step) {
    int mtile, ntile;
    tile_coords(NFULL + (ti.cur >> 2), MT, NT, mtile, ntile);
    ffn_up_tile<2>(A, W, U, smem, mtile * 256 + (ti.cur & 3) * 64, ntile * 128);
  }
}

__device__ __forceinline__ void phase_gemm_in_odd(const Params& P, char* smem) {
  const int tid = threadIdx.x, lane = tid & 63, wave = tid >> 6;
  const int wm = wave >> 1, wn = wave & 1, fr = lane & 15, fq = lane >> 4;
  const u16* A = (const u16*)(P.ws + OFF_H);
  const u16* W = (const u16*)(P.ws + OFF_WIO);
  u16* PO = (u16*)(P.ws + OFF_R1);
  float* DT = (float*)(P.ws + OFF_DT);
  constexpr int MT = 48, NT = 27;
  u16* stg = (u16*)smem + wave * (128 * 72);
  for (TileIter ti(MT * NT); ti.cur < ti.end; ti.cur += ti.step) {
    int mtile, ntile;
    tile_coords(ti.cur, MT, NT, mtile, ntile);
    const int m0 = mtile * 256, n0 = ntile * 128;
    f32x4 acc[8][4];
    gemm_mainloop<true>(A + (size_t)m0 * 1024, 1024, W + (size_t)n0 * 1024, 1024, 1024, (u16*)smem, acc);
#pragma unroll
    for (int mt = 0; mt < 8; mt++) {
#pragma unroll
      for (int nt = 0; nt < 4; nt++) {
        uint2 o;
        o.x = pack2(acc[mt][nt][0], acc[mt][nt][1]);
        o.y = pack2(acc[mt][nt][2], acc[mt][nt][3]);
        *(uint2*)(stg + (mt * 16 + fr) * 72 + nt * 16 + fq * 4) = o;
        const int n = n0 + wn * 64 + nt * 16 + fq * 4;
        if (n >= 3328 && n < 3360) {
          const int t = m0 + wm * 128 + mt * 16 + fr;
          *(float4*)(DT + (size_t)t * 32 + (n - 3328)) = make_float4(acc[mt][nt][0], acc[mt][nt][1], acc[mt][nt][2], acc[mt][nt][3]);
        }
      }
    }
    {
      const int rr = lane >> 3, cc = (lane & 7) * 8;
      u16* dst = PO + (size_t)(m0 + wm * 128 + rr) * 3456 + n0 + wn * 64 + cc;
#pragma unroll
      for (int i = 0; i < 16; i++) {
        const u32x4 v = *(const u32x4*)(stg + (i * 8 + rr) * 72 + cc);
        *(u32x4*)(dst + (size_t)(i * 8) * 3456) = v;
      }
    }
    __syncthreads();
  }
}

__device__ __forceinline__ void fourier_tile(const Params& P, int item, char* smem) {
  const int tid = threadIdx.x, lane = tid & 63, wave = tid >> 6;
  const int wm = wave >> 1, wn = wave & 1, fr = lane & 15, fq = lane >> 4;
  const u16 *D, *YT; int S, tb, mtile, ntile;
  if (item < 128) {
    int seq = item >> 4, r = item & 15; mtile = r >> 1; ntile = r & 1; S = 1024; tb = T_CTX + seq * 1024;
    D = (const u16*)(P.ws + OFF_D1K); YT = (const u16*)(P.ws + OFF_YTS) + (size_t)seq * 256 * 2048;
  } else {
    item -= 128; int seq = item >> 2, r = item & 3; mtile = r >> 1; ntile = r & 1; S = 256; tb = seq * 256;
    D = (const u16*)(P.ws + OFF_D256); YT = (const u16*)(P.ws + OFF_YTC) + (size_t)seq * 256 * 512;
  }
  f32x4 acc[4][4];
  const int K = 2 * S;
  gemm_mainloop<true, 4>(D + (size_t)(mtile * 128) * K, K, YT + (size_t)(ntile * 128) * K, K, K, (u16*)smem, acc);
  u16* MIX = (u16*)(P.ws + OFF_H);
#pragma unroll
  for (int mt = 0; mt < 4; mt++) {
    const int t = tb + mtile * 128 + wm * 64 + mt * 16 + fr;
#pragma unroll
    for (int nt = 0; nt < 4; nt++) {
      const int n = ntile * 128 + wn * 64 + nt * 16 + fq * 4;
      uint2 o;
      o.x = pack2(acc[mt][nt][0], acc[mt][nt][1]);
      o.y = pack2(acc[mt][nt][2], acc[mt][nt][3]);
      *(uint2*)(MIX + (size_t)t * 1024 + n) = o;
    }
  }
}

__device__ __forceinline__ void attn_item(const Params& P, int item, char* smem) {
  const int tid = threadIdx.x, lane = tid & 63, wave = tid >> 6;
  const int fr = lane & 15, fq = lane >> 4;
  bool smp; int seq, head, qb;
  if (item < 768) { smp = true; seq = item / 96; int r = item % 96; head = r >> 3; qb = r & 7; }
  else { item -= 768; smp = false; seq = item / 24; int r = item % 24; head = r >> 1; qb = r & 1; }
  const int nkeys = smp ? 1536 : 256;
  const int tb = smp ? T_CTX + seq * 1024 : seq * 256;
  const int kvh = head / 3;
  const u16* Kp = (const u16*)(P.ws + (smp ? OFF_KBS : OFF_KBC)) + (size_t)((seq * 4 + kvh) * nkeys) * 64;
  const u16* Vp = (const u16*)(P.ws + (smp ? OFF_VTS : OFF_VTC)) + (size_t)((seq * 4 + kvh) * 64) * nkeys;
  const u16* QB = (const u16*)(P.ws + OFF_QB);
  u16* sK = (u16*)smem;
  u16* sV = sK + 2 * 64 * LDT;
  bf16x8 qf[2][2];
  const int qrow0 = tb + qb * 128 + wave * 32;
#pragma unroll
  for (int qt = 0; qt < 2; qt++)
#pragma unroll
    for (int kk = 0; kk < 2; kk++)
      qf[qt][kk] = *(const bf16x8*)(QB + (size_t)(qrow0 + qt * 16 + fr) * 768 + head * 64 + kk * 32 + fq * 8);
  f32x4 ot[2][4];
#pragma unroll
  for (int a = 0; a < 2; a++)
#pragma unroll
    for (int b = 0; b < 4; b++) ot[a][b] = f32x4{0.f, 0.f, 0.f, 0.f};
  float mrun[2] = {-INFINITY, -INFINITY}, lrun[2] = {0.f, 0.f};
  const int lrow = tid >> 3, lcol = (tid & 7) * 8;
  uint4 rk[2], rv[2];
#pragma unroll
  for (int i = 0; i < 2; i++) {
    rk[i] = *(const uint4*)(Kp + (size_t)(lrow + i * 32) * 64 + lcol);
    rv[i] = *(const uint4*)(Vp + (size_t)(lrow + i * 32) * nkeys + lcol);
  }
#pragma unroll
  for (int i = 0; i < 2; i++) {
    *(uint4*)(sK + (lrow + i * 32) * LDT + lcol) = rk[i];
    *(uint4*)(sV + (lrow + i * 32) * LDT + lcol) = rv[i];
  }
  __syncthreads();
  const int nkt = nkeys >> 6;
  for (int kt = 0; kt < nkt; kt++) {
    const int cur = kt & 1;
    const bool more = kt + 1 < nkt;
    if (more) {
      const int key0 = (kt + 1) * 64;
#pragma unroll
      for (int i = 0; i < 2; i++) {
        rk[i] = *(const uint4*)(Kp + (size_t)(key0 + lrow + i * 32) * 64 + lcol);
        rv[i] = *(const uint4*)(Vp + (size_t)(lrow + i * 32) * nkeys + key0 + lcol);
      }
    }
    const u16* cK = sK + cur * 64 * LDT;
    const u16* cV = sV + cur * 64 * LDT;
    f32x4 st[2][4];
#pragma unroll
    for (int k16 = 0; k16 < 4; k16++) {
      const bf16x8 kf0 = *(const bf16x8*)(cK + (k16 * 16 + fr) * LDT + fq * 8);
      const bf16x8 kf1 = *(const bf16x8*)(cK + (k16 * 16 + fr) * LDT + 32 + fq * 8);
#pragma unroll
      for (int qt = 0; qt < 2; qt++) {
        f32x4 z = f32x4{0.f, 0.f, 0.f, 0.f};
        z = MFMA(kf0, qf[qt][0], z);
        st[qt][k16] = MFMA(kf1, qf[qt][1], z);
      }
    }
    bf16x8 pf[2][2];
#pragma unroll
    for (int qt = 0; qt < 2; qt++) {
      float mx = st[qt][0][0];
#pragma unroll
      for (int k16 = 0; k16 < 4; k16++)
#pragma unroll
        for (int r = 0; r < 4; r++) mx = fmaxf(mx, st[qt][k16][r]);
      mx = xor16_max(mx);
      mx = xor32_max(mx);
      if (!__all(mx - mrun[qt] <= 8.0f)) {
        const float mnew = fmaxf(mrun[qt], mx);
        const float alpha = fexp2(mrun[qt] - mnew);
        mrun[qt] = mnew;
        lrun[qt] *= alpha;
#pragma unroll
        for (int dt = 0; dt < 4; dt++)
#pragma unroll
          for (int r = 0; r < 4; r++) ot[qt][dt][r] *= alpha;
      }
      const float mcur = mrun[qt];
      float ps = 0.f;
#pragma unroll
      for (int k16 = 0; k16 < 4; k16++)
#pragma unroll
        for (int r = 0; r < 4; r++) {
          const float p = fexp2(st[qt][k16][r] - mcur);
          st[qt][k16][r] = p;
          ps += p;
        }
      lrun[qt] += ps;
#pragma unroll
      for (int a = 0; a < 2; a++) {
        union { bf16x8 v; unsigned u[4]; } pk;
        pk.u[0] = pack2(st[qt][2 * a][0], st[qt][2 * a][1]);
        pk.u[1] = pack2(st[qt][2 * a][2], st[qt][2 * a][3]);
        pk.u[2] = pack2(st[qt][2 * a + 1][0], st[qt][2 * a + 1][1]);
        pk.u[3] = pack2(st[qt][2 * a + 1][2], st[qt][2 * a + 1][3]);
        pf[qt][a] = pk.v;
      }
    }
#pragma unroll
    for (int a = 0; a < 2; a++)
#pragma unroll
      for (int dt = 0; dt < 4; dt++) {
        union { bf16x8 v; uint2 h[2]; } vf;
        vf.h[0] = *(const uint2*)(cV + (dt * 16 + fr) * LDT + a * 32 + fq * 4);
        vf.h[1] = *(const uint2*)(cV + (dt * 16 + fr) * LDT + a * 32 + 16 + fq * 4);
#pragma unroll
        for (int qt = 0; qt < 2; qt++) ot[qt][dt] = MFMA(vf.v, pf[qt][a], ot[qt][dt]);
      }
    if (more) {
      u16* dK = sK + (cur ^ 1) * 64 * LDT;
      u16* dV = sV + (cur ^ 1) * 64 * LDT;
#pragma unroll
      for (int i = 0; i < 2; i++) {
        *(uint4*)(dK + (lrow + i * 32) * LDT + lcol) = rk[i];
        *(uint4*)(dV + (lrow + i * 32) * LDT + lcol) = rv[i];
      }
    }
    __syncthreads();
  }
  u16* MIX = (u16*)(P.ws + OFF_H);
#pragma unroll
  for (int qt = 0; qt < 2; qt++) {
    float l = lrun[qt];
    l = xor16_sum(l);
    l = xor32_sum(l);
    const float inv = __builtin_amdgcn_rcpf(l);
    const int t = qrow0 + qt * 16 + fr;
#pragma unroll
    for (int dt = 0; dt < 4; dt++) {
      uint2 o;
      o.x = pack2(ot[qt][dt][0] * inv, ot[qt][dt][1] * inv);
      o.y = pack2(ot[qt][dt][2] * inv, ot[qt][dt][3] * inv);
      *(uint2*)(MIX + (size_t)t * 1024 + 256 + head * 64 + dt * 16 + fq * 4) = o;
    }
  }
}

__device__ __forceinline__ void phase_even_mix(const Params& P, char* smem, int* qsh, const int rep) {
  unsigned* ctr = (unsigned*)(P.ws + OFF_Q + rep * 512);
  for (;;) {
    const int it = queue_next(ctr, qsh);
    if (it >= 1344) break;
    if (it < 128) fourier_tile(P, it, smem);
    else if (it < 896) attn_item(P, it - 128, smem);
    else if (it < 960) fourier_tile(P, it - 896 + 128, smem);
    else attn_item(P, it - 960 + 768, smem);
  }
}

__device__ __forceinline__ void ssd_conv8(const u16* __restrict__ PO, int col, const float* __restrict__ cw,
                                          const float* __restrict__ cb, int ch, int tg0, int lo, int hi,
                                          float (&o)[4][8]) {
  uint4 v[7];
#pragma unroll
  for (int r = 0; r < 7; r++) {
    const int t = tg0 - 1 + r;
    v[r] = make_uint4(0u, 0u, 0u, 0u);
    if (t >= lo && t < hi) v[r] = *(const uint4*)(PO + (size_t)t * 3456 + col);
  }
  float w[4][8], b[8];
#pragma unroll
  for (int j = 0; j < 4; j++) {
    const float4 w0 = *(const float4*)(cw + j * 1280 + ch);
    const float4 w1 = *(const float4*)(cw + j * 1280 + ch + 4);
    w[j][0] = w0.x; w[j][1] = w0.y; w[j][2] = w0.z; w[j][3] = w0.w;
    w[j][4] = w1.x; w[j][5] = w1.y; w[j][6] = w1.z; w[j][7] = w1.w;
  }
  {
    const float4 b0 = *(const float4*)(cb + ch);
    const float4 b1 = *(const float4*)(cb + ch + 4);
    b[0] = b0.x; b[1] = b0.y; b[2] = b0.z; b[3] = b0.w; b[4] = b1.x; b[5] = b1.y; b[6] = b1.z; b[7] = b1.w;
  }
#pragma unroll
  for (int tok = 0; tok < 4; tok++)
#pragma unroll
    for (int e = 0; e < 8; e++) o[tok][e] = b[e];
#pragma unroll
  for (int r = 0; r < 7; r++) {
    const unsigned uu[4] = {v[r].x, v[r].y, v[r].z, v[r].w};
#pragma unroll
    for (int e = 0; e < 8; e++) {
      const float x = __uint_as_float((e & 1) ? (uu[e >> 1] & 0xffff0000u) : (uu[e >> 1] << 16));
#pragma unroll
      for (int tok = 0; tok < 4; tok++) {
        const int j = r - tok;
        if (j >= 0 && j < 4) o[tok][e] += w[j][e] * x;
      }
    }
  }
#pragma unroll
  for (int tok = 0; tok < 4; tok++)
#pragma unroll
    for (int e = 0; e < 8; e++) o[tok][e] = silu_f(o[tok][e]);
}


__device__ __forceinline__ void phase_odd_conv(const Params& P) {
  const u16* PO = (const u16*)(P.ws + OFF_R1);
  u16* XC = (u16*)(P.ws + OFF_H);
  const float* cw = PRM(P, PRM_CSW);
  const float* cb = PRM(P, PRM_CSB);
  constexpr int NRUN = T_ALL / 16;
  const int nthr = gridDim.x * 256;
  for (int idx = blockIdx.x * 256 + threadIdx.x; idx < NRUN * 160; idx += nthr) {
    const int c8 = idx % 160, run = idx / 160;
    const int tb16 = run * 16;
    int lo, hi;
    if (tb16 < T_CTX) { lo = tb16 & ~255; hi = lo + 256; }
    else { lo = T_CTX + ((tb16 - T_CTX) & ~1023); hi = lo + 1024; }
    const int ch = c8 * 8;
    float w[4][8], bb[8];
#pragma unroll
    for (int j = 0; j < 4; j++) {
      const float4 w0 = *(const float4*)(cw + j * 1280 + ch);
      const float4 w1 = *(const float4*)(cw + j * 1280 + ch + 4);
      w[j][0] = w0.x; w[j][1] = w0.y; w[j][2] = w0.z; w[j][3] = w0.w;
      w[j][4] = w1.x; w[j][5] = w1.y; w[j][6] = w1.z; w[j][7] = w1.w;
    }
    {
      const float4 b0 = *(const float4*)(cb + ch);
      const float4 b1 = *(const float4*)(cb + ch + 4);
      bb[0] = b0.x; bb[1] = b0.y; bb[2] = b0.z; bb[3] = b0.w; bb[4] = b1.x; bb[5] = b1.y; bb[6] = b1.z; bb[7] = b1.w;
    }
    const u16* src = PO + 2048 + ch;
    u32x4 v[19];
#pragma unroll
    for (int r = 0; r < 19; r++) {
      const int t = tb16 - 1 + r;
      v[r] = u32x4{0u, 0u, 0u, 0u};
      if (t >= lo && t < hi) v[r] = *(const u32x4*)(src + (size_t)t * 3456);
    }
#pragma unroll
    for (int tok = 0; tok < 16; tok++) {
      float o[8];
#pragma unroll
      for (int e = 0; e < 8; e++) o[e] = bb[e];
#pragma unroll
      for (int j = 0; j < 4; j++) {
        const u32x4 vv = v[tok + j];
        const unsigned uu[4] = {vv.x, vv.y, vv.z, vv.w};
#pragma unroll
        for (int e = 0; e < 8; e++) {
          const float x = __uint_as_float((e & 1) ? (uu[e >> 1] & 0xffff0000u) : (uu[e >> 1] << 16));
          o[e] += w[j][e] * x;
        }
      }
      uint4 w4;
      w4.x = pack2(silu_f(o[0]), silu_f(o[1])); w4.y = pack2(silu_f(o[2]), silu_f(o[3]));
      w4.z = pack2(silu_f(o[4]), silu_f(o[5])); w4.w = pack2(silu_f(o[6]), silu_f(o[7]));
      *(uint4*)(XC + (size_t)(tb16 + tok) * 1280 + ch) = w4;
    }
  }
}

__device__ __forceinline__ void ssd_item(const Params& P, int item, char* smem) {
  const int tid = threadIdx.x, lane = tid & 63, wave = tid >> 6;
  const int fr = lane & 15, fq = lane >> 4;
  bool smp; int seq;
  if (item < 256) { smp = true; seq = item >> 5; }
  else { item -= 256; smp = false; seq = item >> 5; }
  const int head = (item & 31) >> 1, dir = item & 1;
  const int nc = smp ? 8 : 2;
  const int tb = smp ? T_CTX + seq * 1024 : seq * 256;
  const int tend = tb + (smp ? 1024 : 256);
  const int g = head >> 3;
  u16* Cs = (u16*)smem;
  u16* Bs = (u16*)(smem + 18432);
  u16* BT = (u16*)(smem + 36864);
  u16* XT = (u16*)(smem + 54272);
  u16* Hb = (u16*)(smem + 71680);
  float* cum2 = (float*)(smem + 79872);
  float* lcs2 = (float*)(smem + 80384);
  float* misc = (float*)(smem + 81408);
  const u16* PO = (const u16*)(P.ws + OFF_R1);
  const float* DT = (const float*)(P.ws + OFF_DT);
  u16* YO = (u16*)(P.ws + OFF_Y) + (size_t)dir * T_ALL * 1024;
  const float Aneg = -__expf(PRM(P, PRM_ALOG)[dir * 16 + head]);
  const float dtb = PRM(P, PRM_DTB)[dir * 16 + head];
  const float Dh = PRM(P, PRM_SSDD)[head];
  f32x4 hacc[4];
#pragma unroll
  for (int nt = 0; nt < 4; nt++) {
#pragma unroll
    for (int r = 0; r < 4; r++) {
      float v = 0.f;
      if (smp) v = P.in[6][(size_t)((seq * 2 + dir) * 16 + head) * 4096 + (wave * 16 + fq * 4 + r) * 64 + nt * 16 + fr];
      hacc[nt][r] = v;
      Hb[(wave * 16 + fq * 4 + r) * 64 + nt * 16 + fr] = f2bf(v);
    }
  }
  const int ch8 = (tid & 7) * 8, rg = tid >> 3;
  const u16* XC = (const u16*)(P.ws + OFF_H);
  u32x4 rx0, rx1, rx2, rx3, rb0, rb1, rb2, rb3;
  float raw_next = 0.f;
  {
    const int c0 = dir ? nc - 1 : 0;
    const u16* xr = XC + (size_t)(tb + c0 * 128 + rg * 4) * 1280 + ch8;
    rx0 = *(const u32x4*)(xr + head * 64); rx1 = *(const u32x4*)(xr + 1280 + head * 64);
    rx2 = *(const u32x4*)(xr + 2560 + head * 64); rx3 = *(const u32x4*)(xr + 3840 + head * 64);
    rb0 = *(const u32x4*)(xr + 1024 + g * 64); rb1 = *(const u32x4*)(xr + 1280 + 1024 + g * 64);
    rb2 = *(const u32x4*)(xr + 2560 + 1024 + g * 64); rb3 = *(const u32x4*)(xr + 3840 + 1024 + g * 64);
    if (tid < 128) raw_next = DT[(size_t)(tb + c0 * 128 + (dir ? 127 - tid : tid)) * 32 + dir * 16 + head];
  }
  for (int ci = 0; ci < nc; ci++) {
    const int c = dir ? nc - 1 - ci : ci;
    const int t0 = tb + c * 128;
    {
      const u16* xrc = XC + (size_t)(t0 + rg * 4) * 1280 + ch8 + 1152 + g * 64;
      const u32x4 rc0 = *(const u32x4*)(xrc), rc1 = *(const u32x4*)(xrc + 1280);
      const u32x4 rc2 = *(const u32x4*)(xrc + 2560), rc3 = *(const u32x4*)(xrc + 3840);
      {
        const unsigned u[4][4] = {{rx0.x, rx0.y, rx0.z, rx0.w}, {rx1.x, rx1.y, rx1.z, rx1.w}, {rx2.x, rx2.y, rx2.z, rx2.w}, {rx3.x, rx3.y, rx3.z, rx3.w}};
#pragma unroll
        for (int q = 0; q < 4; q++) {
          uint2 lo2, hi2;
          lo2.x = (u[0][q] & 0xffffu) | (u[1][q] << 16); lo2.y = (u[2][q] & 0xffffu) | (u[3][q] << 16);
          hi2.x = (u[0][q] >> 16) | (u[1][q] & 0xffff0000u); hi2.y = (u[2][q] >> 16) | (u[3][q] & 0xffff0000u);
          *(uint2*)(XT + (ch8 + 2 * q) * 136 + rg * 4) = lo2;
          *(uint2*)(XT + (ch8 + 2 * q + 1) * 136 + rg * 4) = hi2;
        }
      }
      {
        const unsigned u[4][4] = {{rb0.x, rb0.y, rb0.z, rb0.w}, {rb1.x, rb1.y, rb1.z, rb1.w}, {rb2.x, rb2.y, rb2.z, rb2.w}, {rb3.x, rb3.y, rb3.z, rb3.w}};
#pragma unroll
        for (int q = 0; q < 4; q++) {
          uint2 lo2, hi2;
          lo2.x = (u[0][q] & 0xffffu) | (u[1][q] << 16); lo2.y = (u[2][q] & 0xffffu) | (u[3][q] << 16);
          hi2.x = (u[0][q] >> 16) | (u[1][q] & 0xffff0000u); hi2.y = (u[2][q] >> 16) | (u[3][q] & 0xffff0000u);
          *(uint2*)(BT + (ch8 + 2 * q) * 136 + rg * 4) = lo2;
          *(uint2*)(BT + (ch8 + 2 * q + 1) * 136 + rg * 4) = hi2;
        }
        *(u32x4*)(Bs + (rg * 4 + 0) * LDT + ch8) = rb0;
        *(u32x4*)(Bs + (rg * 4 + 1) * LDT + ch8) = rb1;
        *(u32x4*)(Bs + (rg * 4 + 2) * LDT + ch8) = rb2;
        *(u32x4*)(Bs + (rg * 4 + 3) * LDT + ch8) = rb3;
      }
      *(u32x4*)(Cs + (rg * 4 + 0) * LDT + ch8) = rc0;
      *(u32x4*)(Cs + (rg * 4 + 1) * LDT + ch8) = rc1;
      *(u32x4*)(Cs + (rg * 4 + 2) * LDT + ch8) = rc2;
      *(u32x4*)(Cs + (rg * 4 + 3) * LDT + ch8) = rc3;
    }
    const float raw_cur = raw_next;
    __builtin_amdgcn_sched_barrier(0);
    if (ci + 1 < nc) {
      const int cn = dir ? nc - 2 - ci : ci + 1;
      const u16* xr = XC + (size_t)(tb + cn * 128 + rg * 4) * 1280 + ch8;
      rx0 = *(const u32x4*)(xr + head * 64); rx1 = *(const u32x4*)(xr + 1280 + head * 64);
      rx2 = *(const u32x4*)(xr + 2560 + head * 64); rx3 = *(const u32x4*)(xr + 3840 + head * 64);
      rb0 = *(const u32x4*)(xr + 1024 + g * 64); rb1 = *(const u32x4*)(xr + 1280 + 1024 + g * 64);
      rb2 = *(const u32x4*)(xr + 2560 + 1024 + g * 64); rb3 = *(const u32x4*)(xr + 3840 + 1024 + g * 64);
      if (tid < 128) raw_next = DT[(size_t)(tb + cn * 128 + (dir ? 127 - tid : tid)) * 32 + dir * 16 + head];
    }
    __builtin_amdgcn_sched_barrier(0);
    float sv = 0.f, dtv = 1.f;
    int li = 0;
    if (tid < 128) {
      li = dir ? 127 - tid : tid;
      const float raw = raw_cur + dtb;
      dtv = fmaxf(raw, 0.f) + log1pf(__expf(-fabsf(raw)));
      sv = dtv * Aneg;
#pragma unroll
      for (int o = 1; o < 64; o <<= 1) {
        const float u = __shfl_up(sv, o);
        if (lane >= o) sv += u;
      }
      if (tid == 63) misc[0] = sv;
    }
    __syncthreads();
    if (tid < 128) {
      if (wave == 1) sv += misc[0];
      cum2[li] = sv * LOG2E;
      lcs2[li] = (sv - __logf(dtv)) * LOG2E;
      if (tid == 127) misc[1] = sv * LOG2E;
    }
    __syncthreads();
    const float total2 = misc[1];
#pragma unroll 1
    for (int tt = 0; tt < 2; tt++) {
      const int Tt = wave * 2 + tt;
      const int tl = wave * 32 + tt * 16 + fr;
      bf16x8 cf[2];
#pragma unroll
      for (int kk = 0; kk < 2; kk++) cf[kk] = *(const bf16x8*)(Cs + tl * LDT + kk * 32 + fq * 8);
      f32x4 acc[4];
#pragma unroll
      for (int pt = 0; pt < 4; pt++) {
        const bf16x8 h0 = *(const bf16x8*)(Hb + (pt * 16 + fr) * 64 + fq * 8);
        const bf16x8 h1 = *(const bf16x8*)(Hb + (pt * 16 + fr) * 64 + 32 + fq * 8);
        f32x4 z = f32x4{0.f, 0.f, 0.f, 0.f};
        z = MFMA(h0, cf[0], z);
        acc[pt] = MFMA(h1, cf[1], z);
      }
      const float ct = cum2[tl];
      {
        const float e = fexp2(ct);
#pragma unroll
        for (int pt = 0; pt < 4; pt++)
#pragma unroll
          for (int r = 0; r < 4; r++) acc[pt][r] *= e;
      }
#pragma unroll 1
      for (int a = 0; a < 4; a++) {
        const bool ok = dir ? (2 * a + 1 >= Tt) : (2 * a <= Tt);
        if (!ok) continue;
        f32x4 g0 = f32x4{0.f, 0.f, 0.f, 0.f}, g1 = f32x4{0.f, 0.f, 0.f, 0.f};
#pragma unroll
        for (int kk = 0; kk < 2; kk++) {
          const bf16x8 b0 = *(const bf16x8*)(Bs + ((2 * a) * 16 + fr) * LDT + kk * 32 + fq * 8);
          const bf16x8 b1 = *(const bf16x8*)(Bs + ((2 * a + 1) * 16 + fr) * LDT + kk * 32 + fq * 8);
          g0 = MFMA(b0, cf[kk], g0);
          g1 = MFMA(b1, cf[kk], g1);
        }
        const float4 l0 = *(const float4*)(lcs2 + a * 32 + fq * 4);
        const float4 l1 = *(const float4*)(lcs2 + a * 32 + 16 + fq * 4);
        const float ls0[4] = {l0.x, l0.y, l0.z, l0.w};
        const float ls1[4] = {l1.x, l1.y, l1.z, l1.w};
        float m0[4], m1[4];
#pragma unroll
        for (int r = 0; r < 4; r++) {
          const int s0 = a * 32 + fq * 4 + r, s1 = s0 + 16;
          const bool ok0 = dir ? (s0 >= tl) : (s0 <= tl);
          const bool ok1 = dir ? (s1 >= tl) : (s1 <= tl);
          float v0 = ok0 ? g0[r] * fexp2(ct - ls0[r]) : 0.f;
          float v1 = ok1 ? g1[r] * fexp2(ct - ls1[r]) : 0.f;
          if (!dir && s0 == tl) v0 += Dh;
          if (!dir && s1 == tl) v1 += Dh;
          m0[r] = v0; m1[r] = v1;
        }
        union { bf16x8 v; unsigned u[4]; } pk;
        pk.u[0] = pack2(m0[0], m0[1]); pk.u[1] = pack2(m0[2], m0[3]);
        pk.u[2] = pack2(m1[0], m1[1]); pk.u[3] = pack2(m1[2], m1[3]);
#pragma unroll
        for (int pt = 0; pt < 4; pt++) {
          union { bf16x8 v; uint2 h[2]; } x;
          x.h[0] = *(const uint2*)(XT + (pt * 16 + fr) * 136 + a * 32 + fq * 4);
          x.h[1] = *(const uint2*)(XT + (pt * 16 + fr) * 136 + a * 32 + 16 + fq * 4);
          acc[pt] = MFMA(x.v, pk.v, acc[pt]);
        }
      }
      {
        const int t = t0 + tl;
#pragma unroll
        for (int pt = 0; pt < 4; pt++) {
          uint2 o;
          o.x = pack2(acc[pt][0], acc[pt][1]);
          o.y = pack2(acc[pt][2], acc[pt][3]);
          *(uint2*)(YO + (size_t)t * 1024 + head * 64 + pt * 16 + fq * 4) = o;
        }
      }
    }
    {
      const float et = fexp2(total2);
#pragma unroll
      for (int nt = 0; nt < 4; nt++)
#pragma unroll
        for (int r = 0; r < 4; r++) hacc[nt][r] *= et;
#pragma unroll 1
      for (int ks = 0; ks < 4; ks++) {
        union { bf16x8 v; unsigned u[4]; } xr, xw;
        xr.v = *(const bf16x8*)(XT + (wave * 16 + fr) * 136 + ks * 32 + fq * 8);
        const float4 la = *(const float4*)(lcs2 + ks * 32 + fq * 8);
        const float4 lb = *(const float4*)(lcs2 + ks * 32 + fq * 8 + 4);
        const float lw[8] = {la.x, la.y, la.z, la.w, lb.x, lb.y, lb.z, lb.w};
#pragma unroll
        for (int q = 0; q < 4; q++) {
          const float x0 = __uint_as_float(xr.u[q] << 16) * fexp2(total2 - lw[2 * q]);
          const float x1 = __uint_as_float(xr.u[q] & 0xffff0000u) * fexp2(total2 - lw[2 * q + 1]);
          xw.u[q] = pack2(x0, x1);
        }
#pragma unroll
        for (int nt = 0; nt < 4; nt++) {
          const bf16x8 bt = *(const bf16x8*)(BT + (nt * 16 + fr) * 136 + ks * 32 + fq * 8);
          hacc[nt] = MFMA(xw.v, bt, hacc[nt]);
        }
      }
    }
    __syncthreads();
#pragma unroll
    for (int nt = 0; nt < 4; nt++)
#pragma unroll
      for (int r = 0; r < 4; r++) Hb[(wave * 16 + fq * 4 + r) * 64 + nt * 16 + fr] = f2bf(hacc[nt][r]);
  }
  if (!smp) {
    float* ns = P.out + 14696448 + (size_t)((seq * 2 + dir) * 16 + head) * 4096;
#pragma unroll
    for (int nt = 0; nt < 4; nt++)
#pragma unroll
      for (int r = 0; r < 4; r++) ns[(wave * 16 + fq * 4 + r) * 64 + nt * 16 + fr] = hacc[nt][r];
  }
  __syncthreads();
}

__device__ __forceinline__ void lru_item(const Params& P, int item, char* smem) {
  const int tid = threadIdx.x, lane = tid & 63, wave = tid >> 6;
  const int fr = lane & 15, fq = lane >> 4;
  bool smp; int seq;
  if (item < 128) { smp = true; seq = item >> 4; }
  else { item -= 128; smp = false; seq = item >> 4; }
  const int blk = (item & 15) >> 1, dir = item & 1;
  const int nc = smp ? 16 : 4;
  const int tb = smp ? T_CTX + seq * 1024 : seq * 256;
  const int tend = tb + (smp ? 1024 : 256);
  u16* WaT = (u16*)smem;
  u16* WxT = (u16*)(smem + 9216);
  u16* xcb = (u16*)(smem + 18432);
  float* aL = (float*)(smem + 27648);
  float* bL = (float*)(smem + 45056);
  float* sA = (float*)(smem + 62464);
  float* sH = (float*)(smem + 63488);
  float* hc = (float*)(smem + 64512);
  float* cba = (float*)(smem + 65024);
  float* cbx = (float*)(smem + 65280);
  float* csp = (float*)(smem + 65536);
  const u16* PO = (const u16*)(P.ws + OFF_R1);
  u16* YO = (u16*)(P.ws + OFF_YL) + (size_t)dir * T_ALL * 512;
  {
    const float* wa = PRM(P, PRM_LWA) + (size_t)(dir * 8 + blk) * 4096;
    const float* wx = PRM(P, PRM_LWX) + (size_t)(dir * 8 + blk) * 4096;
    for (int e = tid; e < 4096; e += 256) {
      const int i = e >> 6, j = e & 63;
      WaT[j * LDT + i] = f2bf(wa[e]);
      WxT[j * LDT + i] = f2bf(wx[e]);
    }
    if (tid < 64) {
      const int ch = dir * 512 + blk * 64 + tid;
      cba[tid] = PRM(P, PRM_LBA)[ch];
      cbx[tid] = PRM(P, PRM_LBX)[ch];
      const float lam = -PRM(P, PRM_LAM)[ch];
      csp[tid] = 8.0f * (fmaxf(lam, 0.f) + log1pf(__expf(-fabsf(lam))));
      hc[tid] = smp ? P.in[5][(size_t)(seq * 2 + dir) * 512 + blk * 64 + tid] : 0.f;
    }
  }
  const int ch8 = (tid & 7) * 8, rg = tid >> 3;
  const float* cw = PRM(P, PRM_CLW);
  const float* cb = PRM(P, PRM_CLB);
  u32x4 pv0, pv1, pv2, pv3, pv4;
  {
    const int c0 = dir ? nc - 1 : 0;
    const int tn = tb + c0 * 64 + rg * 2 - 1;
    const int chg = blk * 64 + ch8;
    const u32x4 zz = {0u, 0u, 0u, 0u};
    pv0 = (tn >= tb) ? *(const u32x4*)(PO + (size_t)tn * 3456 + 512 + chg) : zz;
    pv1 = *(const u32x4*)(PO + (size_t)(tn + 1) * 3456 + 512 + chg);
    pv2 = *(const u32x4*)(PO + (size_t)(tn + 2) * 3456 + 512 + chg);
    pv3 = (tn + 3 < tend) ? *(const u32x4*)(PO + (size_t)(tn + 3) * 3456 + 512 + chg) : zz;
    pv4 = (tn + 4 < tend) ? *(const u32x4*)(PO + (size_t)(tn + 4) * 3456 + 512 + chg) : zz;
  }
  for (int ci = 0; ci < nc; ci++) {
    const int c = dir ? nc - 1 - ci : ci;
    const int t0 = tb + c * 64;
    const int cur = ci & 1;
    {
      const int chg = blk * 64 + ch8;
      const u32x4 v[5] = {pv0, pv1, pv2, pv3, pv4};
      if (ci + 1 < nc) {
        const int cn = dir ? nc - 2 - ci : ci + 1;
        const int tn = tb + cn * 64 + rg * 2 - 1;
        const u32x4 zz = {0u, 0u, 0u, 0u};
        pv0 = (tn >= tb) ? *(const u32x4*)(PO + (size_t)tn * 3456 + 512 + chg) : zz;
        pv1 = *(const u32x4*)(PO + (size_t)(tn + 1) * 3456 + 512 + chg);
        pv2 = *(const u32x4*)(PO + (size_t)(tn + 2) * 3456 + 512 + chg);
        pv3 = (tn + 3 < tend) ? *(const u32x4*)(PO + (size_t)(tn + 3) * 3456 + 512 + chg) : zz;
        pv4 = (tn + 4 < tend) ? *(const u32x4*)(PO + (size_t)(tn + 4) * 3456 + 512 + chg) : zz;
      }
      float o[2][8];
      {
        const float4 b0 = *(const float4*)(cb + chg);
        const float4 b1 = *(const float4*)(cb + chg + 4);
        const float bb[8] = {b0.x, b0.y, b0.z, b0.w, b1.x, b1.y, b1.z, b1.w};
#pragma unroll
        for (int e = 0; e < 8; e++) { o[0][e] = bb[e]; o[1][e] = bb[e]; }
      }
#pragma unroll
      for (int j = 0; j < 4; j++) {
        const float4 w0 = *(const float4*)(cw + j * 512 + chg);
        const float4 w1 = *(const float4*)(cw + j * 512 + chg + 4);
        const float ww[8] = {w0.x, w0.y, w0.z, w0.w, w1.x, w1.y, w1.z, w1.w};
#pragma unroll
        for (int tok = 0; tok < 2; tok++) {
          const unsigned uu[4] = {v[tok + j].x, v[tok + j].y, v[tok + j].z, v[tok + j].w};
#pragma unroll
          for (int e = 0; e < 8; e++) {
            const float x = __uint_as_float((e & 1) ? (uu[e >> 1] & 0xffff0000u) : (uu[e >> 1] << 16));
            o[tok][e] += ww[e] * x;
          }
        }
      }
#pragma unroll
      for (int tok = 0; tok < 2; tok++) {
        const int tl = rg * 2 + tok;
        *(float4*)(bL + tl * 68 + ch8) = make_float4(o[tok][0], o[tok][1], o[tok][2], o[tok][3]);
        *(float4*)(bL + tl * 68 + ch8 + 4) = make_float4(o[tok][4], o[tok][5], o[tok][6], o[tok][7]);
        uint4 w4;
        w4.x = pack2(o[tok][0], o[tok][1]); w4.y = pack2(o[tok][2], o[tok][3]);
        w4.z = pack2(o[tok][4], o[tok][5]); w4.w = pack2(o[tok][6], o[tok][7]);
        *(uint4*)(xcb + tl * LDT + ch8) = w4;
      }
    }
    __syncthreads();
    {
      bf16x8 xb[2];
#pragma unroll
      for (int kk = 0; kk < 2; kk++) xb[kk] = *(const bf16x8*)(xcb + (wave * 16 + fr) * LDT + kk * 32 + fq * 8);
      const int tl = wave * 16 + fr;
#pragma unroll
      for (int jt = 0; jt < 4; jt++) {
        f32x4 aR = f32x4{0.f, 0.f, 0.f, 0.f}, aI = f32x4{0.f, 0.f, 0.f, 0.f};
#pragma unroll
        for (int kk = 0; kk < 2; kk++) {
          const bf16x8 wa = *(const bf16x8*)(WaT + (jt * 16 + fr) * LDT + kk * 32 + fq * 8);
          const bf16x8 wx = *(const bf16x8*)(WxT + (jt * 16 + fr) * LDT + kk * 32 + fq * 8);
          aR = MFMA(wa, xb[kk], aR);
          aI = MFMA(wx, xb[kk], aI);
        }
        const int j4 = jt * 16 + fq * 4;
        const float4 xc = *(const float4*)(bL + tl * 68 + j4);
        const float4 ba = *(const float4*)(cba + j4);
        const float4 bx = *(const float4*)(cbx + j4);
        const float4 sp = *(const float4*)(csp + j4);
        const float xcv[4] = {xc.x, xc.y, xc.z, xc.w};
        const float bav[4] = {ba.x, ba.y, ba.z, ba.w};
        const float bxv[4] = {bx.x, bx.y, bx.z, bx.w};
        const float spv[4] = {sp.x, sp.y, sp.z, sp.w};
        float av[4], bv[4];
#pragma unroll
        for (int r = 0; r < 4; r++) {
          const float rr = sigmoid_f(aR[r] + bav[r]);
          const float ii = sigmoid_f(aI[r] + bxv[r]);
          const float la = -rr * spv[r];
          av[r] = __expf(la);
          bv[r] = __builtin_amdgcn_sqrtf(fmaxf(1.0f - av[r] * av[r], 0.f)) * ii * xcv[r];
        }
        *(float4*)(aL + tl * 68 + j4) = make_float4(av[0], av[1], av[2], av[3]);
        *(float4*)(bL + tl * 68 + j4) = make_float4(bv[0], bv[1], bv[2], bv[3]);
      }
    }
    __syncthreads();
    {
      const int j = lane, q = wave;
      float hreg[16], areg[16];
      float h = 0.f, Ap = 1.f;
#pragma unroll
      for (int i = 0; i < 16; i++) {
        const int tl = dir ? 63 - (q * 16 + i) : q * 16 + i;
        const float a = aL[tl * 68 + j], b = bL[tl * 68 + j];
        h = a * h + b;
        Ap *= a;
        hreg[i] = h;
        areg[i] = Ap;
      }
      sA[q * 64 + j] = Ap;
      sH[q * 64 + j] = h;
      __syncthreads();
      float Hin = hc[cur * 64 + j];
      for (int qq = 0; qq < q; qq++) Hin = sA[qq * 64 + j] * Hin + sH[qq * 64 + j];
#pragma unroll
      for (int i = 0; i < 16; i++) {
        const int tl = dir ? 63 - (q * 16 + i) : q * 16 + i;
        const float hv = hreg[i] + areg[i] * Hin;
        YO[(size_t)(t0 + tl) * 512 + blk * 64 + j] = f2bf(hv);
      }
      if (q == 3) hc[(cur ^ 1) * 64 + j] = sA[3 * 64 + j] * Hin + sH[3 * 64 + j];
    }
  }
  __syncthreads();
  if (!smp && tid < 64) {
    P.out[14680064 + (size_t)(seq * 2 + dir) * 512 + blk * 64 + tid] = hc[(nc & 1) * 64 + tid];
  }
  __syncthreads();
}

__device__ __forceinline__ void phase_odd_mix(const Params& P, char* smem, int* qsh, const int rep) {
  unsigned* ctr = (unsigned*)(P.ws + OFF_Q + 256 + rep * 512);
  for (;;) {
    const int it = queue_next(ctr, qsh);
    if (it >= 1152) break;
    bool is_ssd; int idx;
    if (it < 128) { is_ssd = false; idx = it; }
    else if (it < 384) { is_ssd = true; idx = it - 128; }
    else if (it < 640) { is_ssd = false; idx = it - 384 + 128; }
    else { is_ssd = true; idx = it - 640 + 256; }
    if (is_ssd) ssd_item(P, idx, smem);
    else lru_item(P, idx, smem);
  }
}

__device__ __forceinline__ void phase_odd_combine(const Params& P) {
  const int tid = threadIdx.x, lane = tid & 63, wave = tid >> 6;
  const u16* PO = (const u16*)(P.ws + OFF_R1);
  const u16* YSF = (const u16*)(P.ws + OFF_Y);
  const u16* YSB = YSF + (size_t)T_ALL * 1024;
  const u16* YLF = (const u16*)(P.ws + OFF_YL);
  const u16* YLB = YLF + (size_t)T_ALL * 512;
  u16* MIX = (u16*)(P.ws + OFF_H);
  const float* nrm = PRM(P, PRM_SNORM);
  float4 nr[2][2];
#pragma unroll
  for (int hh = 0; hh < 2; hh++) { nr[hh][0] = *(const float4*)(nrm + hh * 512 + lane * 8); nr[hh][1] = *(const float4*)(nrm + hh * 512 + lane * 8 + 4); }
  for (int t = blockIdx.x * 4 + wave; t < T_ALL; t += gridDim.x * 4) {
    {
      const int c = lane * 8;
      const uint4 f = *(const uint4*)(YLF + (size_t)t * 512 + c);
      const uint4 b = *(const uint4*)(YLB + (size_t)t * 512 + c);
      const uint4 gg = *(const uint4*)(PO + (size_t)t * 3456 + c);
      const unsigned fu[4] = {f.x, f.y, f.z, f.w}, bu[4] = {b.x, b.y, b.z, b.w}, gu[4] = {gg.x, gg.y, gg.z, gg.w};
      unsigned ou[4];
#pragma unroll
      for (int q = 0; q < 4; q++) {
        float r[2];
#pragma unroll
        for (int h = 0; h < 2; h++) {
          const float yf = h ? __uint_as_float(fu[q] & 0xffff0000u) : __uint_as_float(fu[q] << 16);
          const float yb = h ? __uint_as_float(bu[q] & 0xffff0000u) : __uint_as_float(bu[q] << 16);
          const float gv = h ? __uint_as_float(gu[q] & 0xffff0000u) : __uint_as_float(gu[q] << 16);
          const float ge = gv * __builtin_amdgcn_rcpf(1.f + __expf(-2.0f * 0.7978845608028654f * (gv + 0.044715f * gv * gv * gv)));
          r[h] = (yf + yb) * ge;
        }
        ou[q] = pack2(r[0], r[1]);
      }
      *(uint4*)(MIX + (size_t)t * 1536 + c) = make_uint4(ou[0], ou[1], ou[2], ou[3]);
    }
    float y[16];
    float ss = 0.f;
#pragma unroll
    for (int hh = 0; hh < 2; hh++) {
      const int c = hh * 512 + lane * 8;
      const uint4 f = *(const uint4*)(YSF + (size_t)t * 1024 + c);
      const uint4 b = *(const uint4*)(YSB + (size_t)t * 1024 + c);
      const uint4 zz = *(const uint4*)(PO + (size_t)t * 3456 + 1024 + c);
      const unsigned fu[4] = {f.x, f.y, f.z, f.w}, bu[4] = {b.x, b.y, b.z, b.w}, zu[4] = {zz.x, zz.y, zz.z, zz.w};
#pragma unroll
      for (int q = 0; q < 4; q++)
#pragma unroll
        for (int h = 0; h < 2; h++) {
          const float yf = h ? __uint_as_float(fu[q] & 0xffff0000u) : __uint_as_float(fu[q] << 16);
          const float yb = h ? __uint_as_float(bu[q] & 0xffff0000u) : __uint_as_float(bu[q] << 16);
          const float zv = h ? __uint_as_float(zu[q] & 0xffff0000u) : __uint_as_float(zu[q] << 16);
          const float v = (yf + yb) * silu_f(zv);
          y[hh * 8 + q * 2 + h] = v;
          ss += v * v;
        }
    }
#pragma unroll
    for (int o = 32; o >= 1; o >>= 1) ss += __shfl_xor(ss, o);
    const float rs = rsqrtf(ss * (1.0f / 1024.0f) + 1e-6f);
#pragma unroll
    for (int hh = 0; hh < 2; hh++) {
      const int c = hh * 512 + lane * 8;
      const float4 n0 = nr[hh][0];
      const float4 n1 = nr[hh][1];
      uint4 o;
      o.x = pack2(y[hh * 8 + 0] * rs * n0.x, y[hh * 8 + 1] * rs * n0.y);
      o.y = pack2(y[hh * 8 + 2] * rs * n0.z, y[hh * 8 + 3] * rs * n0.w);
      o.z = pack2(y[hh * 8 + 4] * rs * n1.x, y[hh * 8 + 5] * rs * n1.y);
      o.w = pack2(y[hh * 8 + 6] * rs * n1.z, y[hh * 8 + 7] * rs * n1.w);
      *(uint4*)(MIX + (size_t)t * 1536 + 512 + c) = o;
    }
  }
}

#ifndef PHMASK
#define PHMASK 0xffffffu
#endif
__device__ __forceinline__ void run_phase(const Params& P, const int ph, char* smem, int* qsh, const int rep = 0) {
  switch (ph) {
    case 0: if (PHMASK & (1u << 0)) phase_prep(P, smem, qsh); break;
    case 1: if (PHMASK & (1u << 1)) phase_norm(P, 0, 0); break;
    case 2: if (PHMASK & (1u << 2)) phase_gemm_in_even(P, smem); break;
    case 3: if (PHMASK & (1u << 3)) phase_even_mix(P, smem, qsh, rep); break;
    case 4: if (PHMASK & (1u << 4)) phase_gemm_resid(P, smem, (const u16*)(P.ws + OFF_H), 1024, (const u16*)(P.ws + OFF_WOE), 1024, 0, 2, true); break;
    case 5: if (PHMASK & (1u << 5)) phase_norm(P, 0, 1); break;
    case 6: if (PHMASK & (1u << 6)) phase_gemm_ffn_up(P, smem, 0); break;
    case 7: if (PHMASK & (1u << 7)) phase_gemm_resid(P, smem, (const u16*)(P.ws + OFF_R1), 2816, (const u16*)(P.ws + OFF_W2), 2816, 0, 5, false); break;
    case 8: if (PHMASK & (1u << 8)) phase_norm(P, 1, 0); break;
    case 9: if (PHMASK & (1u << 9)) phase_gemm_in_odd(P, smem); break;
    case 10: if (PHMASK & (1u << 10)) phase_odd_conv(P); break;
    case 11: if (PHMASK & (1u << 11)) phase_odd_mix(P, smem, qsh, rep); break;
    case 12: if (PHMASK & (1u << 12)) phase_odd_combine(P); break;
    case 13: if (PHMASK & (1u << 13)) phase_gemm_resid(P, smem, (const u16*)(P.ws + OFF_H), 1536, (const u16*)(P.ws + OFF_WOO), 1536, 1, 2, false); break;
    case 14: if (PHMASK & (1u << 14)) phase_norm(P, 1, 1); break;
    case 15: if (PHMASK & (1u << 15)) phase_gemm_ffn_up(P, smem, 1); break;
    case 16: if (PHMASK & (1u << 16)) phase_gemm_resid(P, smem, (const u16*)(P.ws + OFF_R1), 2816, (const u16*)(P.ws + OFF_W2) + (size_t)1024 * 2816, 2816, 1, 5, false); break;
    default: break;
  }
}

constexpr int N_PHASES = 17;

__global__ void __launch_bounds__(256, 2) mega_kernel(Params P, int ph_lo, int ph_hi) {
  __shared__ __attribute__((aligned(16))) char smem[SMEM_BYTES];
  __shared__ uint4 xb_words;
  __shared__ int q_item;
  cg::grid_group grid = cg::this_grid();
  if (threadIdx.x == 0) xb_words = make_uint4(0u, 0u, 0u, 0u);
  __syncthreads();
  XcdBarrier xb = xcd_barrier_post((unsigned*)(P.ws + OFF_BAR), (volatile LAS unsigned*)&xb_words);
  if (ph_lo < 0) grid.sync();
#ifndef DUP_PH
#define DUP_PH -1
#endif
#define RUN_PH(ph) if ((ph) >= ph_lo && (ph) < ph_hi) { run_phase(P, (ph), smem, &q_item); if (DUP_PH == (ph)) { xcd_barrier(xb); run_phase(P, (ph), smem, &q_item, 1); } if ((ph) + 1 < ph_hi) xcd_barrier(xb); }
  RUN_PH(0) RUN_PH(1) RUN_PH(2) RUN_PH(3) RUN_PH(4) RUN_PH(5) RUN_PH(6) RUN_PH(7)
  RUN_PH(8) RUN_PH(9) RUN_PH(10) RUN_PH(11) RUN_PH(12) RUN_PH(13) RUN_PH(14) RUN_PH(15) RUN_PH(16)
}

#ifndef MULTI_LAUNCH
#define MULTI_LAUNCH 0
#endif

extern "C" void kernel_launch(void* const* d_in, const int* in_sizes, int n_in, void* d_out, int out_size, void* d_ws,
                              size_t ws_size, hipStream_t stream) {
  static int grid_blocks = 0;
  if (!grid_blocks) {
    int dev = 0, cus = 0, per_cu = 0;
    (void)hipGetDevice(&dev);
    (void)hipDeviceGetAttribute(&cus, hipDeviceAttributeMultiprocessorCount, dev);
    (void)hipOccupancyMaxActiveBlocksPerMultiprocessor(&per_cu, mega_kernel, 256, 0);
    if (per_cu > 2) per_cu = 2;
    if (per_cu < 1) per_cu = 1;
    grid_blocks = cus * per_cu;
  }
  Params p;
  memset(&p, 0, sizeof(p));
  for (int i = 0; i < 34; i++) p.in[i] = (const float*)d_in[i];
  p.out = (float*)d_out;
  p.ws = (char*)d_ws;
#if MULTI_LAUNCH
  for (int ph = 0; ph < N_PHASES; ph++) {
    int lo = ph, hi = ph + 1;
    void* args[] = {&p, &lo, &hi};
    hipError_t e = hipLaunchCooperativeKernel((void*)mega_kernel, dim3(grid_blocks), dim3(256), args, 0, stream);
    if (e != hipSuccess) fprintf(stderr, "launch failed: %s (grid %d)\n", hipGetErrorString(e), grid_blocks);
  }
#else
  (void)hipMemsetAsync((char*)d_ws + OFF_BAR, 0, 24576, stream);
  int lo = 0, hi = N_PHASES;
  void* args[] = {&p, &lo, &hi};
  hipError_t e = hipLaunchCooperativeKernel((void*)mega_kernel, dim3(grid_blocks), dim3(256), args, 0, stream);
  if (e != hipSuccess) fprintf(stderr, "cooperative launch failed: %s (grid %d)\n", hipGetErrorString(e), grid_blocks);
#endif
}
```

```cpp
#include <hip/hip_runtime.h>
#include <hip/hip_bf16.h>
#include <hip/hip_cooperative_groups.h>
#include <cstdio>
#include <cstring>
namespace cg = cooperative_groups;

typedef unsigned short u16;
using bf16x8 = __attribute__((ext_vector_type(8))) short;
using bf16x4 = __attribute__((ext_vector_type(4))) short;
using f32x4 = __attribute__((ext_vector_type(4))) float;

#define MFMA(a, b, c) __builtin_amdgcn_mfma_f32_16x16x32_bf16(a, b, c, 0, 0, 0)
#define LOG2E 1.4426950408889634f

constexpr int T_ALL = 12288;
constexpr int T_CTX = 4096;
constexpr int SMEM_BYTES = 81664;
constexpr int LDT = 72;

constexpr size_t OFF_WIE = 0;
constexpr size_t OFF_WOE = OFF_WIE + 3670016;
constexpr size_t OFF_WIO = OFF_WOE + 2097152;
constexpr size_t OFF_WOO = OFF_WIO + 7077888;
constexpr size_t OFF_W13 = OFF_WOO + 3145728;
constexpr size_t OFF_W2 = OFF_W13 + 23068672;
constexpr size_t OFF_MOD = OFF_W2 + 11534336;
constexpr size_t OFF_D1K = OFF_MOD + 442368;
constexpr size_t OFF_D256 = OFF_D1K + 4194304;
constexpr size_t OFF_H = OFF_D256 + 262144;
constexpr size_t OFF_R1 = OFF_H + 37748736;
constexpr size_t OFF_Y = OFF_R1 + 84934656;
constexpr size_t OFF_YL = OFF_Y + 50331648;
constexpr size_t OFF_DT = OFF_YL + 25165824;
constexpr size_t OFF_BAR = OFF_DT + 1572864;
constexpr size_t OFF_PRM = OFF_BAR + 32768;
constexpr int PRM_NORM_MIX = 0, PRM_NORM_FFN = 2048, PRM_QN = 4096, PRM_KN = 4160, PRM_CLW = 4224, PRM_CLB = 6272,
              PRM_LBA = 6784, PRM_LBX = 7808, PRM_LAM = 8832, PRM_CSW = 9856, PRM_CSB = 14976, PRM_DTB = 16256,
              PRM_ALOG = 16288, PRM_SSDD = 16320, PRM_SNORM = 16384, PRM_LWA = 17408, PRM_LWX = 82944;
#define PRM(P, off) ((const float*)((P).ws + OFF_PRM) + (off))
constexpr size_t OFF_YTS = OFF_Y;
constexpr size_t OFF_YTC = OFF_Y + 8388608;
constexpr size_t OFF_QB = OFF_Y + 12582912;
constexpr size_t OFF_KBS = OFF_Y + 31457280;
constexpr size_t OFF_KBC = OFF_Y + 37748736;
constexpr size_t OFF_VTS = OFF_Y + 39845888;
constexpr size_t OFF_VTC = OFF_Y + 46137344;

struct Params {
  const float* in[34];
  float* out;
  char* ws;
};

typedef __bf16 bf16x2_t __attribute__((ext_vector_type(2)));
typedef float f32x2_t __attribute__((ext_vector_type(2)));
__device__ __forceinline__ unsigned pack2(float a, float b) {
  f32x2_t v = {a, b};
  bf16x2_t r = __builtin_convertvector(v, bf16x2_t);
  return __builtin_bit_cast(unsigned, r);
}
__device__ __forceinline__ u16 f2bf(float f) { return (u16)(pack2(f, 0.f) & 0xffffu); }
__device__ __forceinline__ float bf2f(u16 h) { return __uint_as_float(((unsigned)h) << 16); }
__device__ __forceinline__ float silu_f(float v) { return v * __builtin_amdgcn_rcpf(1.f + __expf(-v)); }
__device__ __forceinline__ float sigmoid_f(float v) { return __builtin_amdgcn_rcpf(1.f + __expf(-v)); }
__device__ __forceinline__ float fexp2(float v) { return __builtin_amdgcn_exp2f(v); }

__device__ __forceinline__ float xor16_sum(float x) {
  const unsigned u = __float_as_uint(x);
  auto r = __builtin_amdgcn_permlane16_swap(u, u, false, false);
  return __uint_as_float(r[0]) + __uint_as_float(r[1]);
}
__device__ __forceinline__ float xor32_sum(float x) {
  const unsigned u = __float_as_uint(x);
  auto r = __builtin_amdgcn_permlane32_swap(u, u, false, false);
  return __uint_as_float(r[0]) + __uint_as_float(r[1]);
}
__device__ __forceinline__ float xor16_max(float x) {
  const unsigned u = __float_as_uint(x);
  auto r = __builtin_amdgcn_permlane16_swap(u, u, false, false);
  return fmaxf(__uint_as_float(r[0]), __uint_as_float(r[1]));
}
__device__ __forceinline__ float xor32_max(float x) {
  const unsigned u = __float_as_uint(x);
  auto r = __builtin_amdgcn_permlane32_swap(u, u, false, false);
  return fmaxf(__uint_as_float(r[0]), __uint_as_float(r[1]));
}
__device__ __forceinline__ int cond_row(int t) { return t < T_CTX ? 8 : ((t - T_CTX) >> 10); }
__device__ __forceinline__ const float* xin(const Params& P, int t) {
  return t < T_CTX ? P.in[0] + (size_t)t * 1024 : P.in[1] + (size_t)(t - T_CTX) * 1024;
}


#define XB_TMO      128
#define XB_XCNT(j)  (256  + 64 * (j))
#define XB_XSUB(j)  (1280 + 64 * (j))
#define XB_XGEN(j)  (2304 + 64 * (j))
#define XB_TOP      3328
#define XB_TOPGEN   3392
#define XCD_BAR_WORDS 3456
#define XB_SPIN_CAP (1u << 22)
#define LAS __attribute__((address_space(3)))
__device__ __forceinline__ unsigned xb_ld(unsigned* p)              { return __hip_atomic_load(p, __ATOMIC_RELAXED, __HIP_MEMORY_SCOPE_AGENT); }
__device__ __forceinline__ unsigned xb_add(unsigned* p, unsigned v) { return __hip_atomic_fetch_add(p, v, __ATOMIC_RELAXED, __HIP_MEMORY_SCOPE_AGENT); }
__device__ __forceinline__ unsigned xb_xcc_id() { return (unsigned)__builtin_amdgcn_s_getreg((3 << 11) | 20) & 0xFu; }
#define XB_SPIN(cond, bar) do { unsigned _sp = 0; while (cond) { __builtin_amdgcn_s_sleep(1); \
    if ((++_sp & 255u) == 0u) { if (xb_ld(&(bar)[XB_TMO])) break; if (_sp > XB_SPIN_CAP) { atomicAdd(&(bar)[XB_TMO], 1u); break; } } } } while (0)
struct XcdBarrier { unsigned* bar; unsigned x; volatile LAS unsigned* st; };
__device__ __forceinline__ XcdBarrier xcd_barrier_post(unsigned* bar, volatile LAS unsigned* st) {
    XcdBarrier b; b.bar = bar; b.x = xb_xcc_id(); b.st = st;
    if (threadIdx.x == 0) (void)xb_add(&bar[XB_XCNT(b.x)], 1u);
    return b;
}
__device__ __forceinline__ void xcd_barrier_complete(unsigned* bar, unsigned x, unsigned& nloc, unsigned& nx) {
    const unsigned G = gridDim.x * gridDim.y * gridDim.z;
    unsigned sum, cnt, mine, sp = 0u;
    for (;;) {
        sum = 0u; cnt = 0u; mine = 0u;
#pragma unroll
        for (unsigned j = 0; j < 16; ++j) { const unsigned c = xb_ld(&bar[XB_XCNT(j)]); sum += c; cnt += (c > 0u) ? 1u : 0u; mine = (j == x) ? c : mine; }
        if (sum == G) break;
        __builtin_amdgcn_s_sleep(1);
        if ((++sp & 255u) == 0u) { if (xb_ld(&bar[XB_TMO])) break; if (sp > XB_SPIN_CAP) { atomicAdd(&bar[XB_TMO], 1u); break; } }
    }
    nloc = mine > 0u ? mine : 1u; nx = cnt > 0u ? cnt : 1u;
}
__device__ __forceinline__ void xcd_barrier(const XcdBarrier& b) {
    asm volatile("s_waitcnt vmcnt(0)" ::: "memory");
    __syncthreads();
    if (threadIdx.x == 0) {
        unsigned* bar = b.bar;
        __builtin_amdgcn_s_waitcnt(0);
        unsigned nloc = b.st[0], nx = b.st[1];
        if (nloc == 0u) { xcd_barrier_complete(bar, b.x, nloc, nx); b.st[0] = nloc; b.st[1] = nx; }
        const unsigned old = xb_add(&bar[XB_XSUB(b.x)], 1u);
        const unsigned gen = old / nloc;
        if (old + 1u == (gen + 1u) * nloc) {
            __builtin_amdgcn_fence(__ATOMIC_RELEASE, "agent");
            asm volatile("s_waitcnt vmcnt(0)" ::: "memory");
            const unsigned og = xb_add(&bar[XB_TOP], 1u);
            const unsigned tg = og / nx;
            if (og + 1u == (tg + 1u) * nx) xb_add(&bar[XB_TOPGEN], 1u);
            else XB_SPIN(xb_ld(&bar[XB_TOPGEN]) == tg, bar);
            __builtin_amdgcn_fence(__ATOMIC_ACQUIRE, "agent");
            xb_add(&bar[XB_XGEN(b.x)], 1u);
            asm volatile("s_waitcnt vmcnt(0)" ::: "memory");
        } else {
            XB_SPIN(xb_ld(&bar[XB_XGEN(b.x)]) == gen, bar);
            __builtin_amdgcn_fence(__ATOMIC_ACQUIRE, "agent");
            asm volatile("s_waitcnt vmcnt(0)" ::: "memory");
        }
    }
    __syncthreads();
}

using u32x4 = __attribute__((ext_vector_type(4))) unsigned int;
struct GRegs { u32x4 a0, a1, a2, a3, b0, b1; };
template <int MTW>
__device__ __forceinline__ void gemm_gload(GRegs& R, const u16* ga, const u16* gb, int lda, int ldb) {
  R.a0 = *(const u32x4*)(ga);
  R.a1 = *(const u32x4*)(ga + (size_t)64 * lda);
  R.a2 = *(const u32x4*)(ga + (size_t)128 * lda);
  if (MTW == 8) R.a3 = *(const u32x4*)(ga + (size_t)192 * lda);
  R.b0 = *(const u32x4*)(gb);
  R.b1 = *(const u32x4*)(gb + (size_t)64 * ldb);
}
template <int MTW>
__device__ __forceinline__ void gemm_swrite(const GRegs& R, u16* dA, u16* dB) {
  *(u32x4*)(dA) = R.a0;
  *(u32x4*)(dA + 64 * 40) = R.a1;
  *(u32x4*)(dA + 128 * 40) = R.a2;
  if (MTW == 8) *(u32x4*)(dA + 192 * 40) = R.a3;
  *(u32x4*)(dB) = R.b0;
  *(u32x4*)(dB + 64 * 40) = R.b1;
}

template <bool SWAP, int MTW>
__device__ __forceinline__ void gemm_compute_tile(const u16* cA, const u16* cB, f32x4 (&acc)[MTW][4]) {
  constexpr int LS = 40;
  constexpr int HM = MTW / 2;
  bf16x8 bfr[4];
#pragma unroll
  for (int j = 0; j < 4; j++) bfr[j] = *(const bf16x8*)(cB + j * 16 * LS);
#pragma unroll
  for (int h = 0; h < 2; h++) {
    bf16x8 af[HM];
#pragma unroll
    for (int i = 0; i < HM; i++) af[i] = *(const bf16x8*)(cA + (h * HM + i) * 16 * LS);
#pragma unroll
    for (int i = 0; i < HM; i++)
#pragma unroll
      for (int j = 0; j < 4; j++) {
        if (SWAP) acc[h * HM + i][j] = MFMA(bfr[j], af[i], acc[h * HM + i][j]);
        else acc[h * HM + i][j] = MFMA(af[i], bfr[j], acc[h * HM + i][j]);
      }
  }
}

template <bool SWAP, int MTW = 8>
__device__ __forceinline__ void gemm_mainloop_reg(const u16* __restrict__ A, int lda, const u16* __restrict__ Bt, int ldb,
                                              int K, u16* sm, f32x4 (&acc)[MTW][4]) {
  constexpr int LS = 40;
  const int tid = threadIdx.x, lane = tid & 63, wave = tid >> 6;
  const int wm = wave >> 1, wn = wave & 1;
  const int fr = lane & 15, fq = lane >> 4;
  u16* sA = sm;
  u16* sB = sm + 2 * 256 * LS;
  const int lr = tid >> 2, lc = (tid & 3) * 8;
  const u16* ga = A + (size_t)lr * lda + lc;
  const u16* gb = Bt + (size_t)lr * ldb + lc;
  GRegs r0, r1;
#define GLOAD(R, KT) gemm_gload<MTW>(R, ga + (KT) * 32, gb + (KT) * 32, lda, ldb);
#define SWRITE(R, BUF) gemm_swrite<MTW>(R, sA + (BUF) * 256 * LS + lr * LS + lc, sB + (BUF) * 128 * LS + lr * LS + lc);
  GLOAD(r0, 0)
  GLOAD(r1, 1)
#pragma unroll
  for (int i = 0; i < MTW; i++)
#pragma unroll
    for (int j = 0; j < 4; j++) acc[i][j] = f32x4{0.f, 0.f, 0.f, 0.f};
  SWRITE(r0, 0)
  __syncthreads();
  const int nk = K >> 5;
  const u16* cA0 = sA + (wm * 16 * MTW + fr) * LS + fq * 8;
  const u16* cB0 = sB + (wn * 64 + fr) * LS + fq * 8;
  for (int kt = 0; kt < nk; kt += 2) {
    GLOAD(r0, min(kt + 2, nk - 1))
    gemm_compute_tile<SWAP, MTW>(cA0, cB0, acc);
    SWRITE(r1, 1)
    __syncthreads();
    GLOAD(r1, min(kt + 3, nk - 1))
    gemm_compute_tile<SWAP, MTW>(cA0 + 256 * LS, cB0 + 128 * LS, acc);
    SWRITE(r0, 0)
    __syncthreads();
  }
#undef GLOAD
#undef SWRITE
}

__device__ __forceinline__ void glds16(const u16* g, char* lds) {
  __builtin_amdgcn_global_load_lds((const unsigned*)g, (unsigned*)lds, 16, 0, 0);
}
#define DSR128(dst, addr, OFF) asm volatile("ds_read_b128 %0, %1 offset:%2" : "=v"(dst) : "v"(addr), "n"(OFF))
template <bool SWAP, int MTW>
__device__ __forceinline__ void gemm_compute_glds(unsigned aA, unsigned aB, f32x4 (&acc)[MTW][4]) {
  bf16x8 bfr[4], af[MTW];
  DSR128(bfr[0], aB, 0); DSR128(bfr[1], aB, 1024); DSR128(bfr[2], aB, 2048); DSR128(bfr[3], aB, 3072);
  if (MTW == 8) {
    DSR128(af[0], aA, 0); DSR128(af[1], aA, 1024); DSR128(af[2], aA, 2048); DSR128(af[3], aA, 3072);
    DSR128(af[4], aA, 4096); DSR128(af[5], aA, 5120); DSR128(af[6], aA, 6144); DSR128(af[7], aA, 7168);
    asm volatile("s_waitcnt lgkmcnt(4)" : "+v"(bfr[0]), "+v"(bfr[1]), "+v"(bfr[2]), "+v"(bfr[3]), "+v"(af[0]), "+v"(af[1]), "+v"(af[2]), "+v"(af[3]));
  } else if (MTW == 6) {
    DSR128(af[0], aA, 0); DSR128(af[1], aA, 1024); DSR128(af[2], aA, 2048);
    DSR128(af[3], aA, 3072); DSR128(af[4], aA, 4096); DSR128(af[5], aA, 5120);
    asm volatile("s_waitcnt lgkmcnt(3)" : "+v"(bfr[0]), "+v"(bfr[1]), "+v"(bfr[2]), "+v"(bfr[3]), "+v"(af[0]), "+v"(af[1]), "+v"(af[2]));
  } else if (MTW == 4) {
    DSR128(af[0], aA, 0); DSR128(af[1], aA, 1024); DSR128(af[2], aA, 2048); DSR128(af[3], aA, 3072);
    asm volatile("s_waitcnt lgkmcnt(2)" : "+v"(bfr[0]), "+v"(bfr[1]), "+v"(bfr[2]), "+v"(bfr[3]), "+v"(af[0]), "+v"(af[1]));
  } else {
    DSR128(af[0], aA, 0); DSR128(af[1], aA, 1024);
    asm volatile("s_waitcnt lgkmcnt(1)" : "+v"(bfr[0]), "+v"(bfr[1]), "+v"(bfr[2]), "+v"(bfr[3]), "+v"(af[0]));
  }
  constexpr int HM = MTW / 2;
#pragma unroll
  for (int i = 0; i < HM; i++)
#pragma unroll
    for (int j = 0; j < 4; j++) {
      if (SWAP) acc[i][j] = MFMA(bfr[j], af[i], acc[i][j]);
      else acc[i][j] = MFMA(af[i], bfr[j], acc[i][j]);
    }
  __builtin_amdgcn_sched_barrier(0);
  if (MTW == 8) asm volatile("s_waitcnt lgkmcnt(0)" : "+v"(af[4]), "+v"(af[5]), "+v"(af[6]), "+v"(af[7]));
  else if (MTW == 6) asm volatile("s_waitcnt lgkmcnt(0)" : "+v"(af[3]), "+v"(af[4]), "+v"(af[5]));
  else if (MTW == 4) asm volatile("s_waitcnt lgkmcnt(0)" : "+v"(af[2]), "+v"(af[3]));
  else asm volatile("s_waitcnt lgkmcnt(0)" : "+v"(af[1]));
  __builtin_amdgcn_sched_barrier(0);
#pragma unroll
  for (int i = HM; i < MTW; i++)
#pragma unroll
    for (int j = 0; j < 4; j++) {
      if (SWAP) acc[i][j] = MFMA(bfr[j], af[i], acc[i][j]);
      else acc[i][j] = MFMA(af[i], bfr[j], acc[i][j]);
    }
}

template <bool SWAP, int MTW = 8>
__device__ __forceinline__ void gemm_mainloop(const u16* __restrict__ A, int lda, const u16* __restrict__ Bt, int ldb,
                                              int K, u16* sm, f32x4 (&acc)[MTW][4]) {
  constexpr int STG = 24576;
  constexpr int AW = MTW / 2;
  constexpr int NL = AW + 2;
  const int tid = threadIdx.x, lane = tid & 63, wave = tid >> 6;
  const int wm = wave >> 1, wn = wave & 1;
  const int fr = lane & 15, fq = lane >> 4;
  char* smc = (char*)sm;
  const int rowl = lane >> 2;
  const int lch = ((lane & 3) ^ (((lane >> 5) & 1) << 1)) * 8;
  const u16* gA = A + (size_t)(wave * AW * 16 + rowl) * lda + lch;
  const u16* gB = Bt + (size_t)(wave * 32 + rowl) * ldb + lch;
  char* dA = smc + (wave * AW) * 1024;
  char* dB = smc + 16384 + (wave * 2) * 1024;
  const int loff = fr * 64 + ((fq ^ (((fr >> 3) & 1) << 1)) * 16);
  const unsigned lds0 = (unsigned)(size_t)((LAS char*)smc);
  const unsigned rA = lds0 + (wm * MTW) * 1024 + loff;
  const unsigned rB = lds0 + 16384 + (wn * 4) * 1024 + loff;
#define GSTAGE(S, KT) { _Pragma("unroll") for (int _i = 0; _i < AW; _i++) glds16(gA + (size_t)(_i * 16) * lda + (KT) * 32, dA + (S) * STG + _i * 1024); \
                        _Pragma("unroll") for (int _i = 0; _i < 2; _i++) glds16(gB + (size_t)(_i * 16) * ldb + (KT) * 32, dB + (S) * STG + _i * 1024); }
#pragma unroll
  for (int i = 0; i < MTW; i++)
#pragma unroll
    for (int j = 0; j < 4; j++) acc[i][j] = f32x4{0.f, 0.f, 0.f, 0.f};
  const int nk = K >> 5;
  GSTAGE(0, 0)
  GSTAGE(1, 1)
  asm volatile("s_waitcnt vmcnt(%0)" ::"n"(NL) : "memory");
  asm volatile("s_waitcnt lgkmcnt(0)" ::: "memory");
  __builtin_amdgcn_s_barrier();
  int cur = 0;
  for (int t = 0; t < nk; t++) {
    int nx2 = cur + 2; if (nx2 >= 3) nx2 -= 3;
    const bool more = (t + 2 < nk);
    if (more) GSTAGE(nx2, t + 2)
    gemm_compute_glds<SWAP, MTW>(rA + cur * STG, rB + cur * STG, acc);
    if (more) asm volatile("s_waitcnt vmcnt(%0)" ::"n"(NL) : "memory");
    else asm volatile("s_waitcnt vmcnt(0)" ::: "memory");
    asm volatile("s_waitcnt lgkmcnt(0)" ::: "memory");
    __builtin_amdgcn_s_barrier();
    cur = (cur == 2) ? 0 : cur + 1;
  }
#undef GSTAGE
}

template <bool SWAP>
__device__ __forceinline__ void gemm_mainloop128(const u16* __restrict__ A, int lda, const u16* __restrict__ Bt, int ldb,
                                              int K, u16* sm, f32x4 (&acc)[4][4]) {
  const int tid = threadIdx.x, lane = tid & 63, wave = tid >> 6;
  const int wm = wave >> 1, wn = wave & 1;
  const int fr = lane & 15, fq = lane >> 4;
  u16* sA = sm;
  u16* sB = sm + 2 * 128 * LDT;
  const int lr = tid >> 3, lc = (tid & 7) * 8;
  const u16* ga = A + (size_t)lr * lda + lc;
  const u16* gb = Bt + (size_t)lr * ldb + lc;
  uint4 ra[4], rb[4];
#pragma unroll
  for (int i = 0; i < 4; i++) {
    ra[i] = *(const uint4*)(ga + (size_t)(i * 32) * lda);
    rb[i] = *(const uint4*)(gb + (size_t)(i * 32) * ldb);
  }
#pragma unroll
  for (int i = 0; i < 4; i++)
#pragma unroll
    for (int j = 0; j < 4; j++) acc[i][j] = f32x4{0.f, 0.f, 0.f, 0.f};
#pragma unroll
  for (int i = 0; i < 4; i++) {
    *(uint4*)(sA + (lr + i * 32) * LDT + lc) = ra[i];
    *(uint4*)(sB + (lr + i * 32) * LDT + lc) = rb[i];
  }
  __syncthreads();
  const int nk = K >> 6;
  for (int kt = 0; kt < nk; kt++) {
    const int cur = kt & 1;
    const bool more = (kt + 1 < nk);
    if (more) {
      const u16* ga2 = ga + (kt + 1) * 64;
      const u16* gb2 = gb + (kt + 1) * 64;
#pragma unroll
      for (int i = 0; i < 4; i++) {
        ra[i] = *(const uint4*)(ga2 + (size_t)(i * 32) * lda);
        rb[i] = *(const uint4*)(gb2 + (size_t)(i * 32) * ldb);
      }
    }
    const u16* cA = sA + cur * 128 * LDT + (wm * 64 + fr) * LDT + fq * 8;
    const u16* cB = sB + cur * 128 * LDT + (wn * 64 + fr) * LDT + fq * 8;
#pragma unroll
    for (int kk = 0; kk < 2; kk++) {
      bf16x8 af[4], bfr[4];
#pragma unroll
      for (int i = 0; i < 4; i++) af[i] = *(const bf16x8*)(cA + i * 16 * LDT + kk * 32);
#pragma unroll
      for (int j = 0; j < 4; j++) bfr[j] = *(const bf16x8*)(cB + j * 16 * LDT + kk * 32);
#pragma unroll
      for (int i = 0; i < 4; i++)
#pragma unroll
        for (int j = 0; j < 4; j++) {
          if (SWAP) acc[i][j] = MFMA(bfr[j], af[i], acc[i][j]);
          else acc[i][j] = MFMA(af[i], bfr[j], acc[i][j]);
        }
    }
    if (more) {
      u16* dA = sA + (cur ^ 1) * 128 * LDT;
      u16* dB = sB + (cur ^ 1) * 128 * LDT;
#pragma unroll
      for (int i = 0; i < 4; i++) {
        *(uint4*)(dA + (lr + i * 32) * LDT + lc) = ra[i];
        *(uint4*)(dB + (lr + i * 32) * LDT + lc) = rb[i];
      }
    }
    __syncthreads();
  }
}

__device__ __forceinline__ void tile_coords(int L, int MT, int NT, int& mt, int& nt) {
  const int full = NT >> 3;
  const int per = MT * 8;
  if (L < full * per) {
    int sc = L / per, r = L - sc * per;
    mt = r >> 3;
    nt = sc * 8 + (r & 7);
  } else {
    int L2 = L - full * per;
    int w = NT - full * 8;
    mt = L2 / w;
    nt = full * 8 + (L2 - mt * w);
  }
}

struct TileIter {
  int cur, end, step;
  __device__ TileIter(int ntiles) {
    int nb = gridDim.x, b = blockIdx.x;
    if ((nb & 7) == 0) {
      int per = (ntiles + 7) >> 3;
      int x = b & 7, j = b >> 3;
      cur = x * per + j;
      end = min((x + 1) * per, ntiles);
      step = nb >> 3;
    } else {
      cur = b; end = ntiles; step = nb;
    }
  }
};


constexpr size_t OFF_Q = OFF_BAR + 16384;
__device__ __forceinline__ int queue_next(unsigned* ctr, int* sh) {
  __syncthreads();
  if (threadIdx.x == 0) *sh = (int)__hip_atomic_fetch_add(ctr, 1u, __ATOMIC_RELAXED, __HIP_MEMORY_SCOPE_AGENT);
  __syncthreads();
  return *sh;
}

struct TrDesc { const float* src; u16* dst; int lds, nvalid, ldd, mode, rowoff, k0, n0; };
__device__ __forceinline__ TrDesc tr_desc(const Params& P, int j) {
  TrDesc d; int ntn; d.mode = 0; d.rowoff = 0;
  if (j < 320) { d.src = P.in[12] + 256; d.lds = 1536; d.nvalid = 1280; d.dst = (u16*)(P.ws + OFF_WIE); d.ldd = 1024; d.rowoff = 512; ntn = 20; }
  else if ((j -= 320) < 256) { d.src = P.in[15]; d.lds = 1024; d.nvalid = 1024; d.dst = (u16*)(P.ws + OFF_WOE); d.ldd = 1024; ntn = 16; }
  else if ((j -= 256) < 864) { d.src = P.in[16]; d.lds = 3360; d.nvalid = 3360; d.dst = (u16*)(P.ws + OFF_WIO); d.ldd = 1024; ntn = 54; }
  else if ((j -= 864) < 384) { d.src = P.in[30]; d.lds = 1024; d.nvalid = 1024; d.dst = (u16*)(P.ws + OFF_WOO); d.ldd = 1536; ntn = 16; }
  else if ((j -= 384) < 2816) {
    int q = j / 704; j -= q * 704; int l = q >> 1, w3 = q & 1;
    d.src = (w3 ? P.in[32] : P.in[31]) + (size_t)l * 1024 * 2816; d.lds = 2816; d.nvalid = 2816;
    d.dst = (u16*)(P.ws + OFF_W13) + (size_t)l * 5632 * 1024; d.ldd = 1024; d.mode = 1; d.rowoff = w3 * 16; ntn = 44;
  } else {
    j -= 2816; int l = j / 704; j -= l * 704;
    d.src = P.in[33] + (size_t)l * 2816 * 1024; d.lds = 1024; d.nvalid = 1024;
    d.dst = (u16*)(P.ws + OFF_W2) + (size_t)l * 1024 * 2816; d.ldd = 2816; ntn = 16;
  }
  const int kt = j / ntn, nt = j - kt * ntn;
  d.k0 = kt * 64; d.n0 = nt * 64;
  return d;
}
__device__ __forceinline__ void tr_load(const TrDesc& d, int tid, float4 (&v)[4]) {
#pragma unroll
  for (int i = 0; i < 4; i++) {
    const int r = i * 16 + (tid >> 4), n = d.n0 + (tid & 15) * 4;
    v[i] = make_float4(0.f, 0.f, 0.f, 0.f);
    if (n < d.nvalid) v[i] = *(const float4*)(d.src + (size_t)(d.k0 + r) * d.lds + n);
  }
}
__device__ __forceinline__ void tr_emit(const TrDesc& d, int tid, const float4 (&v)[4], float* tile) {
#pragma unroll
  for (int i = 0; i < 4; i++) {
    const int r = i * 16 + (tid >> 4), c4 = (tid & 15) * 4;
    tile[r * 65 + c4] = v[i].x; tile[r * 65 + c4 + 1] = v[i].y; tile[r * 65 + c4 + 2] = v[i].z; tile[r * 65 + c4 + 3] = v[i].w;
  }
  __syncthreads();
#pragma unroll
  for (int i = 0; i < 4; i++) {
    const int n = i * 16 + (tid >> 4), k4 = (tid & 15) * 4;
    const int ng = d.n0 + n;
    const int row = d.mode ? ((ng >> 4) * 32 + (ng & 15) + d.rowoff) : (ng + d.rowoff);
    uint2 o;
    o.x = pack2(tile[(k4 + 0) * 65 + n], tile[(k4 + 1) * 65 + n]);
    o.y = pack2(tile[(k4 + 2) * 65 + n], tile[(k4 + 3) * 65 + n]);
    *(uint2*)(d.dst + (size_t)row * d.ldd + d.k0 + k4) = o;
  }
  __syncthreads();
}
__device__ __forceinline__ void phase_prep(const Params& P, char* smem, int* qsh) {
  const int tid = threadIdx.x, nb = gridDim.x, bid = blockIdx.x;
  const int lane = tid & 63, wave = tid >> 6;
  float* tile = (float*)smem;
  float* tabc = (float*)(smem + 16640);
  float* tabs = tabc + 64;
  float* sc = (float*)(smem + 20480);
  float* red = (float*)(smem + 20480 + 36864);
  {
    float* prm = (float*)(P.ws + OFF_PRM);
    const int gt = bid * 256 + tid, gs = nb * 256;
#define PCOPY(SRC, OFF, N) for (int i = gt; i < (N); i += gs) prm[(OFF) + i] = (SRC)[i];
    PCOPY(P.in[10], PRM_NORM_MIX, 2048) PCOPY(P.in[11], PRM_NORM_FFN, 2048) PCOPY(P.in[13], PRM_QN, 64) PCOPY(P.in[14], PRM_KN, 64)
    PCOPY(P.in[17], PRM_CLW, 2048) PCOPY(P.in[18], PRM_CLB, 512) PCOPY(P.in[20], PRM_LBA, 1024) PCOPY(P.in[22], PRM_LBX, 1024)
    PCOPY(P.in[23], PRM_LAM, 1024) PCOPY(P.in[24], PRM_CSW, 5120) PCOPY(P.in[25], PRM_CSB, 1280) PCOPY(P.in[26], PRM_DTB, 32)
    PCOPY(P.in[27], PRM_ALOG, 32) PCOPY(P.in[28], PRM_SSDD, 16) PCOPY(P.in[29], PRM_SNORM, 1024)
    PCOPY(P.in[19], PRM_LWA, 65536) PCOPY(P.in[21], PRM_LWX, 65536)
#undef PCOPY
  }
  bool sc_ready = false;
  constexpr int N_MOD = 384, N_FF = 64, N_TR = 6048, N_DFT = 544, N_CACHE = 512;
  constexpr int N_ALL = N_MOD + N_FF + N_TR + N_DFT + N_CACHE;
  for (int it = bid; it < N_ALL; it += nb) {
    int j = it;
    if (j < N_MOD) {
      if (!sc_ready) {
        for (int i = tid; i < 9 * 1024; i += 256) {
          int r = i >> 10, k = i & 1023;
          float c = r < 8 ? P.in[2][r * 1024 + k] : P.in[7][k];
          sc[i] = silu_f(c);
        }
        __syncthreads();
        sc_ready = true;
      }
      const int l = j / 192, n0 = (j % 192) * 32;
      const int cgp = tid & 7, kl = tid >> 3;
      float acc[9][4];
#pragma unroll
      for (int r = 0; r < 9; r++)
#pragma unroll
        for (int c = 0; c < 4; c++) acc[r][c] = 0.f;
      const float* w = P.in[8] + (size_t)l * 1024 * 6144 + n0 + cgp * 4;
#pragma unroll 4
      for (int i = 0; i < 32; i++) {
        const int k = i * 32 + kl;
        const float4 wv = *(const float4*)(w + (size_t)k * 6144);
#pragma unroll
        for (int r = 0; r < 9; r++) {
          const float s = sc[r * 1024 + k];
          acc[r][0] += s * wv.x; acc[r][1] += s * wv.y; acc[r][2] += s * wv.z; acc[r][3] += s * wv.w;
        }
      }
#pragma unroll
      for (int r = 0; r < 9; r++)
#pragma unroll
        for (int c = 0; c < 4; c++) {
          float v = acc[r][c];
          v += __shfl_xor(v, 8); v = xor16_sum(v); v = xor32_sum(v);
          acc[r][c] = v;
        }
      if (lane < 8) {
#pragma unroll
        for (int r = 0; r < 9; r++)
#pragma unroll
          for (int c = 0; c < 4; c++) red[(wave * 9 + r) * 32 + cgp * 4 + c] = acc[r][c];
      }
      __syncthreads();
      float* MOD = (float*)(P.ws + OFF_MOD);
      for (int i = tid; i < 288; i += 256) {
        int r = i >> 5, c = i & 31;
        float s = red[(0 * 9 + r) * 32 + c] + red[(1 * 9 + r) * 32 + c] + red[(2 * 9 + r) * 32 + c] + red[(3 * 9 + r) * 32 + c];
        MOD[(l * 9 + r) * 6144 + n0 + c] = s + P.in[9][l * 6144 + n0 + c];
      }
      __syncthreads();
      continue;
    }
    j -= N_MOD;
    if (j < N_FF) {
      const int g = j >> 4, kt = j & 15;
      if (tid < 64) { tabc[tid] = cospif(tid / 32.0f); tabs[tid] = sinpif(tid / 32.0f); }
      const float* src = P.in[12] + (size_t)(kt * 64) * 1536 + g * 64;
#pragma unroll
      for (int i = 0; i < 4; i++) {
        int r = i * 16 + (tid >> 4), c4 = (tid & 15) * 4;
        float4 v = *(const float4*)(src + (size_t)r * 1536 + c4);
        tile[r * 65 + c4] = v.x; tile[r * 65 + c4 + 1] = v.y; tile[r * 65 + c4 + 2] = v.z; tile[r * 65 + c4 + 3] = v.w;
      }
      __syncthreads();
      const int np = tid & 127, kh = tid >> 7;
      const int wsel = np >> 6, cp = np & 63;
      float acc[32];
#pragma unroll
      for (int i = 0; i < 32; i++) acc[i] = 0.f;
      for (int c = 0; c < 64; c++) {
        const int idx = (c * cp) & 63;
        const float coef = wsel ? tabs[idx] : tabc[idx];
#pragma unroll
        for (int i = 0; i < 32; i++) acc[i] += tile[(kh * 32 + i) * 65 + c] * coef;
      }
      u16* dst = (u16*)(P.ws + OFF_WIE) + (size_t)(g * 128 + np) * 1024 + kt * 64 + kh * 32;
#pragma unroll
      for (int i = 0; i < 4; i++) {
        uint4 o;
        o.x = pack2(acc[i * 8 + 0], acc[i * 8 + 1]); o.y = pack2(acc[i * 8 + 2], acc[i * 8 + 3]);
        o.z = pack2(acc[i * 8 + 4], acc[i * 8 + 5]); o.w = pack2(acc[i * 8 + 6], acc[i * 8 + 7]);
        *(uint4*)(dst + i * 8) = o;
      }
      __syncthreads();
      continue;
    }
    j -= N_FF;
    if (j < N_TR) continue;
    j -= N_TR;
    if (j < N_DFT) {
      if (j < 512) {
        u16* D = (u16*)(P.ws + OFF_D1K);
        const int e0 = j * 4096;
        for (int i = 0; i < 16; i++) {
          int e = e0 + i * 256 + tid;
          int sp = e >> 11, k = e & 2047;
          float v;
          if (k < 1024) { int r = (sp * k) & 1023; v = cospif(r * (1.0f / 512.0f)); }
          else { int r = (sp * (k - 1024)) & 1023; v = -sinpif(r * (1.0f / 512.0f)); }
          D[e] = f2bf(v * (1.0f / 256.0f));
        }
      } else {
        u16* D = (u16*)(P.ws + OFF_D256);
        const int e0 = (j - 512) * 4096;
        for (int i = 0; i < 16; i++) {
          int e = e0 + i * 256 + tid;
          int sp = e >> 9, k = e & 511;
          float v;
          if (k < 256) { int r = (sp * k) & 255; v = cospif(r * (1.0f / 128.0f)); }
          else { int r = (sp * (k - 256)) & 255; v = -sinpif(r * (1.0f / 128.0f)); }
          D[e] = f2bf(v * (1.0f / 128.0f));
        }
      }
      continue;
    }
    j -= N_DFT;
    if (j < 256) {
      const int e0 = j * 4096;
      const float* src = P.in[3];
      u16* KB = (u16*)(P.ws + OFF_KBS);
      for (int i = 0; i < 16; i++) {
        int e = e0 + i * 256 + tid;
        int b = e >> 17, p = (e >> 8) & 511, h = (e >> 6) & 3, d = e & 63;
        KB[((size_t)(b * 4 + h) * 1536 + 1024 + p) * 64 + d] = f2bf(src[e]);
      }
    } else {
      const int it2 = j - 256;
      const int b = it2 >> 5, h = (it2 >> 3) & 3, pc = it2 & 7;
      const float* src = P.in[4];
      u16* VT = (u16*)(P.ws + OFF_VTS);
#pragma unroll
      for (int i = 0; i < 4; i++) {
        const int r = i * 16 + (tid >> 4), c4 = (tid & 15) * 4;
        const float4 v = *(const float4*)(src + ((size_t)(b * 512 + pc * 64 + r) * 4 + h) * 64 + c4);
        tile[r * 65 + c4] = v.x; tile[r * 65 + c4 + 1] = v.y; tile[r * 65 + c4 + 2] = v.z; tile[r * 65 + c4 + 3] = v.w;
      }
      __syncthreads();
#pragma unroll
      for (int i = 0; i < 4; i++) {
        const int d = i * 16 + (tid >> 4), p4 = (tid & 15) * 4;
        uint2 o;
        o.x = pack2(tile[(p4 + 0) * 65 + d], tile[(p4 + 1) * 65 + d]);
        o.y = pack2(tile[(p4 + 2) * 65 + d], tile[(p4 + 3) * 65 + d]);
        *(uint2*)(VT + ((size_t)(b * 4 + h) * 64 + d) * 1536 + 1024 + pc * 64 + p4) = o;
      }
      __syncthreads();
    }
  }
  {
    unsigned* ctr = (unsigned*)(P.ws + OFF_BAR + 20480);
    for (;;) {
      const int k = queue_next(ctr, qsh);
      const int j0 = 2 * k;
      if (j0 >= N_TR) break;
      const TrDesc d0 = tr_desc(P, j0);
      const TrDesc d1 = tr_desc(P, j0 + 1);
      float4 v0[4], v1[4];
      tr_load(d0, tid, v0);
      tr_load(d1, tid, v1);
      tr_emit(d0, tid, v0, tile);
      tr_emit(d1, tid, v1, tile);
    }
  }
}

__device__ __forceinline__ void phase_norm(const Params& P, int l, int which) {
  const int tid = threadIdx.x, lane = tid & 63, wave = tid >> 6;
  const float* MOD = (const float*)(P.ws + OFF_MOD);
  const float* gvec = PRM(P, (which ? PRM_NORM_FFN : PRM_NORM_MIX) + l * 1024);
  u16* H = (u16*)(P.ws + OFF_H);
  const int nwaves = gridDim.x * 4;
  const int rpw = (T_ALL + nwaves - 1) / nwaves;
  const int r0 = (blockIdx.x * 4 + wave) * rpw;
  const int r1 = min(r0 + rpw, T_ALL);
  constexpr int NR = 3;
  const int osh = (which ? 3 : 0) * 1024, osc = (which ? 4 : 1) * 1024;
  float4 gm[4], sh[4];
  int cached = -1;
  for (int t0 = r0; t0 < r1; t0 += NR) {
    float4 v[NR][4];
#pragma unroll
    for (int r = 0; r < NR; r++) {
      const int t = min(t0 + r, r1 - 1);
      const float* x = (l == 0 && which == 0) ? xin(P, t) : P.out + (size_t)t * 1024;
#pragma unroll
      for (int j = 0; j < 4; j++) v[r][j] = *(const float4*)(x + j * 256 + lane * 4);
    }
    float ss[NR];
#pragma unroll
    for (int r = 0; r < NR; r++) {
      float a = 0.f;
#pragma unroll
      for (int j = 0; j < 4; j++) a += v[r][j].x * v[r][j].x + v[r][j].y * v[r][j].y + v[r][j].z * v[r][j].z + v[r][j].w * v[r][j].w;
      ss[r] = a;
    }
#pragma unroll
    for (int o = 32; o >= 1; o >>= 1) {
#pragma unroll
      for (int r = 0; r < NR; r++) ss[r] += __shfl_xor(ss[r], o);
    }
#pragma unroll
    for (int r = 0; r < NR; r++) {
      const int t = t0 + r;
      if (t >= r1) continue;
      const int cr = cond_row(t);
      if (cr != cached) {
        cached = cr;
        const float* mb = MOD + (size_t)(l * 9 + cr) * 6144;
#pragma unroll
        for (int j = 0; j < 4; j++) {
          const int c = j * 256 + lane * 4;
          const float4 g = *(const float4*)(gvec + c);
          const float4 cm = *(const float4*)(mb + osc + c);
          sh[j] = *(const float4*)(mb + osh + c);
          gm[j] = make_float4(g.x * (1.f + cm.x), g.y * (1.f + cm.y), g.z * (1.f + cm.z), g.w * (1.f + cm.w));
        }
      }
      const float rs = rsqrtf(ss[r] * (1.0f / 1024.0f) + 1e-6f);
#pragma unroll
      for (int j = 0; j < 4; j++) {
        const int c = j * 256 + lane * 4;
        uint2 o;
        o.x = pack2(v[r][j].x * rs * gm[j].x + sh[j].x, v[r][j].y * rs * gm[j].y + sh[j].y);
        o.y = pack2(v[r][j].z * rs * gm[j].z + sh[j].z, v[r][j].w * rs * gm[j].w + sh[j].w);
        *(uint2*)(H + (size_t)t * 1024 + c) = o;
      }
    }
  }
}

__device__ __forceinline__ void phase_gemm_in_even(const Params& P, char* smem) {
  const int tid = threadIdx.x, lane = tid & 63, wave = tid >> 6;
  const int wm = wave >> 1, wn = wave & 1, fr = lane & 15, fq = lane >> 4;
  const u16* A = (const u16*)(P.ws + OFF_H);
  const u16* W = (const u16*)(P.ws + OFF_WIE);
  constexpr int MT = 48, NT = 14;
  for (TileIter ti(MT * NT); ti.cur < ti.end; ti.cur += ti.step) {
    int mtile, ntile;
    tile_coords(ti.cur, MT, NT, mtile, ntile);
    const int m0 = mtile * 256, n0 = ntile * 128;
    f32x4 acc[8][4];
    const bool swap = (ntile >= 4 && ntile < 12);
    if (swap) gemm_mainloop<true, 8>(A + (size_t)m0 * 1024, 1024, W + (size_t)n0 * 1024, 1024, 1024, (u16*)smem, acc);
    else gemm_mainloop<false, 8>(A + (size_t)m0 * 1024, 1024, W + (size_t)n0 * 1024, 1024, 1024, (u16*)smem, acc);
    const bool smp = m0 >= T_CTX;
    int fr_e = fr, fq_e = fq;
    asm volatile("" : "+v"(fr_e), "+v"(fq_e));
    u16* stg = (u16*)smem + wave * (128 * 72);
    if (ntile < 4) {
      const int g = ntile;
      u16* YT; int S, seq, sbase;
      if (smp) { YT = (u16*)(P.ws + OFF_YTS); S = 1024; seq = (m0 - T_CTX) >> 10; sbase = (m0 - T_CTX) & 1023; }
      else { YT = (u16*)(P.ws + OFF_YTC); S = 256; seq = m0 >> 8; sbase = m0 & 255; }
      u16* base = YT + (size_t)seq * 256 * 2 * S;
      u16* stgT = (u16*)smem + wave * (64 * 136);
#pragma unroll
      for (int mt = 0; mt < 8; mt++)
#pragma unroll
        for (int nt = 0; nt < 4; nt++) {
          uint2 o;
          o.x = pack2(acc[mt][nt][0], acc[mt][nt][1]);
          o.y = pack2(acc[mt][nt][2], acc[mt][nt][3]);
          *(uint2*)(stgT + (nt * 16 + fr_e) * 136 + mt * 16 + fq_e * 4) = o;
        }
      {
        const int rr = lane >> 4, cc = (lane & 15) * 8;
        u16* dst = base + (size_t)(g * 64 + rr) * 2 * S + wn * S + sbase + wm * 128 + cc;
#pragma unroll
        for (int i = 0; i < 16; i++) {
          const u32x4 v = *(const u32x4*)(stgT + (i * 4 + rr) * 136 + cc);
          *(u32x4*)(dst + (size_t)(i * 4) * 2 * S) = v;
        }
      }
    } else if (ntile < 12) {
      const bool isq = ntile < 10;
      const int hcol = n0 + wn * 64 - (isq ? 512 : 1280);
      const int head = hcol >> 6;
      const float* gn = PRM(P, isq ? PRM_QN : PRM_KN);
#pragma unroll
      for (int mt = 0; mt < 8; mt++) {
        __builtin_amdgcn_sched_barrier(0);
        const int t = m0 + wm * 128 + mt * 16 + fr_e;
        float ss = 0.f;
#pragma unroll
        for (int nt = 0; nt < 4; nt++)
#pragma unroll
          for (int r = 0; r < 4; r++) ss += acc[mt][nt][r] * acc[mt][nt][r];
        ss = xor16_sum(ss);
        ss = xor32_sum(ss);
        const float rs = rsqrtf(ss * (1.0f / 64.0f) + 1e-6f);
#pragma unroll
        for (int nt = 0; nt < 4; nt++) {
          const float4 g4 = *(const float4*)(gn + nt * 16 + fq_e * 4);
          acc[mt][nt][0] *= rs * g4.x; acc[mt][nt][1] *= rs * g4.y; acc[mt][nt][2] *= rs * g4.z; acc[mt][nt][3] *= rs * g4.w;
        }
        if (!smp && !isq) {
          float* nk = P.out + 12582912 + (size_t)t * 256 + head * 64;
#pragma unroll
          for (int nt = 0; nt < 4; nt++)
            *(float4*)(nk + nt * 16 + fq_e * 4) = make_float4(acc[mt][nt][0], acc[mt][nt][1], acc[mt][nt][2], acc[mt][nt][3]);
        }
        if (smp) {
          const int s = (t - T_CTX) & 1023;
          const float prow = (float)(s >> 6), pcol = (float)(s & 63);
#pragma unroll
          for (int r = 0; r < 4; r++) {
            const float fre = exp2f(-(float)(fq_e * 4 + r) * (13.287712379549449f / 16.0f));
            const float a0 = prow * fre, a1 = pcol * fre;
            const float c0 = __cosf(a0), s0 = __sinf(a0), c1 = __cosf(a1), s1 = __sinf(a1);
            const float x1 = acc[mt][0][r], x2 = acc[mt][1][r];
            acc[mt][0][r] = x1 * c0 - x2 * s0; acc[mt][1][r] = x2 * c0 + x1 * s0;
            const float y1 = acc[mt][2][r], y2 = acc[mt][3][r];
            acc[mt][2][r] = y1 * c1 - y2 * s1; acc[mt][3][r] = y2 * c1 + y1 * s1;
          }
        }
        {
          const float qs = isq ? 0.125f * LOG2E : 1.0f;
#pragma unroll
          for (int nt = 0; nt < 4; nt++) {
            uint2 o;
            o.x = pack2(acc[mt][nt][0] * qs, acc[mt][nt][1] * qs);
            o.y = pack2(acc[mt][nt][2] * qs, acc[mt][nt][3] * qs);
            *(uint2*)(stg + (mt * 16 + fr_e) * 72 + nt * 16 + fq_e * 4) = o;
          }
        }
      }
      {
        const int rr = lane >> 3, cc = (lane & 7) * 8;
        const int tr0 = m0 + wm * 128;
        u16* dst;
        size_t rstride;
        if (isq) { dst = (u16*)(P.ws + OFF_QB) + (size_t)tr0 * 768 + head * 64; rstride = 768; }
        else if (smp) { const int sq = (tr0 - T_CTX) >> 10, key = (tr0 - T_CTX) & 1023; dst = (u16*)(P.ws + OFF_KBS) + ((size_t)(sq * 4 + head) * 1536 + key) * 64; rstride = 64; }
        else { const int sq = tr0 >> 8, key = tr0 & 255; dst = (u16*)(P.ws + OFF_KBC) + ((size_t)(sq * 4 + head) * 256 + key) * 64; rstride = 64; }
        dst += (size_t)rr * rstride + cc;
#pragma unroll
        for (int i = 0; i < 16; i++) {
          const u32x4 v = *(const u32x4*)(stg + (i * 8 + rr) * 72 + cc);
          *(u32x4*)(dst + (size_t)(i * 8) * rstride) = v;
        }
      }
    } else {
      const int head = (n0 + wn * 64 - 1536) >> 6;
      u16* stgT = (u16*)smem + wave * (64 * 136);
#pragma unroll
      for (int mt = 0; mt < 8; mt++) {
        const int t = m0 + wm * 128 + mt * 16 + fq_e * 4;
#pragma unroll
        for (int nt = 0; nt < 4; nt++) {
          const int d = nt * 16 + fr_e;
          uint2 o;
          o.x = pack2(acc[mt][nt][0], acc[mt][nt][1]);
          o.y = pack2(acc[mt][nt][2], acc[mt][nt][3]);
          *(uint2*)(stgT + d * 136 + mt * 16 + fq_e * 4) = o;
          if (!smp) {
            float* nv = P.out + 13631488 + (size_t)t * 256 + head * 64 + d;
#pragma unroll
            for (int r = 0; r < 4; r++) nv[(size_t)r * 256] = acc[mt][nt][r];
          }
        }
      }
      {
        const int rr = lane >> 4, cc = (lane & 15) * 8;
        const int tr0 = m0 + wm * 128;
        u16* dst; size_t rstride;
        if (smp) { const int sq = (tr0 - T_CTX) >> 10, key = (tr0 - T_CTX) & 1023; dst = (u16*)(P.ws + OFF_VTS) + ((size_t)(sq * 4 + head) * 64) * 1536 + key; rstride = 1536; }
        else { const int sq = tr0 >> 8, key = tr0 & 255; dst = (u16*)(P.ws + OFF_VTC) + ((size_t)(sq * 4 + head) * 64) * 256 + key; rstride = 256; }
        dst += (size_t)rr * rstride + cc;
#pragma unroll
        for (int i = 0; i < 16; i++) {
          const u32x4 v = *(const u32x4*)(stgT + (i * 4 + rr) * 136 + cc);
          *(u32x4*)(dst + (size_t)(i * 4) * rstride) = v;
        }
      }
    }
    __syncthreads();
  }
}

__device__ __forceinline__ void phase_gemm_resid(const Params& P, char* smem, const u16* A, int lda, const u16* W, int K,
                                 int l, int gate_idx, bool from_x) {
  const int tid = threadIdx.x, lane = tid & 63, wave = tid >> 6;
  const int wm = wave >> 1, wn = wave & 1, fr = lane & 15, fq = lane >> 4;
  const float* MOD = (const float*)(P.ws + OFF_MOD);
  constexpr int MT = 64, NT = 8;
  float* stg = (float*)smem + wave * (48 * 68);
  for (TileIter ti(MT * NT); ti.cur < ti.end; ti.cur += ti.step) {
    int mtile, ntile;
    tile_coords(ti.cur, MT, NT, mtile, ntile);
    const int m0 = mtile * 192, n0 = ntile * 128;
    f32x4 acc[6][4];
    gemm_mainloop<true, 6>(A + (size_t)m0 * lda, lda, W + (size_t)n0 * K, K, K, (u16*)smem, acc);
#pragma unroll
    for (int h = 0; h < 2; h++) {
#pragma unroll
      for (int mt = 0; mt < 3; mt++)
#pragma unroll
        for (int nt = 0; nt < 4; nt++)
          *(f32x4*)(stg + (mt * 16 + fr) * 68 + nt * 16 + fq * 4) = acc[h * 3 + mt][nt];
      const int rr = lane >> 4, c4 = (lane & 15) * 4;
      const int n = n0 + wn * 64 + c4;
#pragma unroll
      for (int i = 0; i < 12; i++) {
        const int row = i * 4 + rr;
        const int t = m0 + wm * 96 + h * 48 + row;
        const float4 a4 = *(const float4*)(stg + row * 68 + c4);
        const float4 g = *(const float4*)(MOD + (size_t)(l * 9 + cond_row(t)) * 6144 + gate_idx * 1024 + n);
        const float* bp = from_x ? xin(P, t) : P.out + (size_t)t * 1024;
        const float4 bsv = *(const float4*)(bp + n);
        float4 o;
        o.x = bsv.x + g.x * a4.x; o.y = bsv.y + g.y * a4.y; o.z = bsv.z + g.z * a4.z; o.w = bsv.w + g.w * a4.w;
        *(float4*)(P.out + (size_t)t * 1024 + n) = o;
      }
    }
    __syncthreads();
  }
}

template <int MTW>
__device__ __forceinline__ void ffn_up_tile(const u16* A, const u16* W, u16* U, char* smem, int m0, int n0) {
  const int tid = threadIdx.x, lane = tid & 63, wave = tid >> 6;
  const int wm = wave >> 1, wn = wave & 1, fr = lane & 15, fq = lane >> 4;
  f32x4 acc[MTW][4];
  gemm_mainloop<true, MTW>(A + (size_t)m0 * 1024, 1024, W + (size_t)n0 * 1024, 1024, 1024, (u16*)smem, acc);
  constexpr int R = 16 * MTW;
  u16* stg = (u16*)smem + wm * (R * 72);
#pragma unroll
  for (int mt = 0; mt < MTW; mt++) {
#pragma unroll
    for (int np = 0; np < 2; np++) {
      float r[4];
#pragma unroll
      for (int q = 0; q < 4; q++) r[q] = silu_f(acc[mt][np * 2][q]) * acc[mt][np * 2 + 1][q];
      uint2 o;
      o.x = pack2(r[0], r[1]); o.y = pack2(r[2], r[3]);
      *(uint2*)(stg + (mt * 16 + fr) * 72 + wn * 32 + np * 16 + fq * 4) = o;
    }
  }
  __syncthreads();
  {
    const int rr = lane >> 3, cc = (lane & 7) * 8;
    const int row0 = wn * (R / 2) + rr;
    u16* dst = U + (size_t)(m0 + wm * R + row0) * 2816 + (n0 >> 1) + cc;
#pragma unroll
    for (int i = 0; i < MTW; i++) {
      const u32x4 v = *(const u32x4*)(stg + (row0 + i * 8) * 72 + cc);
      *(u32x4*)(dst + (size_t)(i * 8) * 2816) = v;
    }
  }
  __syncthreads();
}

__device__ __forceinline__ void phase_gemm_ffn_up(const Params& P, char* smem, int l) {
  const u16* A = (const u16*)(P.ws + OFF_H);
  const u16* W = (const u16*)(P.ws + OFF_W13) + (size_t)l * 5632 * 1024;
  u16* U = (u16*)(P.ws + OFF_R1);
  constexpr int MT = 48, NT = 44;
  constexpr int NFULL = 2048;
  for (TileIter ti(NFULL); ti.cur < ti.end; ti.cur += ti.step) {
    int mtile, ntile;
    tile_coords(ti.cur, MT, NT, mtile, ntile);
    ffn_up_tile<8>(A, W, U, smem, mtile * 256, ntile * 128);
  }
  for (TileIter ti((MT * NT - NFULL) * 4); ti.cur < ti.end; ti.cur += ti.step) {
    int mtile, ntile;
    tile_coords(NFULL + (ti.cur >> 2), MT, NT, mtile, ntile);
    ffn_up_tile<2>(A, W, U, smem, mtile * 256 + (ti.cur & 3) * 64, ntile * 128);
  }
}

__device__ __forceinline__ void phase_gemm_in_odd(const Params& P, char* smem) {
  const int tid = threadIdx.x, lane = tid & 63, wave = tid >> 6;
  const int wm = wave >> 1, wn = wave & 1, fr = lane & 15, fq = lane >> 4;
  const u16* A = (const u16*)(P.ws + OFF_H);
  const u16* W = (const u16*)(P.ws + OFF_WIO);
  u16* PO = (u16*)(P.ws + OFF_R1);
  float* DT = (float*)(P.ws + OFF_DT);
  constexpr int MT = 48, NT = 27;
  u16* stg = (u16*)smem + wave * (128 * 72);
  for (TileIter ti(MT * NT); ti.cur < ti.end; ti.cur += ti.step) {
    int mtile, ntile;
    tile_coords(ti.cur, MT, NT, mtile, ntile);
    const int m0 = mtile * 256, n0 = ntile * 128;
    f32x4 acc[8][4];
    gemm_mainloop<true>(A + (size_t)m0 * 1024, 1024, W + (size_t)n0 * 1024, 1024, 1024, (u16*)smem, acc);
#pragma unroll
    for (int mt = 0; mt < 8; mt++) {
#pragma unroll
      for (int nt = 0; nt < 4; nt++) {
        uint2 o;
        o.x = pack2(acc[mt][nt][0], acc[mt][nt][1]);
        o.y = pack2(acc[mt][nt][2], acc[mt][nt][3]);
        *(uint2*)(stg + (mt * 16 + fr) * 72 + nt * 16 + fq * 4) = o;
        const int n = n0 + wn * 64 + nt * 16 + fq * 4;
        if (n >= 3328 && n < 3360) {
          const int t = m0 + wm * 128 + mt * 16 + fr;
          *(float4*)(DT + (size_t)t * 32 + (n - 3328)) = make_float4(acc[mt][nt][0], acc[mt][nt][1], acc[mt][nt][2], acc[mt][nt][3]);
        }
      }
    }
    {
      const int rr = lane >> 3, cc = (lane & 7) * 8;
      u16* dst = PO + (size_t)(m0 + wm * 128 + rr) * 3456 + n0 + wn * 64 + cc;
#pragma unroll
      for (int i = 0; i < 16; i++) {
        const u32x4 v = *(const u32x4*)(stg + (i * 8 + rr) * 72 + cc);
        *(u32x4*)(dst + (size_t)(i * 8) * 3456) = v;
      }
    }
    __syncthreads();
  }
}

__device__ __forceinline__ void fourier_tile(const Params& P, int item, char* smem) {
  const int tid = threadIdx.x, lane = tid & 63, wave = tid >> 6;
  const int wm = wave >> 1, wn = wave & 1, fr = lane & 15, fq = lane >> 4;
  const u16 *D, *YT; int S, tb, mtile, ntile;
  if (item < 128) {
    int seq = item >> 4, r = item & 15; mtile = r >> 1; ntile = r & 1; S = 1024; tb = T_CTX + seq * 1024;
    D = (const u16*)(P.ws + OFF_D1K); YT = (const u16*)(P.ws + OFF_YTS) + (size_t)seq * 256 * 2048;
  } else {
    item -= 128; int seq = item >> 2, r = item & 3; mtile = r >> 1; ntile = r & 1; S = 256; tb = seq * 256;
    D = (const u16*)(P.ws + OFF_D256); YT = (const u16*)(P.ws + OFF_YTC) + (size_t)seq * 256 * 512;
  }
  f32x4 acc[4][4];
  const int K = 2 * S;
  gemm_mainloop<true, 4>(D + (size_t)(mtile * 128) * K, K, YT + (size_t)(ntile * 128) * K, K, K, (u16*)smem, acc);
  u16* MIX = (u16*)(P.ws + OFF_H);
#pragma unroll
  for (int mt = 0; mt < 4; mt++) {
    const int t = tb + mtile * 128 + wm * 64 + mt * 16 + fr;
#pragma unroll
    for (int nt = 0; nt < 4; nt++) {
      const int n = ntile * 128 + wn * 64 + nt * 16 + fq * 4;
      uint2 o;
      o.x = pack2(acc[mt][nt][0], acc[mt][nt][1]);
      o.y = pack2(acc[mt][nt][2], acc[mt][nt][3]);
      *(uint2*)(MIX + (size_t)t * 1024 + n) = o;
    }
  }
}

__device__ __forceinline__ void attn_item(const Params& P, int item, char* smem) {
  const int tid = threadIdx.x, lane = tid & 63, wave = tid >> 6;
  const int fr = lane & 15, fq = lane >> 4;
  bool smp; int seq, head, qb;
  if (item < 768) { smp = true; seq = item / 96; int r = item % 96; head = r >> 3; qb = r & 7; }
  else { item -= 768; smp = false; seq = item / 24; int r = item % 24; head = r >> 1; qb = r & 1; }
  const int nkeys = smp ? 1536 : 256;
  const int tb = smp ? T_CTX + seq * 1024 : seq * 256;
  const int kvh = head / 3;
  const u16* Kp = (const u16*)(P.ws + (smp ? OFF_KBS : OFF_KBC)) + (size_t)((seq * 4 + kvh) * nkeys) * 64;
  const u16* Vp = (const u16*)(P.ws + (smp ? OFF_VTS : OFF_VTC)) + (size_t)((seq * 4 + kvh) * 64) * nkeys;
  const u16* QB = (const u16*)(P.ws + OFF_QB);
  u16* sK = (u16*)smem;
  u16* sV = sK + 2 * 64 * LDT;
  bf16x8 qf[2][2];
  const int qrow0 = tb + qb * 128 + wave * 32;
#pragma unroll
  for (int qt = 0; qt < 2; qt++)
#pragma unroll
    for (int kk = 0; kk < 2; kk++)
      qf[qt][kk] = *(const bf16x8*)(QB + (size_t)(qrow0 + qt * 16 + fr) * 768 + head * 64 + kk * 32 + fq * 8);
  f32x4 ot[2][4];
#pragma unroll
  for (int a = 0; a < 2; a++)
#pragma unroll
    for (int b = 0; b < 4; b++) ot[a][b] = f32x4{0.f, 0.f, 0.f, 0.f};
  float mrun[2] = {-INFINITY, -INFINITY}, lrun[2] = {0.f, 0.f};
  const int lrow = tid >> 3, lcol = (tid & 7) * 8;
  uint4 rk[2], rv[2];
#pragma unroll
  for (int i = 0; i < 2; i++) {
    rk[i] = *(const uint4*)(Kp + (size_t)(lrow + i * 32) * 64 + lcol);
    rv[i] = *(const uint4*)(Vp + (size_t)(lrow + i * 32) * nkeys + lcol);
  }
#pragma unroll
  for (int i = 0; i < 2; i++) {
    *(uint4*)(sK + (lrow + i * 32) * LDT + lcol) = rk[i];
    *(uint4*)(sV + (lrow + i * 32) * LDT + lcol) = rv[i];
  }
  __syncthreads();
  const int nkt = nkeys >> 6;
  for (int kt = 0; kt < nkt; kt++) {
    const int cur = kt & 1;
    const bool more = kt + 1 < nkt;
    if (more) {
      const int key0 = (kt + 1) * 64;
#pragma unroll
      for (int i = 0; i < 2; i++) {
        rk[i] = *(const uint4*)(Kp + (size_t)(key0 + lrow + i * 32) * 64 + lcol);
        rv[i] = *(const uint4*)(Vp + (size_t)(lrow + i * 32) * nkeys + key0 + lcol);
      }
    }
    const u16* cK = sK + cur * 64 * LDT;
    const u16* cV = sV + cur * 64 * LDT;
    f32x4 st[2][4];
#pragma unroll
    for (int k16 = 0; k16 < 4; k16++) {
      const bf16x8 kf0 = *(const bf16x8*)(cK + (k16 * 16 + fr) * LDT + fq * 8);
      const bf16x8 kf1 = *(const bf16x8*)(cK + (k16 * 16 + fr) * LDT + 32 + fq * 8);
#pragma unroll
      for (int qt = 0; qt < 2; qt++) {
        f32x4 z = f32x4{0.f, 0.f, 0.f, 0.f};
        z = MFMA(kf0, qf[qt][0], z);
        st[qt][k16] = MFMA(kf1, qf[qt][1], z);
      }
    }
    bf16x8 pf[2][2];
#pragma unroll
    for (int qt = 0; qt < 2; qt++) {
      float mx = st[qt][0][0];
#pragma unroll
      for (int k16 = 0; k16 < 4; k16++)
#pragma unroll
        for (int r = 0; r < 4; r++) mx = fmaxf(mx, st[qt][k16][r]);
      mx = xor16_max(mx);
      mx = xor32_max(mx);
      if (!__all(mx - mrun[qt] <= 8.0f)) {
        const float mnew = fmaxf(mrun[qt], mx);
        const float alpha = fexp2(mrun[qt] - mnew);
        mrun[qt] = mnew;
        lrun[qt] *= alpha;
#pragma unroll
        for (int dt = 0; dt < 4; dt++)
#pragma unroll
          for (int r = 0; r < 4; r++) ot[qt][dt][r] *= alpha;
      }
      const float mcur = mrun[qt];
      float ps = 0.f;
#pragma unroll
      for (int k16 = 0; k16 < 4; k16++)
#pragma unroll
        for (int r = 0; r < 4; r++) {
          const float p = fexp2(st[qt][k16][r] - mcur);
          st[qt][k16][r] = p;
          ps += p;
        }
      lrun[qt] += ps;
#pragma unroll
      for (int a = 0; a < 2; a++) {
        union { bf16x8 v; unsigned u[4]; } pk;
        pk.u[0] = pack2(st[qt][2 * a][0], st[qt][2 * a][1]);
        pk.u[1] = pack2(st[qt][2 * a][2], st[qt][2 * a][3]);
        pk.u[2] = pack2(st[qt][2 * a + 1][0], st[qt][2 * a + 1][1]);
        pk.u[3] = pack2(st[qt][2 * a + 1][2], st[qt][2 * a + 1][3]);
        pf[qt][a] = pk.v;
      }
    }
#pragma unroll
    for (int a = 0; a < 2; a++)
#pragma unroll
      for (int dt = 0; dt < 4; dt++) {
        union { bf16x8 v; uint2 h[2]; } vf;
        vf.h[0] = *(const uint2*)(cV + (dt * 16 + fr) * LDT + a * 32 + fq * 4);
        vf.h[1] = *(const uint2*)(cV + (dt * 16 + fr) * LDT + a * 32 + 16 + fq * 4);
#pragma unroll
        for (int qt = 0; qt < 2; qt++) ot[qt][dt] = MFMA(vf.v, pf[qt][a], ot[qt][dt]);
      }
    if (more) {
      u16* dK = sK + (cur ^ 1) * 64 * LDT;
      u16* dV = sV + (cur ^ 1) * 64 * LDT;
#pragma unroll
      for (int i = 0; i < 2; i++) {
        *(uint4*)(dK + (lrow + i * 32) * LDT + lcol) = rk[i];
        *(uint4*)(dV + (lrow + i * 32) * LDT + lcol) = rv[i];
      }
    }
    __syncthreads();
  }
  u16* MIX = (u16*)(P.ws + OFF_H);
#pragma unroll
  for (int qt = 0; qt < 2; qt++) {
    float l = lrun[qt];
    l = xor16_sum(l);
    l = xor32_sum(l);
    const float inv = __builtin_amdgcn_rcpf(l);
    const int t = qrow0 + qt * 16 + fr;
#pragma unroll
    for (int dt = 0; dt < 4; dt++) {
      uint2 o;
      o.x = pack2(ot[qt][dt][0] * inv, ot[qt][dt][1] * inv);
      o.y = pack2(ot[qt][dt][2] * inv, ot[qt][dt][3] * inv);
      *(uint2*)(MIX + (size_t)t * 1024 + 256 + head * 64 + dt * 16 + fq * 4) = o;
    }
  }
}

__device__ __forceinline__ void phase_even_mix(const Params& P, char* smem, int* qsh, const int rep) {
  unsigned* ctr = (unsigned*)(P.ws + OFF_Q + rep * 512);
  for (;;) {
    const int it = queue_next(ctr, qsh);
    if (it >= 1344) break;
    if (it < 128) fourier_tile(P, it, smem);
    else if (it < 896) attn_item(P, it - 128, smem);
    else if (it < 960) fourier_tile(P, it - 896 + 128, smem);
    else attn_item(P, it - 960 + 768, smem);
  }
}

__device__ __forceinline__ void ssd_conv8(const u16* __restrict__ PO, int col, const float* __restrict__ cw,
                                          const float* __restrict__ cb, int ch, int tg0, int lo, int hi,
                                          float (&o)[4][8]) {
  uint4 v[7];
#pragma unroll
  for (int r = 0; r < 7; r++) {
    const int t = tg0 - 1 + r;
    v[r] = make_uint4(0u, 0u, 0u, 0u);
    if (t >= lo && t < hi) v[r] = *(const uint4*)(PO + (size_t)t * 3456 + col);
  }
  float w[4][8], b[8];
#pragma unroll
  for (int j = 0; j < 4; j++) {
    const float4 w0 = *(const float4*)(cw + j * 1280 + ch);
    const float4 w1 = *(const float4*)(cw + j * 1280 + ch + 4);
    w[j][0] = w0.x; w[j][1] = w0.y; w[j][2] = w0.z; w[j][3] = w0.w;
    w[j][4] = w1.x; w[j][5] = w1.y; w[j][6] = w1.z; w[j][7] = w1.w;
  }
  {
    const float4 b0 = *(const float4*)(cb + ch);
    const float4 b1 = *(const float4*)(cb + ch + 4);
    b[0] = b0.x; b[1] = b0.y; b[2] = b0.z; b[3] = b0.w; b[4] = b1.x; b[5] = b1.y; b[6] = b1.z; b[7] = b1.w;
  }
#pragma unroll
  for (int tok = 0; tok < 4; tok++)
#pragma unroll
    for (int e = 0; e < 8; e++) o[tok][e] = b[e];
#pragma unroll
  for (int r = 0; r < 7; r++) {
    const unsigned uu[4] = {v[r].x, v[r].y, v[r].z, v[r].w};
#pragma unroll
    for (int e = 0; e < 8; e++) {
      const float x = __uint_as_float((e & 1) ? (uu[e >> 1] & 0xffff0000u) : (uu[e >> 1] << 16));
#pragma unroll
      for (int tok = 0; tok < 4; tok++) {
        const int j = r - tok;
        if (j >= 0 && j < 4) o[tok][e] += w[j][e] * x;
      }
    }
  }
#pragma unroll
  for (int tok = 0; tok < 4; tok++)
#pragma unroll
    for (int e = 0; e < 8; e++) o[tok][e] = silu_f(o[tok][e]);
}


__device__ __forceinline__ void phase_odd_conv(const Params& P) {
  const u16* PO = (const u16*)(P.ws + OFF_R1);
  u16* XC = (u16*)(P.ws + OFF_H);
  const float* cw = PRM(P, PRM_CSW);
  const float* cb = PRM(P, PRM_CSB);
  constexpr int NRUN = T_ALL / 16;
  const int nthr = gridDim.x * 256;
  for (int idx = blockIdx.x * 256 + threadIdx.x; idx < NRUN * 160; idx += nthr) {
    const int c8 = idx % 160, run = idx / 160;
    const int tb16 = run * 16;
    int lo, hi;
    if (tb16 < T_CTX) { lo = tb16 & ~255; hi = lo + 256; }
    else { lo = T_CTX + ((tb16 - T_CTX) & ~1023); hi = lo + 1024; }
    const int ch = c8 * 8;
    float w[4][8], bb[8];
#pragma unroll
    for (int j = 0; j < 4; j++) {
      const float4 w0 = *(const float4*)(cw + j * 1280 + ch);
      const float4 w1 = *(const float4*)(cw + j * 1280 + ch + 4);
      w[j][0] = w0.x; w[j][1] = w0.y; w[j][2] = w0.z; w[j][3] = w0.w;
      w[j][4] = w1.x; w[j][5] = w1.y; w[j][6] = w1.z; w[j][7] = w1.w;
    }
    {
      const float4 b0 = *(const float4*)(cb + ch);
      const float4 b1 = *(const float4*)(cb + ch + 4);
      bb[0] = b0.x; bb[1] = b0.y; bb[2] = b0.z; bb[3] = b0.w; bb[4] = b1.x; bb[5] = b1.y; bb[6] = b1.z; bb[7] = b1.w;
    }
    const u16* src = PO + 2048 + ch;
    u32x4 v[19];
#pragma unroll
    for (int r = 0; r < 19; r++) {
      const int t = tb16 - 1 + r;
      v[r] = u32x4{0u, 0u, 0u, 0u};
      if (t >= lo && t < hi) v[r] = *(const u32x4*)(src + (size_t)t * 3456);
    }
#pragma unroll
    for (int tok = 0; tok < 16; tok++) {
      float o[8];
#pragma unroll
      for (int e = 0; e < 8; e++) o[e] = bb[e];
#pragma unroll
      for (int j = 0; j < 4; j++) {
        const u32x4 vv = v[tok + j];
        const unsigned uu[4] = {vv.x, vv.y, vv.z, vv.w};
#pragma unroll
        for (int e = 0; e < 8; e++) {
          const float x = __uint_as_float((e & 1) ? (uu[e >> 1] & 0xffff0000u) : (uu[e >> 1] << 16));
          o[e] += w[j][e] * x;
        }
      }
      uint4 w4;
      w4.x = pack2(silu_f(o[0]), silu_f(o[1])); w4.y = pack2(silu_f(o[2]), silu_f(o[3]));
      w4.z = pack2(silu_f(o[4]), silu_f(o[5])); w4.w = pack2(silu_f(o[6]), silu_f(o[7]));
      *(uint4*)(XC + (size_t)(tb16 + tok) * 1280 + ch) = w4;
    }
  }
}

__device__ __forceinline__ void ssd_item(const Params& P, int item, char* smem) {
  const int tid = threadIdx.x, lane = tid & 63, wave = tid >> 6;
  const int fr = lane & 15, fq = lane >> 4;
  bool smp; int seq;
  if (item < 256) { smp = true; seq = item >> 5; }
  else { item -= 256; smp = false; seq = item >> 5; }
  const int head = (item & 31) >> 1, dir = item & 1;
  const int nc = smp ? 8 : 2;
  const int tb = smp ? T_CTX + seq * 1024 : seq * 256;
  const int tend = tb + (smp ? 1024 : 256);
  const int g = head >> 3;
  u16* Cs = (u16*)smem;
  u16* Bs = (u16*)(smem + 18432);
  u16* BT = (u16*)(smem + 36864);
  u16* XT = (u16*)(smem + 54272);
  u16* Hb = (u16*)(smem + 71680);
  float* cum2 = (float*)(smem + 79872);
  float* lcs2 = (float*)(smem + 80384);
  float* misc = (float*)(smem + 81408);
  const u16* PO = (const u16*)(P.ws + OFF_R1);
  const float* DT = (const float*)(P.ws + OFF_DT);
  u16* YO = (u16*)(P.ws + OFF_Y) + (size_t)dir * T_ALL * 1024;
  const float Aneg = -__expf(PRM(P, PRM_ALOG)[dir * 16 + head]);
  const float dtb = PRM(P, PRM_DTB)[dir * 16 + head];
  const float Dh = PRM(P, PRM_SSDD)[head];
  f32x4 hacc[4];
#pragma unroll
  for (int nt = 0; nt < 4; nt++) {
#pragma unroll
    for (int r = 0; r < 4; r++) {
      float v = 0.f;
      if (smp) v = P.in[6][(size_t)((seq * 2 + dir) * 16 + head) * 4096 + (wave * 16 + fq * 4 + r) * 64 + nt * 16 + fr];
      hacc[nt][r] = v;
      Hb[(wave * 16 + fq * 4 + r) * 64 + nt * 16 + fr] = f2bf(v);
    }
  }
  const int ch8 = (tid & 7) * 8, rg = tid >> 3;
  const int swzw = (tid & 7) << 3;
  const u16* XC = (const u16*)(P.ws + OFF_H);
  u32x4 rx0, rx1, rx2, rx3, rb0, rb1, rb2, rb3;
  float raw_next = 0.f;
  {
    const int c0 = dir ? nc - 1 : 0;
    const u16* xr = XC + (size_t)(tb + c0 * 128 + rg * 4) * 1280 + ch8;
    rx0 = *(const u32x4*)(xr + head * 64); rx1 = *(const u32x4*)(xr + 1280 + head * 64);
    rx2 = *(const u32x4*)(xr + 2560 + head * 64); rx3 = *(const u32x4*)(xr + 3840 + head * 64);
    rb0 = *(const u32x4*)(xr + 1024 + g * 64); rb1 = *(const u32x4*)(xr + 1280 + 1024 + g * 64);
    rb2 = *(const u32x4*)(xr + 2560 + 1024 + g * 64); rb3 = *(const u32x4*)(xr + 3840 + 1024 + g * 64);
    if (tid < 128) raw_next = DT[(size_t)(tb + c0 * 128 + (dir ? 127 - tid : tid)) * 32 + dir * 16 + head];
  }
  for (int ci = 0; ci < nc; ci++) {
    const int c = dir ? nc - 1 - ci : ci;
    const int t0 = tb + c * 128;
    {
      const u16* xrc = XC + (size_t)(t0 + rg * 4) * 1280 + ch8 + 1152 + g * 64;
      const u32x4 rc0 = *(const u32x4*)(xrc), rc1 = *(const u32x4*)(xrc + 1280);
      const u32x4 rc2 = *(const u32x4*)(xrc + 2560), rc3 = *(const u32x4*)(xrc + 3840);
      {
        const unsigned u[4][4] = {{rx0.x, rx0.y, rx0.z, rx0.w}, {rx1.x, rx1.y, rx1.z, rx1.w}, {rx2.x, rx2.y, rx2.z, rx2.w}, {rx3.x, rx3.y, rx3.z, rx3.w}};
#pragma unroll
        for (int q = 0; q < 4; q++) {
          uint2 lo2, hi2;
          lo2.x = (u[0][q] & 0xffffu) | (u[1][q] << 16); lo2.y = (u[2][q] & 0xffffu) | (u[3][q] << 16);
          hi2.x = (u[0][q] >> 16) | (u[1][q] & 0xffff0000u); hi2.y = (u[2][q] >> 16) | (u[3][q] & 0xffff0000u);
          *(uint2*)(XT + (ch8 + 2 * q) * 136 + ((rg * 4) ^ swzw)) = lo2;
          *(uint2*)(XT + (ch8 + 2 * q + 1) * 136 + ((rg * 4) ^ swzw)) = hi2;
        }
      }
      {
        const unsigned u[4][4] = {{rb0.x, rb0.y, rb0.z, rb0.w}, {rb1.x, rb1.y, rb1.z, rb1.w}, {rb2.x, rb2.y, rb2.z, rb2.w}, {rb3.x, rb3.y, rb3.z, rb3.w}};
#pragma unroll
        for (int q = 0; q < 4; q++) {
          uint2 lo2, hi2;
          lo2.x = (u[0][q] & 0xffffu) | (u[1][q] << 16); lo2.y = (u[2][q] & 0xffffu) | (u[3][q] << 16);
          hi2.x = (u[0][q] >> 16) | (u[1][q] & 0xffff0000u); hi2.y = (u[2][q] >> 16) | (u[3][q] & 0xffff0000u);
          *(uint2*)(BT + (ch8 + 2 * q) * 136 + ((rg * 4) ^ swzw)) = lo2;
          *(uint2*)(BT + (ch8 + 2 * q + 1) * 136 + ((rg * 4) ^ swzw)) = hi2;
        }
        *(u32x4*)(Bs + (rg * 4 + 0) * LDT + ch8) = rb0;
        *(u32x4*)(Bs + (rg * 4 + 1) * LDT + ch8) = rb1;
        *(u32x4*)(Bs + (rg * 4 + 2) * LDT + ch8) = rb2;
        *(u32x4*)(Bs + (rg * 4 + 3) * LDT + ch8) = rb3;
      }
      *(u32x4*)(Cs + (rg * 4 + 0) * LDT + ch8) = rc0;
      *(u32x4*)(Cs + (rg * 4 + 1) * LDT + ch8) = rc1;
      *(u32x4*)(Cs + (rg * 4 + 2) * LDT + ch8) = rc2;
      *(u32x4*)(Cs + (rg * 4 + 3) * LDT + ch8) = rc3;
    }
    const float raw_cur = raw_next;
    __builtin_amdgcn_sched_barrier(0);
    if (ci + 1 < nc) {
      const int cn = dir ? nc - 2 - ci : ci + 1;
      const u16* xr = XC + (size_t)(tb + cn * 128 + rg * 4) * 1280 + ch8;
      rx0 = *(const u32x4*)(xr + head * 64); rx1 = *(const u32x4*)(xr + 1280 + head * 64);
      rx2 = *(const u32x4*)(xr + 2560 + head * 64); rx3 = *(const u32x4*)(xr + 3840 + head * 64);
      rb0 = *(const u32x4*)(xr + 1024 + g * 64); rb1 = *(const u32x4*)(xr + 1280 + 1024 + g * 64);
      rb2 = *(const u32x4*)(xr + 2560 + 1024 + g * 64); rb3 = *(const u32x4*)(xr + 3840 + 1024 + g * 64);
      if (tid < 128) raw_next = DT[(size_t)(tb + cn * 128 + (dir ? 127 - tid : tid)) * 32 + dir * 16 + head];
    }
    __builtin_amdgcn_sched_barrier(0);
    float sv = 0.f, dtv = 1.f;
    int li = 0;
    if (tid < 128) {
      li = dir ? 127 - tid : tid;
      const float raw = raw_cur + dtb;
      dtv = fmaxf(raw, 0.f) + log1pf(__expf(-fabsf(raw)));
      sv = dtv * Aneg;
#pragma unroll
      for (int o = 1; o < 64; o <<= 1) {
        const float u = __shfl_up(sv, o);
        if (lane >= o) sv += u;
      }
      if (tid == 63) misc[0] = sv;
    }
    __syncthreads();
    if (tid < 128) {
      if (wave == 1) sv += misc[0];
      cum2[li] = sv * LOG2E;
      lcs2[li] = (sv - __logf(dtv)) * LOG2E;
      if (tid == 127) misc[1] = sv * LOG2E;
    }
    __syncthreads();
    const float total2 = misc[1];
#pragma unroll 1
    for (int tt = 0; tt < 2; tt++) {
      const int Tt = wave * 2 + tt;
      const int tl = wave * 32 + tt * 16 + fr;
      bf16x8 cf[2];
#pragma unroll
      for (int kk = 0; kk < 2; kk++) cf[kk] = *(const bf16x8*)(Cs + tl * LDT + kk * 32 + fq * 8);
      f32x4 acc[4];
#pragma unroll
      for (int pt = 0; pt < 4; pt++) {
        const bf16x8 h0 = *(const bf16x8*)(Hb + (pt * 16 + fr) * 64 + fq * 8);
        const bf16x8 h1 = *(const bf16x8*)(Hb + (pt * 16 + fr) * 64 + 32 + fq * 8);
        f32x4 z = f32x4{0.f, 0.f, 0.f, 0.f};
        z = MFMA(h0, cf[0], z);
        acc[pt] = MFMA(h1, cf[1], z);
      }
      const float ct = cum2[tl];
      {
        const float e = fexp2(ct);
#pragma unroll
        for (int pt = 0; pt < 4; pt++)
#pragma unroll
          for (int r = 0; r < 4; r++) acc[pt][r] *= e;
      }
#pragma unroll 1
      for (int a = 0; a < 4; a++) {
        const bool ok = dir ? (2 * a + 1 >= Tt) : (2 * a <= Tt);
        if (!ok) continue;
        f32x4 g0 = f32x4{0.f, 0.f, 0.f, 0.f}, g1 = f32x4{0.f, 0.f, 0.f, 0.f};
#pragma unroll
        for (int kk = 0; kk < 2; kk++) {
          const bf16x8 b0 = *(const bf16x8*)(Bs + ((2 * a) * 16 + fr) * LDT + kk * 32 + fq * 8);
          const bf16x8 b1 = *(const bf16x8*)(Bs + ((2 * a + 1) * 16 + fr) * LDT + kk * 32 + fq * 8);
          g0 = MFMA(b0, cf[kk], g0);
          g1 = MFMA(b1, cf[kk], g1);
        }
        const float4 l0 = *(const float4*)(lcs2 + a * 32 + fq * 4);
        const float4 l1 = *(const float4*)(lcs2 + a * 32 + 16 + fq * 4);
        const float ls0[4] = {l0.x, l0.y, l0.z, l0.w};
        const float ls1[4] = {l1.x, l1.y, l1.z, l1.w};
        float m0[4], m1[4];
#pragma unroll
        for (int r = 0; r < 4; r++) {
          const int s0 = a * 32 + fq * 4 + r, s1 = s0 + 16;
          const bool ok0 = dir ? (s0 >= tl) : (s0 <= tl);
          const bool ok1 = dir ? (s1 >= tl) : (s1 <= tl);
          float v0 = ok0 ? g0[r] * fexp2(ct - ls0[r]) : 0.f;
          float v1 = ok1 ? g1[r] * fexp2(ct - ls1[r]) : 0.f;
          if (!dir && s0 == tl) v0 += Dh;
          if (!dir && s1 == tl) v1 += Dh;
          m0[r] = v0; m1[r] = v1;
        }
        union { bf16x8 v; unsigned u[4]; } pk;
        pk.u[0] = pack2(m0[0], m0[1]); pk.u[1] = pack2(m0[2], m0[3]);
        pk.u[2] = pack2(m1[0], m1[1]); pk.u[3] = pack2(m1[2], m1[3]);
#pragma unroll
        for (int pt = 0; pt < 4; pt++) {
          union { bf16x8 v; uint2 h[2]; } x;
          x.h[0] = *(const uint2*)(XT + (pt * 16 + fr) * 136 + ((a * 32 + fq * 4) ^ ((((pt * 2 + (fr >> 3)) & 7)) << 3)));
          x.h[1] = *(const uint2*)(XT + (pt * 16 + fr) * 136 + ((a * 32 + 16 + fq * 4) ^ ((((pt * 2 + (fr >> 3)) & 7)) << 3)));
          acc[pt] = MFMA(x.v, pk.v, acc[pt]);
        }
      }
      {
        const int t = t0 + tl;
#pragma unroll
        for (int pt = 0; pt < 4; pt++) {
          uint2 o;
          o.x = pack2(acc[pt][0], acc[pt][1]);
          o.y = pack2(acc[pt][2], acc[pt][3]);
          *(uint2*)(YO + (size_t)t * 1024 + head * 64 + pt * 16 + fq * 4) = o;
        }
      }
    }
    {
      const float et = fexp2(total2);
#pragma unroll
      for (int nt = 0; nt < 4; nt++)
#pragma unroll
        for (int r = 0; r < 4; r++) hacc[nt][r] *= et;
#pragma unroll 1
      for (int ks = 0; ks < 4; ks++) {
        union { bf16x8 v; unsigned u[4]; } xr, xw;
        xr.v = *(const bf16x8*)(XT + (wave * 16 + fr) * 136 + ((ks * 32 + fq * 8) ^ ((((wave * 2 + (fr >> 3)) & 7)) << 3)));
        const float4 la = *(const float4*)(lcs2 + ks * 32 + fq * 8);
        const float4 lb = *(const float4*)(lcs2 + ks * 32 + fq * 8 + 4);
        const float lw[8] = {la.x, la.y, la.z, la.w, lb.x, lb.y, lb.z, lb.w};
#pragma unroll
        for (int q = 0; q < 4; q++) {
          const float x0 = __uint_as_float(xr.u[q] << 16) * fexp2(total2 - lw[2 * q]);
          const float x1 = __uint_as_float(xr.u[q] & 0xffff0000u) * fexp2(total2 - lw[2 * q + 1]);
          xw.u[q] = pack2(x0, x1);
        }
#pragma unroll
        for (int nt = 0; nt < 4; nt++) {
          const bf16x8 bt = *(const bf16x8*)(BT + (nt * 16 + fr) * 136 + ((ks * 32 + fq * 8) ^ ((((nt * 2 + (fr >> 3)) & 7)) << 3)));
          hacc[nt] = MFMA(xw.v, bt, hacc[nt]);
        }
      }
    }
    __syncthreads();
#pragma unroll
    for (int nt = 0; nt < 4; nt++)
#pragma unroll
      for (int r = 0; r < 4; r++) Hb[(wave * 16 + fq * 4 + r) * 64 + nt * 16 + fr] = f2bf(hacc[nt][r]);
  }
  if (!smp) {
    float* ns = P.out + 14696448 + (size_t)((seq * 2 + dir) * 16 + head) * 4096;
#pragma unroll
    for (int nt = 0; nt < 4; nt++)
#pragma unroll
      for (int r = 0; r < 4; r++) ns[(wave * 16 + fq * 4 + r) * 64 + nt * 16 + fr] = hacc[nt][r];
  }
  __syncthreads();
}

__device__ __forceinline__ void lru_item(const Params& P, int item, char* smem) {
  const int tid = threadIdx.x, lane = tid & 63, wave = tid >> 6;
  const int fr = lane & 15, fq = lane >> 4;
  bool smp; int seq;
  if (item < 128) { smp = true; seq = item >> 4; }
  else { item -= 128; smp = false; seq = item >> 4; }
  const int blk = (item & 15) >> 1, dir = item & 1;
  const int nc = smp ? 16 : 4;
  const int tb = smp ? T_CTX + seq * 1024 : seq * 256;
  const int tend = tb + (smp ? 1024 : 256);
  u16* WaT = (u16*)smem;
  u16* WxT = (u16*)(smem + 9216);
  u16* xcb = (u16*)(smem + 18432);
  float* aL = (float*)(smem + 27648);
  float* bL = (float*)(smem + 45056);
  float* sA = (float*)(smem + 62464);
  float* sH = (float*)(smem + 63488);
  float* hc = (float*)(smem + 64512);
  float* cba = (float*)(smem + 65024);
  float* cbx = (float*)(smem + 65280);
  float* csp = (float*)(smem + 65536);
  const u16* PO = (const u16*)(P.ws + OFF_R1);
  u16* YO = (u16*)(P.ws + OFF_YL) + (size_t)dir * T_ALL * 512;
  {
    const float* wa = PRM(P, PRM_LWA) + (size_t)(dir * 8 + blk) * 4096;
    const float* wx = PRM(P, PRM_LWX) + (size_t)(dir * 8 + blk) * 4096;
    for (int e = tid; e < 4096; e += 256) {
      const int i = e >> 6, j = e & 63;
      WaT[j * LDT + i] = f2bf(wa[e]);
      WxT[j * LDT + i] = f2bf(wx[e]);
    }
    if (tid < 64) {
      const int ch = dir * 512 + blk * 64 + tid;
      cba[tid] = PRM(P, PRM_LBA)[ch];
      cbx[tid] = PRM(P, PRM_LBX)[ch];
      const float lam = -PRM(P, PRM_LAM)[ch];
      csp[tid] = 8.0f * (fmaxf(lam, 0.f) + log1pf(__expf(-fabsf(lam))));
      hc[tid] = smp ? P.in[5][(size_t)(seq * 2 + dir) * 512 + blk * 64 + tid] : 0.f;
    }
  }
  const int ch8 = (tid & 7) * 8, rg = tid >> 3;
  const float* cw = PRM(P, PRM_CLW);
  const float* cb = PRM(P, PRM_CLB);
  u32x4 pv0, pv1, pv2, pv3, pv4;
  {
    const int c0 = dir ? nc - 1 : 0;
    const int tn = tb + c0 * 64 + rg * 2 - 1;
    const int chg = blk * 64 + ch8;
    const u32x4 zz = {0u, 0u, 0u, 0u};
    pv0 = (tn >= tb) ? *(const u32x4*)(PO + (size_t)tn * 3456 + 512 + chg) : zz;
    pv1 = *(const u32x4*)(PO + (size_t)(tn + 1) * 3456 + 512 + chg);
    pv2 = *(const u32x4*)(PO + (size_t)(tn + 2) * 3456 + 512 + chg);
    pv3 = (tn + 3 < tend) ? *(const u32x4*)(PO + (size_t)(tn + 3) * 3456 + 512 + chg) : zz;
    pv4 = (tn + 4 < tend) ? *(const u32x4*)(PO + (size_t)(tn + 4) * 3456 + 512 + chg) : zz;
  }
  for (int ci = 0; ci < nc; ci++) {
    const int c = dir ? nc - 1 - ci : ci;
    const int t0 = tb + c * 64;
    const int cur = ci & 1;
    {
      const int chg = blk * 64 + ch8;
      const u32x4 v[5] = {pv0, pv1, pv2, pv3, pv4};
      if (ci + 1 < nc) {
        const int cn = dir ? nc - 2 - ci : ci + 1;
        const int tn = tb + cn * 64 + rg * 2 - 1;
        const u32x4 zz = {0u, 0u, 0u, 0u};
        pv0 = (tn >= tb) ? *(const u32x4*)(PO + (size_t)tn * 3456 + 512 + chg) : zz;
        pv1 = *(const u32x4*)(PO + (size_t)(tn + 1) * 3456 + 512 + chg);
        pv2 = *(const u32x4*)(PO + (size_t)(tn + 2) * 3456 + 512 + chg);
        pv3 = (tn + 3 < tend) ? *(const u32x4*)(PO + (size_t)(tn + 3) * 3456 + 512 + chg) : zz;
        pv4 = (tn + 4 < tend) ? *(const u32x4*)(PO + (size_t)(tn + 4) * 3456 + 512 + chg) : zz;
      }
      float o[2][8];
      {
        const float4 b0 = *(const float4*)(cb + chg);
        const float4 b1 = *(const float4*)(cb + chg + 4);
        const float bb[8] = {b0.x, b0.y, b0.z, b0.w, b1.x, b1.y, b1.z, b1.w};
#pragma unroll
        for (int e = 0; e < 8; e++) { o[0][e] = bb[e]; o[1][e] = bb[e]; }
      }
#pragma unroll
      for (int j = 0; j < 4; j++) {
        const float4 w0 = *(const float4*)(cw + j * 512 + chg);
        const float4 w1 = *(const float4*)(cw + j * 512 + chg + 4);
        const float ww[8] = {w0.x, w0.y, w0.z, w0.w, w1.x, w1.y, w1.z, w1.w};
#pragma unroll
        for (int tok = 0; tok < 2; tok++) {
          const unsigned uu[4] = {v[tok + j].x, v[tok + j].y, v[tok + j].z, v[tok + j].w};
#pragma unroll
          for (int e = 0; e < 8; e++) {
            const float x = __uint_as_float((e & 1) ? (uu[e >> 1] & 0xffff0000u) : (uu[e >> 1] << 16));
            o[tok][e] += ww[e] * x;
          }
        }
      }
#pragma unroll
      for (int tok = 0; tok < 2; tok++) {
        const int tl = rg * 2 + tok;
        *(float4*)(bL + tl * 68 + ch8) = make_float4(o[tok][0], o[tok][1], o[tok][2], o[tok][3]);
        *(float4*)(bL + tl * 68 + ch8 + 4) = make_float4(o[tok][4], o[tok][5], o[tok][6], o[tok][7]);
        uint4 w4;
        w4.x = pack2(o[tok][0], o[tok][1]); w4.y = pack2(o[tok][2], o[tok][3]);
        w4.z = pack2(o[tok][4], o[tok][5]); w4.w = pack2(o[tok][6], o[tok][7]);
        *(uint4*)(xcb + tl * LDT + ch8) = w4;
      }
    }
    __syncthreads();
    {
      bf16x8 xb[2];
#pragma unroll
      for (int kk = 0; kk < 2; kk++) xb[kk] = *(const bf16x8*)(xcb + (wave * 16 + fr) * LDT + kk * 32 + fq * 8);
      const int tl = wave * 16 + fr;
#pragma unroll
      for (int jt = 0; jt < 4; jt++) {
        f32x4 aR = f32x4{0.f, 0.f, 0.f, 0.f}, aI = f32x4{0.f, 0.f, 0.f, 0.f};
#pragma unroll
        for (int kk = 0; kk < 2; kk++) {
          const bf16x8 wa = *(const bf16x8*)(WaT + (jt * 16 + fr) * LDT + kk * 32 + fq * 8);
          const bf16x8 wx = *(const bf16x8*)(WxT + (jt * 16 + fr) * LDT + kk * 32 + fq * 8);
          aR = MFMA(wa, xb[kk], aR);
          aI = MFMA(wx, xb[kk], aI);
        }
        const int j4 = jt * 16 + fq * 4;
        const float4 xc = *(const float4*)(bL + tl * 68 + j4);
        const float4 ba = *(const float4*)(cba + j4);
        const float4 bx = *(const float4*)(cbx + j4);
        const float4 sp = *(const float4*)(csp + j4);
        const float xcv[4] = {xc.x, xc.y, xc.z, xc.w};
        const float bav[4] = {ba.x, ba.y, ba.z, ba.w};
        const float bxv[4] = {bx.x, bx.y, bx.z, bx.w};
        const float spv[4] = {sp.x, sp.y, sp.z, sp.w};
        float av[4], bv[4];
#pragma unroll
        for (int r = 0; r < 4; r++) {
          const float rr = sigmoid_f(aR[r] + bav[r]);
          const float ii = sigmoid_f(aI[r] + bxv[r]);
          const float la = -rr * spv[r];
          av[r] = __expf(la);
          bv[r] = __builtin_amdgcn_sqrtf(fmaxf(1.0f - av[r] * av[r], 0.f)) * ii * xcv[r];
        }
        *(float4*)(aL + tl * 68 + j4) = make_float4(av[0], av[1], av[2], av[3]);
        *(float4*)(bL + tl * 68 + j4) = make_float4(bv[0], bv[1], bv[2], bv[3]);
      }
    }
    __syncthreads();
    {
      const int j = lane, q = wave;
      float hreg[16], areg[16];
      float h = 0.f, Ap = 1.f;
#pragma unroll
      for (int i = 0; i < 16; i++) {
        const int tl = dir ? 63 - (q * 16 + i) : q * 16 + i;
        const float a = aL[tl * 68 + j], b = bL[tl * 68 + j];
        h = a * h + b;
        Ap *= a;
        hreg[i] = h;
        areg[i] = Ap;
      }
      sA[q * 64 + j] = Ap;
      sH[q * 64 + j] = h;
      __syncthreads();
      float Hin = hc[cur * 64 + j];
      for (int qq = 0; qq < q; qq++) Hin = sA[qq * 64 + j] * Hin + sH[qq * 64 + j];
#pragma unroll
      for (int i = 0; i < 16; i++) {
        const int tl = dir ? 63 - (q * 16 + i) : q * 16 + i;
        const float hv = hreg[i] + areg[i] * Hin;
        YO[(size_t)(t0 + tl) * 512 + blk * 64 + j] = f2bf(hv);
      }
      if (q == 3) hc[(cur ^ 1) * 64 + j] = sA[3 * 64 + j] * Hin + sH[3 * 64 + j];
    }
  }
  __syncthreads();
  if (!smp && tid < 64) {
    P.out[14680064 + (size_t)(seq * 2 + dir) * 512 + blk * 64 + tid] = hc[(nc & 1) * 64 + tid];
  }
  __syncthreads();
}

__device__ __forceinline__ void phase_odd_mix(const Params& P, char* smem, int* qsh, const int rep) {
  unsigned* ctr = (unsigned*)(P.ws + OFF_Q + 256 + rep * 512);
  for (;;) {
    const int it = queue_next(ctr, qsh);
    if (it >= 1152) break;
    bool is_ssd; int idx;
    if (it < 128) { is_ssd = false; idx = it; }
    else if (it < 384) { is_ssd = true; idx = it - 128; }
    else if (it < 640) { is_ssd = false; idx = it - 384 + 128; }
    else { is_ssd = true; idx = it - 640 + 256; }
    if (is_ssd) ssd_item(P, idx, smem);
    else lru_item(P, idx, smem);
  }
}

__device__ __forceinline__ void phase_odd_combine(const Params& P) {
  const int tid = threadIdx.x, lane = tid & 63, wave = tid >> 6;
  const u16* PO = (const u16*)(P.ws + OFF_R1);
  const u16* YSF = (const u16*)(P.ws + OFF_Y);
  const u16* YSB = YSF + (size_t)T_ALL * 1024;
  const u16* YLF = (const u16*)(P.ws + OFF_YL);
  const u16* YLB = YLF + (size_t)T_ALL * 512;
  u16* MIX = (u16*)(P.ws + OFF_H);
  const float* nrm = PRM(P, PRM_SNORM);
  float4 nr[2][2];
#pragma unroll
  for (int hh = 0; hh < 2; hh++) { nr[hh][0] = *(const float4*)(nrm + hh * 512 + lane * 8); nr[hh][1] = *(const float4*)(nrm + hh * 512 + lane * 8 + 4); }
  for (int t = blockIdx.x * 4 + wave; t < T_ALL; t += gridDim.x * 4) {
    {
      const int c = lane * 8;
      const uint4 f = *(const uint4*)(YLF + (size_t)t * 512 + c);
      const uint4 b = *(const uint4*)(YLB + (size_t)t * 512 + c);
      const uint4 gg = *(const uint4*)(PO + (size_t)t * 3456 + c);
      const unsigned fu[4] = {f.x, f.y, f.z, f.w}, bu[4] = {b.x, b.y, b.z, b.w}, gu[4] = {gg.x, gg.y, gg.z, gg.w};
      unsigned ou[4];
#pragma unroll
      for (int q = 0; q < 4; q++) {
        float r[2];
#pragma unroll
        for (int h = 0; h < 2; h++) {
          const float yf = h ? __uint_as_float(fu[q] & 0xffff0000u) : __uint_as_float(fu[q] << 16);
          const float yb = h ? __uint_as_float(bu[q] & 0xffff0000u) : __uint_as_float(bu[q] << 16);
          const float gv = h ? __uint_as_float(gu[q] & 0xffff0000u) : __uint_as_float(gu[q] << 16);
          const float ge = gv * __builtin_amdgcn_rcpf(1.f + __expf(-2.0f * 0.7978845608028654f * (gv + 0.044715f * gv * gv * gv)));
          r[h] = (yf + yb) * ge;
        }
        ou[q] = pack2(r[0], r[1]);
      }
      *(uint4*)(MIX + (size_t)t * 1536 + c) = make_uint4(ou[0], ou[1], ou[2], ou[3]);
    }
    float y[16];
    float ss = 0.f;
#pragma unroll
    for (int hh = 0; hh < 2; hh++) {
      const int c = hh * 512 + lane * 8;
      const uint4 f = *(const uint4*)(YSF + (size_t)t * 1024 + c);
      const uint4 b = *(const uint4*)(YSB + (size_t)t * 1024 + c);
      const uint4 zz = *(const uint4*)(PO + (size_t)t * 3456 + 1024 + c);
      const unsigned fu[4] = {f.x, f.y, f.z, f.w}, bu[4] = {b.x, b.y, b.z, b.w}, zu[4] = {zz.x, zz.y, zz.z, zz.w};
#pragma unroll
      for (int q = 0; q < 4; q++)
#pragma unroll
        for (int h = 0; h < 2; h++) {
          const float yf = h ? __uint_as_float(fu[q] & 0xffff0000u) : __uint_as_float(fu[q] << 16);
          const float yb = h ? __uint_as_float(bu[q] & 0xffff0000u) : __uint_as_float(bu[q] << 16);
          const float zv = h ? __uint_as_float(zu[q] & 0xffff0000u) : __uint_as_float(zu[q] << 16);
          const float v = (yf + yb) * silu_f(zv);
          y[hh * 8 + q * 2 + h] = v;
          ss += v * v;
        }
    }
#pragma unroll
    for (int o = 32; o >= 1; o >>= 1) ss += __shfl_xor(ss, o);
    const float rs = rsqrtf(ss * (1.0f / 1024.0f) + 1e-6f);
#pragma unroll
    for (int hh = 0; hh < 2; hh++) {
      const int c = hh * 512 + lane * 8;
      const float4 n0 = nr[hh][0];
      const float4 n1 = nr[hh][1];
      uint4 o;
      o.x = pack2(y[hh * 8 + 0] * rs * n0.x, y[hh * 8 + 1] * rs * n0.y);
      o.y = pack2(y[hh * 8 + 2] * rs * n0.z, y[hh * 8 + 3] * rs * n0.w);
      o.z = pack2(y[hh * 8 + 4] * rs * n1.x, y[hh * 8 + 5] * rs * n1.y);
      o.w = pack2(y[hh * 8 + 6] * rs * n1.z, y[hh * 8 + 7] * rs * n1.w);
      *(uint4*)(MIX + (size_t)t * 1536 + 512 + c) = o;
    }
  }
}

#ifndef PHMASK
#define PHMASK 0xffffffu
#endif
__device__ __forceinline__ void run_phase(const Params& P, const int ph, char* smem, int* qsh, const int rep = 0) {
  switch (ph) {
    case 0: if (PHMASK & (1u << 0)) phase_prep(P, smem, qsh); break;
    case 1: if (PHMASK & (1u << 1)) phase_norm(P, 0, 0); break;
    case 2: if (PHMASK & (1u << 2)) phase_gemm_in_even(P, smem); break;
    case 3: if (PHMASK & (1u << 3)) phase_even_mix(P, smem, qsh, rep); break;
    case 4: if (PHMASK & (1u << 4)) phase_gemm_resid(P, smem, (const u16*)(P.ws + OFF_H), 1024, (const u16*)(P.ws + OFF_WOE), 1024, 0, 2, true); break;
    case 5: if (PHMASK & (1u << 5)) phase_norm(P, 0, 1); break;
    case 6: if (PHMASK & (1u << 6)) phase_gemm_ffn_up(P, smem, 0); break;
    case 7: if (PHMASK & (1u << 7)) phase_gemm_resid(P, smem, (const u16*)(P.ws + OFF_R1), 2816, (const u16*)(P.ws + OFF_W2), 2816, 0, 5, false); break;
    case 8: if (PHMASK & (1u << 8)) phase_norm(P, 1, 0); break;
    case 9: if (PHMASK & (1u << 9)) phase_gemm_in_odd(P, smem); break;
    case 10: if (PHMASK & (1u << 10)) phase_odd_conv(P); break;
    case 11: if (PHMASK & (1u << 11)) phase_odd_mix(P, smem, qsh, rep); break;
    case 12: if (PHMASK & (1u << 12)) phase_odd_combine(P); break;
    case 13: if (PHMASK & (1u << 13)) phase_gemm_resid(P, smem, (const u16*)(P.ws + OFF_H), 1536, (const u16*)(P.ws + OFF_WOO), 1536, 1, 2, false); break;
    case 14: if (PHMASK & (1u << 14)) phase_norm(P, 1, 1); break;
    case 15: if (PHMASK & (1u << 15)) phase_gemm_ffn_up(P, smem, 1); break;
    case 16: if (PHMASK & (1u << 16)) phase_gemm_resid(P, smem, (const u16*)(P.ws + OFF_R1), 2816, (const u16*)(P.ws + OFF_W2) + (size_t)1024 * 2816, 2816, 1, 5, false); break;
    default: break;
  }
}

constexpr int N_PHASES = 17;

__global__ void __launch_bounds__(256, 2) mega_kernel(Params P, int ph_lo, int ph_hi) {
  __shared__ __attribute__((aligned(16))) char smem[SMEM_BYTES];
  __shared__ uint4 xb_words;
  __shared__ int q_item;
  cg::grid_group grid = cg::this_grid();
  if (threadIdx.x == 0) xb_words = make_uint4(0u, 0u, 0u, 0u);
  __syncthreads();
  XcdBarrier xb = xcd_barrier_post((unsigned*)(P.ws + OFF_BAR), (volatile LAS unsigned*)&xb_words);
  if (ph_lo < 0) grid.sync();
#ifndef DUP_PH
#define DUP_PH -1
#endif
#define RUN_PH(ph) if ((ph) >= ph_lo && (ph) < ph_hi) { run_phase(P, (ph), smem, &q_item); if (DUP_PH == (ph)) { xcd_barrier(xb); run_phase(P, (ph), smem, &q_item, 1); } if ((ph) + 1 < ph_hi) xcd_barrier(xb); }
  RUN_PH(0) RUN_PH(1) RUN_PH(2) RUN_PH(3) RUN_PH(4) RUN_PH(5) RUN_PH(6) RUN_PH(7)
  RUN_PH(8) RUN_PH(9) RUN_PH(10) RUN_PH(11) RUN_PH(12) RUN_PH(13) RUN_PH(14) RUN_PH(15) RUN_PH(16)
}

#ifndef MULTI_LAUNCH
#define MULTI_LAUNCH 0
#endif

extern "C" void kernel_launch(void* const* d_in, const int* in_sizes, int n_in, void* d_out, int out_size, void* d_ws,
                              size_t ws_size, hipStream_t stream) {
  static int grid_blocks = 0;
  if (!grid_blocks) {
    int dev = 0, cus = 0, per_cu = 0;
    (void)hipGetDevice(&dev);
    (void)hipDeviceGetAttribute(&cus, hipDeviceAttributeMultiprocessorCount, dev);
    (void)hipOccupancyMaxActiveBlocksPerMultiprocessor(&per_cu, mega_kernel, 256, 0);
    if (per_cu > 2) per_cu = 2;
    if (per_cu < 1) per_cu = 1;
    grid_blocks = cus * per_cu;
  }
  Params p;
  memset(&p, 0, sizeof(p));
  for (int i = 0; i < 34; i++) p.in[i] = (const float*)d_in[i];
  p.out = (float*)d_out;
  p.ws = (char*)d_ws;
#if MULTI_LAUNCH
  for (int ph = 0; ph < N_PHASES; ph++) {
    int lo = ph, hi = ph + 1;
    void* args[] = {&p, &lo, &hi};
    hipError_t e = hipLaunchCooperativeKernel((void*)mega_kernel, dim3(grid_blocks), dim3(256), args, 0, stream);
    if (e != hipSuccess) fprintf(stderr, "launch failed: %s (grid %d)\n", hipGetErrorString(e), grid_blocks);
  }
#else
  (void)hipMemsetAsync((char*)d_ws + OFF_BAR, 0, 24576, stream);
  int lo = 0, hi = N_PHASES;
  void* args[] = {&p, &lo, &hi};
  hipError_t e = hipLaunchCooperativeKernel((void*)mega_kernel, dim3(grid_blocks), dim3(256), args, 0, stream);
  if (e != hipSuccess) fprintf(stderr, "cooperative launch failed: %s (grid %d)\n", hipGetErrorString(e), grid_blocks);
#endif
}
```
